# Optimizing an MI355X kernel written in HIP

```python
import math
import numpy as np
import jax
import jax.numpy as jnp
from jax import lax

D_MODEL = 1024
BATCH = 8
SEQ = 4096
DEPTH = 1

MLA_HEADS = 8
MLA_NOPE = 64
MLA_ROPE = 32
MLA_V = 64
MLA_Q_LORA = 384
MLA_KV_LORA = 256
ROPE_THETA = 10000.0
Q_BLOCK = 128

DIL_HEADS = 8
DIL_HEAD_DIM = 64
DIL_PATTERNS = ((128, 1), (512, 4), (2048, 16))

REL_BUCKETS = 32
REL_MAX_EXACT = 8
REL_MAX_DIST = 1024

N_EXPERTS = 16
EC_CAPACITY_FACTOR = 2
D_FF_EXPERT = 1536

MLA_WIDTH = MLA_HEADS * MLA_V
DIL_WIDTH = DIL_HEADS * DIL_HEAD_DIM
MIX_WIDTH = MLA_WIDTH + DIL_WIDTH
IN_WIDTH = MLA_Q_LORA + MLA_KV_LORA + MLA_ROPE + 3 * DIL_WIDTH
DEEPNORM_ALPHA = (2 * DEPTH) ** 0.25
DEEPNORM_BETA = (8 * DEPTH) ** -0.25
NORM_EPS = 1e-6
NEG_INF = -1e30

kernel_name = "hybrid_mla_dilated_ec_moe_deepnorm_adaln"


def layer_norm(x, g, b):
    xf = x.astype(jnp.float32)
    mu = jnp.mean(xf, axis=-1, keepdims=True)
    var = jnp.mean(jnp.square(xf - mu), axis=-1, keepdims=True)
    y = (xf - mu) * lax.rsqrt(var + NORM_EPS) * g.astype(jnp.float32) + b.astype(jnp.float32)
    return y.astype(x.dtype)


def rms_norm(x, g):
    xf = x.astype(jnp.float32)
    y = xf * lax.rsqrt(jnp.mean(jnp.square(xf), axis=-1, keepdims=True) + NORM_EPS)
    return (y * g.astype(jnp.float32)).astype(x.dtype)


def rope(t, pos):
    r = t.shape[-1]
    inv = ROPE_THETA ** (-jnp.arange(0, r, 2, dtype=jnp.float32) / r)
    ang = pos.astype(jnp.float32)[:, None] * inv[None, :]
    cos = jnp.cos(ang)[None, :, None, :]
    sin = jnp.sin(ang)[None, :, None, :]
    tf = t.astype(jnp.float32)
    t1, t2 = tf[..., : r // 2], tf[..., r // 2:]
    return jnp.concatenate([t1 * cos - t2 * sin, t1 * sin + t2 * cos], axis=-1).astype(t.dtype)


def t5_bucket(rel):
    half = REL_BUCKETS // 2
    ret = (rel > 0).astype(np.int32) * half
    n = np.abs(rel)
    large = REL_MAX_EXACT + (np.log(np.maximum(n, 1) / REL_MAX_EXACT)
                             / np.log(REL_MAX_DIST / REL_MAX_EXACT)
                             * (half - REL_MAX_EXACT)).astype(np.int32)
    large = np.minimum(large, half - 1)
    return ret + np.where(n < REL_MAX_EXACT, n, large).astype(np.int32)


def mla_mixer(c_q, c_kv, k_rope, q_norm_g, w_uq, kv_norm_g, w_ukv):
    b, s, _ = c_q.shape
    dq = MLA_NOPE + MLA_ROPE
    pos = jnp.arange(s)
    q = (rms_norm(c_q, q_norm_g) @ w_uq).reshape(b, s, MLA_HEADS, dq)
    q = jnp.concatenate([q[..., :MLA_NOPE], rope(q[..., MLA_NOPE:], pos)], axis=-1)
    kv = (rms_norm(c_kv, kv_norm_g) @ w_ukv).reshape(b, s, MLA_HEADS, MLA_NOPE + MLA_V)
    kr = jnp.broadcast_to(rope(k_rope[:, :, None, :], pos), (b, s, MLA_HEADS, MLA_ROPE))
    k = jnp.concatenate([kv[..., :MLA_NOPE], kr], axis=-1)
    v = kv[..., MLA_NOPE:]
    scale = dq ** -0.5
    nq = s // Q_BLOCK
    qb = jnp.moveaxis(q.reshape(b, nq, Q_BLOCK, MLA_HEADS, dq), 1, 0)

    def block(q_blk):
        sc = jnp.einsum('bqhd,bkhd->bhqk', q_blk, k).astype(jnp.float32) * scale
        p = jax.nn.softmax(sc, axis=-1).astype(v.dtype)
        return jnp.einsum('bhqk,bkhd->bqhd', p, v)

    o = lax.map(block, qb)
    return jnp.moveaxis(o, 0, 1).reshape(b, s, MLA_WIDTH)


def banded_attention(q, k, v, bias, half):
    b, g, l, h, dh = q.shape
    nb = -(-l // half)
    lp = nb * half
    qp = jnp.pad(q, ((0, 0), (0, 0), (0, lp - l), (0, 0), (0, 0))).reshape(b, g, nb, half, h, dh)
    pad_kv = ((0, 0), (0, 0), (half, lp - l + half), (0, 0), (0, 0))
    kp = jnp.pad(k, pad_kv)
    vp = jnp.pad(v, pad_kv)

    def band(t):
        return jnp.concatenate(
            [t[:, :, i * half: i * half + lp].reshape(b, g, nb, half, h, dh) for i in range(3)], axis=3)

    kb, vb = band(kp), band(vp)
    rel = np.arange(3 * half)[None, :] - half - np.arange(half)[:, None]
    key_pos = np.arange(nb)[:, None] * half + np.arange(3 * half)[None, :] - half
    mask = (np.abs(rel) <= half)[None] & ((key_pos >= 0) & (key_pos < l))[:, None, :]
    sc = jnp.einsum('bgnqhd,bgnkhd->bgnhqk', qp, kb).astype(jnp.float32) * (dh ** -0.5)
    sc = sc + jnp.transpose(bias, (2, 0, 1))[None, None, None]
    sc = jnp.where(mask[None, None, :, None], sc, NEG_INF)
    m = jnp.max(sc, axis=-1, keepdims=True)
    e = jnp.exp(sc - m)
    den = jnp.sum(e, axis=-1)
    o = jnp.einsum('bgnhqk,bgnkhd->bgnqhd', e, vb.astype(jnp.float32))
    o = o / jnp.swapaxes(den, -1, -2)[..., None]
    lse = jnp.swapaxes(m[..., 0] + jnp.log(den), -1, -2)
    o = o.reshape(b, g, lp, h, dh)[:, :, :l]
    lse = lse.reshape(b, g, lp, h)[:, :, :l]
    return o, lse


def dilated_mixer(q, k, v, rel_bias):
    b, s, h, dh = q.shape
    outs, lses = [], []
    for window, dil in DIL_PATTERNS:
        half = window // 2 // dil
        l = s // dil

        def perm(t):
            return t.reshape(b, l, dil, h, dh).transpose(0, 2, 1, 3, 4)

        rel = np.arange(3 * half)[None, :] - half - np.arange(half)[:, None]
        bias = rel_bias[jnp.asarray(t5_bucket(rel * dil))].astype(jnp.float32)
        o, lse = banded_attention(perm(q), perm(k), perm(v), bias, half)
        outs.append(o.transpose(0, 2, 1, 3, 4).reshape(b, s, h, dh))
        lses.append(lse.transpose(0, 2, 1, 3).reshape(b, s, h))
    w = jax.nn.softmax(jnp.stack(lses, axis=0), axis=0)
    o = jnp.sum(w[..., None] * jnp.stack(outs, axis=0), axis=0)
    return o.reshape(b, s, h * dh).astype(q.dtype)


def expert_choice_ffn(h, w_router, w_gate, w_up, w_down):
    b, s, d = h.shape
    cap = max(1, EC_CAPACITY_FACTOR * s // N_EXPERTS)
    aff = jax.nn.softmax((h @ w_router).astype(jnp.float32), axis=-1)
    vals, idx = lax.top_k(jnp.swapaxes(aff, 1, 2), cap)
    bidx = jnp.arange(b)[:, None, None]
    xin = h[bidx, idx]
    gt = jnp.einsum('becd,edf->becf', xin, w_gate)
    up = jnp.einsum('becd,edf->becf', xin, w_up)
    y = jnp.einsum('becf,efd->becd', jax.nn.silu(gt) * up, w_down)
    y = y * vals[..., None].astype(h.dtype)
    return jnp.zeros_like(h).at[bidx, idx].add(y)


def setup_inputs(seed: int = 0) -> dict:
    key = jax.random.key(seed)
    ks = jax.random.split(key, 20)
    f32 = jnp.float32
    L, D = DEPTH, D_MODEL

    def nrm(k, shape, scale):
        return jax.random.normal(k, shape, f32) * scale

    return {
        "x": nrm(ks[0], (BATCH, SEQ, D), 1.0),
        "c": nrm(ks[1], (BATCH, D), 1.0),
        "w_ada": nrm(ks[2], (L, D, 6 * D), 0.5 * D ** -0.5),
        "b_ada": nrm(ks[3], (L, 6 * D), 0.02),
        "w_in": nrm(ks[4], (L, D, IN_WIDTH), D ** -0.5),
        "q_norm_g": 1.0 + nrm(ks[5], (L, MLA_Q_LORA), 0.02),
        "w_uq": nrm(ks[6], (L, MLA_Q_LORA, MLA_HEADS * (MLA_NOPE + MLA_ROPE)), MLA_Q_LORA ** -0.5),
        "kv_norm_g": 1.0 + nrm(ks[7], (L, MLA_KV_LORA), 0.02),
        "w_ukv": nrm(ks[8], (L, MLA_KV_LORA, MLA_HEADS * (MLA_NOPE + MLA_V)), MLA_KV_LORA ** -0.5),
        "rel_bias": nrm(ks[9], (REL_BUCKETS, DIL_HEADS), 0.1),
        "w_out": nrm(ks[10], (L, MIX_WIDTH, D), MIX_WIDTH ** -0.5 * DEEPNORM_BETA),
        "ln1_g": 1.0 + nrm(ks[11], (L, D), 0.02),
        "ln1_b": nrm(ks[12], (L, D), 0.02),
        "w_router": nrm(ks[13], (L, D, N_EXPERTS), D ** -0.5),
        "w_gate": nrm(ks[14], (L, N_EXPERTS, D, D_FF_EXPERT), D ** -0.5),
        "w_up": nrm(ks[15], (L, N_EXPERTS, D, D_FF_EXPERT), D ** -0.5),
        "w_down": nrm(ks[16], (L, N_EXPERTS, D_FF_EXPERT, D), D_FF_EXPERT ** -0.5 * DEEPNORM_BETA),
        "ln2_g": 1.0 + nrm(ks[17], (L, D), 0.02),
        "ln2_b": nrm(ks[18], (L, D), 0.02),
    }


def reference(x, c, w_ada, b_ada, w_in, q_norm_g, w_uq, kv_norm_g, w_ukv, rel_bias,
              w_out, ln1_g, ln1_b, w_router, w_gate, w_up, w_down, ln2_g, ln2_b):
    b, s, _ = x.shape
    splits = np.cumsum([MLA_Q_LORA, MLA_KV_LORA, MLA_ROPE, DIL_WIDTH, DIL_WIDTH])
    cond = jax.nn.silu(c)
    for l in range(DEPTH):
        mod = cond @ w_ada[l] + b_ada[l]
        sh1, sc1, g1, sh2, sc2, g2 = [m[:, None, :] for m in jnp.split(mod, 6, axis=-1)]

        h = x * (1.0 + sc1) + sh1
        proj = h @ w_in[l]
        c_q, c_kv, k_rope, dq, dk, dv = jnp.split(proj, splits, axis=-1)
        mla_out = mla_mixer(c_q, c_kv, k_rope, q_norm_g[l], w_uq[l], kv_norm_g[l], w_ukv[l])
        hs = (b, s, DIL_HEADS, DIL_HEAD_DIM)
        dil_out = dilated_mixer(dq.reshape(hs), dk.reshape(hs), dv.reshape(hs), rel_bias)
        mix = jnp.concatenate([mla_out, dil_out], axis=-1) @ w_out[l]
        x = layer_norm(DEEPNORM_ALPHA * x + g1 * mix, ln1_g[l], ln1_b[l])

        h = x * (1.0 + sc2) + sh2
        moe = expert_choice_ffn(h, w_router[l], w_gate[l], w_up[l], w_down[l])
        x = layer_norm(DEEPNORM_ALPHA * x + g2 * moe, ln2_g[l], ln2_b[l])
    return x
```

```cpp
#include <hip/hip_runtime.h>
#include <cstdio>
#include <cstdint>

#ifndef MK_ONE_LAUNCH
#define MK_ONE_LAUNCH 1
#endif

#define LAS __attribute__((address_space(3)))
#define GAS __attribute__((address_space(1)))
typedef unsigned short bf16_t;
typedef short bf16x8 __attribute__((ext_vector_type(8)));
typedef short s16x4 __attribute__((ext_vector_type(4)));
typedef float f32x4 __attribute__((ext_vector_type(4)));
typedef float f32x2 __attribute__((ext_vector_type(2)));
typedef float f32x16 __attribute__((ext_vector_type(16)));
typedef unsigned u32x4 __attribute__((ext_vector_type(4)));
typedef unsigned u32x2 __attribute__((ext_vector_type(2)));
typedef int i32x4 __attribute__((ext_vector_type(4)));
typedef int i32x8 __attribute__((ext_vector_type(8)));

constexpr int D_MODEL = 1024, BATCH = 8, SEQ = 4096, M_TOK = BATCH * SEQ;
constexpr int MLA_H = 8, MLA_NOPE = 64, MLA_ROPE = 32, MLA_V = 64, Q_LORA = 384, KV_LORA = 256, MLA_DQ = 96;
constexpr int DIL_H = 8, DIL_D = 64;
constexpr int N_EXP = 16, CAP = 512, D_FF = 1536;
constexpr int IN_W = 2208, IN_WP = 2304;
constexpr float ALPHA = 1.189207115002721f;
constexpr float NORM_EPS = 1e-6f;
constexpr float LOG2E = 1.4426950408889634f;
constexpr float QS_MLA = 0.10206207261596575f * LOG2E;
constexpr float Q8_SCALE = QS_MLA * 2.f * 8.f, K8_SCALE = 0.5f;
constexpr float QS_DIL = 0.125f * LOG2E;
constexpr float NEG_BIG = -1e30f;
#ifndef DBG_MLA_F
#define DBG_MLA_F 1.f
#endif
#ifndef DBG_DIL_F
#define DBG_DIL_F 1.f
#endif
#ifndef DBG_XEXP
#define DBG_XEXP 0
#endif
#ifndef DBG_REP_P0
#define DBG_REP_P0 1
#endif
#ifndef DBG_REP_P7
#define DBG_REP_P7 1
#endif
#ifndef DBG_REP_MLA
#define DBG_REP_MLA 1
#endif
#ifndef DBG_REP_DIL
#define DBG_REP_DIL 1
#endif
#ifndef DBG_REP_P8
#define DBG_REP_P8 1
#endif
#ifndef DBG_REP_P2
#define DBG_REP_P2 1
#endif
#ifndef DBG_REP_P9
#define DBG_REP_P9 1
#endif
#ifndef DBG_REP_P5
#define DBG_REP_P5 1
#endif
#ifndef DBG_REP_THIN
#define DBG_REP_THIN 1
#endif
#ifndef DBG_REP_P3G
#define DBG_REP_P3G 1
#endif
#ifndef DBG_MIX_F
#define DBG_MIX_F 1.f
#endif
#ifndef DBG_MOE_F
#define DBG_MOE_F 1.f
#endif
constexpr float WGU_SCALE = 32.f, WD_SCALE = 64.f, HID_SCALE = 4.f, WIN_SCALE = 32.f, WOUT_SCALE = 32.f, MIX_SCALE = 16.f, Y_SCALE = 64.f;
constexpr int MROWS = N_EXP * BATCH * CAP;

constexpr size_t MiB = 1u << 20;
constexpr size_t WS_CTL = 0, CTL_ZERO_BYTES = 1 * MiB;
constexpr size_t WS_ROPE = 1 * MiB;
constexpr size_t WS_TABG = 1 * MiB + 512 * 1024;
constexpr size_t WS_MODP = 2 * MiB;
constexpr size_t WS_MOD = 5 * MiB;
constexpr size_t WS_AFF = 6 * MiB;
constexpr size_t WS_STAT = 8 * MiB;
constexpr size_t WS_VALS = 8 * MiB + 256 * 1024;
constexpr size_t WS_INV = 9 * MiB;
constexpr size_t WS_SSQ = 11 * MiB;
constexpr size_t WS_WIN = 16 * MiB;
constexpr size_t WS_WUQ = 21 * MiB;
constexpr size_t WS_WK = 22 * MiB;
constexpr size_t WS_WV = 22 * MiB + 512 * 1024;
constexpr size_t WS_WOUT = 23 * MiB;
constexpr size_t WS_LSE = 26 * MiB;
constexpr size_t WS_H = 32 * MiB;
constexpr size_t WS_O1 = 32 * MiB, WS_O2 = 64 * MiB;
constexpr size_t WS_WGU = 96 * MiB;
constexpr size_t WS_WD = 192 * MiB;
constexpr size_t WS_CQ = 96 * MiB;
constexpr size_t WS_CKV = 120 * MiB;
constexpr size_t WS_KR = 136 * MiB;
constexpr size_t WS_DQ = 138 * MiB, WS_DK = 170 * MiB, WS_DV = 202 * MiB;
constexpr size_t WS_Q = 240 * MiB;
constexpr size_t WS_KN = 288 * MiB;
constexpr size_t WS_V = 320 * MiB;
constexpr size_t WS_Z = 240 * MiB;
constexpr size_t WS_MIX = 368 * MiB;
constexpr size_t WS_HID = 240 * MiB;
constexpr size_t WS_VOFF = 336 * MiB;
constexpr size_t WS_XG = 336 * MiB;
constexpr size_t WS_Y = 32 * MiB;
constexpr size_t WS_END = 432 * MiB;
constexpr int CW_BAR = 4096;
constexpr int CW_QUEUE = 64;

constexpr int RING_BYTES = 147456;
constexpr int MISC_OFF = RING_BYTES;
constexpr int LDS_BYTES = RING_BYTES + 512;
constexpr int NWAVES = 8, NTHR = 512;

__device__ __forceinline__ unsigned f2bf(float f) { unsigned u = __builtin_bit_cast(unsigned, f); return (u + 0x7fffu + ((u >> 16) & 1u)) >> 16; }
__device__ __forceinline__ unsigned pk2(float lo, float hi) { return f2bf(lo) | (f2bf(hi) << 16); }
__device__ __forceinline__ unsigned cvt_pk_bf16(float lo, float hi) { unsigned r; asm volatile("v_cvt_pk_bf16_f32 %0, %1, %2" : "=v"(r) : "v"(lo), "v"(hi)); return r; }
__device__ __forceinline__ float bf_lo(unsigned w) { return __builtin_bit_cast(float, w << 16); }
__device__ __forceinline__ float bf_hi(unsigned w) { return __builtin_bit_cast(float, w & 0xffff0000u); }
__device__ __forceinline__ float wave_sum(float v) {
#pragma unroll
    for (int o = 1; o < 64; o <<= 1) v += __shfl_xor(v, o);
    return v;
}
#ifndef DBG_FP8_EMU
#define DBG_FP8_EMU 0
#endif
#ifndef DBG_HID_S
#define DBG_HID_S 4.f
#endif
__device__ __forceinline__ unsigned pk4_fp8(float a, float b, float c, float d) {
    a = __builtin_amdgcn_fmed3f(a, -448.f, 448.f); b = __builtin_amdgcn_fmed3f(b, -448.f, 448.f); c = __builtin_amdgcn_fmed3f(c, -448.f, 448.f); d = __builtin_amdgcn_fmed3f(d, -448.f, 448.f);
    int p = __builtin_amdgcn_cvt_pk_fp8_f32(a, b, 0, false); p = __builtin_amdgcn_cvt_pk_fp8_f32(c, d, p, true); return (unsigned)p;
}
__device__ __forceinline__ unsigned pk4_fp8_nc(float a, float b, float c, float d) { int p = __builtin_amdgcn_cvt_pk_fp8_f32(a, b, 0, false); p = __builtin_amdgcn_cvt_pk_fp8_f32(c, d, p, true); return (unsigned)p; }
__device__ __forceinline__ float q8(float x, float sc, float isc) {
#if DBG_FP8_EMU
    const int p = __builtin_amdgcn_cvt_pk_fp8_f32(x * sc, 0.f, 0, false); return __builtin_amdgcn_cvt_f32_fp8(p, 0) * isc;
#else
    return x;
#endif
}
#define LDS_WAIT() asm volatile("s_waitcnt lgkmcnt(0)" ::: "memory")
#define VM_WAIT() asm volatile("s_waitcnt vmcnt(0)" ::: "memory")

namespace pg8 {
constexpr int BM = 256, BK = 64, HALF = 128, HTB = HALF * BK * 2, STAGE_BYTES = 8 * HTB, NXCD = 8, WGM = 8;
__host__ __device__ __forceinline__ int lds_byte(int r, int c) { const int st = (r >> 4) * 2 + (c >> 5), rr = r & 15, cc = c & 31, ob = rr * 64 + cc * 2; return st * 1024 + (ob ^ (((ob >> 9) & 1) << 5)); }
__host__ __device__ __forceinline__ void stage_rc(int b, int& R, int& C) { const int st = b / 1024, sb = b % 1024, swz = sb ^ (((sb >> 9) & 1) << 5); R = (st >> 1) * 16 + swz / 64; C = (st & 1) * 32 + (swz % 64) / 2; }
__host__ __device__ __forceinline__ int perm32(int rho) { const int n = rho >> 4, i = rho & 15; return 8 * (i >> 2) + 4 * n + (i & 3); }

struct Unit { int pm, pn; };
struct Gemm { const bf16_t* A; const bf16_t* Bt; int M, N, K; int grp; const int* rowsrc; };

struct StaticOrder {
    int nM, nN, nwg, G, c;
    __device__ void init(int M, int N, int G_, int c_) { nM = M / BM; nN = N / BM; nwg = nM * nN; G = G_; c = c_; }
    __device__ bool next(int i, Unit& u) const {
        const long L = (long)i * G + c; if (L >= nwg) return false;
        int wgid = (int)L; { const int q = nwg / NXCD, r = nwg % NXCD, xcd = wgid % NXCD, off = wgid / NXCD; wgid = (xcd < r ? xcd * (q + 1) : r * (q + 1) + (xcd - r) * q) + off; }
        const int nig = WGM * nN, gid = wgid / nig, fm = gid * WGM, gsz = (nM - fm) < WGM ? (nM - fm) : WGM;
        u.pm = fm + ((wgid % nig) % gsz); u.pn = (wgid % nig) / gsz; return true;
    }
};

using ::i32x4; using ::i32x8;
template <class Epi, bool GATHER, bool FP8 = false>
__device__ __forceinline__ void gemm_phase(LAS unsigned char* lds, const Gemm g, const StaticOrder& S, const Epi& E) {
    const int tid = threadIdx.x, wid = __builtin_amdgcn_readfirstlane(tid >> 6), lane = tid & 63, wr = wid >> 2, wc = wid & 3, fr = lane & 15, fq = lane >> 4;
    const int K = g.K, KB = FP8 ? g.K : g.K * 2, nt = KB / 128, nN = g.N / BM;
    unsigned voffA[2], voffB[2];
#pragma unroll
    for (int i = 0; i < 2; ++i) { int R, C; stage_rc(tid * 16 + i * 8192, R, C); const int Rb = (R & ~31) + perm32(R & 31);
        voffA[i] = (unsigned)(R * KB + C * 2); voffB[i] = (unsigned)(Rb * KB + C * 2); }
    const size_t kstep = (size_t)(BK * 2);
    const size_t hstep = GATHER ? (size_t)0 : (size_t)HALF * KB;
    const size_t hstepB = (size_t)HALF * KB, tstep = 2 * hstepB;
    const unsigned ldsw = (unsigned)wid * 1024u;
    const int aoff = lds_byte(wr * 64 + fr, fq * 8), boff = lds_byte(wc * 32 + fr, fq * 8);
#define PG8_SA(b, h) (((b) * 2 + (h)) * HTB)
#define PG8_SB(b, h) ((4 + (b) * 2 + (h)) * HTB)
    const unsigned lds_base_u = (unsigned)__builtin_amdgcn_readfirstlane((int)(unsigned)(uintptr_t)lds + (int)ldsw);
#define PG8_STAGE(bufoff, gbase, voff) do { _Pragma("unroll") for (int _i = 0; _i < 2; ++_i) { \
        if constexpr (FP8) { unsigned keep_; asm volatile("s_mov_b32 %0, m0\n\ts_mov_b32 m0, %3\n\ts_nop 0\n\tglobal_load_lds_dwordx4 %1, %2\n\ts_mov_b32 m0, %0" \
              : "=&s"(keep_) : "v"((voff)[_i]), "s"((const char*)(gbase)), "s"(lds_base_u + (unsigned)((bufoff) + _i * 8192)) : "memory"); } \
        else __builtin_amdgcn_global_load_lds((const unsigned*)((const char*)(gbase) + (voff)[_i]), (LAS unsigned*)(lds + (bufoff) + ldsw + _i * 8192), 16, 0, 0); } } while (0)
#define PG8_LDA(dst, b, h) do { _Pragma("unroll") for (int m = 0; m < 4; ++m) _Pragma("unroll") for (int k = 0; k < 2; ++k) dst[m][k] = *(const LAS bf16x8*)(lds + PG8_SA(b, h) + aoff + m * 2048 + k * 1024); } while (0)
#define PG8_LDB(dst, b, h) do { _Pragma("unroll") for (int n = 0; n < 2; ++n) _Pragma("unroll") for (int k = 0; k < 2; ++k) dst[n][k] = *(const LAS bf16x8*)(lds + PG8_SB(b, h) + boff + n * 2048 + k * 1024); } while (0)
#define PG8_MMA(ai, bj, At, Bt) do { __builtin_amdgcn_s_setprio(1); _Pragma("unroll") for (int m = 0; m < 4; ++m) _Pragma("unroll") for (int n = 0; n < 2; ++n) { \
        if constexpr (FP8) { const i32x8 b8_ = __builtin_shufflevector(__builtin_bit_cast(i32x4, Bt[n][0]), __builtin_bit_cast(i32x4, Bt[n][1]), 0, 1, 2, 3, 4, 5, 6, 7); \
            const i32x8 a8_ = __builtin_shufflevector(__builtin_bit_cast(i32x4, At[m][0]), __builtin_bit_cast(i32x4, At[m][1]), 0, 1, 2, 3, 4, 5, 6, 7); \
            asm volatile("v_mfma_f32_16x16x128_f8f6f4 %0, %1, %2, %0" : "+v"(acc[ai][bj][m][n]) : "v"(b8_), "v"(a8_)); } \
        else { _Pragma("unroll") for (int k = 0; k < 2; ++k) acc[ai][bj][m][n] = __builtin_amdgcn_mfma_f32_16x16x32_bf16(Bt[n][k], At[m][k], acc[ai][bj][m][n], 0, 0, 0); } } \
        __builtin_amdgcn_s_setprio(0); } while (0)
#define PG8_WAIT_V(n) asm volatile("s_waitcnt vmcnt(" #n ")" ::: "memory")
#define PG8_WAIT_L(n) asm volatile("s_waitcnt lgkmcnt(" #n ")" ::: "memory")
#define PG8_BAR __builtin_amdgcn_s_barrier()
#define PG8_SCHED __builtin_amdgcn_sched_barrier(0)
#define PG8_ASRC(U) (GATHER ? (const char*)g.A + (size_t)(((U).pm >> 1) & 7) * ((size_t)SEQ * KB) : (const char*)g.A + (size_t)(U).pm * tstep)
#define PG8_GV(U) (*(const u32x4*)((const unsigned*)g.rowsrc + ((size_t)(U).pm * 512 + tid) * 4))
#define PG8_BSRC(U) ((const char*)g.Bt + (size_t)(((U).pm / g.grp) * nN + (U).pn) * tstep)
    Unit cur, nxt; int ui = 0;
    if (!S.next(0, cur)) return;
    u32x4 gvc = (u32x4){0u, 0u, 0u, 0u}, gvn = gvc, gvnn = gvc;
    if constexpr (GATHER) { gvc = PG8_GV(cur); Unit t1; gvn = S.next(1, t1) ? PG8_GV(t1) : gvc; }
#define PG8_STAGE_A(bufoff, base, H, NEXT) do { if constexpr (GATHER) { const bool nx_ = (NEXT); unsigned va_[2] = {nx_ ? gvn[2 * (H)] : gvc[2 * (H)], nx_ ? gvn[2 * (H) + 1] : gvc[2 * (H) + 1]}; PG8_STAGE(bufoff, base, va_); } \
        else PG8_STAGE(bufoff, (base) + (H) * hstep, voffA); } while (0)
    f32x4 acc[2][2][4][2];
#pragma unroll
    for (int a = 0; a < 2; ++a)
#pragma unroll
        for (int b = 0; b < 2; ++b)
#pragma unroll
            for (int m = 0; m < 4; ++m)
#pragma unroll
                for (int n = 0; n < 2; ++n) acc[a][b][m][n] = (f32x4){0.f, 0.f, 0.f, 0.f};
    bf16x8 At[4][2], B0[2][2], B1[2][2];
    const char* cA = PG8_ASRC(cur);
    const char* cB = PG8_BSRC(cur);
    PG8_STAGE(PG8_SB(0, 0), cB, voffB); PG8_STAGE(PG8_SB(0, 1), cB + hstepB, voffB); PG8_STAGE_A(PG8_SA(0, 0), cA, 0, false); PG8_STAGE_A(PG8_SA(0, 1), cA, 1, false);
    if (wr == 1) PG8_BAR;
    PG8_WAIT_V(2); PG8_BAR;
    PG8_STAGE(PG8_SB(1, 0), cB + kstep, voffB); PG8_STAGE_A(PG8_SA(1, 0), cA + kstep, 0, false); PG8_STAGE(PG8_SB(1, 1), cB + hstepB + kstep, voffB);
    PG8_WAIT_V(6); PG8_BAR;
    for (;;) {
        const bool has_next = S.next(ui + 1, nxt);
        const char* nA = cA; const char* nB = cB;
        if (has_next) { nA = PG8_ASRC(nxt); nB = PG8_BSRC(nxt); }
#pragma unroll 1
        for (int t = 0; t < nt; t += 2) {
            const bool last = (t == nt - 2);
            const char* a1 = cA + (size_t)(t + 1) * kstep;
            const char* a2 = last ? nA : cA + (size_t)(t + 2) * kstep; const char* b2 = last ? nB : cB + (size_t)(t + 2) * kstep;
            const char* a3 = a2 + kstep; const char* b3 = b2 + kstep;
            PG8_LDB(B0, 0, 0); PG8_LDB(B1, 0, 1); PG8_SCHED; PG8_LDA(At, 0, 0); PG8_STAGE_A(PG8_SA(1, 1), a1, 1, false);
            PG8_WAIT_V(8); PG8_WAIT_L(0); PG8_BAR; PG8_MMA(0, 0, At, B0); PG8_MMA(0, 1, At, B1); PG8_BAR; PG8_SCHED;
            PG8_LDA(At, 0, 1); PG8_STAGE(PG8_SB(0, 0), b2, voffB); PG8_STAGE(PG8_SB(0, 1), b2 + hstepB, voffB); PG8_STAGE_A(PG8_SA(0, 0), a2, 0, last);
            PG8_WAIT_V(8); PG8_WAIT_L(0); PG8_BAR; PG8_MMA(1, 0, At, B0); PG8_MMA(1, 1, At, B1); PG8_BAR; PG8_SCHED;
            PG8_LDB(B0, 1, 0); PG8_LDB(B1, 1, 1); PG8_SCHED; PG8_LDA(At, 1, 0); PG8_STAGE_A(PG8_SA(0, 1), a2, 1, last);
            PG8_WAIT_V(8); PG8_WAIT_L(0); PG8_BAR; PG8_MMA(0, 0, At, B0); PG8_MMA(0, 1, At, B1); PG8_BAR; PG8_SCHED;
            PG8_LDA(At, 1, 1); PG8_STAGE(PG8_SB(1, 0), b3, voffB); PG8_STAGE(PG8_SB(1, 1), b3 + hstepB, voffB); PG8_STAGE_A(PG8_SA(1, 0), a3, 0, last);
            PG8_WAIT_V(8); PG8_WAIT_L(0); PG8_BAR; PG8_MMA(1, 0, At, B0); PG8_MMA(1, 1, At, B1); PG8_BAR; PG8_SCHED;
        }
        if (wr == 0) PG8_BAR;
        if constexpr (FP8) asm volatile("s_nop 15\n\ts_nop 15\n\ts_nop 15\n\ts_nop 15" ::: "memory");
        if constexpr (GATHER) { Unit t2; gvnn = S.next(ui + 2, t2) ? PG8_GV(t2) : gvn; }
        E(acc, cur, wr, wc, fr, fq);
        if (!has_next) break;
        if constexpr (GATHER) { gvc = gvn; gvn = gvnn; }
#pragma unroll
        for (int a = 0; a < 2; ++a)
#pragma unroll
            for (int b = 0; b < 2; ++b)
#pragma unroll
                for (int m = 0; m < 4; ++m)
#pragma unroll
                    for (int n = 0; n < 2; ++n) acc[a][b][m][n] = (f32x4){0.f, 0.f, 0.f, 0.f};
        cur = nxt; cA = nA; cB = nB; ++ui;
        if (wr == 1) PG8_BAR;
    }
    PG8_WAIT_V(0);
    PG8_BAR;
#undef PG8_STAGE_A
#undef PG8_GV
#undef PG8_SA
#undef PG8_SB
#undef PG8_STAGE
#undef PG8_LDA
#undef PG8_LDB
#undef PG8_MMA
#undef PG8_WAIT_V
#undef PG8_WAIT_L
#undef PG8_BAR
#undef PG8_SCHED
#undef PG8_ASRC
#undef PG8_BSRC
}
}

#define XB_TMO      128
#define XB_XCNT(j)  (256  + 64 * (j))
#define XB_XSUB(j)  (1280 + 64 * (j))
#define XB_XGEN(j)  (2304 + 64 * (j))
#define XB_TOP      3328
#define XB_TOPGEN   3392
#define XCD_BAR_WORDS 3456
#define XB_SPIN_CAP (1u << 18)
__device__ __forceinline__ unsigned xb_ld(unsigned* p)              { return __hip_atomic_load(p, __ATOMIC_RELAXED, __HIP_MEMORY_SCOPE_AGENT); }
__device__ __forceinline__ unsigned xb_add(unsigned* p, unsigned v) { return __hip_atomic_fetch_add(p, v, __ATOMIC_RELAXED, __HIP_MEMORY_SCOPE_AGENT); }
__device__ __forceinline__ unsigned xb_xcc_id() { return (unsigned)__builtin_amdgcn_s_getreg((3 << 11) | 20) & 0xFu; }
#define XB_SPIN(cond, bar) do { unsigned _sp = 0; while (cond) { __builtin_amdgcn_s_sleep(1); \
    if ((++_sp & 255u) == 0u) { if (xb_ld(&(bar)[XB_TMO])) break; if (_sp > XB_SPIN_CAP) { atomicAdd(&(bar)[XB_TMO], 1u); break; } } } } while (0)
struct XcdBarrier { unsigned* bar; unsigned x; volatile LAS unsigned* st; };
__device__ __forceinline__ XcdBarrier xcd_barrier_post(unsigned* bar, volatile LAS unsigned* st) {
    XcdBarrier b; b.bar = bar; b.x = xb_xcc_id(); b.st = st;
    if (threadIdx.x == 0) (void)xb_add(&bar[XB_XCNT(b.x)], 1u);
    return b;
}
__device__ __forceinline__ void xcd_barrier_complete(unsigned* bar, unsigned x, unsigned& nloc, unsigned& nx) {
    const unsigned G = gridDim.x * gridDim.y * gridDim.z;
    unsigned sum, cnt, mine, sp = 0u;
    for (;;) {
        sum = 0u; cnt = 0u; mine = 0u;
#pragma unroll
        for (unsigned j = 0; j < 16; ++j) { const unsigned c = xb_ld(&bar[XB_XCNT(j)]); sum += c; cnt += (c > 0u) ? 1u : 0u; mine = (j == x) ? c : mine; }
        if (sum == G) break;
        __builtin_amdgcn_s_sleep(1);
        if ((++sp & 255u) == 0u) { if (xb_ld(&bar[XB_TMO])) break; if (sp > XB_SPIN_CAP) { atomicAdd(&bar[XB_TMO], 1u); break; } }
    }
    nloc = mine > 0u ? mine : 1u; nx = cnt > 0u ? cnt : 1u;
}
__device__ __forceinline__ void xcd_barrier(const XcdBarrier& b) {
    asm volatile("s_waitcnt vmcnt(0)" ::: "memory");
    __syncthreads();
    if (threadIdx.x == 0) {
        unsigned* bar = b.bar;
        __builtin_amdgcn_s_waitcnt(0);
        unsigned nloc = b.st[0], nx = b.st[1];
        if (nloc == 0u) { xcd_barrier_complete(bar, b.x, nloc, nx); b.st[0] = nloc; b.st[1] = nx; }
        const unsigned old = xb_add(&bar[XB_XSUB(b.x)], 1u);
        const unsigned gen = old / nloc;
        if (old + 1u == (gen + 1u) * nloc) {
            __builtin_amdgcn_fence(__ATOMIC_RELEASE, "agent");
            asm volatile("s_waitcnt vmcnt(0)" ::: "memory");
            const unsigned og = xb_add(&bar[XB_TOP], 1u);
            const unsigned tg = og / nx;
            if (og + 1u == (tg + 1u) * nx) xb_add(&bar[XB_TOPGEN], 1u);
            else XB_SPIN(xb_ld(&bar[XB_TOPGEN]) == tg, bar);
            __builtin_amdgcn_fence(__ATOMIC_ACQUIRE, "agent");
            xb_add(&bar[XB_XGEN(b.x)], 1u);
            asm volatile("s_waitcnt vmcnt(0)" ::: "memory");
        } else {
            XB_SPIN(xb_ld(&bar[XB_XGEN(b.x)]) == gen, bar);
            __builtin_amdgcn_fence(__ATOMIC_ACQUIRE, "agent");
            asm volatile("s_waitcnt vmcnt(0)" ::: "memory");
        }
    }
    __syncthreads();
}

struct Args {
    const float *x, *c, *w_ada, *b_ada, *w_in, *q_norm_g, *w_uq, *kv_norm_g, *w_ukv, *rel_bias, *w_out, *ln1_g, *ln1_b, *w_router, *w_gate, *w_up, *w_down, *ln2_g, *ln2_b;
    float* out; unsigned char* ws; int ph_lo, ph_hi;
};
struct Frame {
    LAS unsigned char* lds;
    int tid, lane, wave, vcu, G;
    unsigned char* ws;
};
#define WSP(T, off) ((T*)(F.ws + (off)))
typedef const __attribute__((address_space(4))) Args* KArgs;
__device__ __forceinline__ KArgs kargs() { KArgs p = (KArgs)__builtin_amdgcn_kernarg_segment_ptr(); asm volatile("" : "+s"(p)); return p; }

using pg8::Unit;
#define DPERM(s_) ((((s_) & 15) << 8) + ((s_) >> 4))
struct EpiProj {
    bf16_t *CQ, *CKV, *KR, *DQ; float* SSQ; const float* rope;
    __device__ __forceinline__ void operator()(const f32x4 (&acc)[2][2][4][2], const Unit& u, int wr, int wc, int fr, int fq) const {
        const int pn = u.pn;
        if (pn >= 3) {
            const int t = pn - 3; bf16_t* base = DQ + (size_t)(t >> 1) * ((WS_DK - WS_DQ) / 2); const float sc = (t < 2 ? QS_DIL : 1.f) * (1.f / WIN_SCALE);
            const int col0 = (t & 1) * 256 + wc * 32 + 8 * fq;
#pragma unroll
            for (int ai = 0; ai < 2; ++ai)
#pragma unroll
                for (int m = 0; m < 4; ++m) { const size_t row = (size_t)u.pm * 256 + ai * 128 + wr * 64 + m * 16 + fr;
#pragma unroll
                    for (int bj = 0; bj < 2; ++bj) { const f32x4 v0 = acc[ai][bj][m][0] * sc, v1 = acc[ai][bj][m][1] * sc;
                        u32x4 w; w.x = cvt_pk_bf16(v0[0], v0[1]); w.y = cvt_pk_bf16(v0[2], v0[3]); w.z = cvt_pk_bf16(v1[0], v1[1]); w.w = cvt_pk_bf16(v1[2], v1[3]);
                        const int col = col0 + bj * 128;
                        *(u32x4*)(base + ((size_t)((int)(row >> 12) * 8 + (col >> 6)) * SEQ + DPERM((int)row & (SEQ - 1))) * 64 + (col & 63)) = w; } }
        } else {
#pragma unroll
            for (int ai = 0; ai < 2; ++ai)
#pragma unroll
                for (int m = 0; m < 4; ++m) { const size_t row = (size_t)u.pm * 256 + ai * 128 + wr * 64 + m * 16 + fr;
#pragma unroll
                    for (int bj = 0; bj < 2; ++bj) { const f32x4 v0 = acc[ai][bj][m][0] * (1.f / WIN_SCALE), v1 = acc[ai][bj][m][1] * (1.f / WIN_SCALE);
                        const int seg = pn * 2 + bj;
                        if (seg < 5) {
                            float s = (v0[0] * v0[0] + v0[1] * v0[1]) + (v0[2] * v0[2] + v0[3] * v0[3]) + (v1[0] * v1[0] + v1[1] * v1[1]) + (v1[2] * v1[2] + v1[3] * v1[3]);
                            s += __shfl_xor(s, 16); s += __shfl_xor(s, 32);
                            if (fq == 0) SSQ[row * 32 + seg * 4 + wc] = s;
                            u32x4 w; w.x = cvt_pk_bf16(v0[0], v0[1]); w.y = cvt_pk_bf16(v0[2], v0[3]); w.z = cvt_pk_bf16(v1[0], v1[1]); w.w = cvt_pk_bf16(v1[2], v1[3]);
                            if (seg < 3) *(u32x4*)(CQ + row * 384 + seg * 128 + wc * 32 + 8 * fq) = w;
                            else *(u32x4*)(CKV + row * 256 + (seg - 3) * 128 + wc * 32 + 8 * fq) = w;
                        } else if (wc == 0) {
                            const int pos = (int)(row & (SEQ - 1)); const float* rp = rope + pos * 32 + 8 * (fq & 1);
                            const f32x4 c0 = *(const f32x4*)(rp), c1 = *(const f32x4*)(rp + 4), s0 = *(const f32x4*)(rp + 16), s1 = *(const f32x4*)(rp + 20);
                            f32x4 o0, o1;
#pragma unroll
                            for (int j = 0; j < 4; ++j) { const float a = v0[j], b = v1[j]; const float pa = __shfl_xor(a, 32), pb = __shfl_xor(b, 32);
                                o0[j] = fq < 2 ? a * c0[j] - pa * s0[j] : pa * s0[j] + a * c0[j];
                                o1[j] = fq < 2 ? b * c1[j] - pb * s1[j] : pb * s1[j] + b * c1[j]; }
                            u32x2 w; w.x = pk4_fp8(o0[0] * K8_SCALE, o0[1] * K8_SCALE, o0[2] * K8_SCALE, o0[3] * K8_SCALE); w.y = pk4_fp8(o1[0] * K8_SCALE, o1[1] * K8_SCALE, o1[2] * K8_SCALE, o1[3] * K8_SCALE);
                            unsigned char* k8 = (unsigned char*)KR + ((size_t)((row >> 12) * 8) * SEQ + (row & (SEQ - 1))) * 128 + 8 * fq;
#pragma unroll
                            for (int hh = 0; hh < 8; ++hh) { *(u32x2*)(k8 + (size_t)hh * SEQ * 128 + 64) = w; *(u32x2*)(k8 + (size_t)hh * SEQ * 128 + 96) = (u32x2){fq == 0 ? 0x00383838u : 0u, 0u}; }
                        } } }
        }
    }
};
struct EpiQ {
    bf16_t* Q; const float* SSQ; const float* rope;
    __device__ __forceinline__ void operator()(const f32x4 (&acc)[2][2][4][2], const Unit& u, int wr, int wc, int fr, int fq) const {
#pragma unroll
        for (int ai = 0; ai < 2; ++ai)
#pragma unroll
            for (int m = 0; m < 4; ++m) { const size_t row = (size_t)u.pm * 256 + ai * 128 + wr * 64 + m * 16 + fr;
                const f32x4 q0 = *(const f32x4*)(SSQ + row * 32), q1 = *(const f32x4*)(SSQ + row * 32 + 4), q2 = *(const f32x4*)(SSQ + row * 32 + 8);
                const float ss = ((q0[0] + q0[1]) + (q0[2] + q0[3])) + ((q1[0] + q1[1]) + (q1[2] + q1[3])) + ((q2[0] + q2[1]) + (q2[2] + q2[3]));
                const float rs = Q8_SCALE / sqrtf(ss * (1.f / Q_LORA) + NORM_EPS);
                const int pos = (int)(row & (SEQ - 1));
#pragma unroll
                for (int bj = 0; bj < 2; ++bj) { f32x4 v0 = acc[ai][bj][m][0] * rs, v1 = acc[ai][bj][m][1] * rs;
                    const int G32 = u.pn * 8 + bj * 4 + wc;
                    if (G32 % 3 == 2) {
                        const float* rp = rope + pos * 32 + 8 * (fq & 1);
                        const f32x4 c0 = *(const f32x4*)(rp), c1 = *(const f32x4*)(rp + 4), s0 = *(const f32x4*)(rp + 16), s1 = *(const f32x4*)(rp + 20);
                        f32x4 o0, o1;
#pragma unroll
                        for (int j = 0; j < 4; ++j) { const float a = v0[j], b = v1[j]; const float pa = __shfl_xor(a, 32), pb = __shfl_xor(b, 32);
                            o0[j] = fq < 2 ? a * c0[j] - pa * s0[j] : pa * s0[j] + a * c0[j];
                            o1[j] = fq < 2 ? b * c1[j] - pb * s1[j] : pb * s1[j] + b * c1[j]; }
                        v0 = o0; v1 = o1;
                    }
                    u32x2 w; w.x = pk4_fp8(v0[0], v0[1], v0[2], v0[3]); w.y = pk4_fp8(v1[0], v1[1], v1[2], v1[3]);
                    unsigned char* q8 = (unsigned char*)Q + ((size_t)((row >> 12) * 8 + G32 / 3) * SEQ + pos) * 128 + (G32 % 3) * 32 + 8 * fq;
                    *(u32x2*)q8 = w; if (G32 % 3 == 2) *(u32x2*)(q8 + 32) = (u32x2){0u, 0u}; }
                asm volatile("" ::: "memory"); }
    }
};
struct EpiKV {
    bf16_t* O; const float* SSQ;
    __device__ __forceinline__ void operator()(const f32x4 (&acc)[2][2][4][2], const Unit& u, int wr, int wc, int fr, int fq) const {
#pragma unroll
        for (int ai = 0; ai < 2; ++ai)
#pragma unroll
            for (int m = 0; m < 4; ++m) { const size_t row = (size_t)u.pm * 256 + ai * 128 + wr * 64 + m * 16 + fr;
                const f32x4 q0 = *(const f32x4*)(SSQ + row * 32 + 12), q1 = *(const f32x4*)(SSQ + row * 32 + 16);
                const float ss = ((q0[0] + q0[1]) + (q0[2] + q0[3])) + ((q1[0] + q1[1]) + (q1[2] + q1[3]));
                const float rs = 1.f / sqrtf(ss * (1.f / KV_LORA) + NORM_EPS);
#pragma unroll
                for (int bj = 0; bj < 2; ++bj) { const f32x4 v0 = acc[ai][bj][m][0] * rs, v1 = acc[ai][bj][m][1] * rs;
                    u32x4 w; w.x = cvt_pk_bf16(v0[0], v0[1]); w.y = cvt_pk_bf16(v0[2], v0[3]); w.z = cvt_pk_bf16(v1[0], v1[1]); w.w = cvt_pk_bf16(v1[2], v1[3]);
                    *(u32x4*)(O + row * 512 + u.pn * 256 + bj * 128 + wc * 32 + 8 * fq) = w; }
                asm volatile("" ::: "memory"); }
    }
};
struct EpiKN8 {
    unsigned char* K8; const float* SSQ;
    __device__ __forceinline__ void operator()(const f32x4 (&acc)[2][2][4][2], const Unit& u, int wr, int wc, int fr, int fq) const {
#pragma unroll
        for (int ai = 0; ai < 2; ++ai)
#pragma unroll
            for (int m = 0; m < 4; ++m) { const size_t row = (size_t)u.pm * 256 + ai * 128 + wr * 64 + m * 16 + fr;
                const f32x4 q0 = *(const f32x4*)(SSQ + row * 32 + 12), q1 = *(const f32x4*)(SSQ + row * 32 + 16);
                const float ss = ((q0[0] + q0[1]) + (q0[2] + q0[3])) + ((q1[0] + q1[1]) + (q1[2] + q1[3]));
                const float rs = K8_SCALE / sqrtf(ss * (1.f / KV_LORA) + NORM_EPS);
#pragma unroll
                for (int bj = 0; bj < 2; ++bj) { const f32x4 v0 = acc[ai][bj][m][0] * rs, v1 = acc[ai][bj][m][1] * rs;
                    const int col = u.pn * 256 + bj * 128 + wc * 32 + 8 * fq;
                    u32x2 w; w.x = pk4_fp8(v0[0], v0[1], v0[2], v0[3]); w.y = pk4_fp8(v1[0], v1[1], v1[2], v1[3]);
                    *(u32x2*)(K8 + ((size_t)((row >> 12) * 8 + (col >> 6)) * SEQ + (row & (SEQ - 1))) * 128 + (col & 63)) = w; }
                asm volatile("" ::: "memory"); }
    }
};
struct EpiVt8 {
    unsigned char* Vt; const float* SSQ;
    __device__ __forceinline__ void operator()(const f32x4 (&acc)[2][2][4][2], const Unit& u, int wr, int wc, int fr, int fq) const {
        float rs[2][8];
#pragma unroll
        for (int bj = 0; bj < 2; ++bj)
#pragma unroll
            for (int j = 0; j < 8; ++j) { const size_t tok = (size_t)u.pn * 256 + bj * 128 + wc * 32 + 8 * fq + j;
                const f32x4 q0 = *(const f32x4*)(SSQ + tok * 32 + 12), q1 = *(const f32x4*)(SSQ + tok * 32 + 16);
                rs[bj][j] = 1.f / sqrtf((((q0[0] + q0[1]) + (q0[2] + q0[3])) + ((q1[0] + q1[1]) + (q1[2] + q1[3]))) * (1.f / KV_LORA) + NORM_EPS); }
#pragma unroll
        for (int ai = 0; ai < 2; ++ai)
#pragma unroll
            for (int m = 0; m < 4; ++m) { const int ch = u.pm * 256 + ai * 128 + wr * 64 + m * 16 + fr;
#pragma unroll
                for (int bj = 0; bj < 2; ++bj) { const f32x4 v0 = acc[ai][bj][m][0], v1 = acc[ai][bj][m][1];
                    const int tok = u.pn * 256 + bj * 128 + wc * 32 + 8 * fq;
                    u32x2 w; w.x = pk4_fp8(v0[0] * rs[bj][0], v0[1] * rs[bj][1], v0[2] * rs[bj][2], v0[3] * rs[bj][3]); w.y = pk4_fp8(v1[0] * rs[bj][4], v1[1] * rs[bj][5], v1[2] * rs[bj][6], v1[3] * rs[bj][7]);
                    *(u32x2*)(Vt + ((size_t)((tok >> 12) * 512 + ch)) * SEQ + (tok & (SEQ - 1))) = w; } }
    }
};
struct EpiOut {
    float* out; const float* mod;
    __device__ __forceinline__ void operator()(const f32x4 (&acc)[2][2][4][2], const Unit& u, int wr, int wc, int fr, int fq) const {
#pragma unroll
        for (int ai = 0; ai < 2; ++ai)
#pragma unroll
            for (int m = 0; m < 4; ++m) { const size_t row = (size_t)u.pm * 256 + ai * 128 + wr * 64 + m * 16 + fr; const int b = (int)(row >> 12);
#pragma unroll
                for (int bj = 0; bj < 2; ++bj) { const int col = u.pn * 256 + bj * 128 + wc * 32 + 8 * fq;
                    const float* gp = mod + b * 6144 + 2048 + col;
                    const f32x4 g0 = *(const f32x4*)gp, g1 = *(const f32x4*)(gp + 4);
                    const f32x4 m0 = g0 * acc[ai][bj][m][0] * (DBG_MIX_F / (WOUT_SCALE * MIX_SCALE)), m1 = g1 * acc[ai][bj][m][1] * (DBG_MIX_F / (WOUT_SCALE * MIX_SCALE));
                    u32x4 w; w.x = cvt_pk_bf16(m0[0], m0[1]); w.y = cvt_pk_bf16(m0[2], m0[3]); w.z = cvt_pk_bf16(m1[0], m1[1]); w.w = cvt_pk_bf16(m1[2], m1[3]);
                    *(u32x4*)((bf16_t*)(out + row * 1024) + col) = w; } }
    }
};
struct EpiGU {
    bf16_t* H;
    __device__ __forceinline__ void operator()(const f32x4 (&acc)[2][2][4][2], const Unit& u, int wr, int wc, int fr, int fq) const {
#pragma unroll
        for (int ai = 0; ai < 2; ++ai)
#pragma unroll
            for (int m = 0; m < 4; ++m) { const unsigned row = (unsigned)(u.pm * 256 + ai * 128 + wr * 64 + m * 16 + fr);
                float o[8];
#pragma unroll
                for (int n = 0; n < 2; ++n)
#pragma unroll
                    for (int j = 0; j < 4; ++j) { const float ag = acc[ai][0][m][n][j], au = acc[ai][1][m][n][j];
                        constexpr float kk = WGU_SCALE * WGU_SCALE / HID_SCALE;
                        const float e = __builtin_amdgcn_exp2f(ag * (-LOG2E / WGU_SCALE));
                        o[n * 4 + j] = (ag * au) * __builtin_amdgcn_rcpf(__builtin_fmaf(e, kk, kk)); }
                u32x2 w; w.x = pk4_fp8(o[0], o[1], o[2], o[3]); w.y = pk4_fp8(o[4], o[5], o[6], o[7]);
                *(u32x2*)((unsigned char*)H + (row * 1536u + (unsigned)(u.pn * 128 + wc * 32 + 8 * fq))) = w; }
    }
};
struct EpiDown {
    bf16_t* Y; const float* vals;
    __device__ __forceinline__ void operator()(const f32x4 (&acc)[2][2][4][2], const Unit& u, int wr, int wc, int fr, int fq) const {
#pragma unroll
        for (int ai = 0; ai < 2; ++ai)
#pragma unroll
            for (int m = 0; m < 4; ++m) { const unsigned row = (unsigned)(u.pm * 256 + ai * 128 + wr * 64 + m * 16 + fr); const float vv = vals[row] * (Y_SCALE / (WD_SCALE * HID_SCALE));
#pragma unroll
                for (int bj = 0; bj < 2; ++bj) { const f32x4 v0 = acc[ai][bj][m][0] * vv, v1 = acc[ai][bj][m][1] * vv;
                    u32x2 w; w.x = pk4_fp8(v0[0], v0[1], v0[2], v0[3]); w.y = pk4_fp8(v1[0], v1[1], v1[2], v1[3]);
                    *(u32x2*)((unsigned char*)Y + (row * 1024u + (unsigned)(u.pn * 256 + bj * 128 + wc * 32 + 8 * fq))) = w; } }
    }
};

__device__ __forceinline__ s16x4 vtr(const LAS char* p) { return __builtin_bit_cast(s16x4, __builtin_amdgcn_ds_read_tr16_b64_v4i16((LAS s16x4*)p)); }
template <int ND0, int KPITCH, bool BIAS>
__device__ __forceinline__ void attn_tile(const LAS char* Kt, const LAS char* Vt, const bf16x8 (&qr)[ND0], float& m_run, float& l_run, f32x16& o0, f32x16& o1,
                                          const LAS float* tab, int lane) {
    const int r32 = lane & 31, hi = lane >> 5;
    f32x16 p0, p1;
#pragma unroll
    for (int r = 0; r < 16; ++r) { p0[r] = 0.f; p1[r] = 0.f; }
    const LAS char* kp = Kt + r32 * KPITCH + hi * 16;
    bf16x8 kf[2 * ND0];
#pragma unroll
    for (int d0 = 0; d0 < ND0; ++d0) { kf[2 * d0] = *(const LAS bf16x8*)(kp + d0 * 32); kf[2 * d0 + 1] = *(const LAS bf16x8*)(kp + 32 * KPITCH + d0 * 32); }
#pragma unroll
    for (int d0 = 0; d0 < ND0; ++d0) {
        p0 = __builtin_amdgcn_mfma_f32_32x32x16_bf16(kf[2 * d0], qr[d0], p0, 0, 0, 0);
        p1 = __builtin_amdgcn_mfma_f32_32x32x16_bf16(kf[2 * d0 + 1], qr[d0], p1, 0, 0, 0);
    }
    const LAS char* vp = Vt + (4 * hi + ((lane & 15) >> 2)) * 64 + ((lane >> 4) & 1) * 32 + (lane & 3) * 8;
    bf16x8 vf[8];
#pragma unroll
    for (int ks = 0; ks < 4; ++ks) {
        const s16x4 l0 = vtr(vp + ks * 1024), h0 = vtr(vp + ks * 1024 + 512), l1 = vtr(vp + 4096 + ks * 1024), h1 = vtr(vp + 4096 + ks * 1024 + 512);
        vf[2 * ks] = (bf16x8){l0[0], l0[1], l0[2], l0[3], h0[0], h0[1], h0[2], h0[3]}; vf[2 * ks + 1] = (bf16x8){l1[0], l1[1], l1[2], l1[3], h1[0], h1[1], h1[2], h1[3]};
    }
    __builtin_amdgcn_sched_barrier(0);
    if constexpr (BIAS) {
#pragma unroll
        for (int r = 0; r < 16; ++r) { const int kvl = (r & 3) + 8 * (r >> 2) + 4 * hi; p0[r] += tab[kvl]; p1[r] += tab[kvl + 32]; }
    }
    float mx = fmaxf(p0[0], p1[0]);
#pragma unroll
    for (int r = 1; r < 16; ++r) mx = fmaxf(mx, fmaxf(p0[r], p1[r]));
    mx = fmaxf(mx, __shfl_xor(mx, 32));
    const float m_new = fmaxf(m_run, mx);
    const float alpha = __builtin_amdgcn_exp2f(m_run - m_new);
    m_run = m_new;
    float rs = 0.f;
#pragma unroll
    for (int r = 0; r < 16; ++r) { p0[r] = __builtin_amdgcn_exp2f(p0[r] - m_new); p1[r] = __builtin_amdgcn_exp2f(p1[r] - m_new); rs += p0[r] + p1[r]; }
    l_run = l_run * alpha + rs;
#pragma unroll
    for (int r = 0; r < 16; ++r) { o0[r] *= alpha; o1[r] *= alpha; }
    bf16x8 pf[4];
#pragma unroll
    for (int ks = 0; ks < 4; ++ks) { u32x4 w;
        if (ks < 2) { w.x = cvt_pk_bf16(p0[8 * ks + 0], p0[8 * ks + 1]); w.y = cvt_pk_bf16(p0[8 * ks + 2], p0[8 * ks + 3]); w.z = cvt_pk_bf16(p0[8 * ks + 4], p0[8 * ks + 5]); w.w = cvt_pk_bf16(p0[8 * ks + 6], p0[8 * ks + 7]); }
        else { const int k2 = ks - 2; w.x = cvt_pk_bf16(p1[8 * k2 + 0], p1[8 * k2 + 1]); w.y = cvt_pk_bf16(p1[8 * k2 + 2], p1[8 * k2 + 3]); w.z = cvt_pk_bf16(p1[8 * k2 + 4], p1[8 * k2 + 5]); w.w = cvt_pk_bf16(p1[8 * k2 + 6], p1[8 * k2 + 7]); }
        pf[ks] = __builtin_bit_cast(bf16x8, w); }
#pragma unroll
    for (int ks = 0; ks < 4; ++ks) {
        o0 = __builtin_amdgcn_mfma_f32_32x32x16_bf16(vf[2 * ks], pf[ks], o0, 0, 0, 0);
        o1 = __builtin_amdgcn_mfma_f32_32x32x16_bf16(vf[2 * ks + 1], pf[ks], o1, 0, 0, 0);
    }
}

constexpr int MLA_KP = 144, MLA_KB = 64 * MLA_KP, MLA_VP = 80, MLA_BUF = MLA_KB + 64 * MLA_VP;
constexpr float MLA_POFS = 0.f;
__device__ __forceinline__ float max3f(float a, float b, float c) { float r; asm("v_max3_f32 %0, %1, %2, %3" : "=v"(r) : "v"(a), "v"(b), "v"(c)); return r; }
__device__ __forceinline__ float xhalf_max(float m) { auto rr = __builtin_amdgcn_permlane32_swap(__float_as_uint(m), __float_as_uint(m), false, false); float a = __uint_as_float(rr[0]), b = __uint_as_float(rr[1]); float r; asm("v_max_f32_e32 %0, %1, %2" : "=v"(r) : "v"(a), "v"(b)); return r; }
__device__ __forceinline__ float fmin126(float a) { float r; asm("v_min_f32_e32 %0, 0x42fc0000, %1" : "=v"(r) : "v"(a)); return r; }
__device__ __forceinline__ float xhalf_sum(float m) { auto rr = __builtin_amdgcn_permlane32_swap(__float_as_uint(m), __float_as_uint(m), false, false); return __uint_as_float(rr[0]) + __uint_as_float(rr[1]); }
__device__ __forceinline__ float rowmax32(const f32x16& p0, const f32x16& p1) {
    float a = max3f(p0[0], p0[1], p1[0]), b = max3f(p0[2], p0[3], p1[1]); a = max3f(a, p1[2], p1[3]);
#pragma unroll
    for (int r = 4; r < 16; r += 4) { a = max3f(a, p0[r], p0[r + 1]); b = max3f(b, p0[r + 2], p0[r + 3]); a = max3f(a, p1[r], p1[r + 1]); b = max3f(b, p1[r + 2], p1[r + 3]); }
    float m; asm("v_max_f32_e32 %0, %1, %2" : "=v"(m) : "v"(a), "v"(b));
    return xhalf_max(m);
}
template <int ND0, int KPITCH>
__device__ __forceinline__ void qk_tile(f32x16& p0, f32x16& p1, const LAS char* Kt, const bf16x8 (&qr)[ND0], const f32x16& cinit, int lane) {
    const LAS char* kp = Kt + (lane & 31) * KPITCH + (lane >> 5) * 16;
#pragma unroll
    for (int d0 = 0; d0 < ND0; ++d0) {
        const bf16x8 a0 = *(const LAS bf16x8*)(kp + d0 * 32), a1 = *(const LAS bf16x8*)(kp + 32 * KPITCH + d0 * 32);
        if (d0 == 0) { p0 = __builtin_amdgcn_mfma_f32_32x32x16_bf16(a0, qr[0], cinit, 0, 0, 0); p1 = __builtin_amdgcn_mfma_f32_32x32x16_bf16(a1, qr[0], cinit, 0, 0, 0); }
        else { p0 = __builtin_amdgcn_mfma_f32_32x32x16_bf16(a0, qr[d0], p0, 0, 0, 0); p1 = __builtin_amdgcn_mfma_f32_32x32x16_bf16(a1, qr[d0], p1, 0, 0, 0); }
    }
}
__device__ __forceinline__ void pv_tile(f32x16& o0, f32x16& o1, const f32x16& p0, const f32x16& p1, const LAS char* Vt, int lane) {
    const int hi = lane >> 5;
    bf16x8 pf[4];
#pragma unroll
    for (int ks = 0; ks < 4; ++ks) { u32x4 w;
        if (ks < 2) { w.x = cvt_pk_bf16(p0[8 * ks + 0], p0[8 * ks + 1]); w.y = cvt_pk_bf16(p0[8 * ks + 2], p0[8 * ks + 3]); w.z = cvt_pk_bf16(p0[8 * ks + 4], p0[8 * ks + 5]); w.w = cvt_pk_bf16(p0[8 * ks + 6], p0[8 * ks + 7]); }
        else { const int k2 = ks - 2; w.x = cvt_pk_bf16(p1[8 * k2 + 0], p1[8 * k2 + 1]); w.y = cvt_pk_bf16(p1[8 * k2 + 2], p1[8 * k2 + 3]); w.z = cvt_pk_bf16(p1[8 * k2 + 4], p1[8 * k2 + 5]); w.w = cvt_pk_bf16(p1[8 * k2 + 6], p1[8 * k2 + 7]); }
        pf[ks] = __builtin_bit_cast(bf16x8, w); }
    const LAS char* vp = Vt + (4 * hi + ((lane & 15) >> 2)) * 64 + ((lane >> 4) & 1) * 32 + (lane & 3) * 8;
#pragma unroll
    for (int ks = 0; ks < 4; ++ks) {
        const s16x4 l0 = vtr(vp + ks * 1024), h0 = vtr(vp + ks * 1024 + 512), l1 = vtr(vp + 4096 + ks * 1024), h1 = vtr(vp + 4096 + ks * 1024 + 512);
        const bf16x8 v0 = (bf16x8){l0[0], l0[1], l0[2], l0[3], h0[0], h0[1], h0[2], h0[3]}, v1 = (bf16x8){l1[0], l1[1], l1[2], l1[3], h1[0], h1[1], h1[2], h1[3]};
        o0 = __builtin_amdgcn_mfma_f32_32x32x16_bf16(v0, pf[ks], o0, 0, 0, 0);
        o1 = __builtin_amdgcn_mfma_f32_32x32x16_bf16(v1, pf[ks], o1, 0, 0, 0);
    }
}
#define SGB(mask, n) __builtin_amdgcn_sched_group_barrier(mask, n, 0)
__device__ __forceinline__ unsigned enc3_fp8(float v) {
    const int w1 = __builtin_amdgcn_cvt_pk_fp8_f32(__builtin_amdgcn_fmed3f(v, -448.f, 448.f), 0.f, 0, false); const float r1 = v - __builtin_amdgcn_cvt_f32_fp8(w1, 0);
    const int w2 = __builtin_amdgcn_cvt_pk_fp8_f32(__builtin_amdgcn_fmed3f(r1, -448.f, 448.f), 0.f, 0, false); const float r2 = r1 - __builtin_amdgcn_cvt_f32_fp8(w2, 0);
    const int w3 = __builtin_amdgcn_cvt_pk_fp8_f32(__builtin_amdgcn_fmed3f(r2, -448.f, 448.f), 0.f, 0, false);
    return ((unsigned)w1 & 0xffu) | (((unsigned)w2 & 0xffu) << 8) | (((unsigned)w3 & 0xffu) << 16);
}
__device__ __forceinline__ void mla_unit(Frame& F, int b, int h, int qb) {
    int tid = F.tid; asm volatile("" : "+v"(tid));
    const int lane = tid & 63, wid = F.wave, r32 = lane & 31, hi = lane >> 5;
    const unsigned char* Q8 = WSP(const unsigned char, WS_Q); const unsigned char* K8 = WSP(const unsigned char, WS_KN); const unsigned char* Vt8 = WSP(const unsigned char, WS_V);
    bf16_t* MIX = WSP(bf16_t, WS_MIX);
    const size_t tok0 = (size_t)b * SEQ;
    const int q0 = qb * 512 + wid * 64 + r32;
    i32x8 qA[2], qB[2];
    { const unsigned char* qp = Q8 + ((size_t)(b * 8 + h) * SEQ + q0) * 128 + 32 * hi;
#pragma unroll
      for (int ks = 0; ks < 2; ++ks) { const i32x4 lo = *(const i32x4*)(qp + 64 * ks), hh = *(const i32x4*)(qp + 64 * ks + 16); qA[ks] = __builtin_shufflevector(lo, hh, 0, 1, 2, 3, 4, 5, 6, 7);
          const i32x4 lo2 = *(const i32x4*)(qp + 32 * 128 + 64 * ks), hh2 = *(const i32x4*)(qp + 32 * 128 + 64 * ks + 16); qB[ks] = __builtin_shufflevector(lo2, hh2, 0, 1, 2, 3, 4, 5, 6, 7); } }
    const int kv_s = tid >> 3, c_s = tid & 7;
    const unsigned char* k_base = K8 + (size_t)(b * 8 + h) * SEQ * 128; const unsigned k_off = (unsigned)(kv_s * 128 + c_s * 16);
    const unsigned char* v_base = Vt8 + (size_t)(b * 8 + h) * 64 * SEQ; const unsigned v_off = (unsigned)(((tid >> 2) & 63) * SEQ + (tid & 3) * 16);
    const int k_dst = (((kv_s & 31) << 1) | (kv_s >> 5)) * MLA_KP + c_s * 16, v_dst = MLA_KB + ((tid >> 2) & 63) * MLA_VP + (tid & 3) * 16;
    LAS char* lds = (LAS char*)F.lds;
    f32x16 oA0, oA1, oB0, oB1;
#pragma unroll
    for (int r = 0; r < 16; ++r) { oA0[r] = 0.f; oA1[r] = 0.f; oB0[r] = 0.f; oB1[r] = 0.f; }
    float lA = 0.f, lB = 0.f;
    const f32x16 zero16 = (f32x16){0.f, 0.f, 0.f, 0.f, 0.f, 0.f, 0.f, 0.f, 0.f, 0.f, 0.f, 0.f, 0.f, 0.f, 0.f, 0.f};
    const int selw = ((((lane & 15) >> 2) & 1) == ((lane >> 4) & 1)) ? 0x38383838 : 0;
    const i32x8 sel8 = (i32x8){selw, selw, selw, selw, selw, selw, selw, selw};
    const f32x4 zero4 = (f32x4){0.f, 0.f, 0.f, 0.f};
#define MLA_SUM8(b) __builtin_amdgcn_mfma_scale_f32_16x16x128_f8f6f4(sel8, b, zero4, 0, 0, 0, 0, 0, 0)
    u32x4 rk0, rv0, rk1, rv1;
#define MLA_LOADG(t, rk, rv) do { const unsigned o_ = (unsigned)((t) < 64 ? (t) : 63) * 64u; rk = *(const u32x4*)(k_base + (k_off + o_ * 128u)); rv = *(const u32x4*)(v_base + (v_off + o_)); } while (0)
#define MLA_STORE_OFF(off, rk, rv) do { LAS char* d_ = lds + (off); *(LAS u32x4*)(d_ + k_dst) = rk; *(LAS u32x4*)(d_ + v_dst) = rv; } while (0)
#define MLA_KFRAG(dst, base, a, ks) do { const LAS char* p_ = (base) + (a) * 32 * MLA_KP + (ks) * 64; \
        const i32x4 lo_ = *(const LAS i32x4*)p_, hi_ = *(const LAS i32x4*)(p_ + 16); dst = __builtin_shufflevector(lo_, hi_, 0, 1, 2, 3, 4, 5, 6, 7); } while (0)
#define MLA_MFMA8(a, b, c) __builtin_amdgcn_mfma_scale_f32_32x32x64_f8f6f4(a, b, c, 0, 0, 0, 0, 0, 0)
    static_assert(6 * MLA_BUF <= RING_BYTES, "MLA ring");
    const int sig = 32 * ((r32 >> 2) & 1) + (r32 & 3) + 4 * (r32 >> 3);
    const LAS char* kp0 = lds + (2 * (sig & 31) + (sig >> 5)) * MLA_KP + hi * 32;
    const LAS char* vp0 = lds + MLA_KB + r32 * MLA_VP + 32 * hi;
    MLA_LOADG(0, rk0, rv0); MLA_LOADG(1, rk1, rv1); MLA_STORE_OFF(0, rk0, rv0); MLA_STORE_OFF(MLA_BUF, rk1, rv1);
    MLA_LOADG(2, rk0, rv0); MLA_LOADG(3, rk1, rv1); MLA_STORE_OFF(2 * MLA_BUF, rk0, rv0); MLA_STORE_OFF(3 * MLA_BUF, rk1, rv1);
    __syncthreads();
    MLA_LOADG(4, rk0, rv0); MLA_LOADG(5, rk1, rv1);
    i32x8 kf[4];
#define MLA_KFRAGS(slot) do { const LAS char* kp_ = kp0 + (slot); MLA_KFRAG(kf[0], kp_, 0, 0); MLA_KFRAG(kf[1], kp_, 0, 1); MLA_KFRAG(kf[2], kp_, 1, 0); MLA_KFRAG(kf[3], kp_, 1, 1); } while (0)
#define MLA_VFRAGS(slot) do { const LAS char* vp_ = vp0 + (slot); \
        _Pragma("unroll") for (int dh = 0; dh < 2; ++dh) { const i32x4 lo_ = *(const LAS i32x4*)(vp_ + dh * 32 * MLA_VP), hi_ = *(const LAS i32x4*)(vp_ + dh * 32 * MLA_VP + 16); vf[dh] = __builtin_shufflevector(lo_, hi_, 0, 1, 2, 3, 4, 5, 6, 7); } } while (0)
#define MLA_SCORE(q) do { s0 = MLA_MFMA8(kf[0], q[0], zero16); s1 = MLA_MFMA8(kf[2], q[0], zero16); s0 = MLA_MFMA8(kf[1], q[1], s0); s1 = MLA_MFMA8(kf[3], q[1], s1); } while (0)
    f32x16 s0, s1; i32x8 vf[2];
    MLA_KFRAGS(0);
    { MLA_SCORE(qA); const unsigned ea = enc3_fp8(56.5f + 8.f * MLA_POFS - rowmax32(s0, s1));
      MLA_SCORE(qB); const unsigned eb = enc3_fp8(56.5f + 8.f * MLA_POFS - rowmax32(s0, s1));
      qA[1][0] = hi ? (int)ea : qA[1][0]; qB[1][0] = hi ? (int)eb : qB[1][0]; }
#define MLA_PBYTES(pf_) do { _Pragma("unroll") for (int g_ = 0; g_ < 4; ++g_) { unsigned b0_ = 0u, b1_ = 0u; \
            _Pragma("unroll") for (int j_ = 0; j_ < 4; ++j_) { b0_ = __builtin_amdgcn_cvt_pk_u8_f32(s0[4 * g_ + j_], j_, b0_); b1_ = __builtin_amdgcn_cvt_pk_u8_f32(s1[4 * g_ + j_], j_, b1_); } \
            pf_[g_] = (int)b0_; pf_[4 + g_] = (int)b1_; } } while (0)
#define SB0() __builtin_amdgcn_sched_barrier(0)
#define MLA_TILE(this_slot, next_slot) do { \
        MLA_PBYTES(pfA); SB0(); \
        s0 = MLA_MFMA8(kf[0], qB[0], zero16); SB0(); MLA_VFRAGS(this_slot); SB0(); \
        s1 = MLA_MFMA8(kf[2], qB[0], zero16); s0 = MLA_MFMA8(kf[1], qB[1], s0); s1 = MLA_MFMA8(kf[3], qB[1], s1); lB += t_[0]; SB0(); \
        oA0 = MLA_MFMA8(vf[0], pfA, oA0); oA1 = MLA_MFMA8(vf[1], pfA, oA1); t_ = MLA_SUM8(pfA); SB0(); \
        MLA_PBYTES(pfB); asm volatile("" :: "v"(pfA)); SB0(); MLA_KFRAGS(next_slot); SB0(); \
        MLA_SCORE(qA); lA += t_[0]; SB0(); \
        oB0 = MLA_MFMA8(vf[0], pfB, oB0); oB1 = MLA_MFMA8(vf[1], pfB, oB1); t_ = MLA_SUM8(pfB); asm volatile("" :: "v"(pfB)); SB0(); } while (0)
    MLA_SCORE(qA); f32x4 t_ = zero4; i32x8 pfA, pfB;
    if (wid < 4) __builtin_amdgcn_s_setprio(3); else __builtin_amdgcn_s_setprio(1);
    int sl = 0;
#pragma unroll 1
    for (int tp = 0; tp < 32; ++tp) {
        const int s_a = sl * MLA_BUF, s_b = s_a + MLA_BUF, sl2 = sl + 2 >= 6 ? sl - 4 : sl + 2, s_c = sl2 * MLA_BUF, sl4 = sl2 + 2 >= 6 ? sl2 - 4 : sl2 + 2, f_a = sl4 * MLA_BUF, f_b = f_a + MLA_BUF;
        MLA_STORE_OFF(f_a, rk0, rv0); MLA_STORE_OFF(f_b, rk1, rv1);
        MLA_LOADG(2 * tp + 6, rk0, rv0); MLA_LOADG(2 * tp + 7, rk1, rv1);
        __builtin_amdgcn_sched_barrier(0);
        MLA_TILE(s_a, s_b);
        MLA_TILE(s_b, s_c);
        asm volatile("s_waitcnt lgkmcnt(0)" ::: "memory"); __builtin_amdgcn_s_barrier(); asm volatile("" ::: "memory");
        sl = sl2;
    }
    lB += t_[0];
    __builtin_amdgcn_s_setprio(0);
#undef MLA_TILE
#undef SB0
#undef MLA_PBYTES
#undef MLA_SCORE
#undef MLA_KFRAGS
#undef MLA_VFRAGS
#undef MLA_KFRAG
#undef MLA_MFMA8
#undef MLA_STORE_OFF
#undef MLA_LOADG
    int tid2 = F.tid; asm volatile("" : "+v"(tid2));
    const int hi2 = (tid2 >> 5) & 1; const size_t orow0 = tok0 + qb * 512 + wid * 64 + (tid2 & 31);
#pragma unroll
    for (int grp = 0; grp < 2; ++grp) {
        const f32x16& o0 = grp ? oB0 : oA0; const f32x16& o1 = grp ? oB1 : oA1;
        const float inv = DBG_MLA_F / (grp ? lB : lA);
        unsigned char* orow = (unsigned char*)MIX + (orow0 + 32 * grp) * 1024 + h * 64 + 8 * hi2;
        const float invs = inv * MIX_SCALE;
#pragma unroll
        for (int hf = 0; hf < 2; ++hf) { const f32x16& oo = hf ? o1 : o0;
#pragma unroll
            for (int gp = 0; gp < 2; ++gp) { const int e0 = 8 * gp;
                const unsigned a4 = pk4_fp8(oo[e0] * invs, oo[e0 + 1] * invs, oo[e0 + 2] * invs, oo[e0 + 3] * invs), b4 = pk4_fp8(oo[e0 + 4] * invs, oo[e0 + 5] * invs, oo[e0 + 6] * invs, oo[e0 + 7] * invs);
                const unsigned rcv = (unsigned)__shfl_xor((int)(hi2 ? a4 : b4), 32);
                *(u32x2*)(orow + hf * 32 + 16 * gp) = hi2 ? (u32x2){rcv, b4} : (u32x2){a4, rcv}; }
        }
    }
}

constexpr int DIL_KP = 144, DIL_KB = 64 * DIL_KP, DIL_BUF = DIL_KB + 8192, DIL_PAIR = 2 * DIL_BUF, DIL_TAB = 4 * DIL_PAIR;
static_assert(DIL_TAB + 3 * 320 * 4 <= RING_BYTES, "dilated LDS");
template <int MODE>
__device__ __forceinline__ void dil_unit(Frame& F, int b, int h, int sb) {
    const int tid = F.tid, lane = F.lane, wid = F.wave, r32 = lane & 31, hi = lane >> 5;
    const bf16_t* DQ = WSP(const bf16_t, WS_DQ); const bf16_t* DK = WSP(const bf16_t, WS_DK); const bf16_t* DV = WSP(const bf16_t, WS_DV);
    bf16_t* O1 = WSP(bf16_t, WS_O1); bf16_t* O2 = WSP(bf16_t, WS_O2); float* LSE = WSP(float, WS_LSE); bf16_t* MIX = WSP(bf16_t, WS_MIX);
    LAS char* lds = (LAS char*)F.lds;
    LAS float* tab = (LAS float*)(lds + DIL_TAB);
    { const float* tg = WSP(const float, WS_TABG); for (int i = tid; i < 960; i += NTHR) tab[i] = tg[((i / 320) * 8 + h) * 320 + (i % 320)]; }
    const int pair = wid >> 1, pt = (wid & 1) * 64 + lane;
    LAS char* pl = lds + pair * DIL_PAIR;
    const size_t tok0 = (size_t)b * SEQ, hrow0 = (size_t)(b * 8 + h) * SEQ;
    const int qi = (wid & 1) * 32 + r32;
#define DIL_BLK(p_, rho_, dsh_, nb_, r_, n_) const int dsh_ = 2 * (p_), nb_ = 64 >> dsh_; const int i__ = 4 * (rho_) + pair, nbsb__ = 16 >> dsh_, r_ = i__ / nbsb__, n_ = ((sb * 1024) >> dsh_) / 64 + i__ % nbsb__
    u32x4 rk[4], rv[4]; bf16x8 qr[4], qn[4];
#define DIL_LOAD(ts_) do { const int p__ = (ts_) / 12, rho__ = ((ts_) % 12) / 3, jt__ = (ts_) % 3; DIL_BLK(p__, rho__, dsh__, nb__, r__, n__); \
        int kb_ = n__ - 1 + jt__; kb_ = kb_ < 0 ? 0 : (kb_ >= nb__ ? nb__ - 1 : kb_); \
        _Pragma("unroll") for (int c_ = 0; c_ < 4; ++c_) { const int ch_ = pt + 128 * c_, kv_ = ch_ >> 3, cc_ = ch_ & 7; \
            const size_t kpos_ = (size_t)((kb_ * 64 + kv_) << dsh__) + r__; \
            const size_t ko_ = (hrow0 + DPERM((int)kpos_)) * 64 + cc_ * 8; rk[c_] = *(const u32x4*)(DK + ko_); rv[c_] = *(const u32x4*)(DV + ko_); } } while (0)
#define DIL_STORE(buf) do { _Pragma("unroll") for (int c_ = 0; c_ < 4; ++c_) { const int ch_ = pt + 128 * c_, kv_ = ch_ >> 3, cc_ = ch_ & 7; \
            *(LAS u32x4*)(pl + (buf) * DIL_BUF + kv_ * DIL_KP + cc_ * 16) = rk[c_]; \
            *(LAS u32x4*)(pl + (buf) * DIL_BUF + DIL_KB + (cc_ >> 2) * 4096 + kv_ * 64 + (cc_ & 3) * 16) = rv[c_]; } } while (0)
#define DIL_QLOAD(dst, blk_) do { const int p__ = (blk_) / 4, rho__ = (blk_) % 4; DIL_BLK(p__, rho__, dsh__, nb__, r__, n__); (void)nb__; \
        const size_t qpos__ = (size_t)((n__ * 64 + qi) << dsh__) + r__; \
        _Pragma("unroll") for (int d0 = 0; d0 < 4; ++d0) dst[d0] = *(const bf16x8*)(DQ + (hrow0 + DPERM((int)qpos__)) * 64 + d0 * 16 + hi * 8); } while (0)
    DIL_LOAD(0); DIL_QLOAD(qr, 0); DIL_STORE(0);
    asm volatile("" :: "v"(qr[0]), "v"(qr[1]), "v"(qr[2]), "v"(qr[3]));
    __syncthreads();
    float m_run = NEG_BIG, l_run = 0.f; f32x16 o0, o1;
#pragma unroll 1
    for (int ts = 0; ts < 36; ++ts) {
        const int p = ts / 12, rho = (ts % 12) / 3, jt = ts % 3;
        DIL_BLK(p, rho, dsh, nb, r, n);
        if (MODE != 2 && ts + 1 < 36) DIL_LOAD(ts + 1);
        if (jt == 1 && ts + 2 < 36) DIL_QLOAD(qn, ts / 3 + 1);
        if (jt == 0) { m_run = NEG_BIG; l_run = 0.f;
#pragma unroll
            for (int rr = 0; rr < 16; ++rr) { o0[rr] = 0.f; o1[rr] = 0.f; } }
        const int kb = n - 1 + jt;
        if (MODE != 1 && kb >= 0 && kb < nb) {
            const LAS float* tq = tab + p * 320 + (64 * (jt - 1) - qi + 127);
            attn_tile<4, DIL_KP, true>(pl + (ts & 1) * DIL_BUF, pl + (ts & 1) * DIL_BUF + DIL_KB, qr, m_run, l_run, o0, o1, tq, lane);
        }
        if (MODE != 2 && ts + 1 < 36) DIL_STORE((ts + 1) & 1);
        if (jt == 2) asm volatile("" :: "v"(qn[0]), "v"(qn[1]), "v"(qn[2]), "v"(qn[3]));
        if (MODE != 0 && jt == 2) { if (m_run == 12345.f) MIX[0] = (bf16_t)(int)(l_run + o0[3] + o1[5]); }
        if (MODE == 0 && jt == 2) {
            const size_t qpos = (size_t)((n * 64 + qi) << dsh) + r;
            const float lt = l_run + __shfl_xor(l_run, 32); const float inv = 1.f / lt;
            const float lse = m_run + __builtin_amdgcn_logf(lt);
            const size_t grow = tok0 + qpos, prow = hrow0 + DPERM((int)qpos);
            if (p < 2) {
                bf16_t* orow = (p == 0 ? O1 : O2) + prow * 64 + 32 * hi;
#pragma unroll
                for (int k = 0; k < 4; ++k) { const f32x16& oo = k < 2 ? o0 : o1; const int e0 = 8 * (k & 1);
                    u32x4 w; w.x = cvt_pk_bf16(oo[e0] * inv, oo[e0 + 1] * inv); w.y = cvt_pk_bf16(oo[e0 + 2] * inv, oo[e0 + 3] * inv); w.z = cvt_pk_bf16(oo[e0 + 4] * inv, oo[e0 + 5] * inv); w.w = cvt_pk_bf16(oo[e0 + 6] * inv, oo[e0 + 7] * inv);
                    *(u32x4*)(orow + 8 * k) = w; }
                if (hi == 0) LSE[(size_t)p * BATCH * DIL_H * SEQ + prow] = lse;
            } else {
                const float l0 = LSE[prow], l1 = LSE[(size_t)BATCH * DIL_H * SEQ + prow];
                const float mm = fmaxf(fmaxf(l0, l1), lse);
                const float e0 = __builtin_amdgcn_exp2f(l0 - mm), e1 = __builtin_amdgcn_exp2f(l1 - mm), e2 = __builtin_amdgcn_exp2f(lse - mm);
                const float isum = DBG_DIL_F / (e0 + e1 + e2); const float w0 = e0 * isum, w1 = e1 * isum, w2 = e2 * isum * inv;
                const bf16_t* a1 = O1 + prow * 64; const bf16_t* a2 = O2 + prow * 64;
                unsigned char* orow = (unsigned char*)MIX + grow * 1024 + 512 + h * 64;
                u32x4 xa[4], xb[4];
#pragma unroll
                for (int k = 0; k < 4; ++k) { xa[k] = *(const u32x4*)(a1 + 32 * hi + 8 * k); xb[k] = *(const u32x4*)(a2 + 32 * hi + 8 * k); }
                unsigned wm[2][4];
#pragma unroll
                for (int g = 0; g < 4; ++g) {
#pragma unroll
                    for (int hf = 0; hf < 2; ++hf) {
                        const u32x4& A1 = xa[hf * 2 + (g >> 1)]; const u32x4& A2 = xb[hf * 2 + (g >> 1)];
                        u32x2 x1, x2; x1.x = (g & 1) ? A1.z : A1.x; x1.y = (g & 1) ? A1.w : A1.y; x2.x = (g & 1) ? A2.z : A2.x; x2.y = (g & 1) ? A2.w : A2.y;
                        const f32x16& oo = hf ? o1 : o0;
                        const float y0 = w0 * bf_lo(x1.x) + w1 * bf_lo(x2.x) + w2 * oo[4 * g], y1 = w0 * bf_hi(x1.x) + w1 * bf_hi(x2.x) + w2 * oo[4 * g + 1];
                        const float y2 = w0 * bf_lo(x1.y) + w1 * bf_lo(x2.y) + w2 * oo[4 * g + 2], y3 = w0 * bf_hi(x1.y) + w1 * bf_hi(x2.y) + w2 * oo[4 * g + 3];
                        wm[hf][g] = pk4_fp8(y0 * MIX_SCALE, y1 * MIX_SCALE, y2 * MIX_SCALE, y3 * MIX_SCALE);
                    }
                }
#pragma unroll
                for (int hf = 0; hf < 2; ++hf)
#pragma unroll
                    for (int gp = 0; gp < 2; ++gp) {
                        const unsigned rcv = (unsigned)__shfl_xor((int)(hi ? wm[hf][2 * gp] : wm[hf][2 * gp + 1]), 32);
                        *(u32x2*)(orow + hf * 32 + 16 * gp + 8 * hi) = hi ? (u32x2){rcv, wm[hf][2 * gp + 1]} : (u32x2){wm[hf][2 * gp], rcv};
                    }
            }
#pragma unroll
            for (int d0 = 0; d0 < 4; ++d0) qr[d0] = qn[d0];
        }
        if (ts == 25) VM_WAIT();
        __syncthreads();
    }
#undef DIL_LOAD
#undef DIL_STORE
#undef DIL_QLOAD
#undef DIL_BLK
}

__device__ __forceinline__ void transpose_item(const float* W, int ldn, int K, int k0, int n0, bf16_t* WT, int drow, const float* kscale, LAS float* scr, int lane) {
#pragma unroll 8
    for (int i = 0; i < 32; ++i) { const int kk = 2 * i + (lane >> 5); float v = W[(size_t)(k0 + kk) * ldn + n0 + (lane & 31)]; if (kscale) v *= kscale[k0 + kk]; scr[kk * 33 + (lane & 31)] = v; }
    LDS_WAIT(); asm volatile("" ::: "memory");
    const int c = lane & 7;
#pragma unroll
    for (int j = 0; j < 4; ++j) { const int n = (lane >> 3) + 8 * j; const LAS float* s = scr + (8 * c) * 33 + n;
        u32x4 o; o.x = pk2(s[0 * 33], s[1 * 33]); o.y = pk2(s[2 * 33], s[3 * 33]); o.z = pk2(s[4 * 33], s[5 * 33]); o.w = pk2(s[6 * 33], s[7 * 33]);
        *(u32x4*)(WT + (size_t)(drow + n) * K + k0 + 8 * c) = o; }
    LDS_WAIT(); asm volatile("" ::: "memory");
}
__device__ __forceinline__ void transpose_item_f8(const float* W, int ldn, int K, int k0, int n0, unsigned char* WT, int drow, float qs, LAS float* scr, int lane) {
#pragma unroll 8
    for (int i = 0; i < 32; ++i) { const int kk = 2 * i + (lane >> 5); scr[kk * 33 + (lane & 31)] = W[(size_t)(k0 + kk) * ldn + n0 + (lane & 31)] * qs; }
    LDS_WAIT(); asm volatile("" ::: "memory");
    const int c = lane & 7;
#pragma unroll
    for (int j = 0; j < 4; ++j) { const int n = (lane >> 3) + 8 * j; const LAS float* s_ = scr + (8 * c) * 33 + n;
        u32x2 o; o.x = pk4_fp8(s_[0 * 33], s_[1 * 33], s_[2 * 33], s_[3 * 33]); o.y = pk4_fp8(s_[4 * 33], s_[5 * 33], s_[6 * 33], s_[7 * 33]);
        *(u32x2*)(WT + (size_t)(drow + n) * K + k0 + 8 * c) = o; }
    LDS_WAIT(); asm volatile("" ::: "memory");
}
__device__ __forceinline__ void transpose_item64(const float* W, int ldn, int K, int k0, int n0, bf16_t* WT, int drow, LAS float* scr, int lane, float qs, float qis) {
    f32x4 v[16];
    const float* src = W + (size_t)(k0 + (lane >> 4)) * ldn + n0 + 4 * (lane & 15);
#pragma unroll
    for (int j = 0; j < 16; ++j) v[j] = __builtin_nontemporal_load((const f32x4*)(src + (size_t)(4 * j) * ldn));
    LAS float* sw = scr + (lane >> 4) * 65 + 4 * (lane & 15);
#pragma unroll
    for (int j = 0; j < 16; ++j) { sw[(4 * j) * 65 + 0] = v[j][0]; sw[(4 * j) * 65 + 1] = v[j][1]; sw[(4 * j) * 65 + 2] = v[j][2]; sw[(4 * j) * 65 + 3] = v[j][3]; }
    LDS_WAIT(); asm volatile("" ::: "memory");
    const int c = lane & 7;
#pragma unroll
    for (int jj = 0; jj < 8; ++jj) { const int n = (lane >> 3) + 8 * jj; const LAS float* s = scr + (8 * c) * 65 + n;
        u32x2 o; o.x = pk4_fp8(s[0 * 65] * qs, s[1 * 65] * qs, s[2 * 65] * qs, s[3 * 65] * qs); o.y = pk4_fp8(s[4 * 65] * qs, s[5 * 65] * qs, s[6 * 65] * qs, s[7 * 65] * qs);
        *(u32x2*)((unsigned char*)WT + (size_t)(drow + n) * K + k0 + 8 * c) = o; }
    LDS_WAIT(); asm volatile("" ::: "memory");
}
__device__ __forceinline__ int t5_bucket_dev(int rel) {
    const int n = rel < 0 ? -rel : rel; int v;
    if (n < 8) v = n; else v = n < 15 ? 8 : n < 27 ? 9 : n < 50 ? 10 : n < 91 ? 11 : n < 166 ? 12 : n < 305 ? 13 : n < 559 ? 14 : 15;
    return (rel > 0 ? 16 : 0) + v;
}
__device__ __forceinline__ void p0_prologue(Frame& F) { const KArgs ka = kargs();
    struct { const float *c, *w_ada, *w_in, *w_uq, *q_norm_g, *w_ukv, *kv_norm_g, *w_out, *rel_bias; } a;
    a.c = ka->c; a.w_ada = ka->w_ada; a.w_in = ka->w_in; a.w_uq = ka->w_uq; a.q_norm_g = ka->q_norm_g; a.w_ukv = ka->w_ukv; a.kv_norm_g = ka->kv_norm_g; a.w_out = ka->w_out; a.rel_bias = ka->rel_bias;
    LAS float* scr = (LAS float*)(F.lds + 32768 + F.wave * 8704);
    LAS float* sil = (LAS float*)F.lds;
    for (int i = F.tid; i < BATCH * D_MODEL; i += NTHR) { const float v = a.c[i]; sil[i] = v / (1.f + __expf(-v)); }
    __syncthreads();
    const int gw = F.vcu * NWAVES + F.wave, NGW = F.G * NWAVES, lane = F.lane;
    for (int it = gw; it < 16 * 24; it += NGW) {
        const int kb = it / 24, nb = it % 24, k0 = kb * 64, n0 = nb * 256 + lane * 4;
        f32x4 acc[8];
#pragma unroll
        for (int b = 0; b < 8; ++b) acc[b] = (f32x4){0.f, 0.f, 0.f, 0.f};
#pragma unroll 16
        for (int k = 0; k < 64; ++k) { const f32x4 w = *(const f32x4*)(a.w_ada + (size_t)(k0 + k) * 6144 + n0);
#pragma unroll
            for (int b = 0; b < 8; ++b) acc[b] += w * sil[b * 1024 + k0 + k]; }
        float* mp = WSP(float, WS_MODP) + (size_t)kb * 8 * 6144 + n0;
#pragma unroll
        for (int b = 0; b < 8; ++b) *(f32x4*)(mp + b * 6144) = acc[b];
    }
    {
        bf16_t* WIN = WSP(bf16_t, WS_WIN); bf16_t* WUQ = WSP(bf16_t, WS_WUQ); bf16_t* WK = WSP(bf16_t, WS_WK); bf16_t* WV = WSP(bf16_t, WS_WV); bf16_t* WOUT = WSP(bf16_t, WS_WOUT);
        constexpr int I_IN = 16 * 69, I_UQ = 6 * 24, I_KV = 4 * 32, I_OUT = 16 * 32, NIT = I_IN + I_UQ + I_KV + I_OUT;
        for (int it = NGW - 1 - gw; it < NIT; it += NGW) {
            int r = it;
            if (r < I_IN) { const int kb = r / 69, g = r % 69, n0 = g * 32; transpose_item_f8(a.w_in, IN_W, 1024, kb * 64, n0, (unsigned char*)WIN, n0 + (n0 >= 672 ? 96 : 0), WIN_SCALE, scr, lane); continue; } r -= I_IN;
            if (r < I_UQ) { const int kb = r / 24, g = r % 24; transpose_item(a.w_uq, 768, 384, kb * 64, g * 32, WUQ, g * 32, a.q_norm_g, scr, lane); continue; } r -= I_UQ;
            if (r < I_KV) { const int kb = r / 32, g = r % 32, hh = g >> 2, part = g & 3;
                transpose_item(a.w_ukv, 1024, 256, kb * 64, g * 32, part < 2 ? WK : WV, hh * 64 + (part & 1) * 32, a.kv_norm_g, scr, lane); continue; } r -= I_KV;
            { const int kb = r / 32, g = r % 32; transpose_item_f8(a.w_out, 1024, 1024, kb * 64, g * 32, (unsigned char*)WOUT, g * 32, WOUT_SCALE, scr, lane); }
        }
        for (int i = (F.G - 1 - F.vcu) * NTHR + F.tid; i < 96 * 1024 / 16; i += F.G * NTHR) *(u32x4*)((unsigned char*)WIN + (size_t)672 * 1024 + (size_t)i * 16) = (u32x4){0u, 0u, 0u, 0u};
    }
    for (int i = (F.G - 1 - F.vcu) * NTHR + F.tid; i < SEQ * 16; i += F.G * NTHR) { const int pos = i >> 4, j = i & 15;
        const float ang = (float)pos * (float)exp2(-(double)j * (13.287712379549449 / 16.0)); float* rp = WSP(float, WS_ROPE) + pos * 32;
        float sn, cs; sincosf(ang, &sn, &cs);
        rp[j] = cs; rp[16 + j] = sn; }
    for (int i = (F.G - 1 - F.vcu) * NTHR + F.tid; i < 3 * 8 * 320; i += F.G * NTHR) { const int p = i / 2560, hh = (i / 320) & 7, idx = i % 320, delta = idx - 127, dil = 1 << (2 * p);
        float v = NEG_BIG; if (delta >= -64 && delta <= 64) v = a.rel_bias[t5_bucket_dev(delta * dil) * 8 + hh] * LOG2E;
        WSP(float, WS_TABG)[i] = v; }
}
__device__ __forceinline__ void p1_mod_h1(Frame& F) { const KArgs ka = kargs(); const float* const a_x = ka->x; const float* const a_b_ada = ka->b_ada;
    LAS float* shs = (LAS float*)F.lds;
    const float* modp = WSP(const float, WS_MODP); float* mod = WSP(float, WS_MOD);
    for (int i = F.vcu * NTHR + F.tid; i < 8 * 6144; i += F.G * NTHR) { float s = a_b_ada[i % 6144];
#pragma unroll
        for (int kb = 0; kb < 16; ++kb) s += modp[(size_t)kb * 8 * 6144 + i];
        mod[i] = s; }
    bf16_t* H1 = WSP(bf16_t, WS_H);
    const int rpb = M_TOK / F.G;
    const int row0 = F.vcu * rpb, b = row0 >> 12;
    for (int i = F.tid; i < 2048; i += NTHR) { float sv = a_b_ada[i];
#pragma unroll
        for (int kb = 0; kb < 16; ++kb) sv += modp[(size_t)kb * 8 * 6144 + b * 6144 + i];
        shs[i] = sv; }
    __syncthreads();
    f32x4 sh[4], sc[4];
#pragma unroll
    for (int j = 0; j < 4; ++j) { sh[j] = *(const LAS f32x4*)(shs + 4 * F.lane + 256 * j); sc[j] = *(const LAS f32x4*)(shs + 1024 + 4 * F.lane + 256 * j) + 1.f; }
    for (int rr = 2 * F.wave; rr < rpb; rr += 2 * NWAVES) {
        const int row = row0 + rr;
        const f32x4* xr = (const f32x4*)(a_x + (size_t)row * 1024) + F.lane;
        unsigned* o8 = (unsigned*)((unsigned char*)H1 + (size_t)row * 1024) + F.lane;
        f32x4 v[8];
#pragma unroll
        for (int j = 0; j < 8; ++j) v[j] = __builtin_nontemporal_load(xr + 64 * j);
#pragma unroll
        for (int j = 0; j < 8; ++j) { const f32x4 hv = v[j] * sc[j & 3] + sh[j & 3];
            o8[64 * j] = pk4_fp8(hv[0], hv[1], hv[2], hv[3]); }
    }
}
__device__ __forceinline__ void p6_ln1_router(Frame& F) { const KArgs ka = kargs(); const float* const a_w_router = ka->w_router; const float* const a_ln1_g = ka->ln1_g; const float* const a_ln1_b = ka->ln1_b; const float* const a_out = ka->out; const float* const a_x = ka->x;
    LAS f32x4* wr4 = (LAS f32x4*)F.lds;
    for (int idx = F.tid; idx < 1024 * 4; idx += NTHR) { const int k = idx >> 2, e4 = idx & 3, l = (k & 255) >> 2, i = k & 3, j = k >> 8;
        wr4[((j * 4 + i) * 4 + e4) * 64 + l] = *(const f32x4*)(a_w_router + k * 16 + e4 * 4); }
    __syncthreads();
    const float* mod = WSP(const float, WS_MOD); bf16_t* H2 = WSP(bf16_t, WS_H); float* AFF = WSP(float, WS_AFF); float* STAT = WSP(float, WS_STAT);
    const int gw = F.vcu * NWAVES + F.wave, NGW = F.G * NWAVES, lane = F.lane;
    f32x4 vn[4]; u32x2 mn[4];
    { const f32x4* zr = (const f32x4*)(a_x + (size_t)gw * 1024) + lane; const u32x2* mr = (const u32x2*)(a_out + (size_t)gw * 1024) + lane;
#pragma unroll
      for (int j = 0; j < 4; ++j) { vn[j] = zr[64 * j]; mn[j] = mr[64 * j]; } }
    for (int row = gw; row < M_TOK; row += NGW) {
        const int b = row >> 12, s = row & (SEQ - 1);
        f32x4 v[4]; float sm = 0.f;
#pragma unroll
        for (int j = 0; j < 4; ++j) { v[j] = vn[j] * ALPHA + (f32x4){bf_lo(mn[j].x), bf_hi(mn[j].x), bf_lo(mn[j].y), bf_hi(mn[j].y)}; sm += (v[j][0] + v[j][1]) + (v[j][2] + v[j][3]); }
        { const int rn = row + NGW < M_TOK ? row + NGW : row;
          const f32x4* zr = (const f32x4*)(a_x + (size_t)rn * 1024) + lane; const u32x2* mr = (const u32x2*)(a_out + (size_t)rn * 1024) + lane;
#pragma unroll
          for (int j = 0; j < 4; ++j) { vn[j] = zr[64 * j]; mn[j] = mr[64 * j]; } }
        const float mean = wave_sum(sm) * (1.f / 1024.f); float s2 = 0.f;
#pragma unroll
        for (int j = 0; j < 4; ++j) { v[j] = v[j] - mean; s2 += (v[j][0] * v[j][0] + v[j][1] * v[j][1]) + (v[j][2] * v[j][2] + v[j][3] * v[j][3]); }
        const float rstd = 1.f / sqrtf(wave_sum(s2) * (1.f / 1024.f) + NORM_EPS);
        if (lane == 0) *(f32x2*)(STAT + (size_t)row * 2) = (f32x2){mean, rstd};
        float lg[16];
#pragma unroll
        for (int e = 0; e < 16; ++e) lg[e] = 0.f;
        unsigned* h4 = (unsigned*)((unsigned char*)H2 + (size_t)row * 1024) + lane;
#pragma unroll
        for (int j = 0; j < 4; ++j) { const int col = 4 * lane + 256 * j;
            const f32x4 g = *(const f32x4*)(a_ln1_g + col), bb = *(const f32x4*)(a_ln1_b + col);
            const f32x4 x1 = v[j] * rstd * g + bb;
            const f32x4 sh = *(const f32x4*)(mod + b * 6144 + 3072 + col), sc = *(const f32x4*)(mod + b * 6144 + 4096 + col);
            const f32x4 hv = x1 * (sc + 1.f) + sh;
            h4[64 * j] = pk4_fp8(hv[0], hv[1], hv[2], hv[3]);
#pragma unroll
            for (int i = 0; i < 4; ++i) {
#pragma unroll
                for (int e4 = 0; e4 < 4; ++e4) { const f32x4 w = wr4[((j * 4 + i) * 4 + e4) * 64 + lane];
                    lg[e4 * 4 + 0] += hv[i] * w[0]; lg[e4 * 4 + 1] += hv[i] * w[1]; lg[e4 * 4 + 2] += hv[i] * w[2]; lg[e4 * 4 + 3] += hv[i] * w[3]; }
                if (i & 1) asm volatile("" ::: "memory"); }
        }
#pragma unroll
        for (int i = 0; i < 8; ++i) { const bool up = lane & 32; const float keep = up ? lg[i + 8] : lg[i], send = up ? lg[i] : lg[i + 8]; lg[i] = keep + __shfl_xor(send, 32); }
#pragma unroll
        for (int i = 0; i < 4; ++i) { const bool up = lane & 16; const float keep = up ? lg[i + 4] : lg[i], send = up ? lg[i] : lg[i + 4]; lg[i] = keep + __shfl_xor(send, 16); }
#pragma unroll
        for (int i = 0; i < 2; ++i) { const bool up = lane & 8; const float keep = up ? lg[i + 2] : lg[i], send = up ? lg[i] : lg[i + 2]; lg[i] = keep + __shfl_xor(send, 8); }
        { const bool up = lane & 4; const float keep = up ? lg[1] : lg[0], send = up ? lg[0] : lg[1]; lg[0] = keep + __shfl_xor(send, 4); }
        float logit = lg[0]; logit += __shfl_xor(logit, 2); logit += __shfl_xor(logit, 1);
        float mx = logit;
        mx = fmaxf(mx, __shfl_xor(mx, 4)); mx = fmaxf(mx, __shfl_xor(mx, 8)); mx = fmaxf(mx, __shfl_xor(mx, 16)); mx = fmaxf(mx, __shfl_xor(mx, 32));
        const float ex = expf(logit - mx); float se = ex;
        se += __shfl_xor(se, 4); se += __shfl_xor(se, 8); se += __shfl_xor(se, 16); se += __shfl_xor(se, 32);
        const int e = ((lane >> 5) & 1) * 8 + ((lane >> 4) & 1) * 4 + ((lane >> 3) & 1) * 2 + ((lane >> 2) & 1);
        if ((lane & 3) == 0) AFF[((size_t)b * 16 + e) * SEQ + s] = ex / se;
    }
}
__device__ __forceinline__ unsigned block_excl_scan(unsigned v, LAS unsigned* tmp, int tid, int lane, int wave, unsigned& total) {
    unsigned inc = v;
#pragma unroll
    for (int o = 1; o < 64; o <<= 1) { const unsigned t = __shfl_up(inc, o); if (lane >= o) inc += t; }
    __syncthreads();
    if (lane == 63) tmp[wave] = inc;
    __syncthreads();
    unsigned base = 0, tot = 0;
#pragma unroll
    for (int w = 0; w < NWAVES; ++w) { const unsigned t = tmp[w]; if (w < wave) base += t; tot += t; }
    total = tot;
    return base + inc - v;
}
__device__ __forceinline__ void topk_unit(Frame& F, int b, int e) {
    LAS unsigned* hist = (LAS unsigned*)F.lds; LAS unsigned* sh = hist + 256; LAS unsigned* tmp = hist + 272;
    const int tid = F.tid, lane = F.lane, wave = F.wave;
    const float* aff = WSP(const float, WS_AFF) + ((size_t)b * 16 + e) * SEQ;
    unsigned key[8];
    { const u32x4 k0 = *(const u32x4*)(aff + tid * 8), k1 = *(const u32x4*)(aff + tid * 8 + 4); key[0] = k0.x; key[1] = k0.y; key[2] = k0.z; key[3] = k0.w; key[4] = k1.x; key[5] = k1.y; key[6] = k1.z; key[7] = k1.w; }
    unsigned prefix = 0, need = CAP;
#pragma unroll 1
    for (int pass = 0; pass < 4; ++pass) {
        const int shift = 24 - 8 * pass;
        if (tid < 256) hist[tid] = 0u;
        __syncthreads();
#pragma unroll
        for (int i = 0; i < 8; ++i) { const bool in = (pass == 0) || ((key[i] >> (shift + 8)) == prefix); if (in) (void)__hip_atomic_fetch_add(&hist[(key[i] >> shift) & 255u], 1u, __ATOMIC_RELAXED, __HIP_MEMORY_SCOPE_WORKGROUP); }
        __syncthreads();
        if (wave == 0) {
            const unsigned c0 = hist[4 * lane], c1 = hist[4 * lane + 1], c2 = hist[4 * lane + 2], c3 = hist[4 * lane + 3], s = c0 + c1 + c2 + c3;
            unsigned incl = s;
#pragma unroll
            for (int o = 1; o < 64; o <<= 1) { const unsigned t = __shfl_down(incl, o); if (lane + o < 64) incl += t; }
            const unsigned above = incl - s;
            if (above < need && need <= incl) {
                unsigned aa = above; int d;
                if (aa + c3 >= need) d = 3; else { aa += c3; if (aa + c2 >= need) d = 2; else { aa += c2; if (aa + c1 >= need) d = 1; else { aa += c1; d = 0; } } }
                sh[0] = (prefix << 8) | (unsigned)(4 * lane + d); sh[1] = need - aa;
            }
        }
        __syncthreads();
        prefix = sh[0]; need = sh[1];
    }
    const unsigned T = prefix;
    unsigned cg = 0, ce = 0;
#pragma unroll
    for (int i = 0; i < 8; ++i) { cg += key[i] > T; ce += key[i] == T; }
    unsigned tot;
    const unsigned eq_before = block_excl_scan(ce, tmp, tid, lane, wave, tot);
    unsigned sel_mask = 0, nsel = 0, er = eq_before;
#pragma unroll
    for (int i = 0; i < 8; ++i) { bool s = key[i] > T; if (key[i] == T) { s = er < need; ++er; } if (s) { sel_mask |= 1u << i; ++nsel; } }
    unsigned slot = block_excl_scan(nsel, tmp, tid, lane, wave, tot);
    LAS int* lst = (LAS int*)(hist + 512);
    float* vals = WSP(float, WS_VALS) + (e * 8 + b) * CAP; int* inv = WSP(int, WS_INV);
#pragma unroll
    for (int i = 0; i < 8; ++i) { const int tok = tid * 8 + i; int sl = -1;
        if (sel_mask & (1u << i)) { sl = (int)slot; if (slot < (unsigned)CAP) { lst[slot] = tok; vals[slot] = __builtin_bit_cast(float, key[i]); } ++slot; }
        inv[((size_t)b * SEQ + tok) * 16 + e] = sl; }
    __syncthreads();
    { unsigned* VOFF = WSP(unsigned, WS_VOFF);
#pragma unroll
      for (int hh = 0; hh < 2; ++hh) { u32x4 o;
#pragma unroll
          for (int i = 0; i < 2; ++i) { int R, C; pg8::stage_rc(tid * 16 + i * 8192, R, C);
              o[i] = (unsigned)lst[hh * 256 + R] * 1024u + (unsigned)(C * 2); o[2 + i] = (unsigned)lst[hh * 256 + 128 + R] * 1024u + (unsigned)(C * 2); }
          *(u32x4*)(VOFF + ((size_t)((e * 8 + b) * 2 + hh) * 512 + tid) * 4) = o; } }
    __syncthreads();
}
template <int PART>
__device__ __forceinline__ void p7_expert_weights(Frame& F) { const KArgs ka = kargs(); const float* const a_w_gate = ka->w_gate; const float* const a_w_up = ka->w_up; const float* const a_w_down = ka->w_down;
    LAS float* scr = (LAS float*)(F.lds + 4096 + F.wave * 16640);
    bf16_t* WGU = WSP(bf16_t, WS_WGU); bf16_t* WD = WSP(bf16_t, WS_WD);
    constexpr int I_G = 16 * 16 * 24, I_D = 16 * 24 * 16;
    const int bx = (int)blockIdx.x;
    if (PART == 0) {
        const bool split = (F.G == 256); const bool tk = split && bx < BATCH * N_EXP;
        const int v0 = split ? ((tk ? bx : bx - 128) * NWAVES + F.wave) + (tk ? 7168 : 0) : F.wave * F.G + bx;
        const int vstep = split ? 1024 : F.G * NWAVES, vend = split ? (tk ? 2 * I_G : 7168) : 2 * I_G;
        static_assert(1024 * 12 == 2 * I_G, "P7 item split");
        for (int it = v0; it < vend; it += vstep) {
            int r = it; const int up = r >= I_G; if (up) r -= I_G; const int ex = r / 384, q = r % 384, kb = q / 24, g = q % 24, f = g * 64;
            transpose_item64((up ? a_w_up : a_w_gate) + (size_t)ex * 1024 * 1536, 1536, 1024, kb * 64, f, (bf16_t*)((unsigned char*)WGU + (size_t)ex * 3072 * 1024), (f >> 7) * 256 + up * 128 + (f & 127), scr, F.lane, WGU_SCALE, 0.f); }
    } else {
        for (int r = F.wave * F.G + bx; r < I_D; r += F.G * NWAVES) { const int ex = r / 384, q = r % 384, kb = q / 16, g = q % 16;
            transpose_item64(a_w_down + (size_t)ex * 1536 * 1024, 1024, 1536, kb * 64, g * 64, (bf16_t*)((unsigned char*)WD + (size_t)ex * 1024 * 1536), g * 64, scr, F.lane, WD_SCALE, 0.f); }
    }
}
__device__ __forceinline__ void p10_final(Frame& F, float* dst_override = nullptr) { const KArgs ka = kargs(); const float* const a_ln2_g = ka->ln2_g; const float* const a_ln2_b = ka->ln2_b; float* const a_out = ka->out;
    const float* const a_ln1_g = ka->ln1_g; const float* const a_ln1_b = ka->ln1_b; const float* const a_x = ka->x;
    const float* mod = WSP(const float, WS_MOD); const bf16_t* Y = WSP(const bf16_t, WS_Y); const int* inv = WSP(const int, WS_INV); const float* STAT = WSP(const float, WS_STAT);
    const int gw = F.vcu * NWAVES + F.wave, NGW = F.G * NWAVES, lane = F.lane;
    int slot_n = inv[(size_t)gw * 16 + (lane & 15)];
    f32x4 xn[4]; u32x2 mn[4]; f32x2 stn = *(const f32x2*)(STAT + (size_t)gw * 2);
    { const f32x4* xr0 = (const f32x4*)(a_x + (size_t)gw * 1024) + lane; const u32x2* mr0 = (const u32x2*)(a_out + (size_t)gw * 1024) + lane;
#pragma unroll
      for (int j = 0; j < 4; ++j) { xn[j] = xr0[64 * j]; mn[j] = mr0[64 * j]; } }
    for (int row = gw; row < M_TOK; row += NGW) {
        const int b = row >> 12;
        f32x4* xr = (f32x4*)(a_out + (size_t)row * 1024) + lane;
        const int myslot = slot_n; f32x4 xc[4]; const float mean1 = stn[0], rstd1 = stn[1];
#pragma unroll
        for (int j = 0; j < 4; ++j) xc[j] = xn[j] * ALPHA + (f32x4){bf_lo(mn[j].x), bf_hi(mn[j].x), bf_lo(mn[j].y), bf_hi(mn[j].y)};
        unsigned long long msk = __ballot(myslot >= 0) & 0xFFFFull;
        f32x4 mo[4];
#pragma unroll
        for (int j = 0; j < 4; ++j) mo[j] = (f32x4){0.f, 0.f, 0.f, 0.f};
        { const int rn = row + NGW < M_TOK ? row + NGW : row;
          slot_n = inv[(size_t)rn * 16 + (lane & 15)]; stn = *(const f32x2*)(STAT + (size_t)rn * 2);
          const f32x4* xrn = (const f32x4*)(a_x + (size_t)rn * 1024) + lane; const u32x2* mrn = (const u32x2*)(a_out + (size_t)rn * 1024) + lane;
#pragma unroll
          for (int j = 0; j < 4; ++j) { xn[j] = xrn[64 * j]; mn[j] = mrn[64 * j]; } }
        while (msk) {
            const int e0 = __builtin_ctzll(msk); msk &= msk - 1;
            const bool two = msk != 0; const int e1 = two ? __builtin_ctzll(msk) : e0; if (two) msk &= msk - 1;
            const int s0 = __shfl(myslot, e0), s1 = __shfl(myslot, e1);
            const unsigned* y0 = (const unsigned*)((const unsigned char*)Y + ((size_t)(e0 * 8 + b) * CAP + s0) * 1024) + lane;
            const unsigned* y1 = (const unsigned*)((const unsigned char*)Y + ((size_t)(e1 * 8 + b) * CAP + s1) * 1024) + lane;
            unsigned w0[4], w1[4];
#pragma unroll
            for (int j = 0; j < 4; ++j) { w0[j] = y0[64 * j]; w1[j] = y1[64 * j]; }
            const float f1 = two ? 1.f : 0.f;
#pragma unroll
            for (int j = 0; j < 4; ++j) { const auto a0 = __builtin_amdgcn_cvt_pk_f32_fp8((int)w0[j], false), a1 = __builtin_amdgcn_cvt_pk_f32_fp8((int)w0[j], true);
                const auto c0 = __builtin_amdgcn_cvt_pk_f32_fp8((int)w1[j], false), c1 = __builtin_amdgcn_cvt_pk_f32_fp8((int)w1[j], true);
                mo[j][0] += a0[0] + f1 * c0[0]; mo[j][1] += a0[1] + f1 * c0[1]; mo[j][2] += a1[0] + f1 * c1[0]; mo[j][3] += a1[1] + f1 * c1[1]; }
        }
        f32x4 v[4]; float sm = 0.f;
#pragma unroll
        for (int j = 0; j < 4; ++j) { const int col = 4 * lane + 256 * j; const f32x4 g2 = *(const f32x4*)(mod + b * 6144 + 5120 + col);
            const f32x4 x1 = (xc[j] - mean1) * rstd1 * *(const f32x4*)(a_ln1_g + col) + *(const f32x4*)(a_ln1_b + col);
            v[j] = x1 * ALPHA + g2 * mo[j] * (DBG_MOE_F / Y_SCALE); sm += (v[j][0] + v[j][1]) + (v[j][2] + v[j][3]); }
        const float mean = wave_sum(sm) * (1.f / 1024.f); float s2 = 0.f;
#pragma unroll
        for (int j = 0; j < 4; ++j) { v[j] = v[j] - mean; s2 += (v[j][0] * v[j][0] + v[j][1] * v[j][1]) + (v[j][2] * v[j][2] + v[j][3] * v[j][3]); }
        const float rstd = 1.f / sqrtf(wave_sum(s2) * (1.f / 1024.f) + NORM_EPS);
#pragma unroll
        for (int j = 0; j < 4; ++j) { const int col = 4 * lane + 256 * j; const f32x4 g = *(const f32x4*)(a_ln2_g + col), bb = *(const f32x4*)(a_ln2_b + col);
            (dst_override ? (f32x4*)(dst_override + (size_t)row * 1024) + lane : xr)[64 * j] = v[j] * rstd * g + bb; }
    }
}
constexpr int N_PHASES = 11;
__global__ void __launch_bounds__(NTHR, 2) fwd_kernel(Args args) {
    extern __shared__ __attribute__((aligned(16))) unsigned char lds_raw[];
    Frame F;
    F.lds = (LAS unsigned char*)lds_raw;
    F.tid = threadIdx.x; F.lane = F.tid & 63; F.wave = __builtin_amdgcn_readfirstlane(F.tid >> 6);
    F.G = gridDim.x; { const int bx = blockIdx.x; F.vcu = (F.G % 8 == 0) ? (bx % 8) * (F.G / 8) + bx / 8 : bx; }
    F.ws = kargs()->ws;
    volatile LAS unsigned* MISC = (volatile LAS unsigned*)(F.lds + MISC_OFF);
    for (int u = F.tid; u < (LDS_BYTES - MISC_OFF) / 4; u += NTHR) MISC[u] = 0u;
    __syncthreads();
    const int lo = kargs()->ph_lo, hi = kargs()->ph_hi;
    unsigned* barw = (unsigned*)(F.ws + WS_CTL) + CW_BAR;
    XcdBarrier bar; bar.bar = barw; bar.x = 0; bar.st = nullptr;
    if (hi - lo > 1) bar = xcd_barrier_post(barw, MISC + 8);
#ifndef PHMASK
#define PHMASK 0x7ff
#endif
#define IN(k) ((((PHMASK) >> (k)) & 1) && lo <= (k) && (k) < hi)
#define SEAM(k) do { if (IN(k) && IN((k) + 1)) xcd_barrier(bar); } while (0)

    if (IN(0)) { p0_prologue(F);
#if DBG_REP_P0 > 1
        __syncthreads(); p0_prologue(F);
#endif
    } SEAM(0);
    if (IN(1)) { _Pragma("unroll 1") for (int rep_ = 0; rep_ < DBG_REP_THIN; ++rep_) p1_mod_h1(F); } SEAM(1);
    if (IN(2)) {
        pg8::Gemm g{WSP(const bf16_t, WS_H), WSP(const bf16_t, WS_WIN), M_TOK, IN_WP, 1024, 1 << 30, nullptr};
        pg8::StaticOrder S; S.init(M_TOK, IN_WP, F.G, (int)blockIdx.x);
        static_assert(WS_DV - WS_DK == WS_DK - WS_DQ, "dq/dk/dv contiguous");
        EpiProj E{WSP(bf16_t, WS_CQ), WSP(bf16_t, WS_CKV), WSP(bf16_t, WS_KN)  , WSP(bf16_t, WS_DQ), WSP(float, WS_SSQ), WSP(const float, WS_ROPE)};
        pg8::gemm_phase<EpiProj, false, true>(F.lds, g, S, E);

    } SEAM(2);
    if (IN(3)) {
#ifdef DBG_DIL_MODE
        __syncthreads();
        for (int u = F.vcu; u < BATCH * DIL_H * 4; u += F.G) dil_unit<DBG_DIL_MODE>(F, u >> 5, (u >> 2) & 7, u & 3);
        __syncthreads();
#endif
#ifndef NO_P3G
#ifndef NO_GQ
        { pg8::Gemm g{WSP(const bf16_t, WS_CQ), WSP(const bf16_t, WS_WUQ), M_TOK, 768, Q_LORA, 1 << 30, nullptr};
          pg8::StaticOrder S; S.init(M_TOK, 768, F.G, (int)blockIdx.x);
          EpiQ E{WSP(bf16_t, WS_Q), WSP(const float, WS_SSQ), WSP(const float, WS_ROPE)};
          pg8::gemm_phase<EpiQ, false>(F.lds, g, S, E);
#if DBG_REP_P3G > 1
          pg8::gemm_phase<EpiQ, false>(F.lds, g, S, E);
#endif
 }
#endif
#ifndef NO_GK
        { pg8::Gemm g{WSP(const bf16_t, WS_CKV), WSP(const bf16_t, WS_WK), M_TOK, 512, KV_LORA, 1 << 30, nullptr};
          pg8::StaticOrder S; S.init(M_TOK, 512, F.G, (int)blockIdx.x);
          EpiKN8 E{WSP(unsigned char, WS_KN), WSP(const float, WS_SSQ)};
          pg8::gemm_phase<EpiKN8, false>(F.lds, g, S, E); }
#endif
        { pg8::Gemm g{WSP(const bf16_t, WS_WV), WSP(const bf16_t, WS_CKV), 512, M_TOK, KV_LORA, 1 << 30, nullptr};
          pg8::StaticOrder S; S.init(512, M_TOK, F.G, (int)blockIdx.x);
          EpiVt8 E{WSP(unsigned char, WS_V), WSP(const float, WS_SSQ)};
          pg8::gemm_phase<EpiVt8, false>(F.lds, g, S, E); }
#endif
    } SEAM(3);
    if (IN(4)) {
        const bool dil_first = (F.vcu & 1) == 0;
#ifndef NO_DIL
        if (dil_first) {
            for (int u = F.vcu; u < BATCH * DIL_H * 4; u += F.G) dil_unit<0>(F, u >> 5, (u >> 2) & 7, u & 3);
            __syncthreads();
        }
#endif
#pragma unroll 1
        for (int rep = 0; rep < DBG_REP_MLA; ++rep)
        for (int u = F.vcu; u < BATCH * MLA_H * 8; u += F.G) mla_unit(F, u >> 6, (u >> 3) & 7, u & 7);
#ifndef NO_DIL
        if (!dil_first) {
            __syncthreads();
            for (int u = F.vcu; u < BATCH * DIL_H * 4; u += F.G) dil_unit<0>(F, u >> 5, (u >> 2) & 7, u & 3);
            __syncthreads();
        }
#endif
    } SEAM(4);
    if (IN(5)) {
        pg8::Gemm g{WSP(const bf16_t, WS_MIX), WSP(const bf16_t, WS_WOUT), M_TOK, 1024, 1024, 1 << 30, nullptr};
        pg8::StaticOrder S; S.init(M_TOK, 1024, F.G, (int)blockIdx.x);
        EpiOut E{kargs()->out, WSP(const float, WS_MOD)};
        pg8::gemm_phase<EpiOut, false, true>(F.lds, g, S, E);

    } SEAM(5);
    if (IN(6)) { _Pragma("unroll 1") for (int rep_ = 0; rep_ < DBG_REP_THIN; ++rep_) { p6_ln1_router(F); __syncthreads(); } } SEAM(6);
    if (IN(7)) {
        for (int u = blockIdx.x; u < BATCH * N_EXP; u += F.G) topk_unit(F, u >> 4, u & 15);
        p7_expert_weights<0>(F);
    } SEAM(7);
    if (IN(8)) {
        const bool wd_first = (F.vcu & 1) == 0;
        if (wd_first) { p7_expert_weights<1>(F); __syncthreads(); }
        pg8::Gemm g{WSP(const bf16_t, WS_H), WSP(const bf16_t, WS_WGU), MROWS, 3072, 1024, 16, WSP(const int, WS_VOFF)};
        pg8::StaticOrder S; S.init(MROWS, 3072, F.G, (int)blockIdx.x);
        EpiGU E{WSP(bf16_t, WS_HID)};
        pg8::gemm_phase<EpiGU, true, true>(F.lds, g, S, E);
#if DBG_REP_P8 > 1
          pg8::gemm_phase<EpiGU, false, true>(F.lds, g, S, E);
#endif
        if (!wd_first) { __syncthreads(); p7_expert_weights<1>(F); }
    } SEAM(8);
    if (IN(9)) {
        pg8::Gemm g{WSP(const bf16_t, WS_HID), WSP(const bf16_t, WS_WD), MROWS, 1024, D_FF, 16, nullptr};
        pg8::StaticOrder S; S.init(MROWS, 1024, F.G, (int)blockIdx.x);
        EpiDown E{WSP(bf16_t, WS_Y), WSP(const float, WS_VALS)};
        pg8::gemm_phase<EpiDown, false, true>(F.lds, g, S, E);
#if DBG_REP_P9 > 1
          pg8::gemm_phase<EpiDown, false, true>(F.lds, g, S, E);
#endif

    } SEAM(9);
    if (IN(10)) {
#ifdef DBG_REP_P10
        p10_final(F, WSP(float, WS_Z)); __syncthreads();
#endif
        p10_final(F); }
#undef IN
#undef SEAM
}

extern "C" void kernel_launch(void* const* d_in, const int* in_sizes, int n_in, void* d_out, int out_size, void* d_ws, size_t ws_size, hipStream_t stream) {
    static int grid = 0;
    if (grid == 0) {
        if (n_in != 19 || in_sizes[0] != M_TOK * D_MODEL || out_size != M_TOK * D_MODEL || ws_size < WS_END) {
            fprintf(stderr, "kernel_launch: unexpected shapes (n_in %d, in0 %d, out %d, ws %zu); nothing launched\n", n_in, n_in > 0 ? in_sizes[0] : -1, out_size, ws_size); grid = -1; return; }
        int dev = 0, cus = 0, per_cu = 0;
        if (hipGetDevice(&dev) != hipSuccess || hipDeviceGetAttribute(&cus, hipDeviceAttributeMultiprocessorCount, dev) != hipSuccess) { grid = -1; return; }
        if (hipFuncSetAttribute((const void*)fwd_kernel, hipFuncAttributeMaxDynamicSharedMemorySize, LDS_BYTES) != hipSuccess) { fprintf(stderr, "kernel_launch: hipFuncSetAttribute failed\n"); grid = -1; return; }
        if (hipOccupancyMaxActiveBlocksPerMultiprocessor(&per_cu, (const void*)fwd_kernel, NTHR, LDS_BYTES) != hipSuccess || per_cu < 1)
            fprintf(stderr, "kernel_launch: note: occupancy query reports %d workgroups per CU\n", per_cu);
        (void)hipGetLastError();
        grid = cus < 256 ? cus : 256;
    }
    if (grid < 0) return;
    (void)hipMemsetAsync((char*)d_ws + WS_CTL, 0, CTL_ZERO_BYTES, stream);
    Args a{};
    a.x = (const float*)d_in[0]; a.c = (const float*)d_in[1]; a.w_ada = (const float*)d_in[2]; a.b_ada = (const float*)d_in[3]; a.w_in = (const float*)d_in[4];
    a.q_norm_g = (const float*)d_in[5]; a.w_uq = (const float*)d_in[6]; a.kv_norm_g = (const float*)d_in[7]; a.w_ukv = (const float*)d_in[8]; a.rel_bias = (const float*)d_in[9];
    a.w_out = (const float*)d_in[10]; a.ln1_g = (const float*)d_in[11]; a.ln1_b = (const float*)d_in[12]; a.w_router = (const float*)d_in[13]; a.w_gate = (const float*)d_in[14];
    a.w_up = (const float*)d_in[15]; a.w_down = (const float*)d_in[16]; a.ln2_g = (const float*)d_in[17]; a.ln2_b = (const float*)d_in[18];
    a.out = (float*)d_out; a.ws = (unsigned char*)d_ws;
#if MK_ONE_LAUNCH
    a.ph_lo = 0; a.ph_hi = N_PHASES;
    hipLaunchKernelGGL(fwd_kernel, dim3(grid), dim3(NTHR), LDS_BYTES, stream, a);
#else
    for (int p = 0; p < N_PHASES; ++p) { a.ph_lo = p; a.ph_hi = p + 1; hipLaunchKernelGGL(fwd_kernel, dim3(grid), dim3(NTHR), LDS_BYTES, stream, a); }
#endif
}
```

```cpp
#include <hip/hip_runtime.h>
#include <cstdio>
#include <cstdint>

#ifndef MK_ONE_LAUNCH
#define MK_ONE_LAUNCH 1
#endif

#define LAS __attribute__((address_space(3)))
#define GAS __attribute__((address_space(1)))
typedef unsigned short bf16_t;
typedef short bf16x8 __attribute__((ext_vector_type(8)));
typedef short s16x4 __attribute__((ext_vector_type(4)));
typedef float f32x4 __attribute__((ext_vector_type(4)));
typedef float f32x2 __attribute__((ext_vector_type(2)));
typedef float f32x16 __attribute__((ext_vector_type(16)));
typedef unsigned u32x4 __attribute__((ext_vector_type(4)));
typedef unsigned u32x2 __attribute__((ext_vector_type(2)));
typedef int i32x4 __attribute__((ext_vector_type(4)));
typedef int i32x8 __attribute__((ext_vector_type(8)));

constexpr int D_MODEL = 1024, BATCH = 8, SEQ = 4096, M_TOK = BATCH * SEQ;
constexpr int MLA_H = 8, MLA_NOPE = 64, MLA_ROPE = 32, MLA_V = 64, Q_LORA = 384, KV_LORA = 256, MLA_DQ = 96;
constexpr int DIL_H = 8, DIL_D = 64;
constexpr int N_EXP = 16, CAP = 512, D_FF = 1536;
constexpr int IN_W = 2208, IN_WP = 2304;
constexpr float ALPHA = 1.189207115002721f;
constexpr float NORM_EPS = 1e-6f;
constexpr float LOG2E = 1.4426950408889634f;
constexpr float QS_MLA = 0.10206207261596575f * LOG2E;
constexpr float Q8_SCALE = QS_MLA * 2.f * 8.f, K8_SCALE = 0.5f;
constexpr float QS_DIL = 0.125f * LOG2E;
constexpr float NEG_BIG = -1e30f;
#ifndef DBG_MLA_F
#define DBG_MLA_F 1.f
#endif
#ifndef DBG_DIL_F
#define DBG_DIL_F 1.f
#endif
#ifndef DBG_XEXP
#define DBG_XEXP 0
#endif
#ifndef DBG_REP_P0
#define DBG_REP_P0 1
#endif
#ifndef DBG_REP_P7
#define DBG_REP_P7 1
#endif
#ifndef DBG_REP_MLA
#define DBG_REP_MLA 1
#endif
#ifndef DBG_REP_DIL
#define DBG_REP_DIL 1
#endif
#ifndef DBG_REP_P8
#define DBG_REP_P8 1
#endif
#ifndef DBG_REP_P2
#define DBG_REP_P2 1
#endif
#ifndef DBG_REP_P9
#define DBG_REP_P9 1
#endif
#ifndef DBG_REP_P5
#define DBG_REP_P5 1
#endif
#ifndef DBG_REP_THIN
#define DBG_REP_THIN 1
#endif
#ifndef DBG_REP_P3G
#define DBG_REP_P3G 1
#endif
#ifndef DBG_MIX_F
#define DBG_MIX_F 1.f
#endif
#ifndef DBG_MOE_F
#define DBG_MOE_F 1.f
#endif
constexpr float WGU_SCALE = 32.f, WD_SCALE = 64.f, HID_SCALE = 4.f, WIN_SCALE = 32.f, WOUT_SCALE = 32.f, MIX_SCALE = 16.f, Y_SCALE = 64.f;
constexpr int MROWS = N_EXP * BATCH * CAP;

constexpr size_t MiB = 1u << 20;
constexpr size_t WS_CTL = 0, CTL_ZERO_BYTES = 1 * MiB;
constexpr size_t WS_ROPE = 1 * MiB;
constexpr size_t WS_TABG = 1 * MiB + 512 * 1024;
constexpr size_t WS_MODP = 2 * MiB;
constexpr size_t WS_MOD = 5 * MiB;
constexpr size_t WS_AFF = 6 * MiB;
constexpr size_t WS_STAT = 8 * MiB;
constexpr size_t WS_VALS = 8 * MiB + 256 * 1024;
constexpr size_t WS_INV = 9 * MiB;
constexpr size_t WS_SSQ = 11 * MiB;
constexpr size_t WS_WIN = 16 * MiB;
constexpr size_t WS_WUQ = 21 * MiB;
constexpr size_t WS_WK = 22 * MiB;
constexpr size_t WS_WV = 22 * MiB + 512 * 1024;
constexpr size_t WS_WOUT = 23 * MiB;
constexpr size_t WS_LSE = 26 * MiB;
constexpr size_t WS_H = 32 * MiB;
constexpr size_t WS_O1 = 32 * MiB, WS_O2 = 64 * MiB;
constexpr size_t WS_WGU = 96 * MiB;
constexpr size_t WS_WD = 192 * MiB;
constexpr size_t WS_CQ = 96 * MiB;
constexpr size_t WS_CKV = 120 * MiB;
constexpr size_t WS_KR = 136 * MiB;
constexpr size_t WS_DQ = 138 * MiB, WS_DK = 170 * MiB, WS_DV = 202 * MiB;
constexpr size_t WS_Q = 240 * MiB;
constexpr size_t WS_KN = 288 * MiB;
constexpr size_t WS_V = 320 * MiB;
constexpr size_t WS_Z = 240 * MiB;
constexpr size_t WS_MIX = 368 * MiB;
constexpr size_t WS_HID = 240 * MiB;
constexpr size_t WS_VOFF = 336 * MiB;
constexpr size_t WS_XG = 336 * MiB;
constexpr size_t WS_Y = 32 * MiB;
constexpr size_t WS_END = 432 * MiB;
constexpr int CW_BAR = 4096;
constexpr int CW_QUEUE = 64;

constexpr int RING_BYTES = 147456;
constexpr int MISC_OFF = RING_BYTES;
constexpr int LDS_BYTES = RING_BYTES + 512;
constexpr int NWAVES = 8, NTHR = 512;

__device__ __forceinline__ unsigned f2bf(float f) { unsigned u = __builtin_bit_cast(unsigned, f); return (u + 0x7fffu + ((u >> 16) & 1u)) >> 16; }
__device__ __forceinline__ unsigned pk2(float lo, float hi) { return f2bf(lo) | (f2bf(hi) << 16); }
__device__ __forceinline__ unsigned cvt_pk_bf16(float lo, float hi) { unsigned r; asm volatile("v_cvt_pk_bf16_f32 %0, %1, %2" : "=v"(r) : "v"(lo), "v"(hi)); return r; }
__device__ __forceinline__ float bf_lo(unsigned w) { return __builtin_bit_cast(float, w << 16); }
__device__ __forceinline__ float bf_hi(unsigned w) { return __builtin_bit_cast(float, w & 0xffff0000u); }
template <int CTRL> __device__ __forceinline__ float dpp_f(float v) { return __builtin_bit_cast(float, __builtin_amdgcn_update_dpp(0, __builtin_bit_cast(int, v), CTRL, 0xF, 0xF, true)); }
__device__ __forceinline__ float lane_f(float v, int l) { return __builtin_bit_cast(float, __builtin_amdgcn_readlane(__builtin_bit_cast(int, v), l)); }
__device__ __forceinline__ float wave_sum(float v) {
    v += dpp_f<0xB1>(v); v += dpp_f<0x4E>(v); v += dpp_f<0x141>(v); v += dpp_f<0x140>(v);
    return (lane_f(v, 0) + lane_f(v, 16)) + (lane_f(v, 32) + lane_f(v, 48));
}
__device__ __forceinline__ float wave_max(float v) {
    v = fmaxf(v, dpp_f<0xB1>(v)); v = fmaxf(v, dpp_f<0x4E>(v)); v = fmaxf(v, dpp_f<0x141>(v)); v = fmaxf(v, dpp_f<0x140>(v));
    return fmaxf(fmaxf(lane_f(v, 0), lane_f(v, 16)), fmaxf(lane_f(v, 32), lane_f(v, 48)));
}
#ifndef DBG_FP8_EMU
#define DBG_FP8_EMU 0
#endif
#ifndef DBG_HID_S
#define DBG_HID_S 4.f
#endif
__device__ __forceinline__ unsigned pk4_fp8(float a, float b, float c, float d) {
    a = __builtin_amdgcn_fmed3f(a, -448.f, 448.f); b = __builtin_amdgcn_fmed3f(b, -448.f, 448.f); c = __builtin_amdgcn_fmed3f(c, -448.f, 448.f); d = __builtin_amdgcn_fmed3f(d, -448.f, 448.f);
    int p = __builtin_amdgcn_cvt_pk_fp8_f32(a, b, 0, false); p = __builtin_amdgcn_cvt_pk_fp8_f32(c, d, p, true); return (unsigned)p;
}
__device__ __forceinline__ unsigned pk4_fp8_nc(float a, float b, float c, float d) { int p = __builtin_amdgcn_cvt_pk_fp8_f32(a, b, 0, false); p = __builtin_amdgcn_cvt_pk_fp8_f32(c, d, p, true); return (unsigned)p; }
__device__ __forceinline__ float q8(float x, float sc, float isc) {
#if DBG_FP8_EMU
    const int p = __builtin_amdgcn_cvt_pk_fp8_f32(x * sc, 0.f, 0, false); return __builtin_amdgcn_cvt_f32_fp8(p, 0) * isc;
#else
    return x;
#endif
}
#define LDS_WAIT() asm volatile("s_waitcnt lgkmcnt(0)" ::: "memory")
#define VM_WAIT() asm volatile("s_waitcnt vmcnt(0)" ::: "memory")

namespace pg8 {
constexpr int BM = 256, BK = 64, HALF = 128, HTB = HALF * BK * 2, STAGE_BYTES = 8 * HTB, NXCD = 8, WGM = 8;
__host__ __device__ __forceinline__ int lds_byte(int r, int c) { const int st = (r >> 4) * 2 + (c >> 5), rr = r & 15, cc = c & 31, ob = rr * 64 + cc * 2; return st * 1024 + (ob ^ (((ob >> 9) & 1) << 5)); }
__host__ __device__ __forceinline__ void stage_rc(int b, int& R, int& C) { const int st = b / 1024, sb = b % 1024, swz = sb ^ (((sb >> 9) & 1) << 5); R = (st >> 1) * 16 + swz / 64; C = (st & 1) * 32 + (swz % 64) / 2; }
__host__ __device__ __forceinline__ int perm32(int rho) { const int n = rho >> 4, i = rho & 15; return 8 * (i >> 2) + 4 * n + (i & 3); }

struct Unit { int pm, pn; };
struct Gemm { const bf16_t* A; const bf16_t* Bt; int M, N, K; int grp; const int* rowsrc; };

struct StaticOrder {
    int nM, nN, nwg, G, c;
    __device__ void init(int M, int N, int G_, int c_) { nM = M / BM; nN = N / BM; nwg = nM * nN; G = G_; c = c_; }
    __device__ bool next(int i, Unit& u) const {
        const long L = (long)i * G + c; if (L >= nwg) return false;
        int wgid = (int)L; { const int q = nwg / NXCD, r = nwg % NXCD, xcd = wgid % NXCD, off = wgid / NXCD; wgid = (xcd < r ? xcd * (q + 1) : r * (q + 1) + (xcd - r) * q) + off; }
        const int nig = WGM * nN, gid = wgid / nig, fm = gid * WGM, gsz = (nM - fm) < WGM ? (nM - fm) : WGM;
        u.pm = fm + ((wgid % nig) % gsz); u.pn = (wgid % nig) / gsz; return true;
    }
};

using ::i32x4; using ::i32x8;
template <class Epi, bool GATHER, bool FP8 = false>
__device__ __forceinline__ void gemm_phase(LAS unsigned char* lds, const Gemm g, const StaticOrder& S, const Epi& E) {
    const int tid = threadIdx.x, wid = __builtin_amdgcn_readfirstlane(tid >> 6), lane = tid & 63, wr = wid >> 2, wc = wid & 3, fr = lane & 15, fq = lane >> 4;
    const int K = g.K, KB = FP8 ? g.K : g.K * 2, nt = KB / 128, nN = g.N / BM;
    unsigned voffA[2], voffB[2];
#pragma unroll
    for (int i = 0; i < 2; ++i) { int R, C; stage_rc(tid * 16 + i * 8192, R, C); const int Rb = (R & ~31) + perm32(R & 31);
        voffA[i] = (unsigned)(R * KB + C * 2); voffB[i] = (unsigned)(Rb * KB + C * 2); }
    const size_t kstep = (size_t)(BK * 2);
    const size_t hstep = GATHER ? (size_t)0 : (size_t)HALF * KB;
    const size_t hstepB = (size_t)HALF * KB, tstep = 2 * hstepB;
    const unsigned ldsw = (unsigned)wid * 1024u;
    const int aoff = lds_byte(wr * 64 + fr, fq * 8), boff = lds_byte(wc * 32 + fr, fq * 8);
#define PG8_SA(b, h) (((b) * 2 + (h)) * HTB)
#define PG8_SB(b, h) ((4 + (b) * 2 + (h)) * HTB)
    const unsigned lds_base_u = (unsigned)__builtin_amdgcn_readfirstlane((int)(unsigned)(uintptr_t)lds + (int)ldsw);
#define PG8_STAGE(bufoff, gbase, voff) do { _Pragma("unroll") for (int _i = 0; _i < 2; ++_i) { \
        if constexpr (FP8) { unsigned keep_; asm volatile("s_mov_b32 %0, m0\n\ts_mov_b32 m0, %3\n\ts_nop 0\n\tglobal_load_lds_dwordx4 %1, %2\n\ts_mov_b32 m0, %0" \
              : "=&s"(keep_) : "v"((voff)[_i]), "s"((const char*)(gbase)), "s"(lds_base_u + (unsigned)((bufoff) + _i * 8192)) : "memory"); } \
        else __builtin_amdgcn_global_load_lds((const unsigned*)((const char*)(gbase) + (voff)[_i]), (LAS unsigned*)(lds + (bufoff) + ldsw + _i * 8192), 16, 0, 0); } } while (0)
#define PG8_LDA(dst, b, h) do { _Pragma("unroll") for (int m = 0; m < 4; ++m) _Pragma("unroll") for (int k = 0; k < 2; ++k) dst[m][k] = *(const LAS bf16x8*)(lds + PG8_SA(b, h) + aoff + m * 2048 + k * 1024); } while (0)
#define PG8_LDB(dst, b, h) do { _Pragma("unroll") for (int n = 0; n < 2; ++n) _Pragma("unroll") for (int k = 0; k < 2; ++k) dst[n][k] = *(const LAS bf16x8*)(lds + PG8_SB(b, h) + boff + n * 2048 + k * 1024); } while (0)
#define PG8_MMA(ai, bj, At, Bt) do { __builtin_amdgcn_s_setprio(1); _Pragma("unroll") for (int m = 0; m < 4; ++m) _Pragma("unroll") for (int n = 0; n < 2; ++n) { \
        if constexpr (FP8) { const i32x8 b8_ = __builtin_shufflevector(__builtin_bit_cast(i32x4, Bt[n][0]), __builtin_bit_cast(i32x4, Bt[n][1]), 0, 1, 2, 3, 4, 5, 6, 7); \
            const i32x8 a8_ = __builtin_shufflevector(__builtin_bit_cast(i32x4, At[m][0]), __builtin_bit_cast(i32x4, At[m][1]), 0, 1, 2, 3, 4, 5, 6, 7); \
            asm volatile("v_mfma_f32_16x16x128_f8f6f4 %0, %1, %2, %0" : "+v"(acc[ai][bj][m][n]) : "v"(b8_), "v"(a8_)); } \
        else { _Pragma("unroll") for (int k = 0; k < 2; ++k) acc[ai][bj][m][n] = __builtin_amdgcn_mfma_f32_16x16x32_bf16(Bt[n][k], At[m][k], acc[ai][bj][m][n], 0, 0, 0); } } \
        __builtin_amdgcn_s_setprio(0); } while (0)
#define PG8_WAIT_V(n) asm volatile("s_waitcnt vmcnt(" #n ")" ::: "memory")
#define PG8_WAIT_L(n) asm volatile("s_waitcnt lgkmcnt(" #n ")" ::: "memory")
#define PG8_BAR __builtin_amdgcn_s_barrier()
#define PG8_SCHED __builtin_amdgcn_sched_barrier(0)
#define PG8_ASRC(U) (GATHER ? (const char*)g.A + (size_t)(((U).pm >> 1) & 7) * ((size_t)SEQ * KB) : (const char*)g.A + (size_t)(U).pm * tstep)
#define PG8_GV(U) (*(const u32x4*)((const unsigned*)g.rowsrc + ((size_t)(U).pm * 512 + tid) * 4))
#define PG8_BSRC(U) ((const char*)g.Bt + (size_t)(((U).pm / g.grp) * nN + (U).pn) * tstep)
    Unit cur, nxt; int ui = 0;
    if (!S.next(0, cur)) return;
    u32x4 gvc = (u32x4){0u, 0u, 0u, 0u}, gvn = gvc, gvnn = gvc;
    if constexpr (GATHER) { gvc = PG8_GV(cur); Unit t1; gvn = S.next(1, t1) ? PG8_GV(t1) : gvc; }
#define PG8_STAGE_A(bufoff, base, H, NEXT) do { if constexpr (GATHER) { const bool nx_ = (NEXT); unsigned va_[2] = {nx_ ? gvn[2 * (H)] : gvc[2 * (H)], nx_ ? gvn[2 * (H) + 1] : gvc[2 * (H) + 1]}; PG8_STAGE(bufoff, base, va_); } \
        else PG8_STAGE(bufoff, (base) + (H) * hstep, voffA); } while (0)
    f32x4 acc[2][2][4][2];
#pragma unroll
    for (int a = 0; a < 2; ++a)
#pragma unroll
        for (int b = 0; b < 2; ++b)
#pragma unroll
            for (int m = 0; m < 4; ++m)
#pragma unroll
                for (int n = 0; n < 2; ++n) acc[a][b][m][n] = (f32x4){0.f, 0.f, 0.f, 0.f};
    bf16x8 At[4][2], B0[2][2], B1[2][2];
    const char* cA = PG8_ASRC(cur);
    const char* cB = PG8_BSRC(cur);
    PG8_STAGE(PG8_SB(0, 0), cB, voffB); PG8_STAGE(PG8_SB(0, 1), cB + hstepB, voffB); PG8_STAGE_A(PG8_SA(0, 0), cA, 0, false); PG8_STAGE_A(PG8_SA(0, 1), cA, 1, false);
    if (wr == 1) PG8_BAR;
    PG8_WAIT_V(2); PG8_BAR;
    PG8_STAGE(PG8_SB(1, 0), cB + kstep, voffB); PG8_STAGE_A(PG8_SA(1, 0), cA + kstep, 0, false); PG8_STAGE(PG8_SB(1, 1), cB + hstepB + kstep, voffB);
    PG8_WAIT_V(6); PG8_BAR;
    for (;;) {
        const bool has_next = S.next(ui + 1, nxt);
        const char* nA = cA; const char* nB = cB;
        if (has_next) { nA = PG8_ASRC(nxt); nB = PG8_BSRC(nxt); }
#pragma unroll 1
        for (int t = 0; t < nt; t += 2) {
            const bool last = (t == nt - 2);
            const char* a1 = cA + (size_t)(t + 1) * kstep;
            const char* a2 = last ? nA : cA + (size_t)(t + 2) * kstep; const char* b2 = last ? nB : cB + (size_t)(t + 2) * kstep;
            const char* a3 = a2 + kstep; const char* b3 = b2 + kstep;
            PG8_LDB(B0, 0, 0); PG8_LDB(B1, 0, 1); PG8_SCHED; PG8_LDA(At, 0, 0); PG8_STAGE_A(PG8_SA(1, 1), a1, 1, false);
            PG8_WAIT_V(8); PG8_WAIT_L(0); PG8_BAR; PG8_MMA(0, 0, At, B0); PG8_MMA(0, 1, At, B1); PG8_BAR; PG8_SCHED;
            PG8_LDA(At, 0, 1); PG8_STAGE(PG8_SB(0, 0), b2, voffB); PG8_STAGE(PG8_SB(0, 1), b2 + hstepB, voffB); PG8_STAGE_A(PG8_SA(0, 0), a2, 0, last);
            PG8_WAIT_V(8); PG8_WAIT_L(0); PG8_BAR; PG8_MMA(1, 0, At, B0); PG8_MMA(1, 1, At, B1); PG8_BAR; PG8_SCHED;
            PG8_LDB(B0, 1, 0); PG8_LDB(B1, 1, 1); PG8_SCHED; PG8_LDA(At, 1, 0); PG8_STAGE_A(PG8_SA(0, 1), a2, 1, last);
            PG8_WAIT_V(8); PG8_WAIT_L(0); PG8_BAR; PG8_MMA(0, 0, At, B0); PG8_MMA(0, 1, At, B1); PG8_BAR; PG8_SCHED;
            PG8_LDA(At, 1, 1); PG8_STAGE(PG8_SB(1, 0), b3, voffB); PG8_STAGE(PG8_SB(1, 1), b3 + hstepB, voffB); PG8_STAGE_A(PG8_SA(1, 0), a3, 0, last);
            PG8_WAIT_V(8); PG8_WAIT_L(0); PG8_BAR; PG8_MMA(1, 0, At, B0); PG8_MMA(1, 1, At, B1); PG8_BAR; PG8_SCHED;
        }
        if (wr == 0) PG8_BAR;
        if constexpr (FP8) asm volatile("s_nop 15\n\ts_nop 15\n\ts_nop 15\n\ts_nop 15" ::: "memory");
        if constexpr (GATHER) { Unit t2; gvnn = S.next(ui + 2, t2) ? PG8_GV(t2) : gvn; }
        E(acc, cur, wr, wc, fr, fq);
        if (!has_next) break;
        if constexpr (GATHER) { gvc = gvn; gvn = gvnn; }
#pragma unroll
        for (int a = 0; a < 2; ++a)
#pragma unroll
            for (int b = 0; b < 2; ++b)
#pragma unroll
                for (int m = 0; m < 4; ++m)
#pragma unroll
                    for (int n = 0; n < 2; ++n) acc[a][b][m][n] = (f32x4){0.f, 0.f, 0.f, 0.f};
        cur = nxt; cA = nA; cB = nB; ++ui;
        if (wr == 1) PG8_BAR;
    }
    PG8_WAIT_V(0);
    PG8_BAR;
#undef PG8_STAGE_A
#undef PG8_GV
#undef PG8_SA
#undef PG8_SB
#undef PG8_STAGE
#undef PG8_LDA
#undef PG8_LDB
#undef PG8_MMA
#undef PG8_WAIT_V
#undef PG8_WAIT_L
#undef PG8_BAR
#undef PG8_SCHED
#undef PG8_ASRC
#undef PG8_BSRC
}
}

#define XB_TMO      128
#define XB_XCNT(j)  (256  + 64 * (j))
#define XB_XSUB(j)  (1280 + 64 * (j))
#define XB_XGEN(j)  (2304 + 64 * (j))
#define XB_TOP      3328
#define XB_TOPGEN   3392
#define XCD_BAR_WORDS 3456
#define XB_SPIN_CAP (1u << 18)
__device__ __forceinline__ unsigned xb_ld(unsigned* p)              { return __hip_atomic_load(p, __ATOMIC_RELAXED, __HIP_MEMORY_SCOPE_AGENT); }
__device__ __forceinline__ unsigned xb_add(unsigned* p, unsigned v) { return __hip_atomic_fetch_add(p, v, __ATOMIC_RELAXED, __HIP_MEMORY_SCOPE_AGENT); }
__device__ __forceinline__ unsigned xb_xcc_id() { return (unsigned)__builtin_amdgcn_s_getreg((3 << 11) | 20) & 0xFu; }
#define XB_SPIN(cond, bar) do { unsigned _sp = 0; while (cond) { __builtin_amdgcn_s_sleep(1); \
    if ((++_sp & 255u) == 0u) { if (xb_ld(&(bar)[XB_TMO])) break; if (_sp > XB_SPIN_CAP) { atomicAdd(&(bar)[XB_TMO], 1u); break; } } } } while (0)
struct XcdBarrier { unsigned* bar; unsigned x; volatile LAS unsigned* st; };
__device__ __forceinline__ XcdBarrier xcd_barrier_post(unsigned* bar, volatile LAS unsigned* st) {
    XcdBarrier b; b.bar = bar; b.x = xb_xcc_id(); b.st = st;
    if (threadIdx.x == 0) (void)xb_add(&bar[XB_XCNT(b.x)], 1u);
    return b;
}
__device__ __forceinline__ void xcd_barrier_complete(unsigned* bar, unsigned x, unsigned& nloc, unsigned& nx) {
    const unsigned G = gridDim.x * gridDim.y * gridDim.z;
    unsigned sum, cnt, mine, sp = 0u;
    for (;;) {
        sum = 0u; cnt = 0u; mine = 0u;
#pragma unroll
        for (unsigned j = 0; j < 16; ++j) { const unsigned c = xb_ld(&bar[XB_XCNT(j)]); sum += c; cnt += (c > 0u) ? 1u : 0u; mine = (j == x) ? c : mine; }
        if (sum == G) break;
        __builtin_amdgcn_s_sleep(1);
        if ((++sp & 255u) == 0u) { if (xb_ld(&bar[XB_TMO])) break; if (sp > XB_SPIN_CAP) { atomicAdd(&bar[XB_TMO], 1u); break; } }
    }
    nloc = mine > 0u ? mine : 1u; nx = cnt > 0u ? cnt : 1u;
}
__device__ __forceinline__ void xcd_barrier(const XcdBarrier& b) {
    asm volatile("s_waitcnt vmcnt(0)" ::: "memory");
    __syncthreads();
    if (threadIdx.x == 0) {
        unsigned* bar = b.bar;
        __builtin_amdgcn_s_waitcnt(0);
        unsigned nloc = b.st[0], nx = b.st[1];
        if (nloc == 0u) { xcd_barrier_complete(bar, b.x, nloc, nx); b.st[0] = nloc; b.st[1] = nx; }
        const unsigned old = xb_add(&bar[XB_XSUB(b.x)], 1u);
        const unsigned gen = old / nloc;
        if (old + 1u == (gen + 1u) * nloc) {
            __builtin_amdgcn_fence(__ATOMIC_RELEASE, "agent");
            asm volatile("s_waitcnt vmcnt(0)" ::: "memory");
            const unsigned og = xb_add(&bar[XB_TOP], 1u);
            const unsigned tg = og / nx;
            if (og + 1u == (tg + 1u) * nx) xb_add(&bar[XB_TOPGEN], 1u);
            else XB_SPIN(xb_ld(&bar[XB_TOPGEN]) == tg, bar);
            __builtin_amdgcn_fence(__ATOMIC_ACQUIRE, "agent");
            xb_add(&bar[XB_XGEN(b.x)], 1u);
            asm volatile("s_waitcnt vmcnt(0)" ::: "memory");
        } else {
            XB_SPIN(xb_ld(&bar[XB_XGEN(b.x)]) == gen, bar);
            __builtin_amdgcn_fence(__ATOMIC_ACQUIRE, "agent");
            asm volatile("s_waitcnt vmcnt(0)" ::: "memory");
        }
    }
    __syncthreads();
}

struct Args {
    const float *x, *c, *w_ada, *b_ada, *w_in, *q_norm_g, *w_uq, *kv_norm_g, *w_ukv, *rel_bias, *w_out, *ln1_g, *ln1_b, *w_router, *w_gate, *w_up, *w_down, *ln2_g, *ln2_b;
    float* out; unsigned char* ws; int ph_lo, ph_hi;
};
struct Frame {
    LAS unsigned char* lds;
    int tid, lane, wave, vcu, G;
    unsigned char* ws;
};
#define WSP(T, off) ((T*)(F.ws + (off)))
typedef const __attribute__((address_space(4))) Args* KArgs;
__device__ __forceinline__ KArgs kargs() { KArgs p = (KArgs)__builtin_amdgcn_kernarg_segment_ptr(); asm volatile("" : "+s"(p)); return p; }

using pg8::Unit;
#define DPERM(s_) ((((s_) & 15) << 8) + ((s_) >> 4))
struct EpiProj {
    bf16_t *CQ, *CKV, *KR, *DQ; float* SSQ; const float* rope;
    __device__ __forceinline__ void operator()(const f32x4 (&acc)[2][2][4][2], const Unit& u, int wr, int wc, int fr, int fq) const {
        const int pn = u.pn;
        if (pn >= 3) {
            const int t = pn - 3; bf16_t* base = DQ + (size_t)(t >> 1) * ((WS_DK - WS_DQ) / 2); const float sc = (t < 2 ? QS_DIL : 1.f) * (1.f / WIN_SCALE);
            const int col0 = (t & 1) * 256 + wc * 32 + 8 * fq;
#pragma unroll
            for (int ai = 0; ai < 2; ++ai)
#pragma unroll
                for (int m = 0; m < 4; ++m) { const size_t row = (size_t)u.pm * 256 + ai * 128 + wr * 64 + m * 16 + fr;
#pragma unroll
                    for (int bj = 0; bj < 2; ++bj) { const f32x4 v0 = acc[ai][bj][m][0] * sc, v1 = acc[ai][bj][m][1] * sc;
                        u32x4 w; w.x = cvt_pk_bf16(v0[0], v0[1]); w.y = cvt_pk_bf16(v0[2], v0[3]); w.z = cvt_pk_bf16(v1[0], v1[1]); w.w = cvt_pk_bf16(v1[2], v1[3]);
                        const int col = col0 + bj * 128;
                        *(u32x4*)(base + ((size_t)((int)(row >> 12) * 8 + (col >> 6)) * SEQ + DPERM((int)row & (SEQ - 1))) * 64 + (col & 63)) = w; } }
        } else {
#pragma unroll
            for (int ai = 0; ai < 2; ++ai)
#pragma unroll
                for (int m = 0; m < 4; ++m) { const size_t row = (size_t)u.pm * 256 + ai * 128 + wr * 64 + m * 16 + fr;
#pragma unroll
                    for (int bj = 0; bj < 2; ++bj) { const f32x4 v0 = acc[ai][bj][m][0] * (1.f / WIN_SCALE), v1 = acc[ai][bj][m][1] * (1.f / WIN_SCALE);
                        const int seg = pn * 2 + bj;
                        if (seg < 5) {
                            float s = (v0[0] * v0[0] + v0[1] * v0[1]) + (v0[2] * v0[2] + v0[3] * v0[3]) + (v1[0] * v1[0] + v1[1] * v1[1]) + (v1[2] * v1[2] + v1[3] * v1[3]);
                            s += __shfl_xor(s, 16); s += __shfl_xor(s, 32);
                            if (fq == 0) SSQ[row * 32 + seg * 4 + wc] = s;
                            u32x4 w; w.x = cvt_pk_bf16(v0[0], v0[1]); w.y = cvt_pk_bf16(v0[2], v0[3]); w.z = cvt_pk_bf16(v1[0], v1[1]); w.w = cvt_pk_bf16(v1[2], v1[3]);
                            if (seg < 3) *(u32x4*)(CQ + row * 384 + seg * 128 + wc * 32 + 8 * fq) = w;
                            else *(u32x4*)(CKV + row * 256 + (seg - 3) * 128 + wc * 32 + 8 * fq) = w;
                        } else if (wc == 0) {
                            const int pos = (int)(row & (SEQ - 1)); const float* rp = rope + pos * 32 + 8 * (fq & 1);
                            const f32x4 c0 = *(const f32x4*)(rp), c1 = *(const f32x4*)(rp + 4), s0 = *(const f32x4*)(rp + 16), s1 = *(const f32x4*)(rp + 20);
                            f32x4 o0, o1;
#pragma unroll
                            for (int j = 0; j < 4; ++j) { const float a = v0[j], b = v1[j]; const float pa = __shfl_xor(a, 32), pb = __shfl_xor(b, 32);
                                o0[j] = fq < 2 ? a * c0[j] - pa * s0[j] : pa * s0[j] + a * c0[j];
                                o1[j] = fq < 2 ? b * c1[j] - pb * s1[j] : pb * s1[j] + b * c1[j]; }
                            u32x2 w; w.x = pk4_fp8(o0[0] * K8_SCALE, o0[1] * K8_SCALE, o0[2] * K8_SCALE, o0[3] * K8_SCALE); w.y = pk4_fp8(o1[0] * K8_SCALE, o1[1] * K8_SCALE, o1[2] * K8_SCALE, o1[3] * K8_SCALE);
                            unsigned char* k8 = (unsigned char*)KR + ((size_t)((row >> 12) * 8) * SEQ + (row & (SEQ - 1))) * 128 + 8 * fq;
#pragma unroll
                            for (int hh = 0; hh < 8; ++hh) { *(u32x2*)(k8 + (size_t)hh * SEQ * 128 + 64) = w; *(u32x2*)(k8 + (size_t)hh * SEQ * 128 + 96) = (u32x2){fq == 0 ? 0x00383838u : 0u, 0u}; }
                        } } }
        }
    }
};
struct EpiQ {
    bf16_t* Q; const float* SSQ; const float* rope;
    __device__ __forceinline__ void operator()(const f32x4 (&acc)[2][2][4][2], const Unit& u, int wr, int wc, int fr, int fq) const {
#pragma unroll
        for (int ai = 0; ai < 2; ++ai)
#pragma unroll
            for (int m = 0; m < 4; ++m) { const size_t row = (size_t)u.pm * 256 + ai * 128 + wr * 64 + m * 16 + fr;
                const f32x4 q0 = *(const f32x4*)(SSQ + row * 32), q1 = *(const f32x4*)(SSQ + row * 32 + 4), q2 = *(const f32x4*)(SSQ + row * 32 + 8);
                const float ss = ((q0[0] + q0[1]) + (q0[2] + q0[3])) + ((q1[0] + q1[1]) + (q1[2] + q1[3])) + ((q2[0] + q2[1]) + (q2[2] + q2[3]));
                const float rs = Q8_SCALE / sqrtf(ss * (1.f / Q_LORA) + NORM_EPS);
                const int pos = (int)(row & (SEQ - 1));
#pragma unroll
                for (int bj = 0; bj < 2; ++bj) { f32x4 v0 = acc[ai][bj][m][0] * rs, v1 = acc[ai][bj][m][1] * rs;
                    const int G32 = u.pn * 8 + bj * 4 + wc;
                    if (G32 % 3 == 2) {
                        const float* rp = rope + pos * 32 + 8 * (fq & 1);
                        const f32x4 c0 = *(const f32x4*)(rp), c1 = *(const f32x4*)(rp + 4), s0 = *(const f32x4*)(rp + 16), s1 = *(const f32x4*)(rp + 20);
                        f32x4 o0, o1;
#pragma unroll
                        for (int j = 0; j < 4; ++j) { const float a = v0[j], b = v1[j]; const float pa = __shfl_xor(a, 32), pb = __shfl_xor(b, 32);
                            o0[j] = fq < 2 ? a * c0[j] - pa * s0[j] : pa * s0[j] + a * c0[j];
                            o1[j] = fq < 2 ? b * c1[j] - pb * s1[j] : pb * s1[j] + b * c1[j]; }
                        v0 = o0; v1 = o1;
                    }
                    u32x2 w; w.x = pk4_fp8(v0[0], v0[1], v0[2], v0[3]); w.y = pk4_fp8(v1[0], v1[1], v1[2], v1[3]);
                    unsigned char* q8 = (unsigned char*)Q + ((size_t)((row >> 12) * 8 + G32 / 3) * SEQ + pos) * 128 + (G32 % 3) * 32 + 8 * fq;
                    *(u32x2*)q8 = w; if (G32 % 3 == 2) *(u32x2*)(q8 + 32) = (u32x2){0u, 0u}; }
                asm volatile("" ::: "memory"); }
    }
};
struct EpiKV {
    bf16_t* O; const float* SSQ;
    __device__ __forceinline__ void operator()(const f32x4 (&acc)[2][2][4][2], const Unit& u, int wr, int wc, int fr, int fq) const {
#pragma unroll
        for (int ai = 0; ai < 2; ++ai)
#pragma unroll
            for (int m = 0; m < 4; ++m) { const size_t row = (size_t)u.pm * 256 + ai * 128 + wr * 64 + m * 16 + fr;
                const f32x4 q0 = *(const f32x4*)(SSQ + row * 32 + 12), q1 = *(const f32x4*)(SSQ + row * 32 + 16);
                const float ss = ((q0[0] + q0[1]) + (q0[2] + q0[3])) + ((q1[0] + q1[1]) + (q1[2] + q1[3]));
                const float rs = 1.f / sqrtf(ss * (1.f / KV_LORA) + NORM_EPS);
#pragma unroll
                for (int bj = 0; bj < 2; ++bj) { const f32x4 v0 = acc[ai][bj][m][0] * rs, v1 = acc[ai][bj][m][1] * rs;
                    u32x4 w; w.x = cvt_pk_bf16(v0[0], v0[1]); w.y = cvt_pk_bf16(v0[2], v0[3]); w.z = cvt_pk_bf16(v1[0], v1[1]); w.w = cvt_pk_bf16(v1[2], v1[3]);
                    *(u32x4*)(O + row * 512 + u.pn * 256 + bj * 128 + wc * 32 + 8 * fq) = w; }
                asm volatile("" ::: "memory"); }
    }
};
struct EpiKN8 {
    unsigned char* K8; const float* SSQ;
    __device__ __forceinline__ void operator()(const f32x4 (&acc)[2][2][4][2], const Unit& u, int wr, int wc, int fr, int fq) const {
#pragma unroll
        for (int ai = 0; ai < 2; ++ai)
#pragma unroll
            for (int m = 0; m < 4; ++m) { const size_t row = (size_t)u.pm * 256 + ai * 128 + wr * 64 + m * 16 + fr;
                const f32x4 q0 = *(const f32x4*)(SSQ + row * 32 + 12), q1 = *(const f32x4*)(SSQ + row * 32 + 16);
                const float ss = ((q0[0] + q0[1]) + (q0[2] + q0[3])) + ((q1[0] + q1[1]) + (q1[2] + q1[3]));
                const float rs = K8_SCALE / sqrtf(ss * (1.f / KV_LORA) + NORM_EPS);
#pragma unroll
                for (int bj = 0; bj < 2; ++bj) { const f32x4 v0 = acc[ai][bj][m][0] * rs, v1 = acc[ai][bj][m][1] * rs;
                    const int col = u.pn * 256 + bj * 128 + wc * 32 + 8 * fq;
                    u32x2 w; w.x = pk4_fp8(v0[0], v0[1], v0[2], v0[3]); w.y = pk4_fp8(v1[0], v1[1], v1[2], v1[3]);
                    *(u32x2*)(K8 + ((size_t)((row >> 12) * 8 + (col >> 6)) * SEQ + (row & (SEQ - 1))) * 128 + (col & 63)) = w; }
                asm volatile("" ::: "memory"); }
    }
};
struct EpiVt8 {
    unsigned char* Vt; const float* SSQ;
    __device__ __forceinline__ void operator()(const f32x4 (&acc)[2][2][4][2], const Unit& u, int wr, int wc, int fr, int fq) const {
        float rs[2][8];
#pragma unroll
        for (int bj = 0; bj < 2; ++bj)
#pragma unroll
            for (int j = 0; j < 8; ++j) { const size_t tok = (size_t)u.pn * 256 + bj * 128 + wc * 32 + 8 * fq + j;
                const f32x4 q0 = *(const f32x4*)(SSQ + tok * 32 + 12), q1 = *(const f32x4*)(SSQ + tok * 32 + 16);
                rs[bj][j] = 1.f / sqrtf((((q0[0] + q0[1]) + (q0[2] + q0[3])) + ((q1[0] + q1[1]) + (q1[2] + q1[3]))) * (1.f / KV_LORA) + NORM_EPS); }
#pragma unroll
        for (int ai = 0; ai < 2; ++ai)
#pragma unroll
            for (int m = 0; m < 4; ++m) { const int ch = u.pm * 256 + ai * 128 + wr * 64 + m * 16 + fr;
#pragma unroll
                for (int bj = 0; bj < 2; ++bj) { const f32x4 v0 = acc[ai][bj][m][0], v1 = acc[ai][bj][m][1];
                    const int tok = u.pn * 256 + bj * 128 + wc * 32 + 8 * fq;
                    u32x2 w; w.x = pk4_fp8(v0[0] * rs[bj][0], v0[1] * rs[bj][1], v0[2] * rs[bj][2], v0[3] * rs[bj][3]); w.y = pk4_fp8(v1[0] * rs[bj][4], v1[1] * rs[bj][5], v1[2] * rs[bj][6], v1[3] * rs[bj][7]);
                    *(u32x2*)(Vt + ((size_t)((tok >> 12) * 512 + ch)) * SEQ + (tok & (SEQ - 1))) = w; } }
    }
};
struct EpiOut {
    float* out; const float* mod;
    __device__ __forceinline__ void operator()(const f32x4 (&acc)[2][2][4][2], const Unit& u, int wr, int wc, int fr, int fq) const {
#pragma unroll
        for (int ai = 0; ai < 2; ++ai)
#pragma unroll
            for (int m = 0; m < 4; ++m) { const size_t row = (size_t)u.pm * 256 + ai * 128 + wr * 64 + m * 16 + fr; const int b = (int)(row >> 12);
#pragma unroll
                for (int bj = 0; bj < 2; ++bj) { const int col = u.pn * 256 + bj * 128 + wc * 32 + 8 * fq;
                    const float* gp = mod + b * 6144 + 2048 + col;
                    const f32x4 g0 = *(const f32x4*)gp, g1 = *(const f32x4*)(gp + 4);
                    const f32x4 m0 = g0 * acc[ai][bj][m][0] * (DBG_MIX_F / (WOUT_SCALE * MIX_SCALE)), m1 = g1 * acc[ai][bj][m][1] * (DBG_MIX_F / (WOUT_SCALE * MIX_SCALE));
                    u32x4 w; w.x = cvt_pk_bf16(m0[0], m0[1]); w.y = cvt_pk_bf16(m0[2], m0[3]); w.z = cvt_pk_bf16(m1[0], m1[1]); w.w = cvt_pk_bf16(m1[2], m1[3]);
                    *(u32x4*)((bf16_t*)(out + row * 1024) + col) = w; } }
    }
};
struct EpiGU {
    bf16_t* H;
    __device__ __forceinline__ void operator()(const f32x4 (&acc)[2][2][4][2], const Unit& u, int wr, int wc, int fr, int fq) const {
#pragma unroll
        for (int ai = 0; ai < 2; ++ai)
#pragma unroll
            for (int m = 0; m < 4; ++m) { const unsigned row = (unsigned)(u.pm * 256 + ai * 128 + wr * 64 + m * 16 + fr);
                float o[8];
#pragma unroll
                for (int n = 0; n < 2; ++n)
#pragma unroll
                    for (int j = 0; j < 4; ++j) { const float ag = acc[ai][0][m][n][j], au = acc[ai][1][m][n][j];
                        constexpr float kk = WGU_SCALE * WGU_SCALE / HID_SCALE;
                        const float e = __builtin_amdgcn_exp2f(ag * (-LOG2E / WGU_SCALE));
                        o[n * 4 + j] = (ag * au) * __builtin_amdgcn_rcpf(__builtin_fmaf(e, kk, kk)); }
                u32x2 w; w.x = pk4_fp8(o[0], o[1], o[2], o[3]); w.y = pk4_fp8(o[4], o[5], o[6], o[7]);
                *(u32x2*)((unsigned char*)H + (row * 1536u + (unsigned)(u.pn * 128 + wc * 32 + 8 * fq))) = w; }
    }
};
struct EpiDown {
    bf16_t* Y; const float* vals;
    __device__ __forceinline__ void operator()(const f32x4 (&acc)[2][2][4][2], const Unit& u, int wr, int wc, int fr, int fq) const {
#pragma unroll
        for (int ai = 0; ai < 2; ++ai)
#pragma unroll
            for (int m = 0; m < 4; ++m) { const unsigned row = (unsigned)(u.pm * 256 + ai * 128 + wr * 64 + m * 16 + fr); const float vv = vals[row] * (Y_SCALE / (WD_SCALE * HID_SCALE));
#pragma unroll
                for (int bj = 0; bj < 2; ++bj) { const f32x4 v0 = acc[ai][bj][m][0] * vv, v1 = acc[ai][bj][m][1] * vv;
                    u32x2 w; w.x = pk4_fp8(v0[0], v0[1], v0[2], v0[3]); w.y = pk4_fp8(v1[0], v1[1], v1[2], v1[3]);
                    *(u32x2*)((unsigned char*)Y + (row * 1024u + (unsigned)(u.pn * 256 + bj * 128 + wc * 32 + 8 * fq))) = w; } }
    }
};

__device__ __forceinline__ s16x4 vtr(const LAS char* p) { return __builtin_bit_cast(s16x4, __builtin_amdgcn_ds_read_tr16_b64_v4i16((LAS s16x4*)p)); }
template <int ND0, int KPITCH, bool BIAS>
__device__ __forceinline__ void attn_tile(const LAS char* Kt, const LAS char* Vt, const bf16x8 (&qr)[ND0], float& m_run, float& l_run, f32x16& o0, f32x16& o1,
                                          const LAS float* tab, int lane) {
    const int r32 = lane & 31, hi = lane >> 5;
    f32x16 p0, p1;
#pragma unroll
    for (int r = 0; r < 16; ++r) { p0[r] = 0.f; p1[r] = 0.f; }
    const LAS char* kp = Kt + r32 * KPITCH + hi * 16;
    bf16x8 kf[2 * ND0];
#pragma unroll
    for (int d0 = 0; d0 < ND0; ++d0) { kf[2 * d0] = *(const LAS bf16x8*)(kp + d0 * 32); kf[2 * d0 + 1] = *(const LAS bf16x8*)(kp + 32 * KPITCH + d0 * 32); }
#pragma unroll
    for (int d0 = 0; d0 < ND0; ++d0) {
        p0 = __builtin_amdgcn_mfma_f32_32x32x16_bf16(kf[2 * d0], qr[d0], p0, 0, 0, 0);
        p1 = __builtin_amdgcn_mfma_f32_32x32x16_bf16(kf[2 * d0 + 1], qr[d0], p1, 0, 0, 0);
    }
    const LAS char* vp = Vt + (4 * hi + ((lane & 15) >> 2)) * 64 + ((lane >> 4) & 1) * 32 + (lane & 3) * 8;
    bf16x8 vf[8];
#pragma unroll
    for (int ks = 0; ks < 4; ++ks) {
        const s16x4 l0 = vtr(vp + ks * 1024), h0 = vtr(vp + ks * 1024 + 512), l1 = vtr(vp + 4096 + ks * 1024), h1 = vtr(vp + 4096 + ks * 1024 + 512);
        vf[2 * ks] = (bf16x8){l0[0], l0[1], l0[2], l0[3], h0[0], h0[1], h0[2], h0[3]}; vf[2 * ks + 1] = (bf16x8){l1[0], l1[1], l1[2], l1[3], h1[0], h1[1], h1[2], h1[3]};
    }
    __builtin_amdgcn_sched_barrier(0);
    if constexpr (BIAS) {
#pragma unroll
        for (int r = 0; r < 16; ++r) { const int kvl = (r & 3) + 8 * (r >> 2) + 4 * hi; p0[r] += tab[kvl]; p1[r] += tab[kvl + 32]; }
    }
    float mx = fmaxf(p0[0], p1[0]);
#pragma unroll
    for (int r = 1; r < 16; ++r) mx = fmaxf(mx, fmaxf(p0[r], p1[r]));
    mx = fmaxf(mx, __shfl_xor(mx, 32));
    const float m_new = fmaxf(m_run, mx);
    const float alpha = __builtin_amdgcn_exp2f(m_run - m_new);
    m_run = m_new;
    float rs = 0.f;
#pragma unroll
    for (int r = 0; r < 16; ++r) { p0[r] = __builtin_amdgcn_exp2f(p0[r] - m_new); p1[r] = __builtin_amdgcn_exp2f(p1[r] - m_new); rs += p0[r] + p1[r]; }
    l_run = l_run * alpha + rs;
#pragma unroll
    for (int r = 0; r < 16; ++r) { o0[r] *= alpha; o1[r] *= alpha; }
    bf16x8 pf[4];
#pragma unroll
    for (int ks = 0; ks < 4; ++ks) { u32x4 w;
        if (ks < 2) { w.x = cvt_pk_bf16(p0[8 * ks + 0], p0[8 * ks + 1]); w.y = cvt_pk_bf16(p0[8 * ks + 2], p0[8 * ks + 3]); w.z = cvt_pk_bf16(p0[8 * ks + 4], p0[8 * ks + 5]); w.w = cvt_pk_bf16(p0[8 * ks + 6], p0[8 * ks + 7]); }
        else { const int k2 = ks - 2; w.x = cvt_pk_bf16(p1[8 * k2 + 0], p1[8 * k2 + 1]); w.y = cvt_pk_bf16(p1[8 * k2 + 2], p1[8 * k2 + 3]); w.z = cvt_pk_bf16(p1[8 * k2 + 4], p1[8 * k2 + 5]); w.w = cvt_pk_bf16(p1[8 * k2 + 6], p1[8 * k2 + 7]); }
        pf[ks] = __builtin_bit_cast(bf16x8, w); }
#pragma unroll
    for (int ks = 0; ks < 4; ++ks) {
        o0 = __builtin_amdgcn_mfma_f32_32x32x16_bf16(vf[2 * ks], pf[ks], o0, 0, 0, 0);
        o1 = __builtin_amdgcn_mfma_f32_32x32x16_bf16(vf[2 * ks + 1], pf[ks], o1, 0, 0, 0);
    }
}

constexpr int MLA_KP = 144, MLA_KB = 64 * MLA_KP, MLA_VP = 80, MLA_BUF = MLA_KB + 64 * MLA_VP;
constexpr float MLA_POFS = 0.f;
__device__ __forceinline__ float max3f(float a, float b, float c) { float r; asm("v_max3_f32 %0, %1, %2, %3" : "=v"(r) : "v"(a), "v"(b), "v"(c)); return r; }
__device__ __forceinline__ float xhalf_max(float m) { auto rr = __builtin_amdgcn_permlane32_swap(__float_as_uint(m), __float_as_uint(m), false, false); float a = __uint_as_float(rr[0]), b = __uint_as_float(rr[1]); float r; asm("v_max_f32_e32 %0, %1, %2" : "=v"(r) : "v"(a), "v"(b)); return r; }
__device__ __forceinline__ float fmin126(float a) { float r; asm("v_min_f32_e32 %0, 0x42fc0000, %1" : "=v"(r) : "v"(a)); return r; }
__device__ __forceinline__ float xhalf_sum(float m) { auto rr = __builtin_amdgcn_permlane32_swap(__float_as_uint(m), __float_as_uint(m), false, false); return __uint_as_float(rr[0]) + __uint_as_float(rr[1]); }
__device__ __forceinline__ float rowmax32(const f32x16& p0, const f32x16& p1) {
    float a = max3f(p0[0], p0[1], p1[0]), b = max3f(p0[2], p0[3], p1[1]); a = max3f(a, p1[2], p1[3]);
#pragma unroll
    for (int r = 4; r < 16; r += 4) { a = max3f(a, p0[r], p0[r + 1]); b = max3f(b, p0[r + 2], p0[r + 3]); a = max3f(a, p1[r], p1[r + 1]); b = max3f(b, p1[r + 2], p1[r + 3]); }
    float m; asm("v_max_f32_e32 %0, %1, %2" : "=v"(m) : "v"(a), "v"(b));
    return xhalf_max(m);
}
template <int ND0, int KPITCH>
__device__ __forceinline__ void qk_tile(f32x16& p0, f32x16& p1, const LAS char* Kt, const bf16x8 (&qr)[ND0], const f32x16& cinit, int lane) {
    const LAS char* kp = Kt + (lane & 31) * KPITCH + (lane >> 5) * 16;
#pragma unroll
    for (int d0 = 0; d0 < ND0; ++d0) {
        const bf16x8 a0 = *(const LAS bf16x8*)(kp + d0 * 32), a1 = *(const LAS bf16x8*)(kp + 32 * KPITCH + d0 * 32);
        if (d0 == 0) { p0 = __builtin_amdgcn_mfma_f32_32x32x16_bf16(a0, qr[0], cinit, 0, 0, 0); p1 = __builtin_amdgcn_mfma_f32_32x32x16_bf16(a1, qr[0], cinit, 0, 0, 0); }
        else { p0 = __builtin_amdgcn_mfma_f32_32x32x16_bf16(a0, qr[d0], p0, 0, 0, 0); p1 = __builtin_amdgcn_mfma_f32_32x32x16_bf16(a1, qr[d0], p1, 0, 0, 0); }
    }
}
__device__ __forceinline__ void pv_tile(f32x16& o0, f32x16& o1, const f32x16& p0, const f32x16& p1, const LAS char* Vt, int lane) {
    const int hi = lane >> 5;
    bf16x8 pf[4];
#pragma unroll
    for (int ks = 0; ks < 4; ++ks) { u32x4 w;
        if (ks < 2) { w.x = cvt_pk_bf16(p0[8 * ks + 0], p0[8 * ks + 1]); w.y = cvt_pk_bf16(p0[8 * ks + 2], p0[8 * ks + 3]); w.z = cvt_pk_bf16(p0[8 * ks + 4], p0[8 * ks + 5]); w.w = cvt_pk_bf16(p0[8 * ks + 6], p0[8 * ks + 7]); }
        else { const int k2 = ks - 2; w.x = cvt_pk_bf16(p1[8 * k2 + 0], p1[8 * k2 + 1]); w.y = cvt_pk_bf16(p1[8 * k2 + 2], p1[8 * k2 + 3]); w.z = cvt_pk_bf16(p1[8 * k2 + 4], p1[8 * k2 + 5]); w.w = cvt_pk_bf16(p1[8 * k2 + 6], p1[8 * k2 + 7]); }
        pf[ks] = __builtin_bit_cast(bf16x8, w); }
    const LAS char* vp = Vt + (4 * hi + ((lane & 15) >> 2)) * 64 + ((lane >> 4) & 1) * 32 + (lane & 3) * 8;
#pragma unroll
    for (int ks = 0; ks < 4; ++ks) {
        const s16x4 l0 = vtr(vp + ks * 1024), h0 = vtr(vp + ks * 1024 + 512), l1 = vtr(vp + 4096 + ks * 1024), h1 = vtr(vp + 4096 + ks * 1024 + 512);
        const bf16x8 v0 = (bf16x8){l0[0], l0[1], l0[2], l0[3], h0[0], h0[1], h0[2], h0[3]}, v1 = (bf16x8){l1[0], l1[1], l1[2], l1[3], h1[0], h1[1], h1[2], h1[3]};
        o0 = __builtin_amdgcn_mfma_f32_32x32x16_bf16(v0, pf[ks], o0, 0, 0, 0);
        o1 = __builtin_amdgcn_mfma_f32_32x32x16_bf16(v1, pf[ks], o1, 0, 0, 0);
    }
}
#define SGB(mask, n) __builtin_amdgcn_sched_group_barrier(mask, n, 0)
__device__ __forceinline__ unsigned enc3_fp8(float v) {
    const int w1 = __builtin_amdgcn_cvt_pk_fp8_f32(__builtin_amdgcn_fmed3f(v, -448.f, 448.f), 0.f, 0, false); const float r1 = v - __builtin_amdgcn_cvt_f32_fp8(w1, 0);
    const int w2 = __builtin_amdgcn_cvt_pk_fp8_f32(__builtin_amdgcn_fmed3f(r1, -448.f, 448.f), 0.f, 0, false); const float r2 = r1 - __builtin_amdgcn_cvt_f32_fp8(w2, 0);
    const int w3 = __builtin_amdgcn_cvt_pk_fp8_f32(__builtin_amdgcn_fmed3f(r2, -448.f, 448.f), 0.f, 0, false);
    return ((unsigned)w1 & 0xffu) | (((unsigned)w2 & 0xffu) << 8) | (((unsigned)w3 & 0xffu) << 16);
}
__device__ __forceinline__ void mla_unit(Frame& F, int b, int h, int qb) {
    int tid = F.tid; asm volatile("" : "+v"(tid));
    const int lane = tid & 63, wid = F.wave, r32 = lane & 31, hi = lane >> 5;
    const unsigned char* Q8 = WSP(const unsigned char, WS_Q); const unsigned char* K8 = WSP(const unsigned char, WS_KN); const unsigned char* Vt8 = WSP(const unsigned char, WS_V);
    bf16_t* MIX = WSP(bf16_t, WS_MIX);
    const size_t tok0 = (size_t)b * SEQ;
    const int q0 = qb * 512 + wid * 64 + r32;
    i32x8 qA[2], qB[2];
    { const unsigned char* qp = Q8 + ((size_t)(b * 8 + h) * SEQ + q0) * 128 + 32 * hi;
#pragma unroll
      for (int ks = 0; ks < 2; ++ks) { const i32x4 lo = *(const i32x4*)(qp + 64 * ks), hh = *(const i32x4*)(qp + 64 * ks + 16); qA[ks] = __builtin_shufflevector(lo, hh, 0, 1, 2, 3, 4, 5, 6, 7);
          const i32x4 lo2 = *(const i32x4*)(qp + 32 * 128 + 64 * ks), hh2 = *(const i32x4*)(qp + 32 * 128 + 64 * ks + 16); qB[ks] = __builtin_shufflevector(lo2, hh2, 0, 1, 2, 3, 4, 5, 6, 7); } }
    const int kv_s = tid >> 3, c_s = tid & 7;
    const unsigned char* k_base = K8 + (size_t)(b * 8 + h) * SEQ * 128; const unsigned k_off = (unsigned)(kv_s * 128 + c_s * 16);
    const unsigned char* v_base = Vt8 + (size_t)(b * 8 + h) * 64 * SEQ; const unsigned v_off = (unsigned)(((tid >> 2) & 63) * SEQ + (tid & 3) * 16);
    const int k_dst = (((kv_s & 31) << 1) | (kv_s >> 5)) * MLA_KP + c_s * 16, v_dst = MLA_KB + ((tid >> 2) & 63) * MLA_VP + (tid & 3) * 16;
    LAS char* lds = (LAS char*)F.lds;
    f32x16 oA0, oA1, oB0, oB1;
#pragma unroll
    for (int r = 0; r < 16; ++r) { oA0[r] = 0.f; oA1[r] = 0.f; oB0[r] = 0.f; oB1[r] = 0.f; }
    float lA = 0.f, lB = 0.f;
    const f32x16 zero16 = (f32x16){0.f, 0.f, 0.f, 0.f, 0.f, 0.f, 0.f, 0.f, 0.f, 0.f, 0.f, 0.f, 0.f, 0.f, 0.f, 0.f};
    const int selw = ((((lane & 15) >> 2) & 1) == ((lane >> 4) & 1)) ? 0x38383838 : 0;
    const i32x8 sel8 = (i32x8){selw, selw, selw, selw, selw, selw, selw, selw};
    const f32x4 zero4 = (f32x4){0.f, 0.f, 0.f, 0.f};
#define MLA_SUM8(b) __builtin_amdgcn_mfma_scale_f32_16x16x128_f8f6f4(sel8, b, zero4, 0, 0, 0, 0, 0, 0)
    u32x4 rk0, rv0, rk1, rv1;
#define MLA_LOADG(t, rk, rv) do { const unsigned o_ = (unsigned)((t) < 64 ? (t) : 63) * 64u; rk = *(const u32x4*)(k_base + (k_off + o_ * 128u)); rv = *(const u32x4*)(v_base + (v_off + o_)); } while (0)
#define MLA_STORE_OFF(off, rk, rv) do { LAS char* d_ = lds + (off); *(LAS u32x4*)(d_ + k_dst) = rk; *(LAS u32x4*)(d_ + v_dst) = rv; } while (0)
#define MLA_KFRAG(dst, base, a, ks) do { const LAS char* p_ = (base) + (a) * 32 * MLA_KP + (ks) * 64; \
        const i32x4 lo_ = *(const LAS i32x4*)p_, hi_ = *(const LAS i32x4*)(p_ + 16); dst = __builtin_shufflevector(lo_, hi_, 0, 1, 2, 3, 4, 5, 6, 7); } while (0)
#define MLA_MFMA8(a, b, c) __builtin_amdgcn_mfma_scale_f32_32x32x64_f8f6f4(a, b, c, 0, 0, 0, 0, 0, 0)
    static_assert(6 * MLA_BUF <= RING_BYTES, "MLA ring");
    const int sig = 32 * ((r32 >> 2) & 1) + (r32 & 3) + 4 * (r32 >> 3);
    const LAS char* kp0 = lds + (2 * (sig & 31) + (sig >> 5)) * MLA_KP + hi * 32;
    const LAS char* vp0 = lds + MLA_KB + r32 * MLA_VP + 32 * hi;
    MLA_LOADG(0, rk0, rv0); MLA_LOADG(1, rk1, rv1); MLA_STORE_OFF(0, rk0, rv0); MLA_STORE_OFF(MLA_BUF, rk1, rv1);
    MLA_LOADG(2, rk0, rv0); MLA_LOADG(3, rk1, rv1); MLA_STORE_OFF(2 * MLA_BUF, rk0, rv0); MLA_STORE_OFF(3 * MLA_BUF, rk1, rv1);
    __syncthreads();
    MLA_LOADG(4, rk0, rv0); MLA_LOADG(5, rk1, rv1);
    i32x8 kf[4];
#define MLA_KFRAGS(slot) do { const LAS char* kp_ = kp0 + (slot); MLA_KFRAG(kf[0], kp_, 0, 0); MLA_KFRAG(kf[1], kp_, 0, 1); MLA_KFRAG(kf[2], kp_, 1, 0); MLA_KFRAG(kf[3], kp_, 1, 1); } while (0)
#define MLA_VFRAGS(slot) do { const LAS char* vp_ = vp0 + (slot); \
        _Pragma("unroll") for (int dh = 0; dh < 2; ++dh) { const i32x4 lo_ = *(const LAS i32x4*)(vp_ + dh * 32 * MLA_VP), hi_ = *(const LAS i32x4*)(vp_ + dh * 32 * MLA_VP + 16); vf[dh] = __builtin_shufflevector(lo_, hi_, 0, 1, 2, 3, 4, 5, 6, 7); } } while (0)
#define MLA_SCORE(q) do { s0 = MLA_MFMA8(kf[0], q[0], zero16); s1 = MLA_MFMA8(kf[2], q[0], zero16); s0 = MLA_MFMA8(kf[1], q[1], s0); s1 = MLA_MFMA8(kf[3], q[1], s1); } while (0)
    f32x16 s0, s1; i32x8 vf[2];
    MLA_KFRAGS(0);
    { MLA_SCORE(qA); const unsigned ea = enc3_fp8(56.5f + 8.f * MLA_POFS - rowmax32(s0, s1));
      MLA_SCORE(qB); const unsigned eb = enc3_fp8(56.5f + 8.f * MLA_POFS - rowmax32(s0, s1));
      qA[1][0] = hi ? (int)ea : qA[1][0]; qB[1][0] = hi ? (int)eb : qB[1][0]; }
#define MLA_PBYTES(pf_) do { _Pragma("unroll") for (int g_ = 0; g_ < 4; ++g_) { unsigned b0_ = 0u, b1_ = 0u; \
            _Pragma("unroll") for (int j_ = 0; j_ < 4; ++j_) { b0_ = __builtin_amdgcn_cvt_pk_u8_f32(s0[4 * g_ + j_], j_, b0_); b1_ = __builtin_amdgcn_cvt_pk_u8_f32(s1[4 * g_ + j_], j_, b1_); } \
            pf_[g_] = (int)b0_; pf_[4 + g_] = (int)b1_; } } while (0)
#define SB0() __builtin_amdgcn_sched_barrier(0)
#define MLA_TILE(this_slot, next_slot) do { i32x8 pf_; \
        MLA_PBYTES(pf_); SB0(); lB += t_[0]; MLA_VFRAGS(this_slot); SB0(); MLA_SCORE(qB); SB0(); \
        oA0 = MLA_MFMA8(vf[0], pf_, oA0); oA1 = MLA_MFMA8(vf[1], pf_, oA1); t_ = MLA_SUM8(pf_); SB0(); \
        MLA_PBYTES(pf_); SB0(); lA += t_[0]; MLA_KFRAGS(next_slot); SB0(); \
        oB0 = MLA_MFMA8(vf[0], pf_, oB0); oB1 = MLA_MFMA8(vf[1], pf_, oB1); t_ = MLA_SUM8(pf_); SB0(); MLA_SCORE(qA); SB0(); } while (0)
    MLA_SCORE(qA); f32x4 t_ = zero4;
    if (wid < 4) __builtin_amdgcn_s_setprio(3); else __builtin_amdgcn_s_setprio(1);
    int sl = 0;
#pragma unroll 1
    for (int tp = 0; tp < 32; ++tp) {
        const int s_a = sl * MLA_BUF, s_b = s_a + MLA_BUF, sl2 = sl + 2 >= 6 ? sl - 4 : sl + 2, s_c = sl2 * MLA_BUF, sl4 = sl2 + 2 >= 6 ? sl2 - 4 : sl2 + 2, f_a = sl4 * MLA_BUF, f_b = f_a + MLA_BUF;
        MLA_STORE_OFF(f_a, rk0, rv0); MLA_STORE_OFF(f_b, rk1, rv1);
        MLA_LOADG(2 * tp + 6, rk0, rv0); MLA_LOADG(2 * tp + 7, rk1, rv1);
        __builtin_amdgcn_sched_barrier(0);
        MLA_TILE(s_a, s_b);
        MLA_TILE(s_b, s_c);
        asm volatile("s_waitcnt lgkmcnt(0)" ::: "memory"); __builtin_amdgcn_s_barrier(); asm volatile("" ::: "memory");
        sl = sl2;
    }
    lB += t_[0];
    __builtin_amdgcn_s_setprio(0);
#undef MLA_TILE
#undef SB0
#undef MLA_PBYTES
#undef MLA_SCORE
#undef MLA_KFRAGS
#undef MLA_VFRAGS
#undef MLA_KFRAG
#undef MLA_MFMA8
#undef MLA_STORE_OFF
#undef MLA_LOADG
    int tid2 = F.tid; asm volatile("" : "+v"(tid2));
    const int hi2 = (tid2 >> 5) & 1; const size_t orow0 = tok0 + qb * 512 + wid * 64 + (tid2 & 31);
#pragma unroll
    for (int grp = 0; grp < 2; ++grp) {
        const f32x16& o0 = grp ? oB0 : oA0; const f32x16& o1 = grp ? oB1 : oA1;
        const float inv = DBG_MLA_F / (grp ? lB : lA);
        unsigned char* orow = (unsigned char*)MIX + (orow0 + 32 * grp) * 1024 + h * 64 + 8 * hi2;
        const float invs = inv * MIX_SCALE;
#pragma unroll
        for (int hf = 0; hf < 2; ++hf) { const f32x16& oo = hf ? o1 : o0;
#pragma unroll
            for (int gp = 0; gp < 2; ++gp) { const int e0 = 8 * gp;
                const unsigned a4 = pk4_fp8(oo[e0] * invs, oo[e0 + 1] * invs, oo[e0 + 2] * invs, oo[e0 + 3] * invs), b4 = pk4_fp8(oo[e0 + 4] * invs, oo[e0 + 5] * invs, oo[e0 + 6] * invs, oo[e0 + 7] * invs);
                const unsigned rcv = (unsigned)__shfl_xor((int)(hi2 ? a4 : b4), 32);
                *(u32x2*)(orow + hf * 32 + 16 * gp) = hi2 ? (u32x2){rcv, b4} : (u32x2){a4, rcv}; }
        }
    }
}

constexpr int DIL_KP = 144, DIL_KB = 64 * DIL_KP, DIL_BUF = DIL_KB + 8192, DIL_PAIR = 2 * DIL_BUF, DIL_TAB = 4 * DIL_PAIR;
static_assert(DIL_TAB + 3 * 320 * 4 <= RING_BYTES, "dilated LDS");
template <int MODE>
__device__ __forceinline__ void dil_unit(Frame& F, int b, int h, int sb) {
    const int tid = F.tid, lane = F.lane, wid = F.wave, r32 = lane & 31, hi = lane >> 5;
    const bf16_t* DQ = WSP(const bf16_t, WS_DQ); const bf16_t* DK = WSP(const bf16_t, WS_DK); const bf16_t* DV = WSP(const bf16_t, WS_DV);
    bf16_t* O1 = WSP(bf16_t, WS_O1); bf16_t* O2 = WSP(bf16_t, WS_O2); float* LSE = WSP(float, WS_LSE); bf16_t* MIX = WSP(bf16_t, WS_MIX);
    LAS char* lds = (LAS char*)F.lds;
    LAS float* tab = (LAS float*)(lds + DIL_TAB);
    { const float* tg = WSP(const float, WS_TABG); for (int i = tid; i < 960; i += NTHR) tab[i] = tg[((i / 320) * 8 + h) * 320 + (i % 320)]; }
    const int pair = wid >> 1, pt = (wid & 1) * 64 + lane;
    LAS char* pl = lds + pair * DIL_PAIR;
    const size_t tok0 = (size_t)b * SEQ, hrow0 = (size_t)(b * 8 + h) * SEQ;
    const int qi = (wid & 1) * 32 + r32;
#define DIL_BLK(p_, rho_, dsh_, nb_, r_, n_) const int dsh_ = 2 * (p_), nb_ = 64 >> dsh_; const int i__ = 4 * (rho_) + pair, nbsb__ = 16 >> dsh_, r_ = i__ / nbsb__, n_ = ((sb * 1024) >> dsh_) / 64 + i__ % nbsb__
    u32x4 rk[4], rv[4]; bf16x8 qr[4], qn[4];
#define DIL_LOAD(ts_) do { const int p__ = (ts_) / 12, rho__ = ((ts_) % 12) / 3, jt__ = (ts_) % 3; DIL_BLK(p__, rho__, dsh__, nb__, r__, n__); \
        int kb_ = n__ - 1 + jt__; kb_ = kb_ < 0 ? 0 : (kb_ >= nb__ ? nb__ - 1 : kb_); \
        _Pragma("unroll") for (int c_ = 0; c_ < 4; ++c_) { const int ch_ = pt + 128 * c_, kv_ = ch_ >> 3, cc_ = ch_ & 7; \
            const size_t kpos_ = (size_t)((kb_ * 64 + kv_) << dsh__) + r__; \
            const size_t ko_ = (hrow0 + DPERM((int)kpos_)) * 64 + cc_ * 8; rk[c_] = *(const u32x4*)(DK + ko_); rv[c_] = *(const u32x4*)(DV + ko_); } } while (0)
#define DIL_STORE(buf) do { _Pragma("unroll") for (int c_ = 0; c_ < 4; ++c_) { const int ch_ = pt + 128 * c_, kv_ = ch_ >> 3, cc_ = ch_ & 7; \
            *(LAS u32x4*)(pl + (buf) * DIL_BUF + kv_ * DIL_KP + cc_ * 16) = rk[c_]; \
            *(LAS u32x4*)(pl + (buf) * DIL_BUF + DIL_KB + (cc_ >> 2) * 4096 + kv_ * 64 + (cc_ & 3) * 16) = rv[c_]; } } while (0)
#define DIL_QLOAD(dst, blk_) do { const int p__ = (blk_) / 4, rho__ = (blk_) % 4; DIL_BLK(p__, rho__, dsh__, nb__, r__, n__); (void)nb__; \
        const size_t qpos__ = (size_t)((n__ * 64 + qi) << dsh__) + r__; \
        _Pragma("unroll") for (int d0 = 0; d0 < 4; ++d0) dst[d0] = *(const bf16x8*)(DQ + (hrow0 + DPERM((int)qpos__)) * 64 + d0 * 16 + hi * 8); } while (0)
    DIL_LOAD(0); DIL_QLOAD(qr, 0); DIL_STORE(0);
    asm volatile("" :: "v"(qr[0]), "v"(qr[1]), "v"(qr[2]), "v"(qr[3]));
    __syncthreads();
    float m_run = NEG_BIG, l_run = 0.f; f32x16 o0, o1;
#pragma unroll 1
    for (int ts = 0; ts < 36; ++ts) {
        const int p = ts / 12, rho = (ts % 12) / 3, jt = ts % 3;
        DIL_BLK(p, rho, dsh, nb, r, n);
        if (MODE != 2 && ts + 1 < 36) DIL_LOAD(ts + 1);
        if (jt == 1 && ts + 2 < 36) DIL_QLOAD(qn, ts / 3 + 1);
        if (jt == 0) { m_run = NEG_BIG; l_run = 0.f;
#pragma unroll
            for (int rr = 0; rr < 16; ++rr) { o0[rr] = 0.f; o1[rr] = 0.f; } }
        const int kb = n - 1 + jt;
        if (MODE != 1 && kb >= 0 && kb < nb) {
            const LAS float* tq = tab + p * 320 + (64 * (jt - 1) - qi + 127);
            attn_tile<4, DIL_KP, true>(pl + (ts & 1) * DIL_BUF, pl + (ts & 1) * DIL_BUF + DIL_KB, qr, m_run, l_run, o0, o1, tq, lane);
        }
        if (MODE != 2 && ts + 1 < 36) DIL_STORE((ts + 1) & 1);
        if (jt == 2) asm volatile("" :: "v"(qn[0]), "v"(qn[1]), "v"(qn[2]), "v"(qn[3]));
        if (MODE != 0 && jt == 2) { if (m_run == 12345.f) MIX[0] = (bf16_t)(int)(l_run + o0[3] + o1[5]); }
        if (MODE == 0 && jt == 2) {
            const size_t qpos = (size_t)((n * 64 + qi) << dsh) + r;
            const float lt = l_run + __shfl_xor(l_run, 32); const float inv = 1.f / lt;
            const float lse = m_run + __builtin_amdgcn_logf(lt);
            const size_t grow = tok0 + qpos, prow = hrow0 + DPERM((int)qpos);
            if (p < 2) {
                bf16_t* orow = (p == 0 ? O1 : O2) + prow * 64 + 32 * hi;
#pragma unroll
                for (int k = 0; k < 4; ++k) { const f32x16& oo = k < 2 ? o0 : o1; const int e0 = 8 * (k & 1);
                    u32x4 w; w.x = cvt_pk_bf16(oo[e0] * inv, oo[e0 + 1] * inv); w.y = cvt_pk_bf16(oo[e0 + 2] * inv, oo[e0 + 3] * inv); w.z = cvt_pk_bf16(oo[e0 + 4] * inv, oo[e0 + 5] * inv); w.w = cvt_pk_bf16(oo[e0 + 6] * inv, oo[e0 + 7] * inv);
                    *(u32x4*)(orow + 8 * k) = w; }
                if (hi == 0) LSE[(size_t)p * BATCH * DIL_H * SEQ + prow] = lse;
            } else {
                const float l0 = LSE[prow], l1 = LSE[(size_t)BATCH * DIL_H * SEQ + prow];
                const float mm = fmaxf(fmaxf(l0, l1), lse);
                const float e0 = __builtin_amdgcn_exp2f(l0 - mm), e1 = __builtin_amdgcn_exp2f(l1 - mm), e2 = __builtin_amdgcn_exp2f(lse - mm);
                const float isum = DBG_DIL_F / (e0 + e1 + e2); const float w0 = e0 * isum, w1 = e1 * isum, w2 = e2 * isum * inv;
                const bf16_t* a1 = O1 + prow * 64; const bf16_t* a2 = O2 + prow * 64;
                unsigned char* orow = (unsigned char*)MIX + grow * 1024 + 512 + h * 64;
                u32x4 xa[4], xb[4];
#pragma unroll
                for (int k = 0; k < 4; ++k) { xa[k] = *(const u32x4*)(a1 + 32 * hi + 8 * k); xb[k] = *(const u32x4*)(a2 + 32 * hi + 8 * k); }
                unsigned wm[2][4];
#pragma unroll
                for (int g = 0; g < 4; ++g) {
#pragma unroll
                    for (int hf = 0; hf < 2; ++hf) {
                        const u32x4& A1 = xa[hf * 2 + (g >> 1)]; const u32x4& A2 = xb[hf * 2 + (g >> 1)];
                        u32x2 x1, x2; x1.x = (g & 1) ? A1.z : A1.x; x1.y = (g & 1) ? A1.w : A1.y; x2.x = (g & 1) ? A2.z : A2.x; x2.y = (g & 1) ? A2.w : A2.y;
                        const f32x16& oo = hf ? o1 : o0;
                        const float y0 = w0 * bf_lo(x1.x) + w1 * bf_lo(x2.x) + w2 * oo[4 * g], y1 = w0 * bf_hi(x1.x) + w1 * bf_hi(x2.x) + w2 * oo[4 * g + 1];
                        const float y2 = w0 * bf_lo(x1.y) + w1 * bf_lo(x2.y) + w2 * oo[4 * g + 2], y3 = w0 * bf_hi(x1.y) + w1 * bf_hi(x2.y) + w2 * oo[4 * g + 3];
                        wm[hf][g] = pk4_fp8(y0 * MIX_SCALE, y1 * MIX_SCALE, y2 * MIX_SCALE, y3 * MIX_SCALE);
                    }
                }
#pragma unroll
                for (int hf = 0; hf < 2; ++hf)
#pragma unroll
                    for (int gp = 0; gp < 2; ++gp) {
                        const unsigned rcv = (unsigned)__shfl_xor((int)(hi ? wm[hf][2 * gp] : wm[hf][2 * gp + 1]), 32);
                        *(u32x2*)(orow + hf * 32 + 16 * gp + 8 * hi) = hi ? (u32x2){rcv, wm[hf][2 * gp + 1]} : (u32x2){wm[hf][2 * gp], rcv};
                    }
            }
#pragma unroll
            for (int d0 = 0; d0 < 4; ++d0) qr[d0] = qn[d0];
        }
        if (ts == 25) VM_WAIT();
        __syncthreads();
    }
#undef DIL_LOAD
#undef DIL_STORE
#undef DIL_QLOAD
#undef DIL_BLK
}

__device__ __forceinline__ void transpose_item(const float* W, int ldn, int K, int k0, int n0, bf16_t* WT, int drow, const float* kscale, LAS float* scr, int lane) {
#pragma unroll 8
    for (int i = 0; i < 32; ++i) { const int kk = 2 * i + (lane >> 5); float v = W[(size_t)(k0 + kk) * ldn + n0 + (lane & 31)]; if (kscale) v *= kscale[k0 + kk]; scr[kk * 33 + (lane & 31)] = v; }
    LDS_WAIT(); asm volatile("" ::: "memory");
    const int c = lane & 7;
#pragma unroll
    for (int j = 0; j < 4; ++j) { const int n = (lane >> 3) + 8 * j; const LAS float* s = scr + (8 * c) * 33 + n;
        u32x4 o; o.x = pk2(s[0 * 33], s[1 * 33]); o.y = pk2(s[2 * 33], s[3 * 33]); o.z = pk2(s[4 * 33], s[5 * 33]); o.w = pk2(s[6 * 33], s[7 * 33]);
        *(u32x4*)(WT + (size_t)(drow + n) * K + k0 + 8 * c) = o; }
    LDS_WAIT(); asm volatile("" ::: "memory");
}
__device__ __forceinline__ void transpose_item_f8(const float* W, int ldn, int K, int k0, int n0, unsigned char* WT, int drow, float qs, LAS float* scr, int lane) {
#pragma unroll 8
    for (int i = 0; i < 32; ++i) { const int kk = 2 * i + (lane >> 5); scr[kk * 33 + (lane & 31)] = W[(size_t)(k0 + kk) * ldn + n0 + (lane & 31)] * qs; }
    LDS_WAIT(); asm volatile("" ::: "memory");
    const int c = lane & 7;
#pragma unroll
    for (int j = 0; j < 4; ++j) { const int n = (lane >> 3) + 8 * j; const LAS float* s_ = scr + (8 * c) * 33 + n;
        u32x2 o; o.x = pk4_fp8(s_[0 * 33], s_[1 * 33], s_[2 * 33], s_[3 * 33]); o.y = pk4_fp8(s_[4 * 33], s_[5 * 33], s_[6 * 33], s_[7 * 33]);
        *(u32x2*)(WT + (size_t)(drow + n) * K + k0 + 8 * c) = o; }
    LDS_WAIT(); asm volatile("" ::: "memory");
}
__device__ __forceinline__ void transpose_item64(const float* W, int ldn, int K, int k0, int n0, bf16_t* WT, int drow, LAS float* scr, int lane, float qs, float qis) {
    f32x4 v[16];
    const float* src = W + (size_t)(k0 + (lane >> 4)) * ldn + n0 + 4 * (lane & 15);
#pragma unroll
    for (int j = 0; j < 16; ++j) v[j] = __builtin_nontemporal_load((const f32x4*)(src + (size_t)(4 * j) * ldn));
    LAS float* sw = scr + (lane >> 4) * 65 + 4 * (lane & 15);
#pragma unroll
    for (int j = 0; j < 16; ++j) { sw[(4 * j) * 65 + 0] = v[j][0]; sw[(4 * j) * 65 + 1] = v[j][1]; sw[(4 * j) * 65 + 2] = v[j][2]; sw[(4 * j) * 65 + 3] = v[j][3]; }
    LDS_WAIT(); asm volatile("" ::: "memory");
    const int c = lane & 7;
#pragma unroll
    for (int jj = 0; jj < 8; ++jj) { const int n = (lane >> 3) + 8 * jj; const LAS float* s = scr + (8 * c) * 65 + n;
        u32x2 o; o.x = pk4_fp8(s[0 * 65] * qs, s[1 * 65] * qs, s[2 * 65] * qs, s[3 * 65] * qs); o.y = pk4_fp8(s[4 * 65] * qs, s[5 * 65] * qs, s[6 * 65] * qs, s[7 * 65] * qs);
        *(u32x2*)((unsigned char*)WT + (size_t)(drow + n) * K + k0 + 8 * c) = o; }
    LDS_WAIT(); asm volatile("" ::: "memory");
}
__device__ __forceinline__ int t5_bucket_dev(int rel) {
    const int n = rel < 0 ? -rel : rel; int v;
    if (n < 8) v = n; else v = n < 15 ? 8 : n < 27 ? 9 : n < 50 ? 10 : n < 91 ? 11 : n < 166 ? 12 : n < 305 ? 13 : n < 559 ? 14 : 15;
    return (rel > 0 ? 16 : 0) + v;
}
__device__ __forceinline__ void p0_prologue(Frame& F) { const KArgs ka = kargs();
    struct { const float *c, *w_ada, *w_in, *w_uq, *q_norm_g, *w_ukv, *kv_norm_g, *w_out, *rel_bias; } a;
    a.c = ka->c; a.w_ada = ka->w_ada; a.w_in = ka->w_in; a.w_uq = ka->w_uq; a.q_norm_g = ka->q_norm_g; a.w_ukv = ka->w_ukv; a.kv_norm_g = ka->kv_norm_g; a.w_out = ka->w_out; a.rel_bias = ka->rel_bias;
    LAS float* scr = (LAS float*)(F.lds + 32768 + F.wave * 8704);
    LAS float* sil = (LAS float*)F.lds;
    for (int i = F.tid; i < BATCH * D_MODEL; i += NTHR) { const float v = a.c[i]; sil[i] = v / (1.f + __expf(-v)); }
    __syncthreads();
    const int gw = F.vcu * NWAVES + F.wave, NGW = F.G * NWAVES, lane = F.lane;
    for (int it = gw; it < 16 * 24; it += NGW) {
        const int kb = it / 24, nb = it % 24, k0 = kb * 64, n0 = nb * 256 + lane * 4;
        f32x4 acc[8];
#pragma unroll
        for (int b = 0; b < 8; ++b) acc[b] = (f32x4){0.f, 0.f, 0.f, 0.f};
#pragma unroll 16
        for (int k = 0; k < 64; ++k) { const f32x4 w = *(const f32x4*)(a.w_ada + (size_t)(k0 + k) * 6144 + n0);
#pragma unroll
            for (int b = 0; b < 8; ++b) acc[b] += w * sil[b * 1024 + k0 + k]; }
        float* mp = WSP(float, WS_MODP) + (size_t)kb * 8 * 6144 + n0;
#pragma unroll
        for (int b = 0; b < 8; ++b) *(f32x4*)(mp + b * 6144) = acc[b];
    }
    {
        bf16_t* WIN = WSP(bf16_t, WS_WIN); bf16_t* WUQ = WSP(bf16_t, WS_WUQ); bf16_t* WK = WSP(bf16_t, WS_WK); bf16_t* WV = WSP(bf16_t, WS_WV); bf16_t* WOUT = WSP(bf16_t, WS_WOUT);
        constexpr int I_IN = 16 * 69, I_UQ = 6 * 24, I_KV = 4 * 32, I_OUT = 16 * 32, NIT = I_IN + I_UQ + I_KV + I_OUT;
        for (int it = NGW - 1 - gw; it < NIT; it += NGW) {
            int r = it;
            if (r < I_IN) { const int kb = r / 69, g = r % 69, n0 = g * 32; transpose_item_f8(a.w_in, IN_W, 1024, kb * 64, n0, (unsigned char*)WIN, n0 + (n0 >= 672 ? 96 : 0), WIN_SCALE, scr, lane); continue; } r -= I_IN;
            if (r < I_UQ) { const int kb = r / 24, g = r % 24; transpose_item(a.w_uq, 768, 384, kb * 64, g * 32, WUQ, g * 32, a.q_norm_g, scr, lane); continue; } r -= I_UQ;
            if (r < I_KV) { const int kb = r / 32, g = r % 32, hh = g >> 2, part = g & 3;
                transpose_item(a.w_ukv, 1024, 256, kb * 64, g * 32, part < 2 ? WK : WV, hh * 64 + (part & 1) * 32, a.kv_norm_g, scr, lane); continue; } r -= I_KV;
            { const int kb = r / 32, g = r % 32; transpose_item_f8(a.w_out, 1024, 1024, kb * 64, g * 32, (unsigned char*)WOUT, g * 32, WOUT_SCALE, scr, lane); }
        }
        for (int i = (F.G - 1 - F.vcu) * NTHR + F.tid; i < 96 * 1024 / 16; i += F.G * NTHR) *(u32x4*)((unsigned char*)WIN + (size_t)672 * 1024 + (size_t)i * 16) = (u32x4){0u, 0u, 0u, 0u};
    }
    for (int i = (F.G - 1 - F.vcu) * NTHR + F.tid; i < SEQ * 16; i += F.G * NTHR) { const int pos = i >> 4, j = i & 15;
        const float ang = (float)pos * (float)exp2(-(double)j * (13.287712379549449 / 16.0)); float* rp = WSP(float, WS_ROPE) + pos * 32;
        float sn, cs; sincosf(ang, &sn, &cs);
        rp[j] = cs; rp[16 + j] = sn; }
    for (int i = (F.G - 1 - F.vcu) * NTHR + F.tid; i < 3 * 8 * 320; i += F.G * NTHR) { const int p = i / 2560, hh = (i / 320) & 7, idx = i % 320, delta = idx - 127, dil = 1 << (2 * p);
        float v = NEG_BIG; if (delta >= -64 && delta <= 64) v = a.rel_bias[t5_bucket_dev(delta * dil) * 8 + hh] * LOG2E;
        WSP(float, WS_TABG)[i] = v; }
}
__device__ __forceinline__ void p1_mod_h1(Frame& F) { const KArgs ka = kargs(); const float* const a_x = ka->x; const float* const a_b_ada = ka->b_ada;
    LAS float* shs = (LAS float*)F.lds;
    const float* modp = WSP(const float, WS_MODP); float* mod = WSP(float, WS_MOD);
    for (int i = F.vcu * NTHR + F.tid; i < 8 * 6144; i += F.G * NTHR) { float s = a_b_ada[i % 6144];
#pragma unroll
        for (int kb = 0; kb < 16; ++kb) s += modp[(size_t)kb * 8 * 6144 + i];
        mod[i] = s; }
    bf16_t* H1 = WSP(bf16_t, WS_H);
    const int rpb = M_TOK / F.G;
    const int row0 = F.vcu * rpb, b = row0 >> 12;
    for (int i = F.tid; i < 2048; i += NTHR) { float sv = a_b_ada[i];
#pragma unroll
        for (int kb = 0; kb < 16; ++kb) sv += modp[(size_t)kb * 8 * 6144 + b * 6144 + i];
        shs[i] = sv; }
    __syncthreads();
    f32x4 sh[4], sc[4];
#pragma unroll
    for (int j = 0; j < 4; ++j) { sh[j] = *(const LAS f32x4*)(shs + 4 * F.lane + 256 * j); sc[j] = *(const LAS f32x4*)(shs + 1024 + 4 * F.lane + 256 * j) + 1.f; }
    for (int rr = 2 * F.wave; rr < rpb; rr += 2 * NWAVES) {
        const int row = row0 + rr;
        const f32x4* xr = (const f32x4*)(a_x + (size_t)row * 1024) + F.lane;
        unsigned* o8 = (unsigned*)((unsigned char*)H1 + (size_t)row * 1024) + F.lane;
        f32x4 v[8];
#pragma unroll
        for (int j = 0; j < 8; ++j) v[j] = __builtin_nontemporal_load(xr + 64 * j);
#pragma unroll
        for (int j = 0; j < 8; ++j) { const f32x4 hv = v[j] * sc[j & 3] + sh[j & 3];
            o8[64 * j] = pk4_fp8(hv[0], hv[1], hv[2], hv[3]); }
    }
}
__device__ __forceinline__ void p6_ln1_router(Frame& F) { const KArgs ka = kargs(); const float* const a_w_router = ka->w_router; const float* const a_ln1_g = ka->ln1_g; const float* const a_ln1_b = ka->ln1_b; const float* const a_out = ka->out; const float* const a_x = ka->x;
    LAS f32x4* wr4 = (LAS f32x4*)F.lds;
    for (int idx = F.tid; idx < 1024 * 4; idx += NTHR) { const int k = idx >> 2, e4 = idx & 3, l = (k & 255) >> 2, i = k & 3, j = k >> 8;
        wr4[((j * 4 + i) * 4 + e4) * 64 + l] = *(const f32x4*)(a_w_router + k * 16 + e4 * 4); }
    __syncthreads();
    const float* mod = WSP(const float, WS_MOD); bf16_t* H2 = WSP(bf16_t, WS_H); float* AFF = WSP(float, WS_AFF); float* STAT = WSP(float, WS_STAT);
    const int gw = F.vcu * NWAVES + F.wave, NGW = F.G * NWAVES, lane = F.lane;
    f32x4 vn[2][4]; u32x2 mn[2][4];
#define P6_LOAD(r0_) do { _Pragma("unroll") for (int q = 0; q < 2; ++q) { const int rq_ = (r0_) + q * NGW < M_TOK ? (r0_) + q * NGW : (r0_); const unsigned ro_ = (unsigned)rq_ * 4096u; \
        _Pragma("unroll") for (int j = 0; j < 4; ++j) { vn[q][j] = *(const f32x4*)((const char*)a_x + (ro_ + (unsigned)(lane * 16 + j * 1024))); mn[q][j] = *(const u32x2*)((const char*)a_out + (ro_ + (unsigned)(lane * 8 + j * 512))); } } } while (0)
    P6_LOAD(gw);
    for (int row0 = gw; row0 < M_TOK; row0 += 2 * NGW) {
        f32x4 v[2][4]; float mean[2], rstd[2];
#pragma unroll
        for (int q = 0; q < 2; ++q) { float sm = 0.f;
#pragma unroll
            for (int j = 0; j < 4; ++j) { v[q][j] = vn[q][j] * ALPHA + (f32x4){bf_lo(mn[q][j].x), bf_hi(mn[q][j].x), bf_lo(mn[q][j].y), bf_hi(mn[q][j].y)}; sm += (v[q][j][0] + v[q][j][1]) + (v[q][j][2] + v[q][j][3]); }
            mean[q] = sm; }
        { const int rn = row0 + 2 * NGW < M_TOK ? row0 + 2 * NGW : row0; P6_LOAD(rn); }
#pragma unroll
        for (int q = 0; q < 2; ++q) { mean[q] = wave_sum(mean[q]) * (1.f / 1024.f); float s2 = 0.f;
#pragma unroll
            for (int j = 0; j < 4; ++j) { v[q][j] = v[q][j] - mean[q]; s2 += (v[q][j][0] * v[q][j][0] + v[q][j][1] * v[q][j][1]) + (v[q][j][2] * v[q][j][2] + v[q][j][3] * v[q][j][3]); }
            rstd[q] = 1.f / sqrtf(wave_sum(s2) * (1.f / 1024.f) + NORM_EPS); }
        const int rowq[2] = {row0, row0 + NGW < M_TOK ? row0 + NGW : row0};
        if (lane == 0) { *(f32x2*)(STAT + (size_t)rowq[0] * 2) = (f32x2){mean[0], rstd[0]}; *(f32x2*)(STAT + (size_t)rowq[1] * 2) = (f32x2){mean[1], rstd[1]}; }
        asm volatile("" ::: "memory");
        f32x2 lg2[2][8];
#pragma unroll
        for (int q = 0; q < 2; ++q)
#pragma unroll
            for (int e = 0; e < 8; ++e) lg2[q][e] = (f32x2){0.f, 0.f};
#pragma unroll
        for (int j = 0; j < 4; ++j) { const int col = 4 * lane + 256 * j;
            const f32x4 g = *(const f32x4*)((const char*)a_ln1_g + (unsigned)(col * 4)), bb = *(const f32x4*)((const char*)a_ln1_b + (unsigned)(col * 4));
#pragma unroll
            for (int q = 0; q < 2; ++q) { const int b = rowq[q] >> 12;
                const f32x4 x1 = v[q][j] * rstd[q] * g + bb;
                const f32x4 sh = *(const f32x4*)((const char*)mod + (unsigned)((b * 6144 + 3072 + col) * 4)), sc = *(const f32x4*)((const char*)mod + (unsigned)((b * 6144 + 4096 + col) * 4));
                const f32x4 hv = x1 * (sc + 1.f) + sh; v[q][j] = hv;
                *(unsigned*)((unsigned char*)H2 + ((unsigned)rowq[q] * 1024u + (unsigned)(lane * 4 + j * 256))) = pk4_fp8(hv[0], hv[1], hv[2], hv[3]); } }
        asm volatile("" ::: "memory");
#pragma unroll
        for (int j = 0; j < 4; ++j) {
#pragma unroll
            for (int i = 0; i < 4; ++i) {
#pragma unroll
                for (int e4 = 0; e4 < 4; ++e4) { const f32x4 w = wr4[((j * 4 + i) * 4 + e4) * 64 + lane]; const f32x2 w01 = (f32x2){w[0], w[1]}, w23 = (f32x2){w[2], w[3]};
#pragma unroll
                    for (int q = 0; q < 2; ++q) { const f32x2 hh = (f32x2){v[q][j][i], v[q][j][i]};
                        lg2[q][e4 * 2 + 0] = __builtin_elementwise_fma(hh, w01, lg2[q][e4 * 2 + 0]); lg2[q][e4 * 2 + 1] = __builtin_elementwise_fma(hh, w23, lg2[q][e4 * 2 + 1]); } }
                asm volatile("" : "+v"(lg2[0][0]), "+v"(lg2[0][1]), "+v"(lg2[0][2]), "+v"(lg2[0][3]), "+v"(lg2[0][4]), "+v"(lg2[0][5]), "+v"(lg2[0][6]), "+v"(lg2[0][7]), "+v"(lg2[1][0]), "+v"(lg2[1][1]), "+v"(lg2[1][2]), "+v"(lg2[1][3]), "+v"(lg2[1][4]), "+v"(lg2[1][5]), "+v"(lg2[1][6]), "+v"(lg2[1][7]) :: "memory"); }
        }
#pragma unroll
        for (int q = 0; q < 2; ++q) {
            float lg[16];
#pragma unroll
            for (int e = 0; e < 8; ++e) { lg[2 * e] = lg2[q][e][0]; lg[2 * e + 1] = lg2[q][e][1]; }
#pragma unroll
            for (int i = 0; i < 8; ++i) { float x = lg[i], y = lg[i + 8];
                asm("s_nop 1\n\tv_permlane32_swap_b32 %0, %1" : "+v"(x), "+v"(y)); lg[i] = x + y; }
#pragma unroll
            for (int i = 0; i < 4; ++i) { const bool up = lane & 8; const float keep = up ? lg[i + 4] : lg[i], send = up ? lg[i] : lg[i + 4]; lg[i] = keep + dpp_f<0x128>(send); }
#pragma unroll
            for (int i = 0; i < 2; ++i) { const bool up = lane & 2; const float keep = up ? lg[i + 2] : lg[i], send = up ? lg[i] : lg[i + 2]; lg[i] = keep + dpp_f<0x4E>(send); }
            { const bool up = lane & 1; const float keep = up ? lg[1] : lg[0], send = up ? lg[0] : lg[1]; lg[0] = keep + dpp_f<0xB1>(send); }
            float logit = lg[0]; logit += dpp_f<0x1B>(dpp_f<0x141>(logit)); logit += __shfl_xor(logit, 16);
            const float mx = wave_max(logit);
            const float ex = expf(logit - mx); const float se = wave_sum(ex) * 0.25f;
            const int e = ((lane >> 5) & 1) * 8 + ((lane >> 3) & 1) * 4 + ((lane >> 1) & 1) * 2 + (lane & 1);
            const int b = rowq[q] >> 12, sq = rowq[q] & (SEQ - 1);
            if ((lane & 0x14) == 0) AFF[((size_t)b * 16 + e) * SEQ + sq] = ex / se;
            asm volatile("" ::: "memory");
        }
    }
#undef P6_LOAD
}
__device__ __forceinline__ unsigned block_excl_scan(unsigned v, LAS unsigned* tmp, int tid, int lane, int wave, unsigned& total) {
    unsigned inc = v;
#pragma unroll
    for (int o = 1; o < 64; o <<= 1) { const unsigned t = __shfl_up(inc, o); if (lane >= o) inc += t; }
    __syncthreads();
    if (lane == 63) tmp[wave] = inc;
    __syncthreads();
    unsigned base = 0, tot = 0;
#pragma unroll
    for (int w = 0; w < NWAVES; ++w) { const unsigned t = tmp[w]; if (w < wave) base += t; tot += t; }
    total = tot;
    return base + inc - v;
}
__device__ __forceinline__ void topk_unit(Frame& F, int b, int e) {
    LAS unsigned* hist = (LAS unsigned*)F.lds; LAS unsigned* sh = hist + 256; LAS unsigned* tmp = hist + 272;
    const int tid = F.tid, lane = F.lane, wave = F.wave;
    const float* aff = WSP(const float, WS_AFF) + ((size_t)b * 16 + e) * SEQ;
    unsigned key[8];
    { const u32x4 k0 = *(const u32x4*)(aff + tid * 8), k1 = *(const u32x4*)(aff + tid * 8 + 4); key[0] = k0.x; key[1] = k0.y; key[2] = k0.z; key[3] = k0.w; key[4] = k1.x; key[5] = k1.y; key[6] = k1.z; key[7] = k1.w; }
    unsigned prefix = 0, need = CAP;
#pragma unroll 1
    for (int pass = 0; pass < 4; ++pass) {
        const int shift = 24 - 8 * pass;
        if (tid < 256) hist[tid] = 0u;
        __syncthreads();
#pragma unroll
        for (int i = 0; i < 8; ++i) { const bool in = (pass == 0) || ((key[i] >> (shift + 8)) == prefix); if (in) (void)__hip_atomic_fetch_add(&hist[(key[i] >> shift) & 255u], 1u, __ATOMIC_RELAXED, __HIP_MEMORY_SCOPE_WORKGROUP); }
        __syncthreads();
        if (wave == 0) {
            const unsigned c0 = hist[4 * lane], c1 = hist[4 * lane + 1], c2 = hist[4 * lane + 2], c3 = hist[4 * lane + 3], s = c0 + c1 + c2 + c3;
            unsigned incl = s;
#pragma unroll
            for (int o = 1; o < 64; o <<= 1) { const unsigned t = __shfl_down(incl, o); if (lane + o < 64) incl += t; }
            const unsigned above = incl - s;
            if (above < need && need <= incl) {
                unsigned aa = above; int d;
                if (aa + c3 >= need) d = 3; else { aa += c3; if (aa + c2 >= need) d = 2; else { aa += c2; if (aa + c1 >= need) d = 1; else { aa += c1; d = 0; } } }
                sh[0] = (prefix << 8) | (unsigned)(4 * lane + d); sh[1] = need - aa;
            }
        }
        __syncthreads();
        prefix = sh[0]; need = sh[1];
    }
    const unsigned T = prefix;
    unsigned cg = 0, ce = 0;
#pragma unroll
    for (int i = 0; i < 8; ++i) { cg += key[i] > T; ce += key[i] == T; }
    unsigned tot;
    const unsigned eq_before = block_excl_scan(ce, tmp, tid, lane, wave, tot);
    unsigned sel_mask = 0, nsel = 0, er = eq_before;
#pragma unroll
    for (int i = 0; i < 8; ++i) { bool s = key[i] > T; if (key[i] == T) { s = er < need; ++er; } if (s) { sel_mask |= 1u << i; ++nsel; } }
    unsigned slot = block_excl_scan(nsel, tmp, tid, lane, wave, tot);
    LAS int* lst = (LAS int*)(hist + 512);
    float* vals = WSP(float, WS_VALS) + (e * 8 + b) * CAP; int* inv = WSP(int, WS_INV);
#pragma unroll
    for (int i = 0; i < 8; ++i) { const int tok = tid * 8 + i; int sl = -1;
        if (sel_mask & (1u << i)) { sl = (int)slot; if (slot < (unsigned)CAP) { lst[slot] = tok; vals[slot] = __builtin_bit_cast(float, key[i]); } ++slot; }
        inv[((size_t)b * SEQ + tok) * 16 + e] = sl; }
    __syncthreads();
    { unsigned* VOFF = WSP(unsigned, WS_VOFF);
#pragma unroll
      for (int hh = 0; hh < 2; ++hh) { u32x4 o;
#pragma unroll
          for (int i = 0; i < 2; ++i) { int R, C; pg8::stage_rc(tid * 16 + i * 8192, R, C);
              o[i] = (unsigned)lst[hh * 256 + R] * 1024u + (unsigned)(C * 2); o[2 + i] = (unsigned)lst[hh * 256 + 128 + R] * 1024u + (unsigned)(C * 2); }
          *(u32x4*)(VOFF + ((size_t)((e * 8 + b) * 2 + hh) * 512 + tid) * 4) = o; } }
    __syncthreads();
}
template <int PART>
__device__ __forceinline__ void p7_expert_weights(Frame& F) { const KArgs ka = kargs(); const float* const a_w_gate = ka->w_gate; const float* const a_w_up = ka->w_up; const float* const a_w_down = ka->w_down;
    LAS float* scr = (LAS float*)(F.lds + 4096 + F.wave * 16640);
    bf16_t* WGU = WSP(bf16_t, WS_WGU); bf16_t* WD = WSP(bf16_t, WS_WD);
    constexpr int I_G = 16 * 16 * 24, I_D = 16 * 24 * 16;
    const int bx = (int)blockIdx.x;
    if (PART == 0) {
        const bool split = (F.G == 256); const bool tk = split && bx < BATCH * N_EXP;
        const int v0 = split ? ((tk ? bx : bx - 128) * NWAVES + F.wave) + (tk ? 7168 : 0) : F.wave * F.G + bx;
        const int vstep = split ? 1024 : F.G * NWAVES, vend = split ? (tk ? 2 * I_G : 7168) : 2 * I_G;
        static_assert(1024 * 12 == 2 * I_G, "P7 item split");
        for (int it = v0; it < vend; it += vstep) {
            int r = it; const int up = r >= I_G; if (up) r -= I_G; const int ex = r / 384, q = r % 384, kb = q / 24, g = q % 24, f = g * 64;
            transpose_item64((up ? a_w_up : a_w_gate) + (size_t)ex * 1024 * 1536, 1536, 1024, kb * 64, f, (bf16_t*)((unsigned char*)WGU + (size_t)ex * 3072 * 1024), (f >> 7) * 256 + up * 128 + (f & 127), scr, F.lane, WGU_SCALE, 0.f); }
    } else {
        for (int r = F.wave * F.G + bx; r < I_D; r += F.G * NWAVES) { const int ex = r / 384, q = r % 384, kb = q / 16, g = q % 16;
            transpose_item64(a_w_down + (size_t)ex * 1536 * 1024, 1024, 1536, kb * 64, g * 64, (bf16_t*)((unsigned char*)WD + (size_t)ex * 1024 * 1536), g * 64, scr, F.lane, WD_SCALE, 0.f); }
    }
}
__device__ __forceinline__ void p10_final(Frame& F, float* dst_override = nullptr) { const KArgs ka = kargs(); const float* const a_ln2_g = ka->ln2_g; const float* const a_ln2_b = ka->ln2_b; float* const a_out = ka->out;
    const float* const a_ln1_g = ka->ln1_g; const float* const a_ln1_b = ka->ln1_b; const float* const a_x = ka->x;
    const float* mod = WSP(const float, WS_MOD); const bf16_t* Y = WSP(const bf16_t, WS_Y); const int* inv = WSP(const int, WS_INV); const float* STAT = WSP(const float, WS_STAT);
    const int gw = F.vcu * NWAVES + F.wave, NGW = F.G * NWAVES, lane = F.lane;
    int slot_n = inv[(size_t)gw * 16 + (lane & 15)];
    f32x4 xn[4]; u32x2 mn[4]; f32x2 stn = *(const f32x2*)(STAT + (size_t)gw * 2);
    { const f32x4* xr0 = (const f32x4*)(a_x + (size_t)gw * 1024) + lane; const u32x2* mr0 = (const u32x2*)(a_out + (size_t)gw * 1024) + lane;
#pragma unroll
      for (int j = 0; j < 4; ++j) { xn[j] = xr0[64 * j]; mn[j] = mr0[64 * j]; } }
    for (int row = gw; row < M_TOK; row += NGW) {
        const int b = row >> 12;
        f32x4* xr = (f32x4*)(a_out + (size_t)row * 1024) + lane;
        const int myslot = slot_n; f32x4 xc[4]; const float mean1 = stn[0], rstd1 = stn[1];
#pragma unroll
        for (int j = 0; j < 4; ++j) xc[j] = xn[j] * ALPHA + (f32x4){bf_lo(mn[j].x), bf_hi(mn[j].x), bf_lo(mn[j].y), bf_hi(mn[j].y)};
        unsigned long long msk = __ballot(myslot >= 0) & 0xFFFFull;
        f32x4 mo[4];
#pragma unroll
        for (int j = 0; j < 4; ++j) mo[j] = (f32x4){0.f, 0.f, 0.f, 0.f};
        { const int rn = row + NGW < M_TOK ? row + NGW : row;
          slot_n = inv[(size_t)rn * 16 + (lane & 15)]; stn = *(const f32x2*)(STAT + (size_t)rn * 2);
          const f32x4* xrn = (const f32x4*)(a_x + (size_t)rn * 1024) + lane; const u32x2* mrn = (const u32x2*)(a_out + (size_t)rn * 1024) + lane;
#pragma unroll
          for (int j = 0; j < 4; ++j) { xn[j] = xrn[64 * j]; mn[j] = mrn[64 * j]; } }
        while (msk) {
            const int e0 = __builtin_ctzll(msk); msk &= msk - 1;
            const bool two = msk != 0; const int e1 = two ? __builtin_ctzll(msk) : e0; if (two) msk &= msk - 1;
            const int s0 = __shfl(myslot, e0), s1 = __shfl(myslot, e1);
            const unsigned* y0 = (const unsigned*)((const unsigned char*)Y + ((size_t)(e0 * 8 + b) * CAP + s0) * 1024) + lane;
            const unsigned* y1 = (const unsigned*)((const unsigned char*)Y + ((size_t)(e1 * 8 + b) * CAP + s1) * 1024) + lane;
            unsigned w0[4], w1[4];
#pragma unroll
            for (int j = 0; j < 4; ++j) { w0[j] = y0[64 * j]; w1[j] = y1[64 * j]; }
            const float f1 = two ? 1.f : 0.f;
#pragma unroll
            for (int j = 0; j < 4; ++j) { const auto a0 = __builtin_amdgcn_cvt_pk_f32_fp8((int)w0[j], false), a1 = __builtin_amdgcn_cvt_pk_f32_fp8((int)w0[j], true);
                const auto c0 = __builtin_amdgcn_cvt_pk_f32_fp8((int)w1[j], false), c1 = __builtin_amdgcn_cvt_pk_f32_fp8((int)w1[j], true);
                mo[j][0] += a0[0] + f1 * c0[0]; mo[j][1] += a0[1] + f1 * c0[1]; mo[j][2] += a1[0] + f1 * c1[0]; mo[j][3] += a1[1] + f1 * c1[1]; }
        }
        f32x4 v[4]; float sm = 0.f;
#pragma unroll
        for (int j = 0; j < 4; ++j) { const int col = 4 * lane + 256 * j; const f32x4 g2 = *(const f32x4*)(mod + b * 6144 + 5120 + col);
            const f32x4 x1 = (xc[j] - mean1) * rstd1 * *(const f32x4*)(a_ln1_g + col) + *(const f32x4*)(a_ln1_b + col);
            v[j] = x1 * ALPHA + g2 * mo[j] * (DBG_MOE_F / Y_SCALE); sm += (v[j][0] + v[j][1]) + (v[j][2] + v[j][3]); }
        const float mean = wave_sum(sm) * (1.f / 1024.f); float s2 = 0.f;
#pragma unroll
        for (int j = 0; j < 4; ++j) { v[j] = v[j] - mean; s2 += (v[j][0] * v[j][0] + v[j][1] * v[j][1]) + (v[j][2] * v[j][2] + v[j][3] * v[j][3]); }
        const float rstd = 1.f / sqrtf(wave_sum(s2) * (1.f / 1024.f) + NORM_EPS);
#pragma unroll
        for (int j = 0; j < 4; ++j) { const int col = 4 * lane + 256 * j; const f32x4 g = *(const f32x4*)(a_ln2_g + col), bb = *(const f32x4*)(a_ln2_b + col);
            (dst_override ? (f32x4*)(dst_override + (size_t)row * 1024) + lane : xr)[64 * j] = v[j] * rstd * g + bb; }
    }
}
constexpr int N_PHASES = 11;
__global__ void __launch_bounds__(NTHR, 2) fwd_kernel(Args args) {
    extern __shared__ __attribute__((aligned(16))) unsigned char lds_raw[];
    Frame F;
    F.lds = (LAS unsigned char*)lds_raw;
    F.tid = threadIdx.x; F.lane = F.tid & 63; F.wave = __builtin_amdgcn_readfirstlane(F.tid >> 6);
    F.G = gridDim.x; { const int bx = blockIdx.x; F.vcu = (F.G % 8 == 0) ? (bx % 8) * (F.G / 8) + bx / 8 : bx; }
    F.ws = kargs()->ws;
    volatile LAS unsigned* MISC = (volatile LAS unsigned*)(F.lds + MISC_OFF);
    for (int u = F.tid; u < (LDS_BYTES - MISC_OFF) / 4; u += NTHR) MISC[u] = 0u;
    __syncthreads();
    const int lo = kargs()->ph_lo, hi = kargs()->ph_hi;
    unsigned* barw = (unsigned*)(F.ws + WS_CTL) + CW_BAR;
    XcdBarrier bar; bar.bar = barw; bar.x = 0; bar.st = nullptr;
    if (hi - lo > 1) bar = xcd_barrier_post(barw, MISC + 8);
#ifndef PHMASK
#define PHMASK 0x7ff
#endif
#define IN(k) ((((PHMASK) >> (k)) & 1) && lo <= (k) && (k) < hi)
#define SEAM(k) do { if (IN(k) && IN((k) + 1)) xcd_barrier(bar); } while (0)

    if (IN(0)) { p0_prologue(F);
#if DBG_REP_P0 > 1
        __syncthreads(); p0_prologue(F);
#endif
    } SEAM(0);
    if (IN(1)) { _Pragma("unroll 1") for (int rep_ = 0; rep_ < DBG_REP_THIN; ++rep_) p1_mod_h1(F); } SEAM(1);
    if (IN(2)) {
        pg8::Gemm g{WSP(const bf16_t, WS_H), WSP(const bf16_t, WS_WIN), M_TOK, IN_WP, 1024, 1 << 30, nullptr};
        pg8::StaticOrder S; S.init(M_TOK, IN_WP, F.G, (int)blockIdx.x);
        static_assert(WS_DV - WS_DK == WS_DK - WS_DQ, "dq/dk/dv contiguous");
        EpiProj E{WSP(bf16_t, WS_CQ), WSP(bf16_t, WS_CKV), WSP(bf16_t, WS_KN)  , WSP(bf16_t, WS_DQ), WSP(float, WS_SSQ), WSP(const float, WS_ROPE)};
        pg8::gemm_phase<EpiProj, false, true>(F.lds, g, S, E);

    } SEAM(2);
    if (IN(3)) {
#ifdef DBG_DIL_MODE
        __syncthreads();
        for (int u = F.vcu; u < BATCH * DIL_H * 4; u += F.G) dil_unit<DBG_DIL_MODE>(F, u >> 5, (u >> 2) & 7, u & 3);
        __syncthreads();
#endif
#ifndef NO_P3G
#ifndef NO_GQ
        { pg8::Gemm g{WSP(const bf16_t, WS_CQ), WSP(const bf16_t, WS_WUQ), M_TOK, 768, Q_LORA, 1 << 30, nullptr};
          pg8::StaticOrder S; S.init(M_TOK, 768, F.G, (int)blockIdx.x);
          EpiQ E{WSP(bf16_t, WS_Q), WSP(const float, WS_SSQ), WSP(const float, WS_ROPE)};
          pg8::gemm_phase<EpiQ, false>(F.lds, g, S, E);
#if DBG_REP_P3G > 1
          pg8::gemm_phase<EpiQ, false>(F.lds, g, S, E);
#endif
 }
#endif
#ifndef NO_GK
        { pg8::Gemm g{WSP(const bf16_t, WS_CKV), WSP(const bf16_t, WS_WK), M_TOK, 512, KV_LORA, 1 << 30, nullptr};
          pg8::StaticOrder S; S.init(M_TOK, 512, F.G, (int)blockIdx.x);
          EpiKN8 E{WSP(unsigned char, WS_KN), WSP(const float, WS_SSQ)};
          pg8::gemm_phase<EpiKN8, false>(F.lds, g, S, E); }
#endif
        { pg8::Gemm g{WSP(const bf16_t, WS_WV), WSP(const bf16_t, WS_CKV), 512, M_TOK, KV_LORA, 1 << 30, nullptr};
          pg8::StaticOrder S; S.init(512, M_TOK, F.G, (int)blockIdx.x);
          EpiVt8 E{WSP(unsigned char, WS_V), WSP(const float, WS_SSQ)};
          pg8::gemm_phase<EpiVt8, false>(F.lds, g, S, E); }
#endif
    } SEAM(3);
    if (IN(4)) {
        const bool dil_first = (F.vcu & 1) == 0;
#ifndef NO_DIL
        if (dil_first) {
            for (int u = F.vcu; u < BATCH * DIL_H * 4; u += F.G) dil_unit<0>(F, u >> 5, (u >> 2) & 7, u & 3);
            __syncthreads();
        }
#endif
#pragma unroll 1
        for (int rep = 0; rep < DBG_REP_MLA; ++rep)
        for (int u = F.vcu; u < BATCH * MLA_H * 8; u += F.G) mla_unit(F, u >> 6, (u >> 3) & 7, u & 7);
#ifndef NO_DIL
        if (!dil_first) {
            __syncthreads();
            for (int u = F.vcu; u < BATCH * DIL_H * 4; u += F.G) dil_unit<0>(F, u >> 5, (u >> 2) & 7, u & 3);
            __syncthreads();
        }
#endif
    } SEAM(4);
    if (IN(5)) {
        pg8::Gemm g{WSP(const bf16_t, WS_MIX), WSP(const bf16_t, WS_WOUT), M_TOK, 1024, 1024, 1 << 30, nullptr};
        pg8::StaticOrder S; S.init(M_TOK, 1024, F.G, (int)blockIdx.x);
        EpiOut E{kargs()->out, WSP(const float, WS_MOD)};
        pg8::gemm_phase<EpiOut, false, true>(F.lds, g, S, E);

    } SEAM(5);
    if (IN(6)) { _Pragma("unroll 1") for (int rep_ = 0; rep_ < DBG_REP_THIN; ++rep_) { p6_ln1_router(F); __syncthreads(); } } SEAM(6);
    if (IN(7)) {
        for (int u = blockIdx.x; u < BATCH * N_EXP; u += F.G) topk_unit(F, u >> 4, u & 15);
        p7_expert_weights<0>(F);
    } SEAM(7);
    if (IN(8)) {
        const bool wd_first = (F.vcu & 1) == 0;
        if (wd_first) { p7_expert_weights<1>(F); __syncthreads(); }
        pg8::Gemm g{WSP(const bf16_t, WS_H), WSP(const bf16_t, WS_WGU), MROWS, 3072, 1024, 16, WSP(const int, WS_VOFF)};
        pg8::StaticOrder S; S.init(MROWS, 3072, F.G, (int)blockIdx.x);
        EpiGU E{WSP(bf16_t, WS_HID)};
        pg8::gemm_phase<EpiGU, true, true>(F.lds, g, S, E);
#if DBG_REP_P8 > 1
          pg8::gemm_phase<EpiGU, false, true>(F.lds, g, S, E);
#endif
        if (!wd_first) { __syncthreads(); p7_expert_weights<1>(F); }
    } SEAM(8);
    if (IN(9)) {
        pg8::Gemm g{WSP(const bf16_t, WS_HID), WSP(const bf16_t, WS_WD), MROWS, 1024, D_FF, 16, nullptr};
        pg8::StaticOrder S; S.init(MROWS, 1024, F.G, (int)blockIdx.x);
        EpiDown E{WSP(bf16_t, WS_Y), WSP(const float, WS_VALS)};
        pg8::gemm_phase<EpiDown, false, true>(F.lds, g, S, E);
#if DBG_REP_P9 > 1
          pg8::gemm_phase<EpiDown, false, true>(F.lds, g, S, E);
#endif

    } SEAM(9);
    if (IN(10)) {
#ifdef DBG_REP_P10
        p10_final(F, WSP(float, WS_Z)); __syncthreads();
#endif
        p10_final(F); }
#undef IN
#undef SEAM
}

extern "C" void kernel_launch(void* const* d_in, const int* in_sizes, int n_in, void* d_out, int out_size, void* d_ws, size_t ws_size, hipStream_t stream) {
    static int grid = 0;
    if (grid == 0) {
        if (n_in != 19 || in_sizes[0] != M_TOK * D_MODEL || out_size != M_TOK * D_MODEL || ws_size < WS_END) {
            fprintf(stderr, "kernel_launch: unexpected shapes (n_in %d, in0 %d, out %d, ws %zu); nothing launched\n", n_in, n_in > 0 ? in_sizes[0] : -1, out_size, ws_size); grid = -1; return; }
        int dev = 0, cus = 0, per_cu = 0;
        if (hipGetDevice(&dev) != hipSuccess || hipDeviceGetAttribute(&cus, hipDeviceAttributeMultiprocessorCount, dev) != hipSuccess) { grid = -1; return; }
        if (hipFuncSetAttribute((const void*)fwd_kernel, hipFuncAttributeMaxDynamicSharedMemorySize, LDS_BYTES) != hipSuccess) { fprintf(stderr, "kernel_launch: hipFuncSetAttribute failed\n"); grid = -1; return; }
        if (hipOccupancyMaxActiveBlocksPerMultiprocessor(&per_cu, (const void*)fwd_kernel, NTHR, LDS_BYTES) != hipSuccess || per_cu < 1)
            fprintf(stderr, "kernel_launch: note: occupancy query reports %d workgroups per CU\n", per_cu);
        (void)hipGetLastError();
        grid = cus < 256 ? cus : 256;
    }
    if (grid < 0) return;
    (void)hipMemsetAsync((char*)d_ws + WS_CTL, 0, CTL_ZERO_BYTES, stream);
    Args a{};
    a.x = (const float*)d_in[0]; a.c = (const float*)d_in[1]; a.w_ada = (const float*)d_in[2]; a.b_ada = (const float*)d_in[3]; a.w_in = (const float*)d_in[4];
    a.q_norm_g = (const float*)d_in[5]; a.w_uq = (const float*)d_in[6]; a.kv_norm_g = (const float*)d_in[7]; a.w_ukv = (const float*)d_in[8]; a.rel_bias = (const float*)d_in[9];
    a.w_out = (const float*)d_in[10]; a.ln1_g = (const float*)d_in[11]; a.ln1_b = (const float*)d_in[12]; a.w_router = (const float*)d_in[13]; a.w_gate = (const float*)d_in[14];
    a.w_up = (const float*)d_in[15]; a.w_down = (const float*)d_in[16]; a.ln2_g = (const float*)d_in[17]; a.ln2_b = (const float*)d_in[18];
    a.out = (float*)d_out; a.ws = (unsigned char*)d_ws;
#if MK_ONE_LAUNCH
    a.ph_lo = 0; a.ph_hi = N_PHASES;
    hipLaunchKernelGGL(fwd_kernel, dim3(grid), dim3(NTHR), LDS_BYTES, stream, a);
#else
    for (int p = 0; p < N_PHASES; ++p) { a.ph_lo = p; a.ph_hi = p + 1; hipLaunchKernelGGL(fwd_kernel, dim3(grid), dim3(NTHR), LDS_BYTES, stream, a); }
#endif
}
```

```cpp
#include <hip/hip_runtime.h>
#include <cstdio>
#include <cstdint>

#ifndef MK_ONE_LAUNCH
#define MK_ONE_LAUNCH 1
#endif

#define LAS __attribute__((address_space(3)))
#define GAS __attribute__((address_space(1)))
typedef unsigned short bf16_t;
typedef short bf16x8 __attribute__((ext_vector_type(8)));
typedef short s16x4 __attribute__((ext_vector_type(4)));
typedef float f32x4 __attribute__((ext_vector_type(4)));
typedef float f32x2 __attribute__((ext_vector_type(2)));
typedef float f32x16 __attribute__((ext_vector_type(16)));
typedef unsigned u32x4 __attribute__((ext_vector_type(4)));
typedef unsigned u32x2 __attribute__((ext_vector_type(2)));
typedef int i32x4 __attribute__((ext_vector_type(4)));
typedef int i32x8 __attribute__((ext_vector_type(8)));

constexpr int D_MODEL = 1024, BATCH = 8, SEQ = 4096, M_TOK = BATCH * SEQ;
constexpr int MLA_H = 8, MLA_NOPE = 64, MLA_ROPE = 32, MLA_V = 64, Q_LORA = 384, KV_LORA = 256, MLA_DQ = 96;
constexpr int DIL_H = 8, DIL_D = 64;
constexpr int N_EXP = 16, CAP = 512, D_FF = 1536;
constexpr int IN_W = 2208, IN_WP = 2304;
constexpr float ALPHA = 1.189207115002721f;
constexpr float NORM_EPS = 1e-6f;
constexpr float LOG2E = 1.4426950408889634f;
constexpr float QS_MLA = 0.10206207261596575f * LOG2E;
constexpr float Q8_SCALE = QS_MLA * 2.f * 8.f, K8_SCALE = 0.5f;
constexpr float QS_DIL = 0.125f * LOG2E;
constexpr float NEG_BIG = -1e30f;
#ifndef DBG_MLA_F
#define DBG_MLA_F 1.f
#endif
#ifndef DBG_DIL_F
#define DBG_DIL_F 1.f
#endif
#ifndef DBG_XEXP
#define DBG_XEXP 0
#endif
#ifndef DBG_REP_P0
#define DBG_REP_P0 1
#endif
#ifndef DBG_REP_P7
#define DBG_REP_P7 1
#endif
#ifndef DBG_REP_MLA
#define DBG_REP_MLA 1
#endif
#ifndef DBG_REP_DIL
#define DBG_REP_DIL 1
#endif
#ifndef DBG_REP_P8
#define DBG_REP_P8 1
#endif
#ifndef DBG_REP_P2
#define DBG_REP_P2 1
#endif
#ifndef DBG_REP_P9
#define DBG_REP_P9 1
#endif
#ifndef DBG_REP_P5
#define DBG_REP_P5 1
#endif
#ifndef DBG_REP_THIN
#define DBG_REP_THIN 1
#endif
#ifndef DBG_REP_P3G
#define DBG_REP_P3G 1
#endif
#ifndef DBG_MIX_F
#define DBG_MIX_F 1.f
#endif
#ifndef DBG_MOE_F
#define DBG_MOE_F 1.f
#endif
constexpr float WGU_SCALE = 32.f, WD_SCALE = 64.f, HID_SCALE = 4.f, WIN_SCALE = 32.f, WOUT_SCALE = 32.f, MIX_SCALE = 16.f, Y_SCALE = 64.f;
constexpr int MROWS = N_EXP * BATCH * CAP;

constexpr size_t MiB = 1u << 20;
constexpr size_t WS_CTL = 0, CTL_ZERO_BYTES = 1 * MiB;
constexpr size_t WS_ROPE = 1 * MiB;
constexpr size_t WS_TABG = 1 * MiB + 512 * 1024;
constexpr size_t WS_MODP = 2 * MiB;
constexpr size_t WS_MOD = 5 * MiB;
constexpr size_t WS_AFF = 6 * MiB;
constexpr size_t WS_STAT = 8 * MiB;
constexpr size_t WS_VALS = 8 * MiB + 256 * 1024;
constexpr size_t WS_INV = 9 * MiB;
constexpr size_t WS_SSQ = 11 * MiB;
constexpr size_t WS_WIN = 16 * MiB;
constexpr size_t WS_WUQ = 21 * MiB;
constexpr size_t WS_WK = 22 * MiB;
constexpr size_t WS_WV = 22 * MiB + 512 * 1024;
constexpr size_t WS_WOUT = 23 * MiB;
constexpr size_t WS_LSE = 26 * MiB;
constexpr size_t WS_H = 32 * MiB;
constexpr size_t WS_O1 = 32 * MiB, WS_O2 = 64 * MiB;
constexpr size_t WS_WGU = 96 * MiB;
constexpr size_t WS_WD = 192 * MiB;
constexpr size_t WS_CQ = 96 * MiB;
constexpr size_t WS_CKV = 120 * MiB;
constexpr size_t WS_KR = 136 * MiB;
constexpr size_t WS_DQ = 138 * MiB, WS_DK = 170 * MiB, WS_DV = 202 * MiB;
constexpr size_t WS_Q = 240 * MiB;
constexpr size_t WS_KN = 288 * MiB;
constexpr size_t WS_V = 320 * MiB;
constexpr size_t WS_Z = 240 * MiB;
constexpr size_t WS_MIX = 368 * MiB;
constexpr size_t WS_HID = 240 * MiB;
constexpr size_t WS_VOFF = 336 * MiB;
constexpr size_t WS_XG = 336 * MiB;
constexpr size_t WS_Y = 32 * MiB;
constexpr size_t WS_M = 432 * MiB;
constexpr size_t WS_END = 496 * MiB;
constexpr int CW_BAR = 4096;
constexpr int CW_QUEUE = 64;

constexpr int RING_BYTES = 147456;
constexpr int MISC_OFF = RING_BYTES;
constexpr int LDS_BYTES = RING_BYTES + 512;
constexpr int NWAVES = 8, NTHR = 512;

__device__ __forceinline__ unsigned f2bf(float f) { unsigned u = __builtin_bit_cast(unsigned, f); return (u + 0x7fffu + ((u >> 16) & 1u)) >> 16; }
__device__ __forceinline__ unsigned pk2(float lo, float hi) { return f2bf(lo) | (f2bf(hi) << 16); }
__device__ __forceinline__ unsigned cvt_pk_bf16(float lo, float hi) { unsigned r; asm volatile("v_cvt_pk_bf16_f32 %0, %1, %2" : "=v"(r) : "v"(lo), "v"(hi)); return r; }
__device__ __forceinline__ float bf_lo(unsigned w) { return __builtin_bit_cast(float, w << 16); }
__device__ __forceinline__ float bf_hi(unsigned w) { return __builtin_bit_cast(float, w & 0xffff0000u); }
template <int CTRL> __device__ __forceinline__ float dpp_f(float v) { return __builtin_bit_cast(float, __builtin_amdgcn_update_dpp(0, __builtin_bit_cast(int, v), CTRL, 0xF, 0xF, true)); }
__device__ __forceinline__ float lane_f(float v, int l) { return __builtin_bit_cast(float, __builtin_amdgcn_readlane(__builtin_bit_cast(int, v), l)); }
__device__ __forceinline__ float wave_sum(float v) {
    v += dpp_f<0xB1>(v); v += dpp_f<0x4E>(v); v += dpp_f<0x141>(v); v += dpp_f<0x140>(v);
    return (lane_f(v, 0) + lane_f(v, 16)) + (lane_f(v, 32) + lane_f(v, 48));
}
__device__ __forceinline__ float wave_max(float v) {
    v = fmaxf(v, dpp_f<0xB1>(v)); v = fmaxf(v, dpp_f<0x4E>(v)); v = fmaxf(v, dpp_f<0x141>(v)); v = fmaxf(v, dpp_f<0x140>(v));
    return fmaxf(fmaxf(lane_f(v, 0), lane_f(v, 16)), fmaxf(lane_f(v, 32), lane_f(v, 48)));
}
#ifndef DBG_FP8_EMU
#define DBG_FP8_EMU 0
#endif
#ifndef DBG_HID_S
#define DBG_HID_S 4.f
#endif
__device__ __forceinline__ unsigned pk4_fp8(float a, float b, float c, float d) {
    a = __builtin_amdgcn_fmed3f(a, -448.f, 448.f); b = __builtin_amdgcn_fmed3f(b, -448.f, 448.f); c = __builtin_amdgcn_fmed3f(c, -448.f, 448.f); d = __builtin_amdgcn_fmed3f(d, -448.f, 448.f);
    int p = __builtin_amdgcn_cvt_pk_fp8_f32(a, b, 0, false); p = __builtin_amdgcn_cvt_pk_fp8_f32(c, d, p, true); return (unsigned)p;
}
__device__ __forceinline__ unsigned pk4_fp8_nc(float a, float b, float c, float d) { int p = __builtin_amdgcn_cvt_pk_fp8_f32(a, b, 0, false); p = __builtin_amdgcn_cvt_pk_fp8_f32(c, d, p, true); return (unsigned)p; }
__device__ __forceinline__ float q8(float x, float sc, float isc) {
#if DBG_FP8_EMU
    const int p = __builtin_amdgcn_cvt_pk_fp8_f32(x * sc, 0.f, 0, false); return __builtin_amdgcn_cvt_f32_fp8(p, 0) * isc;
#else
    return x;
#endif
}
#define LDS_WAIT() asm volatile("s_waitcnt lgkmcnt(0)" ::: "memory")
#define VM_WAIT() asm volatile("s_waitcnt vmcnt(0)" ::: "memory")

namespace pg8 {
constexpr int BM = 256, BK = 64, HALF = 128, HTB = HALF * BK * 2, STAGE_BYTES = 8 * HTB, NXCD = 8, WGM = 8;
__host__ __device__ __forceinline__ int lds_byte(int r, int c) { const int st = (r >> 4) * 2 + (c >> 5), rr = r & 15, cc = c & 31, ob = rr * 64 + cc * 2; return st * 1024 + (ob ^ (((ob >> 9) & 1) << 5)); }
__host__ __device__ __forceinline__ void stage_rc(int b, int& R, int& C) { const int st = b / 1024, sb = b % 1024, swz = sb ^ (((sb >> 9) & 1) << 5); R = (st >> 1) * 16 + swz / 64; C = (st & 1) * 32 + (swz % 64) / 2; }
__host__ __device__ __forceinline__ int perm32(int rho) { const int n = rho >> 4, i = rho & 15; return 8 * (i >> 2) + 4 * n + (i & 3); }

struct Unit { int pm, pn; };
struct Gemm { const bf16_t* A; const bf16_t* Bt; int M, N, K; int grp; const int* rowsrc; };

struct StaticOrder {
    int nM, nN, nwg, G, c;
    __device__ void init(int M, int N, int G_, int c_) { nM = M / BM; nN = N / BM; nwg = nM * nN; G = G_; c = c_; }
    __device__ bool next(int i, Unit& u) const {
        const long L = (long)i * G + c; if (L >= nwg) return false;
        int wgid = (int)L; { const int q = nwg / NXCD, r = nwg % NXCD, xcd = wgid % NXCD, off = wgid / NXCD; wgid = (xcd < r ? xcd * (q + 1) : r * (q + 1) + (xcd - r) * q) + off; }
        const int nig = WGM * nN, gid = wgid / nig, fm = gid * WGM, gsz = (nM - fm) < WGM ? (nM - fm) : WGM;
        u.pm = fm + ((wgid % nig) % gsz); u.pn = (wgid % nig) / gsz; return true;
    }
};

using ::i32x4; using ::i32x8;
template <class Epi, bool GATHER, bool FP8 = false>
__device__ __forceinline__ void gemm_phase(LAS unsigned char* lds, const Gemm g, const StaticOrder& S, const Epi& E) {
    const int tid = threadIdx.x, wid = __builtin_amdgcn_readfirstlane(tid >> 6), lane = tid & 63, wr = wid >> 2, wc = wid & 3, fr = lane & 15, fq = lane >> 4;
    const int K = g.K, KB = FP8 ? g.K : g.K * 2, nt = KB / 128, nN = g.N / BM;
    unsigned voffA[2], voffB[2];
#pragma unroll
    for (int i = 0; i < 2; ++i) { int R, C; stage_rc(tid * 16 + i * 8192, R, C); const int Rb = (R & ~31) + perm32(R & 31);
        voffA[i] = (unsigned)(R * KB + C * 2); voffB[i] = (unsigned)(Rb * KB + C * 2); }
    const size_t kstep = (size_t)(BK * 2);
    const size_t hstep = GATHER ? (size_t)0 : (size_t)HALF * KB;
    const size_t hstepB = (size_t)HALF * KB, tstep = 2 * hstepB;
    const unsigned ldsw = (unsigned)wid * 1024u;
    const int aoff = lds_byte(wr * 64 + fr, fq * 8), boff = lds_byte(wc * 32 + fr, fq * 8);
#define PG8_SA(b, h) (((b) * 2 + (h)) * HTB)
#define PG8_SB(b, h) ((4 + (b) * 2 + (h)) * HTB)
    const unsigned lds_base_u = (unsigned)__builtin_amdgcn_readfirstlane((int)(unsigned)(uintptr_t)lds + (int)ldsw);
#define PG8_STAGE(bufoff, gbase, voff) do { _Pragma("unroll") for (int _i = 0; _i < 2; ++_i) { \
        if constexpr (FP8) { unsigned keep_; asm volatile("s_mov_b32 %0, m0\n\ts_mov_b32 m0, %3\n\ts_nop 0\n\tglobal_load_lds_dwordx4 %1, %2\n\ts_mov_b32 m0, %0" \
              : "=&s"(keep_) : "v"((voff)[_i]), "s"((const char*)(gbase)), "s"(lds_base_u + (unsigned)((bufoff) + _i * 8192)) : "memory"); } \
        else __builtin_amdgcn_global_load_lds((const unsigned*)((const char*)(gbase) + (voff)[_i]), (LAS unsigned*)(lds + (bufoff) + ldsw + _i * 8192), 16, 0, 0); } } while (0)
#define PG8_LDA(dst, b, h) do { _Pragma("unroll") for (int m = 0; m < 4; ++m) _Pragma("unroll") for (int k = 0; k < 2; ++k) dst[m][k] = *(const LAS bf16x8*)(lds + PG8_SA(b, h) + aoff + m * 2048 + k * 1024); } while (0)
#define PG8_LDB(dst, b, h) do { _Pragma("unroll") for (int n = 0; n < 2; ++n) _Pragma("unroll") for (int k = 0; k < 2; ++k) dst[n][k] = *(const LAS bf16x8*)(lds + PG8_SB(b, h) + boff + n * 2048 + k * 1024); } while (0)
#define PG8_MMA(ai, bj, At, Bt) do { __builtin_amdgcn_s_setprio(1); _Pragma("unroll") for (int m = 0; m < 4; ++m) _Pragma("unroll") for (int n = 0; n < 2; ++n) { \
        if constexpr (FP8) { const i32x8 b8_ = __builtin_shufflevector(__builtin_bit_cast(i32x4, Bt[n][0]), __builtin_bit_cast(i32x4, Bt[n][1]), 0, 1, 2, 3, 4, 5, 6, 7); \
            const i32x8 a8_ = __builtin_shufflevector(__builtin_bit_cast(i32x4, At[m][0]), __builtin_bit_cast(i32x4, At[m][1]), 0, 1, 2, 3, 4, 5, 6, 7); \
            asm volatile("v_mfma_f32_16x16x128_f8f6f4 %0, %1, %2, %0" : "+v"(acc[ai][bj][m][n]) : "v"(b8_), "v"(a8_)); } \
        else { _Pragma("unroll") for (int k = 0; k < 2; ++k) acc[ai][bj][m][n] = __builtin_amdgcn_mfma_f32_16x16x32_bf16(Bt[n][k], At[m][k], acc[ai][bj][m][n], 0, 0, 0); } } \
        __builtin_amdgcn_s_setprio(0); } while (0)
#define PG8_WAIT_V(n) asm volatile("s_waitcnt vmcnt(" #n ")" ::: "memory")
#define PG8_WAIT_L(n) asm volatile("s_waitcnt lgkmcnt(" #n ")" ::: "memory")
#define PG8_BAR __builtin_amdgcn_s_barrier()
#define PG8_SCHED __builtin_amdgcn_sched_barrier(0)
#define PG8_ASRC(U) (GATHER ? (const char*)g.A + (size_t)(((U).pm >> 1) & 7) * ((size_t)SEQ * KB) : (const char*)g.A + (size_t)(U).pm * tstep)
#define PG8_GV(U) (*(const u32x4*)((const unsigned*)g.rowsrc + ((size_t)(U).pm * 512 + tid) * 4))
#define PG8_BSRC(U) ((const char*)g.Bt + (size_t)(((U).pm / g.grp) * nN + (U).pn) * tstep)
    Unit cur, nxt; int ui = 0;
    if (!S.next(0, cur)) return;
    u32x4 gvc = (u32x4){0u, 0u, 0u, 0u}, gvn = gvc, gvnn = gvc;
    if constexpr (GATHER) { gvc = PG8_GV(cur); Unit t1; gvn = S.next(1, t1) ? PG8_GV(t1) : gvc; }
#define PG8_STAGE_A(bufoff, base, H, NEXT) do { if constexpr (GATHER) { const bool nx_ = (NEXT); unsigned va_[2] = {nx_ ? gvn[2 * (H)] : gvc[2 * (H)], nx_ ? gvn[2 * (H) + 1] : gvc[2 * (H) + 1]}; PG8_STAGE(bufoff, base, va_); } \
        else PG8_STAGE(bufoff, (base) + (H) * hstep, voffA); } while (0)
    f32x4 acc[2][2][4][2];
#pragma unroll
    for (int a = 0; a < 2; ++a)
#pragma unroll
        for (int b = 0; b < 2; ++b)
#pragma unroll
            for (int m = 0; m < 4; ++m)
#pragma unroll
                for (int n = 0; n < 2; ++n) acc[a][b][m][n] = (f32x4){0.f, 0.f, 0.f, 0.f};
    bf16x8 At[4][2], B0[2][2], B1[2][2];
    const char* cA = PG8_ASRC(cur);
    const char* cB = PG8_BSRC(cur);
    PG8_STAGE(PG8_SB(0, 0), cB, voffB); PG8_STAGE(PG8_SB(0, 1), cB + hstepB, voffB); PG8_STAGE_A(PG8_SA(0, 0), cA, 0, false); PG8_STAGE_A(PG8_SA(0, 1), cA, 1, false);
    if (wr == 1) PG8_BAR;
    PG8_WAIT_V(2); PG8_BAR;
    PG8_STAGE(PG8_SB(1, 0), cB + kstep, voffB); PG8_STAGE_A(PG8_SA(1, 0), cA + kstep, 0, false); PG8_STAGE(PG8_SB(1, 1), cB + hstepB + kstep, voffB);
    PG8_WAIT_V(6); PG8_BAR;
    for (;;) {
        const bool has_next = S.next(ui + 1, nxt);
        const char* nA = cA; const char* nB = cB;
        if (has_next) { nA = PG8_ASRC(nxt); nB = PG8_BSRC(nxt); }
#pragma unroll 1
        for (int t = 0; t < nt; t += 2) {
            const bool last = (t == nt - 2);
            const char* a1 = cA + (size_t)(t + 1) * kstep;
            const char* a2 = last ? nA : cA + (size_t)(t + 2) * kstep; const char* b2 = last ? nB : cB + (size_t)(t + 2) * kstep;
            const char* a3 = a2 + kstep; const char* b3 = b2 + kstep;
            PG8_LDB(B0, 0, 0); PG8_LDB(B1, 0, 1); PG8_SCHED; PG8_LDA(At, 0, 0); PG8_STAGE_A(PG8_SA(1, 1), a1, 1, false);
            PG8_WAIT_V(8); PG8_WAIT_L(0); PG8_BAR; PG8_MMA(0, 0, At, B0); PG8_MMA(0, 1, At, B1); PG8_BAR; PG8_SCHED;
            PG8_LDA(At, 0, 1); PG8_STAGE(PG8_SB(0, 0), b2, voffB); PG8_STAGE(PG8_SB(0, 1), b2 + hstepB, voffB); PG8_STAGE_A(PG8_SA(0, 0), a2, 0, last);
            PG8_WAIT_V(8); PG8_WAIT_L(0); PG8_BAR; PG8_MMA(1, 0, At, B0); PG8_MMA(1, 1, At, B1); PG8_BAR; PG8_SCHED;
            PG8_LDB(B0, 1, 0); PG8_LDB(B1, 1, 1); PG8_SCHED; PG8_LDA(At, 1, 0); PG8_STAGE_A(PG8_SA(0, 1), a2, 1, last);
            PG8_WAIT_V(8); PG8_WAIT_L(0); PG8_BAR; PG8_MMA(0, 0, At, B0); PG8_MMA(0, 1, At, B1); PG8_BAR; PG8_SCHED;
            PG8_LDA(At, 1, 1); PG8_STAGE(PG8_SB(1, 0), b3, voffB); PG8_STAGE(PG8_SB(1, 1), b3 + hstepB, voffB); PG8_STAGE_A(PG8_SA(1, 0), a3, 0, last);
            PG8_WAIT_V(8); PG8_WAIT_L(0); PG8_BAR; PG8_MMA(1, 0, At, B0); PG8_MMA(1, 1, At, B1); PG8_BAR; PG8_SCHED;
        }
        if (wr == 0) PG8_BAR;
        if constexpr (FP8) asm volatile("s_nop 15\n\ts_nop 15\n\ts_nop 15\n\ts_nop 15" ::: "memory");
        if constexpr (GATHER) { Unit t2; gvnn = S.next(ui + 2, t2) ? PG8_GV(t2) : gvn; }
        E(acc, cur, wr, wc, fr, fq);
        if (!has_next) break;
        if constexpr (GATHER) { gvc = gvn; gvn = gvnn; }
#pragma unroll
        for (int a = 0; a < 2; ++a)
#pragma unroll
            for (int b = 0; b < 2; ++b)
#pragma unroll
                for (int m = 0; m < 4; ++m)
#pragma unroll
                    for (int n = 0; n < 2; ++n) acc[a][b][m][n] = (f32x4){0.f, 0.f, 0.f, 0.f};
        cur = nxt; cA = nA; cB = nB; ++ui;
        if (wr == 1) PG8_BAR;
    }
    PG8_WAIT_V(0);
    PG8_BAR;
#undef PG8_STAGE_A
#undef PG8_GV
#undef PG8_SA
#undef PG8_SB
#undef PG8_STAGE
#undef PG8_LDA
#undef PG8_LDB
#undef PG8_MMA
#undef PG8_WAIT_V
#undef PG8_WAIT_L
#undef PG8_BAR
#undef PG8_SCHED
#undef PG8_ASRC
#undef PG8_BSRC
}
}

#define XB_TMO      128
#define XB_XCNT(j)  (256  + 64 * (j))
#define XB_XSUB(j)  (1280 + 64 * (j))
#define XB_XGEN(j)  (2304 + 64 * (j))
#define XB_TOP      3328
#define XB_TOPGEN   3392
#define XCD_BAR_WORDS 3456
#define XB_SPIN_CAP (1u << 18)
__device__ __forceinline__ unsigned xb_ld(unsigned* p)              { return __hip_atomic_load(p, __ATOMIC_RELAXED, __HIP_MEMORY_SCOPE_AGENT); }
__device__ __forceinline__ unsigned xb_add(unsigned* p, unsigned v) { return __hip_atomic_fetch_add(p, v, __ATOMIC_RELAXED, __HIP_MEMORY_SCOPE_AGENT); }
__device__ __forceinline__ unsigned xb_xcc_id() { return (unsigned)__builtin_amdgcn_s_getreg((3 << 11) | 20) & 0xFu; }
#define XB_SPIN(cond, bar) do { unsigned _sp = 0; while (cond) { __builtin_amdgcn_s_sleep(1); \
    if ((++_sp & 255u) == 0u) { if (xb_ld(&(bar)[XB_TMO])) break; if (_sp > XB_SPIN_CAP) { atomicAdd(&(bar)[XB_TMO], 1u); break; } } } } while (0)
struct XcdBarrier { unsigned* bar; unsigned x; volatile LAS unsigned* st; };
__device__ __forceinline__ XcdBarrier xcd_barrier_post(unsigned* bar, volatile LAS unsigned* st) {
    XcdBarrier b; b.bar = bar; b.x = xb_xcc_id(); b.st = st;
    if (threadIdx.x == 0) (void)xb_add(&bar[XB_XCNT(b.x)], 1u);
    return b;
}
__device__ __forceinline__ void xcd_barrier_complete(unsigned* bar, unsigned x, unsigned& nloc, unsigned& nx) {
    const unsigned G = gridDim.x * gridDim.y * gridDim.z;
    unsigned sum, cnt, mine, sp = 0u;
    for (;;) {
        sum = 0u; cnt = 0u; mine = 0u;
#pragma unroll
        for (unsigned j = 0; j < 16; ++j) { const unsigned c = xb_ld(&bar[XB_XCNT(j)]); sum += c; cnt += (c > 0u) ? 1u : 0u; mine = (j == x) ? c : mine; }
        if (sum == G) break;
        __builtin_amdgcn_s_sleep(1);
        if ((++sp & 255u) == 0u) { if (xb_ld(&bar[XB_TMO])) break; if (sp > XB_SPIN_CAP) { atomicAdd(&bar[XB_TMO], 1u); break; } }
    }
    nloc = mine > 0u ? mine : 1u; nx = cnt > 0u ? cnt : 1u;
}
__device__ __forceinline__ void xcd_barrier(const XcdBarrier& b) {
    asm volatile("s_waitcnt vmcnt(0)" ::: "memory");
    __syncthreads();
    if (threadIdx.x == 0) {
        unsigned* bar = b.bar;
        __builtin_amdgcn_s_waitcnt(0);
        unsigned nloc = b.st[0], nx = b.st[1];
        if (nloc == 0u) { xcd_barrier_complete(bar, b.x, nloc, nx); b.st[0] = nloc; b.st[1] = nx; }
        const unsigned old = xb_add(&bar[XB_XSUB(b.x)], 1u);
        const unsigned gen = old / nloc;
        if (old + 1u == (gen + 1u) * nloc) {
            __builtin_amdgcn_fence(__ATOMIC_RELEASE, "agent");
            asm volatile("s_waitcnt vmcnt(0)" ::: "memory");
            const unsigned og = xb_add(&bar[XB_TOP], 1u);
            const unsigned tg = og / nx;
            if (og + 1u == (tg + 1u) * nx) xb_add(&bar[XB_TOPGEN], 1u);
            else XB_SPIN(xb_ld(&bar[XB_TOPGEN]) == tg, bar);
            __builtin_amdgcn_fence(__ATOMIC_ACQUIRE, "agent");
            xb_add(&bar[XB_XGEN(b.x)], 1u);
            asm volatile("s_waitcnt vmcnt(0)" ::: "memory");
        } else {
            XB_SPIN(xb_ld(&bar[XB_XGEN(b.x)]) == gen, bar);
            __builtin_amdgcn_fence(__ATOMIC_ACQUIRE, "agent");
            asm volatile("s_waitcnt vmcnt(0)" ::: "memory");
        }
    }
    __syncthreads();
}

struct Args {
    const float *x, *c, *w_ada, *b_ada, *w_in, *q_norm_g, *w_uq, *kv_norm_g, *w_ukv, *rel_bias, *w_out, *ln1_g, *ln1_b, *w_router, *w_gate, *w_up, *w_down, *ln2_g, *ln2_b;
    float* out; unsigned char* ws; int ph_lo, ph_hi;
};
struct Frame {
    LAS unsigned char* lds;
    int tid, lane, wave, vcu, G;
    unsigned char* ws;
};
#define WSP(T, off) ((T*)(F.ws + (off)))
typedef const __attribute__((address_space(4))) Args* KArgs;
__device__ __forceinline__ KArgs kargs() { KArgs p = (KArgs)__builtin_amdgcn_kernarg_segment_ptr(); asm volatile("" : "+s"(p)); return p; }

using pg8::Unit;
#define DPERM(s_) ((((s_) & 15) << 8) + ((s_) >> 4))
struct EpiProj {
    bf16_t *CQ, *CKV, *KR, *DQ; float* SSQ; const float* rope;
    __device__ __forceinline__ void operator()(const f32x4 (&acc)[2][2][4][2], const Unit& u, int wr, int wc, int fr, int fq) const {
        const int pn = u.pn;
        if (pn >= 3) {
            const int t = pn - 3; bf16_t* base = DQ + (size_t)(t >> 1) * ((WS_DK - WS_DQ) / 2); const float sc = (t < 2 ? QS_DIL : 1.f) * (1.f / WIN_SCALE);
            const int col0 = (t & 1) * 256 + wc * 32 + 8 * fq;
#pragma unroll
            for (int ai = 0; ai < 2; ++ai)
#pragma unroll
                for (int m = 0; m < 4; ++m) { const size_t row = (size_t)u.pm * 256 + ai * 128 + wr * 64 + m * 16 + fr;
#pragma unroll
                    for (int bj = 0; bj < 2; ++bj) { const f32x4 v0 = acc[ai][bj][m][0] * sc, v1 = acc[ai][bj][m][1] * sc;
                        u32x4 w; w.x = cvt_pk_bf16(v0[0], v0[1]); w.y = cvt_pk_bf16(v0[2], v0[3]); w.z = cvt_pk_bf16(v1[0], v1[1]); w.w = cvt_pk_bf16(v1[2], v1[3]);
                        const int col = col0 + bj * 128;
                        *(u32x4*)(base + ((size_t)((int)(row >> 12) * 8 + (col >> 6)) * SEQ + DPERM((int)row & (SEQ - 1))) * 64 + (col & 63)) = w; } }
        } else {
#pragma unroll
            for (int ai = 0; ai < 2; ++ai)
#pragma unroll
                for (int m = 0; m < 4; ++m) { const size_t row = (size_t)u.pm * 256 + ai * 128 + wr * 64 + m * 16 + fr;
#pragma unroll
                    for (int bj = 0; bj < 2; ++bj) { const f32x4 v0 = acc[ai][bj][m][0] * (1.f / WIN_SCALE), v1 = acc[ai][bj][m][1] * (1.f / WIN_SCALE);
                        const int seg = pn * 2 + bj;
                        if (seg < 5) {
                            float s = (v0[0] * v0[0] + v0[1] * v0[1]) + (v0[2] * v0[2] + v0[3] * v0[3]) + (v1[0] * v1[0] + v1[1] * v1[1]) + (v1[2] * v1[2] + v1[3] * v1[3]);
                            s += __shfl_xor(s, 16); s += __shfl_xor(s, 32);
                            if (fq == 0) SSQ[row * 32 + seg * 4 + wc] = s;
                            u32x4 w; w.x = cvt_pk_bf16(v0[0], v0[1]); w.y = cvt_pk_bf16(v0[2], v0[3]); w.z = cvt_pk_bf16(v1[0], v1[1]); w.w = cvt_pk_bf16(v1[2], v1[3]);
                            if (seg < 3) *(u32x4*)(CQ + row * 384 + seg * 128 + wc * 32 + 8 * fq) = w;
                            else *(u32x4*)(CKV + row * 256 + (seg - 3) * 128 + wc * 32 + 8 * fq) = w;
                        } else if (wc == 0) {
                            const int pos = (int)(row & (SEQ - 1)); const float* rp = rope + pos * 32 + 8 * (fq & 1);
                            const f32x4 c0 = *(const f32x4*)(rp), c1 = *(const f32x4*)(rp + 4), s0 = *(const f32x4*)(rp + 16), s1 = *(const f32x4*)(rp + 20);
                            f32x4 o0, o1;
#pragma unroll
                            for (int j = 0; j < 4; ++j) { const float a = v0[j], b = v1[j]; const float pa = __shfl_xor(a, 32), pb = __shfl_xor(b, 32);
                                o0[j] = fq < 2 ? a * c0[j] - pa * s0[j] : pa * s0[j] + a * c0[j];
                                o1[j] = fq < 2 ? b * c1[j] - pb * s1[j] : pb * s1[j] + b * c1[j]; }
                            u32x2 w; w.x = pk4_fp8(o0[0] * K8_SCALE, o0[1] * K8_SCALE, o0[2] * K8_SCALE, o0[3] * K8_SCALE); w.y = pk4_fp8(o1[0] * K8_SCALE, o1[1] * K8_SCALE, o1[2] * K8_SCALE, o1[3] * K8_SCALE);
                            unsigned char* k8 = (unsigned char*)KR + ((size_t)((row >> 12) * 8) * SEQ + (row & (SEQ - 1))) * 128 + 8 * fq;
#pragma unroll
                            for (int hh = 0; hh < 8; ++hh) { *(u32x2*)(k8 + (size_t)hh * SEQ * 128 + 64) = w; *(u32x2*)(k8 + (size_t)hh * SEQ * 128 + 96) = (u32x2){fq == 0 ? 0x00383838u : 0u, 0u}; }
                        } } }
        }
    }
};
struct EpiQ {
    bf16_t* Q; const float* SSQ; const float* rope;
    __device__ __forceinline__ void operator()(const f32x4 (&acc)[2][2][4][2], const Unit& u, int wr, int wc, int fr, int fq) const {
#pragma unroll
        for (int ai = 0; ai < 2; ++ai)
#pragma unroll
            for (int m = 0; m < 4; ++m) { const size_t row = (size_t)u.pm * 256 + ai * 128 + wr * 64 + m * 16 + fr;
                const f32x4 q0 = *(const f32x4*)(SSQ + row * 32), q1 = *(const f32x4*)(SSQ + row * 32 + 4), q2 = *(const f32x4*)(SSQ + row * 32 + 8);
                const float ss = ((q0[0] + q0[1]) + (q0[2] + q0[3])) + ((q1[0] + q1[1]) + (q1[2] + q1[3])) + ((q2[0] + q2[1]) + (q2[2] + q2[3]));
                const float rs = Q8_SCALE / sqrtf(ss * (1.f / Q_LORA) + NORM_EPS);
                const int pos = (int)(row & (SEQ - 1));
#pragma unroll
                for (int bj = 0; bj < 2; ++bj) { f32x4 v0 = acc[ai][bj][m][0] * rs, v1 = acc[ai][bj][m][1] * rs;
                    const int G32 = u.pn * 8 + bj * 4 + wc;
                    if (G32 % 3 == 2) {
                        const float* rp = rope + pos * 32 + 8 * (fq & 1);
                        const f32x4 c0 = *(const f32x4*)(rp), c1 = *(const f32x4*)(rp + 4), s0 = *(const f32x4*)(rp + 16), s1 = *(const f32x4*)(rp + 20);
                        f32x4 o0, o1;
#pragma unroll
                        for (int j = 0; j < 4; ++j) { const float a = v0[j], b = v1[j]; const float pa = __shfl_xor(a, 32), pb = __shfl_xor(b, 32);
                            o0[j] = fq < 2 ? a * c0[j] - pa * s0[j] : pa * s0[j] + a * c0[j];
                            o1[j] = fq < 2 ? b * c1[j] - pb * s1[j] : pb * s1[j] + b * c1[j]; }
                        v0 = o0; v1 = o1;
                    }
                    u32x2 w; w.x = pk4_fp8(v0[0], v0[1], v0[2], v0[3]); w.y = pk4_fp8(v1[0], v1[1], v1[2], v1[3]);
                    unsigned char* q8 = (unsigned char*)Q + ((size_t)((row >> 12) * 8 + G32 / 3) * SEQ + pos) * 128 + (G32 % 3) * 32 + 8 * fq;
                    *(u32x2*)q8 = w; if (G32 % 3 == 2) *(u32x2*)(q8 + 32) = (u32x2){0u, 0u}; }
                asm volatile("" ::: "memory"); }
    }
};
struct EpiKV {
    bf16_t* O; const float* SSQ;
    __device__ __forceinline__ void operator()(const f32x4 (&acc)[2][2][4][2], const Unit& u, int wr, int wc, int fr, int fq) const {
#pragma unroll
        for (int ai = 0; ai < 2; ++ai)
#pragma unroll
            for (int m = 0; m < 4; ++m) { const size_t row = (size_t)u.pm * 256 + ai * 128 + wr * 64 + m * 16 + fr;
                const f32x4 q0 = *(const f32x4*)(SSQ + row * 32 + 12), q1 = *(const f32x4*)(SSQ + row * 32 + 16);
                const float ss = ((q0[0] + q0[1]) + (q0[2] + q0[3])) + ((q1[0] + q1[1]) + (q1[2] + q1[3]));
                const float rs = 1.f / sqrtf(ss * (1.f / KV_LORA) + NORM_EPS);
#pragma unroll
                for (int bj = 0; bj < 2; ++bj) { const f32x4 v0 = acc[ai][bj][m][0] * rs, v1 = acc[ai][bj][m][1] * rs;
                    u32x4 w; w.x = cvt_pk_bf16(v0[0], v0[1]); w.y = cvt_pk_bf16(v0[2], v0[3]); w.z = cvt_pk_bf16(v1[0], v1[1]); w.w = cvt_pk_bf16(v1[2], v1[3]);
                    *(u32x4*)(O + row * 512 + u.pn * 256 + bj * 128 + wc * 32 + 8 * fq) = w; }
                asm volatile("" ::: "memory"); }
    }
};
struct EpiKN8 {
    unsigned char* K8; const float* SSQ;
    __device__ __forceinline__ void operator()(const f32x4 (&acc)[2][2][4][2], const Unit& u, int wr, int wc, int fr, int fq) const {
#pragma unroll
        for (int ai = 0; ai < 2; ++ai)
#pragma unroll
            for (int m = 0; m < 4; ++m) { const size_t row = (size_t)u.pm * 256 + ai * 128 + wr * 64 + m * 16 + fr;
                const f32x4 q0 = *(const f32x4*)(SSQ + row * 32 + 12), q1 = *(const f32x4*)(SSQ + row * 32 + 16);
                const float ss = ((q0[0] + q0[1]) + (q0[2] + q0[3])) + ((q1[0] + q1[1]) + (q1[2] + q1[3]));
                const float rs = K8_SCALE / sqrtf(ss * (1.f / KV_LORA) + NORM_EPS);
#pragma unroll
                for (int bj = 0; bj < 2; ++bj) { const f32x4 v0 = acc[ai][bj][m][0] * rs, v1 = acc[ai][bj][m][1] * rs;
                    const int col = u.pn * 256 + bj * 128 + wc * 32 + 8 * fq;
                    u32x2 w; w.x = pk4_fp8(v0[0], v0[1], v0[2], v0[3]); w.y = pk4_fp8(v1[0], v1[1], v1[2], v1[3]);
                    *(u32x2*)(K8 + ((size_t)((row >> 12) * 8 + (col >> 6)) * SEQ + (row & (SEQ - 1))) * 128 + (col & 63)) = w; }
                asm volatile("" ::: "memory"); }
    }
};
struct EpiVt8 {
    unsigned char* Vt; const float* SSQ;
    __device__ __forceinline__ void operator()(const f32x4 (&acc)[2][2][4][2], const Unit& u, int wr, int wc, int fr, int fq) const {
        float rs[2][8];
#pragma unroll
        for (int bj = 0; bj < 2; ++bj)
#pragma unroll
            for (int j = 0; j < 8; ++j) { const size_t tok = (size_t)u.pn * 256 + bj * 128 + wc * 32 + 8 * fq + j;
                const f32x4 q0 = *(const f32x4*)(SSQ + tok * 32 + 12), q1 = *(const f32x4*)(SSQ + tok * 32 + 16);
                rs[bj][j] = 1.f / sqrtf((((q0[0] + q0[1]) + (q0[2] + q0[3])) + ((q1[0] + q1[1]) + (q1[2] + q1[3]))) * (1.f / KV_LORA) + NORM_EPS); }
#pragma unroll
        for (int ai = 0; ai < 2; ++ai)
#pragma unroll
            for (int m = 0; m < 4; ++m) { const int ch = u.pm * 256 + ai * 128 + wr * 64 + m * 16 + fr;
#pragma unroll
                for (int bj = 0; bj < 2; ++bj) { const f32x4 v0 = acc[ai][bj][m][0], v1 = acc[ai][bj][m][1];
                    const int tok = u.pn * 256 + bj * 128 + wc * 32 + 8 * fq;
                    u32x2 w; w.x = pk4_fp8(v0[0] * rs[bj][0], v0[1] * rs[bj][1], v0[2] * rs[bj][2], v0[3] * rs[bj][3]); w.y = pk4_fp8(v1[0] * rs[bj][4], v1[1] * rs[bj][5], v1[2] * rs[bj][6], v1[3] * rs[bj][7]);
                    *(u32x2*)(Vt + ((size_t)((tok >> 12) * 512 + ch)) * SEQ + (tok & (SEQ - 1))) = w; } }
    }
};
struct EpiOut {
    bf16_t* out; const float* mod;
    __device__ __forceinline__ void operator()(const f32x4 (&acc)[2][2][4][2], const Unit& u, int wr, int wc, int fr, int fq) const {
#pragma unroll
        for (int ai = 0; ai < 2; ++ai)
#pragma unroll
            for (int m = 0; m < 4; ++m) { const size_t row = (size_t)u.pm * 256 + ai * 128 + wr * 64 + m * 16 + fr; const int b = (int)(row >> 12);
#pragma unroll
                for (int bj = 0; bj < 2; ++bj) { const int col = u.pn * 256 + bj * 128 + wc * 32 + 8 * fq;
                    const float* gp = mod + b * 6144 + 2048 + col;
                    const f32x4 g0 = *(const f32x4*)gp, g1 = *(const f32x4*)(gp + 4);
                    const f32x4 m0 = g0 * acc[ai][bj][m][0] * (DBG_MIX_F / (WOUT_SCALE * MIX_SCALE)), m1 = g1 * acc[ai][bj][m][1] * (DBG_MIX_F / (WOUT_SCALE * MIX_SCALE));
                    u32x4 w; w.x = cvt_pk_bf16(m0[0], m0[1]); w.y = cvt_pk_bf16(m0[2], m0[3]); w.z = cvt_pk_bf16(m1[0], m1[1]); w.w = cvt_pk_bf16(m1[2], m1[3]);
                    *(u32x4*)(out + row * 1024 + col) = w; } }
    }
};
struct EpiGU {
    bf16_t* H;
    __device__ __forceinline__ void operator()(const f32x4 (&acc)[2][2][4][2], const Unit& u, int wr, int wc, int fr, int fq) const {
#pragma unroll
        for (int ai = 0; ai < 2; ++ai)
#pragma unroll
            for (int m = 0; m < 4; ++m) { const unsigned row = (unsigned)(u.pm * 256 + ai * 128 + wr * 64 + m * 16 + fr);
                float o[8];
#pragma unroll
                for (int n = 0; n < 2; ++n)
#pragma unroll
                    for (int j = 0; j < 4; ++j) { const float ag = acc[ai][0][m][n][j], au = acc[ai][1][m][n][j];
                        constexpr float kk = WGU_SCALE * WGU_SCALE / HID_SCALE;
                        const float e = __builtin_amdgcn_exp2f(ag * (-LOG2E / WGU_SCALE));
                        o[n * 4 + j] = (ag * au) * __builtin_amdgcn_rcpf(__builtin_fmaf(e, kk, kk)); }
                u32x2 w; w.x = pk4_fp8(o[0], o[1], o[2], o[3]); w.y = pk4_fp8(o[4], o[5], o[6], o[7]);
                *(u32x2*)((unsigned char*)H + (row * 1536u + (unsigned)(u.pn * 128 + wc * 32 + 8 * fq))) = w; }
    }
};
struct EpiDown {
    bf16_t* Y; const float* vals;
    __device__ __forceinline__ void operator()(const f32x4 (&acc)[2][2][4][2], const Unit& u, int wr, int wc, int fr, int fq) const {
#pragma unroll
        for (int ai = 0; ai < 2; ++ai)
#pragma unroll
            for (int m = 0; m < 4; ++m) { const unsigned row = (unsigned)(u.pm * 256 + ai * 128 + wr * 64 + m * 16 + fr); const float vv = vals[row] * (Y_SCALE / (WD_SCALE * HID_SCALE));
#pragma unroll
                for (int bj = 0; bj < 2; ++bj) { const f32x4 v0 = acc[ai][bj][m][0] * vv, v1 = acc[ai][bj][m][1] * vv;
                    u32x2 w; w.x = pk4_fp8(v0[0], v0[1], v0[2], v0[3]); w.y = pk4_fp8(v1[0], v1[1], v1[2], v1[3]);
                    *(u32x2*)((unsigned char*)Y + (row * 1024u + (unsigned)(u.pn * 256 + bj * 128 + wc * 32 + 8 * fq))) = w; } }
    }
};

__device__ __forceinline__ s16x4 vtr(const LAS char* p) { return __builtin_bit_cast(s16x4, __builtin_amdgcn_ds_read_tr16_b64_v4i16((LAS s16x4*)p)); }
template <int ND0, int KPITCH, bool BIAS>
__device__ __forceinline__ void attn_tile(const LAS char* Kt, const LAS char* Vt, const bf16x8 (&qr)[ND0], float& m_run, float& l_run, f32x16& o0, f32x16& o1,
                                          const LAS float* tab, int lane) {
    const int r32 = lane & 31, hi = lane >> 5;
    f32x16 p0, p1;
#pragma unroll
    for (int r = 0; r < 16; ++r) { p0[r] = 0.f; p1[r] = 0.f; }
    const LAS char* kp = Kt + r32 * KPITCH + hi * 16;
    bf16x8 kf[2 * ND0];
#pragma unroll
    for (int d0 = 0; d0 < ND0; ++d0) { kf[2 * d0] = *(const LAS bf16x8*)(kp + d0 * 32); kf[2 * d0 + 1] = *(const LAS bf16x8*)(kp + 32 * KPITCH + d0 * 32); }
#pragma unroll
    for (int d0 = 0; d0 < ND0; ++d0) {
        p0 = __builtin_amdgcn_mfma_f32_32x32x16_bf16(kf[2 * d0], qr[d0], p0, 0, 0, 0);
        p1 = __builtin_amdgcn_mfma_f32_32x32x16_bf16(kf[2 * d0 + 1], qr[d0], p1, 0, 0, 0);
    }
    const LAS char* vp = Vt + (4 * hi + ((lane & 15) >> 2)) * 64 + ((lane >> 4) & 1) * 32 + (lane & 3) * 8;
    bf16x8 vf[8];
#pragma unroll
    for (int ks = 0; ks < 4; ++ks) {
        const s16x4 l0 = vtr(vp + ks * 1024), h0 = vtr(vp + ks * 1024 + 512), l1 = vtr(vp + 4096 + ks * 1024), h1 = vtr(vp + 4096 + ks * 1024 + 512);
        vf[2 * ks] = (bf16x8){l0[0], l0[1], l0[2], l0[3], h0[0], h0[1], h0[2], h0[3]}; vf[2 * ks + 1] = (bf16x8){l1[0], l1[1], l1[2], l1[3], h1[0], h1[1], h1[2], h1[3]};
    }
    __builtin_amdgcn_sched_barrier(0);
    if constexpr (BIAS) {
#pragma unroll
        for (int r = 0; r < 16; ++r) { const int kvl = (r & 3) + 8 * (r >> 2) + 4 * hi; p0[r] += tab[kvl]; p1[r] += tab[kvl + 32]; }
    }
    float mx = fmaxf(p0[0], p1[0]);
#pragma unroll
    for (int r = 1; r < 16; ++r) mx = fmaxf(mx, fmaxf(p0[r], p1[r]));
    mx = fmaxf(mx, __shfl_xor(mx, 32));
    const float m_new = fmaxf(m_run, mx);
    const float alpha = __builtin_amdgcn_exp2f(m_run - m_new);
    m_run = m_new;
    float rs = 0.f;
#pragma unroll
    for (int r = 0; r < 16; ++r) { p0[r] = __builtin_amdgcn_exp2f(p0[r] - m_new); p1[r] = __builtin_amdgcn_exp2f(p1[r] - m_new); rs += p0[r] + p1[r]; }
    l_run = l_run * alpha + rs;
#pragma unroll
    for (int r = 0; r < 16; ++r) { o0[r] *= alpha; o1[r] *= alpha; }
    bf16x8 pf[4];
#pragma unroll
    for (int ks = 0; ks < 4; ++ks) { u32x4 w;
        if (ks < 2) { w.x = cvt_pk_bf16(p0[8 * ks + 0], p0[8 * ks + 1]); w.y = cvt_pk_bf16(p0[8 * ks + 2], p0[8 * ks + 3]); w.z = cvt_pk_bf16(p0[8 * ks + 4], p0[8 * ks + 5]); w.w = cvt_pk_bf16(p0[8 * ks + 6], p0[8 * ks + 7]); }
        else { const int k2 = ks - 2; w.x = cvt_pk_bf16(p1[8 * k2 + 0], p1[8 * k2 + 1]); w.y = cvt_pk_bf16(p1[8 * k2 + 2], p1[8 * k2 + 3]); w.z = cvt_pk_bf16(p1[8 * k2 + 4], p1[8 * k2 + 5]); w.w = cvt_pk_bf16(p1[8 * k2 + 6], p1[8 * k2 + 7]); }
        pf[ks] = __builtin_bit_cast(bf16x8, w); }
#pragma unroll
    for (int ks = 0; ks < 4; ++ks) {
        o0 = __builtin_amdgcn_mfma_f32_32x32x16_bf16(vf[2 * ks], pf[ks], o0, 0, 0, 0);
        o1 = __builtin_amdgcn_mfma_f32_32x32x16_bf16(vf[2 * ks + 1], pf[ks], o1, 0, 0, 0);
    }
}

constexpr int MLA_KP = 144, MLA_KB = 64 * MLA_KP, MLA_VP = 80, MLA_BUF = MLA_KB + 64 * MLA_VP;
constexpr float MLA_POFS = 0.f;
__device__ __forceinline__ float max3f(float a, float b, float c) { float r; asm("v_max3_f32 %0, %1, %2, %3" : "=v"(r) : "v"(a), "v"(b), "v"(c)); return r; }
__device__ __forceinline__ float xhalf_max(float m) { auto rr = __builtin_amdgcn_permlane32_swap(__float_as_uint(m), __float_as_uint(m), false, false); float a = __uint_as_float(rr[0]), b = __uint_as_float(rr[1]); float r; asm("v_max_f32_e32 %0, %1, %2" : "=v"(r) : "v"(a), "v"(b)); return r; }
__device__ __forceinline__ float fmin126(float a) { float r; asm("v_min_f32_e32 %0, 0x42fc0000, %1" : "=v"(r) : "v"(a)); return r; }
__device__ __forceinline__ float xhalf_sum(float m) { auto rr = __builtin_amdgcn_permlane32_swap(__float_as_uint(m), __float_as_uint(m), false, false); return __uint_as_float(rr[0]) + __uint_as_float(rr[1]); }
__device__ __forceinline__ float rowmax32(const f32x16& p0, const f32x16& p1) {
    float a = max3f(p0[0], p0[1], p1[0]), b = max3f(p0[2], p0[3], p1[1]); a = max3f(a, p1[2], p1[3]);
#pragma unroll
    for (int r = 4; r < 16; r += 4) { a = max3f(a, p0[r], p0[r + 1]); b = max3f(b, p0[r + 2], p0[r + 3]); a = max3f(a, p1[r], p1[r + 1]); b = max3f(b, p1[r + 2], p1[r + 3]); }
    float m; asm("v_max_f32_e32 %0, %1, %2" : "=v"(m) : "v"(a), "v"(b));
    return xhalf_max(m);
}
template <int ND0, int KPITCH>
__device__ __forceinline__ void qk_tile(f32x16& p0, f32x16& p1, const LAS char* Kt, const bf16x8 (&qr)[ND0], const f32x16& cinit, int lane) {
    const LAS char* kp = Kt + (lane & 31) * KPITCH + (lane >> 5) * 16;
#pragma unroll
    for (int d0 = 0; d0 < ND0; ++d0) {
        const bf16x8 a0 = *(const LAS bf16x8*)(kp + d0 * 32), a1 = *(const LAS bf16x8*)(kp + 32 * KPITCH + d0 * 32);
        if (d0 == 0) { p0 = __builtin_amdgcn_mfma_f32_32x32x16_bf16(a0, qr[0], cinit, 0, 0, 0); p1 = __builtin_amdgcn_mfma_f32_32x32x16_bf16(a1, qr[0], cinit, 0, 0, 0); }
        else { p0 = __builtin_amdgcn_mfma_f32_32x32x16_bf16(a0, qr[d0], p0, 0, 0, 0); p1 = __builtin_amdgcn_mfma_f32_32x32x16_bf16(a1, qr[d0], p1, 0, 0, 0); }
    }
}
__device__ __forceinline__ void pv_tile(f32x16& o0, f32x16& o1, const f32x16& p0, const f32x16& p1, const LAS char* Vt, int lane) {
    const int hi = lane >> 5;
    bf16x8 pf[4];
#pragma unroll
    for (int ks = 0; ks < 4; ++ks) { u32x4 w;
        if (ks < 2) { w.x = cvt_pk_bf16(p0[8 * ks + 0], p0[8 * ks + 1]); w.y = cvt_pk_bf16(p0[8 * ks + 2], p0[8 * ks + 3]); w.z = cvt_pk_bf16(p0[8 * ks + 4], p0[8 * ks + 5]); w.w = cvt_pk_bf16(p0[8 * ks + 6], p0[8 * ks + 7]); }
        else { const int k2 = ks - 2; w.x = cvt_pk_bf16(p1[8 * k2 + 0], p1[8 * k2 + 1]); w.y = cvt_pk_bf16(p1[8 * k2 + 2], p1[8 * k2 + 3]); w.z = cvt_pk_bf16(p1[8 * k2 + 4], p1[8 * k2 + 5]); w.w = cvt_pk_bf16(p1[8 * k2 + 6], p1[8 * k2 + 7]); }
        pf[ks] = __builtin_bit_cast(bf16x8, w); }
    const LAS char* vp = Vt + (4 * hi + ((lane & 15) >> 2)) * 64 + ((lane >> 4) & 1) * 32 + (lane & 3) * 8;
#pragma unroll
    for (int ks = 0; ks < 4; ++ks) {
        const s16x4 l0 = vtr(vp + ks * 1024), h0 = vtr(vp + ks * 1024 + 512), l1 = vtr(vp + 4096 + ks * 1024), h1 = vtr(vp + 4096 + ks * 1024 + 512);
        const bf16x8 v0 = (bf16x8){l0[0], l0[1], l0[2], l0[3], h0[0], h0[1], h0[2], h0[3]}, v1 = (bf16x8){l1[0], l1[1], l1[2], l1[3], h1[0], h1[1], h1[2], h1[3]};
        o0 = __builtin_amdgcn_mfma_f32_32x32x16_bf16(v0, pf[ks], o0, 0, 0, 0);
        o1 = __builtin_amdgcn_mfma_f32_32x32x16_bf16(v1, pf[ks], o1, 0, 0, 0);
    }
}
#define SGB(mask, n) __builtin_amdgcn_sched_group_barrier(mask, n, 0)
__device__ __forceinline__ unsigned enc3_fp8(float v) {
    const int w1 = __builtin_amdgcn_cvt_pk_fp8_f32(__builtin_amdgcn_fmed3f(v, -448.f, 448.f), 0.f, 0, false); const float r1 = v - __builtin_amdgcn_cvt_f32_fp8(w1, 0);
    const int w2 = __builtin_amdgcn_cvt_pk_fp8_f32(__builtin_amdgcn_fmed3f(r1, -448.f, 448.f), 0.f, 0, false); const float r2 = r1 - __builtin_amdgcn_cvt_f32_fp8(w2, 0);
    const int w3 = __builtin_amdgcn_cvt_pk_fp8_f32(__builtin_amdgcn_fmed3f(r2, -448.f, 448.f), 0.f, 0, false);
    return ((unsigned)w1 & 0xffu) | (((unsigned)w2 & 0xffu) << 8) | (((unsigned)w3 & 0xffu) << 16);
}
__device__ __forceinline__ void mla_unit(Frame& F, int b, int h, int qb) {
    int tid = F.tid; asm volatile("" : "+v"(tid));
    const int lane = tid & 63, wid = F.wave, r32 = lane & 31, hi = lane >> 5;
    const unsigned char* Q8 = WSP(const unsigned char, WS_Q); const unsigned char* K8 = WSP(const unsigned char, WS_KN); const unsigned char* Vt8 = WSP(const unsigned char, WS_V);
    bf16_t* MIX = WSP(bf16_t, WS_MIX);
    const size_t tok0 = (size_t)b * SEQ;
    const int q0 = qb * 512 + wid * 64 + r32;
    i32x8 qA[2], qB[2];
    { const unsigned char* qp = Q8 + ((size_t)(b * 8 + h) * SEQ + q0) * 128 + 32 * hi;
#pragma unroll
      for (int ks = 0; ks < 2; ++ks) { const i32x4 lo = *(const i32x4*)(qp + 64 * ks), hh = *(const i32x4*)(qp + 64 * ks + 16); qA[ks] = __builtin_shufflevector(lo, hh, 0, 1, 2, 3, 4, 5, 6, 7);
          const i32x4 lo2 = *(const i32x4*)(qp + 32 * 128 + 64 * ks), hh2 = *(const i32x4*)(qp + 32 * 128 + 64 * ks + 16); qB[ks] = __builtin_shufflevector(lo2, hh2, 0, 1, 2, 3, 4, 5, 6, 7); } }
    const int kv_s = tid >> 3, c_s = tid & 7;
    const unsigned char* k_base = K8 + (size_t)(b * 8 + h) * SEQ * 128; const unsigned k_off = (unsigned)(kv_s * 128 + c_s * 16);
    const unsigned char* v_base = Vt8 + (size_t)(b * 8 + h) * 64 * SEQ; const unsigned v_off = (unsigned)(((tid >> 2) & 63) * SEQ + (tid & 3) * 16);
    const int k_dst = (((kv_s & 31) << 1) | (kv_s >> 5)) * MLA_KP + c_s * 16, v_dst = MLA_KB + ((tid >> 2) & 63) * MLA_VP + (tid & 3) * 16;
    LAS char* lds = (LAS char*)F.lds;
    f32x16 oA0, oA1, oB0, oB1;
#pragma unroll
    for (int r = 0; r < 16; ++r) { oA0[r] = 0.f; oA1[r] = 0.f; oB0[r] = 0.f; oB1[r] = 0.f; }
    float lA = 0.f, lB = 0.f;
    const f32x16 zero16 = (f32x16){0.f, 0.f, 0.f, 0.f, 0.f, 0.f, 0.f, 0.f, 0.f, 0.f, 0.f, 0.f, 0.f, 0.f, 0.f, 0.f};
    const int selw = ((((lane & 15) >> 2) & 1) == ((lane >> 4) & 1)) ? 0x38383838 : 0;
    const i32x8 sel8 = (i32x8){selw, selw, selw, selw, selw, selw, selw, selw};
    const f32x4 zero4 = (f32x4){0.f, 0.f, 0.f, 0.f};
#define MLA_SUM8(b) __builtin_amdgcn_mfma_scale_f32_16x16x128_f8f6f4(sel8, b, zero4, 0, 0, 0, 0, 0, 0)
    u32x4 rk0, rv0, rk1, rv1;
#define MLA_LOADG(t, rk, rv) do { const unsigned o_ = (unsigned)((t) < 64 ? (t) : 63) * 64u; rk = *(const u32x4*)(k_base + (k_off + o_ * 128u)); rv = *(const u32x4*)(v_base + (v_off + o_)); } while (0)
#define MLA_STORE_OFF(off, rk, rv) do { LAS char* d_ = lds + (off); *(LAS u32x4*)(d_ + k_dst) = rk; *(LAS u32x4*)(d_ + v_dst) = rv; } while (0)
#define MLA_KFRAG(dst, base, a, ks) do { const LAS char* p_ = (base) + (a) * 32 * MLA_KP + (ks) * 64; \
        const i32x4 lo_ = *(const LAS i32x4*)p_, hi_ = *(const LAS i32x4*)(p_ + 16); dst = __builtin_shufflevector(lo_, hi_, 0, 1, 2, 3, 4, 5, 6, 7); } while (0)
#define MLA_MFMA8(a, b, c) __builtin_amdgcn_mfma_scale_f32_32x32x64_f8f6f4(a, b, c, 0, 0, 0, 0, 0, 0)
    static_assert(6 * MLA_BUF <= RING_BYTES, "MLA ring");
    const int sig = 32 * ((r32 >> 2) & 1) + (r32 & 3) + 4 * (r32 >> 3);
    const LAS char* kp0 = lds + (2 * (sig & 31) + (sig >> 5)) * MLA_KP + hi * 32;
    const LAS char* vp0 = lds + MLA_KB + r32 * MLA_VP + 32 * hi;
    MLA_LOADG(0, rk0, rv0); MLA_LOADG(1, rk1, rv1); MLA_STORE_OFF(0, rk0, rv0); MLA_STORE_OFF(MLA_BUF, rk1, rv1);
    MLA_LOADG(2, rk0, rv0); MLA_LOADG(3, rk1, rv1); MLA_STORE_OFF(2 * MLA_BUF, rk0, rv0); MLA_STORE_OFF(3 * MLA_BUF, rk1, rv1);
    __syncthreads();
    MLA_LOADG(4, rk0, rv0); MLA_LOADG(5, rk1, rv1);
    i32x8 kf[4];
#define MLA_KFRAGS(slot) do { const LAS char* kp_ = kp0 + (slot); MLA_KFRAG(kf[0], kp_, 0, 0); MLA_KFRAG(kf[1], kp_, 0, 1); MLA_KFRAG(kf[2], kp_, 1, 0); MLA_KFRAG(kf[3], kp_, 1, 1); } while (0)
#define MLA_VFRAGS(slot) do { const LAS char* vp_ = vp0 + (slot); \
        _Pragma("unroll") for (int dh = 0; dh < 2; ++dh) { const i32x4 lo_ = *(const LAS i32x4*)(vp_ + dh * 32 * MLA_VP), hi_ = *(const LAS i32x4*)(vp_ + dh * 32 * MLA_VP + 16); vf[dh] = __builtin_shufflevector(lo_, hi_, 0, 1, 2, 3, 4, 5, 6, 7); } } while (0)
#define MLA_SCORE(q) do { s0 = MLA_MFMA8(kf[0], q[0], zero16); s1 = MLA_MFMA8(kf[2], q[0], zero16); s0 = MLA_MFMA8(kf[1], q[1], s0); s1 = MLA_MFMA8(kf[3], q[1], s1); } while (0)
    f32x16 s0, s1; i32x8 vf[2];
    MLA_KFRAGS(0);
    { MLA_SCORE(qA); const unsigned ea = enc3_fp8(56.5f + 8.f * MLA_POFS - rowmax32(s0, s1));
      MLA_SCORE(qB); const unsigned eb = enc3_fp8(56.5f + 8.f * MLA_POFS - rowmax32(s0, s1));
      qA[1][0] = hi ? (int)ea : qA[1][0]; qB[1][0] = hi ? (int)eb : qB[1][0]; }
#define MLA_PBYTES(pf_) do { _Pragma("unroll") for (int g_ = 0; g_ < 4; ++g_) { unsigned b0_ = 0u, b1_ = 0u; \
            _Pragma("unroll") for (int j_ = 0; j_ < 4; ++j_) { b0_ = __builtin_amdgcn_cvt_pk_u8_f32(s0[4 * g_ + j_], j_, b0_); b1_ = __builtin_amdgcn_cvt_pk_u8_f32(s1[4 * g_ + j_], j_, b1_); } \
            pf_[g_] = (int)b0_; pf_[4 + g_] = (int)b1_; } } while (0)
#define SB0() __builtin_amdgcn_sched_barrier(0)
#define MLA_TILE(this_slot, next_slot) do { i32x8 pf_; \
        MLA_PBYTES(pf_); SB0(); lB += t_[0]; MLA_VFRAGS(this_slot); SB0(); MLA_SCORE(qB); SB0(); \
        oA0 = MLA_MFMA8(vf[0], pf_, oA0); oA1 = MLA_MFMA8(vf[1], pf_, oA1); t_ = MLA_SUM8(pf_); SB0(); \
        MLA_PBYTES(pf_); SB0(); lA += t_[0]; MLA_KFRAGS(next_slot); SB0(); \
        oB0 = MLA_MFMA8(vf[0], pf_, oB0); oB1 = MLA_MFMA8(vf[1], pf_, oB1); t_ = MLA_SUM8(pf_); SB0(); MLA_SCORE(qA); SB0(); } while (0)
    MLA_SCORE(qA); f32x4 t_ = zero4;
    if (wid < 4) __builtin_amdgcn_s_setprio(3); else __builtin_amdgcn_s_setprio(1);
    int sl = 0;
#pragma unroll 1
    for (int tp = 0; tp < 32; ++tp) {
        const int s_a = sl * MLA_BUF, s_b = s_a + MLA_BUF, sl2 = sl + 2 >= 6 ? sl - 4 : sl + 2, s_c = sl2 * MLA_BUF, sl4 = sl2 + 2 >= 6 ? sl2 - 4 : sl2 + 2, f_a = sl4 * MLA_BUF, f_b = f_a + MLA_BUF;
        MLA_STORE_OFF(f_a, rk0, rv0); MLA_STORE_OFF(f_b, rk1, rv1);
        MLA_LOADG(2 * tp + 6, rk0, rv0); MLA_LOADG(2 * tp + 7, rk1, rv1);
        __builtin_amdgcn_sched_barrier(0);
        MLA_TILE(s_a, s_b);
        MLA_TILE(s_b, s_c);
        asm volatile("s_waitcnt lgkmcnt(0)" ::: "memory"); __builtin_amdgcn_s_barrier(); asm volatile("" ::: "memory");
        sl = sl2;
    }
    lB += t_[0];
    __builtin_amdgcn_s_setprio(0);
#undef MLA_TILE
#undef SB0
#undef MLA_PBYTES
#undef MLA_SCORE
#undef MLA_KFRAGS
#undef MLA_VFRAGS
#undef MLA_KFRAG
#undef MLA_MFMA8
#undef MLA_STORE_OFF
#undef MLA_LOADG
    int tid2 = F.tid; asm volatile("" : "+v"(tid2));
    const int hi2 = (tid2 >> 5) & 1; const size_t orow0 = tok0 + qb * 512 + wid * 64 + (tid2 & 31);
#pragma unroll
    for (int grp = 0; grp < 2; ++grp) {
        const f32x16& o0 = grp ? oB0 : oA0; const f32x16& o1 = grp ? oB1 : oA1;
        const float inv = DBG_MLA_F / (grp ? lB : lA);
        unsigned char* orow = (unsigned char*)MIX + (orow0 + 32 * grp) * 1024 + h * 64 + 8 * hi2;
        const float invs = inv * MIX_SCALE;
#pragma unroll
        for (int hf = 0; hf < 2; ++hf) { const f32x16& oo = hf ? o1 : o0;
#pragma unroll
            for (int gp = 0; gp < 2; ++gp) { const int e0 = 8 * gp;
                const unsigned a4 = pk4_fp8(oo[e0] * invs, oo[e0 + 1] * invs, oo[e0 + 2] * invs, oo[e0 + 3] * invs), b4 = pk4_fp8(oo[e0 + 4] * invs, oo[e0 + 5] * invs, oo[e0 + 6] * invs, oo[e0 + 7] * invs);
                const unsigned rcv = (unsigned)__shfl_xor((int)(hi2 ? a4 : b4), 32);
                *(u32x2*)(orow + hf * 32 + 16 * gp) = hi2 ? (u32x2){rcv, b4} : (u32x2){a4, rcv}; }
        }
    }
}

constexpr int DIL_KP = 144, DIL_KB = 64 * DIL_KP, DIL_BUF = DIL_KB + 8192, DIL_PAIR = 2 * DIL_BUF, DIL_TAB = 4 * DIL_PAIR;
static_assert(DIL_TAB + 3 * 320 * 4 <= RING_BYTES, "dilated LDS");
template <int MODE>
__device__ __forceinline__ void dil_unit(Frame& F, int b, int h, int sb) {
    const int tid = F.tid, lane = F.lane, wid = F.wave, r32 = lane & 31, hi = lane >> 5;
    const bf16_t* DQ = WSP(const bf16_t, WS_DQ); const bf16_t* DK = WSP(const bf16_t, WS_DK); const bf16_t* DV = WSP(const bf16_t, WS_DV);
    bf16_t* O1 = WSP(bf16_t, WS_O1); bf16_t* O2 = WSP(bf16_t, WS_O2); float* LSE = WSP(float, WS_LSE); bf16_t* MIX = WSP(bf16_t, WS_MIX);
    LAS char* lds = (LAS char*)F.lds;
    LAS float* tab = (LAS float*)(lds + DIL_TAB);
    { const float* tg = WSP(const float, WS_TABG); for (int i = tid; i < 960; i += NTHR) tab[i] = tg[((i / 320) * 8 + h) * 320 + (i % 320)]; }
    const int pair = wid >> 1, pt = (wid & 1) * 64 + lane;
    LAS char* pl = lds + pair * DIL_PAIR;
    const size_t tok0 = (size_t)b * SEQ, hrow0 = (size_t)(b * 8 + h) * SEQ;
    const int qi = (wid & 1) * 32 + r32;
#define DIL_BLK(p_, rho_, dsh_, nb_, r_, n_) const int dsh_ = 2 * (p_), nb_ = 64 >> dsh_; const int i__ = 4 * (rho_) + pair, nbsb__ = 16 >> dsh_, r_ = i__ / nbsb__, n_ = ((sb * 1024) >> dsh_) / 64 + i__ % nbsb__
    u32x4 rk[4], rv[4]; bf16x8 qr[4], qn[4];
#define DIL_LOAD(ts_) do { const int p__ = (ts_) / 12, rho__ = ((ts_) % 12) / 3, jt__ = (ts_) % 3; DIL_BLK(p__, rho__, dsh__, nb__, r__, n__); \
        int kb_ = n__ - 1 + jt__; kb_ = kb_ < 0 ? 0 : (kb_ >= nb__ ? nb__ - 1 : kb_); \
        _Pragma("unroll") for (int c_ = 0; c_ < 4; ++c_) { const int ch_ = pt + 128 * c_, kv_ = ch_ >> 3, cc_ = ch_ & 7; \
            const size_t kpos_ = (size_t)((kb_ * 64 + kv_) << dsh__) + r__; \
            const size_t ko_ = (hrow0 + DPERM((int)kpos_)) * 64 + cc_ * 8; rk[c_] = *(const u32x4*)(DK + ko_); rv[c_] = *(const u32x4*)(DV + ko_); } } while (0)
#define DIL_STORE(buf) do { _Pragma("unroll") for (int c_ = 0; c_ < 4; ++c_) { const int ch_ = pt + 128 * c_, kv_ = ch_ >> 3, cc_ = ch_ & 7; \
            *(LAS u32x4*)(pl + (buf) * DIL_BUF + kv_ * DIL_KP + cc_ * 16) = rk[c_]; \
            *(LAS u32x4*)(pl + (buf) * DIL_BUF + DIL_KB + (cc_ >> 2) * 4096 + kv_ * 64 + (cc_ & 3) * 16) = rv[c_]; } } while (0)
#define DIL_QLOAD(dst, blk_) do { const int p__ = (blk_) / 4, rho__ = (blk_) % 4; DIL_BLK(p__, rho__, dsh__, nb__, r__, n__); (void)nb__; \
        const size_t qpos__ = (size_t)((n__ * 64 + qi) << dsh__) + r__; \
        _Pragma("unroll") for (int d0 = 0; d0 < 4; ++d0) dst[d0] = *(const bf16x8*)(DQ + (hrow0 + DPERM((int)qpos__)) * 64 + d0 * 16 + hi * 8); } while (0)
    DIL_LOAD(0); DIL_QLOAD(qr, 0); DIL_STORE(0);
    asm volatile("" :: "v"(qr[0]), "v"(qr[1]), "v"(qr[2]), "v"(qr[3]));
    __syncthreads();
    float m_run = NEG_BIG, l_run = 0.f; f32x16 o0, o1;
#pragma unroll 1
    for (int ts = 0; ts < 36; ++ts) {
        const int p = ts / 12, rho = (ts % 12) / 3, jt = ts % 3;
        DIL_BLK(p, rho, dsh, nb, r, n);
        if (MODE != 2 && ts + 1 < 36) DIL_LOAD(ts + 1);
        if (jt == 1 && ts + 2 < 36) DIL_QLOAD(qn, ts / 3 + 1);
        if (jt == 0) { m_run = NEG_BIG; l_run = 0.f;
#pragma unroll
            for (int rr = 0; rr < 16; ++rr) { o0[rr] = 0.f; o1[rr] = 0.f; } }
        const int kb = n - 1 + jt;
        if (MODE != 1 && kb >= 0 && kb < nb) {
            const LAS float* tq = tab + p * 320 + (64 * (jt - 1) - qi + 127);
            attn_tile<4, DIL_KP, true>(pl + (ts & 1) * DIL_BUF, pl + (ts & 1) * DIL_BUF + DIL_KB, qr, m_run, l_run, o0, o1, tq, lane);
        }
        if (MODE != 2 && ts + 1 < 36) DIL_STORE((ts + 1) & 1);
        if (jt == 2) asm volatile("" :: "v"(qn[0]), "v"(qn[1]), "v"(qn[2]), "v"(qn[3]));
        if (MODE != 0 && jt == 2) { if (m_run == 12345.f) MIX[0] = (bf16_t)(int)(l_run + o0[3] + o1[5]); }
        if (MODE == 0 && jt == 2) {
            const size_t qpos = (size_t)((n * 64 + qi) << dsh) + r;
            const float lt = l_run + __shfl_xor(l_run, 32); const float inv = 1.f / lt;
            const float lse = m_run + __builtin_amdgcn_logf(lt);
            const size_t grow = tok0 + qpos, prow = hrow0 + DPERM((int)qpos);
            if (p < 2) {
                bf16_t* orow = (p == 0 ? O1 : O2) + prow * 64 + 32 * hi;
#pragma unroll
                for (int k = 0; k < 4; ++k) { const f32x16& oo = k < 2 ? o0 : o1; const int e0 = 8 * (k & 1);
                    u32x4 w; w.x = cvt_pk_bf16(oo[e0] * inv, oo[e0 + 1] * inv); w.y = cvt_pk_bf16(oo[e0 + 2] * inv, oo[e0 + 3] * inv); w.z = cvt_pk_bf16(oo[e0 + 4] * inv, oo[e0 + 5] * inv); w.w = cvt_pk_bf16(oo[e0 + 6] * inv, oo[e0 + 7] * inv);
                    *(u32x4*)(orow + 8 * k) = w; }
                if (hi == 0) LSE[(size_t)p * BATCH * DIL_H * SEQ + prow] = lse;
            } else {
                const float l0 = LSE[prow], l1 = LSE[(size_t)BATCH * DIL_H * SEQ + prow];
                const float mm = fmaxf(fmaxf(l0, l1), lse);
                const float e0 = __builtin_amdgcn_exp2f(l0 - mm), e1 = __builtin_amdgcn_exp2f(l1 - mm), e2 = __builtin_amdgcn_exp2f(lse - mm);
                const float isum = DBG_DIL_F / (e0 + e1 + e2); const float w0 = e0 * isum, w1 = e1 * isum, w2 = e2 * isum * inv;
                const bf16_t* a1 = O1 + prow * 64; const bf16_t* a2 = O2 + prow * 64;
                unsigned char* orow = (unsigned char*)MIX + grow * 1024 + 512 + h * 64;
                u32x4 xa[4], xb[4];
#pragma unroll
                for (int k = 0; k < 4; ++k) { xa[k] = *(const u32x4*)(a1 + 32 * hi + 8 * k); xb[k] = *(const u32x4*)(a2 + 32 * hi + 8 * k); }
                unsigned wm[2][4];
#pragma unroll
                for (int g = 0; g < 4; ++g) {
#pragma unroll
                    for (int hf = 0; hf < 2; ++hf) {
                        const u32x4& A1 = xa[hf * 2 + (g >> 1)]; const u32x4& A2 = xb[hf * 2 + (g >> 1)];
                        u32x2 x1, x2; x1.x = (g & 1) ? A1.z : A1.x; x1.y = (g & 1) ? A1.w : A1.y; x2.x = (g & 1) ? A2.z : A2.x; x2.y = (g & 1) ? A2.w : A2.y;
                        const f32x16& oo = hf ? o1 : o0;
                        const float y0 = w0 * bf_lo(x1.x) + w1 * bf_lo(x2.x) + w2 * oo[4 * g], y1 = w0 * bf_hi(x1.x) + w1 * bf_hi(x2.x) + w2 * oo[4 * g + 1];
                        const float y2 = w0 * bf_lo(x1.y) + w1 * bf_lo(x2.y) + w2 * oo[4 * g + 2], y3 = w0 * bf_hi(x1.y) + w1 * bf_hi(x2.y) + w2 * oo[4 * g + 3];
                        wm[hf][g] = pk4_fp8(y0 * MIX_SCALE, y1 * MIX_SCALE, y2 * MIX_SCALE, y3 * MIX_SCALE);
                    }
                }
#pragma unroll
                for (int hf = 0; hf < 2; ++hf)
#pragma unroll
                    for (int gp = 0; gp < 2; ++gp) {
                        const unsigned rcv = (unsigned)__shfl_xor((int)(hi ? wm[hf][2 * gp] : wm[hf][2 * gp + 1]), 32);
                        *(u32x2*)(orow + hf * 32 + 16 * gp + 8 * hi) = hi ? (u32x2){rcv, wm[hf][2 * gp + 1]} : (u32x2){wm[hf][2 * gp], rcv};
                    }
            }
#pragma unroll
            for (int d0 = 0; d0 < 4; ++d0) qr[d0] = qn[d0];
        }
        if (ts == 25) VM_WAIT();
        __syncthreads();
    }
#undef DIL_LOAD
#undef DIL_STORE
#undef DIL_QLOAD
#undef DIL_BLK
}

__device__ __forceinline__ void transpose_item(const float* W, int ldn, int K, int k0, int n0, bf16_t* WT, int drow, const float* kscale, LAS float* scr, int lane) {
#pragma unroll 8
    for (int i = 0; i < 32; ++i) { const int kk = 2 * i + (lane >> 5); float v = W[(size_t)(k0 + kk) * ldn + n0 + (lane & 31)]; if (kscale) v *= kscale[k0 + kk]; scr[kk * 33 + (lane & 31)] = v; }
    LDS_WAIT(); asm volatile("" ::: "memory");
    const int c = lane & 7;
#pragma unroll
    for (int j = 0; j < 4; ++j) { const int n = (lane >> 3) + 8 * j; const LAS float* s = scr + (8 * c) * 33 + n;
        u32x4 o; o.x = pk2(s[0 * 33], s[1 * 33]); o.y = pk2(s[2 * 33], s[3 * 33]); o.z = pk2(s[4 * 33], s[5 * 33]); o.w = pk2(s[6 * 33], s[7 * 33]);
        *(u32x4*)(WT + (size_t)(drow + n) * K + k0 + 8 * c) = o; }
    LDS_WAIT(); asm volatile("" ::: "memory");
}
__device__ __forceinline__ void transpose_item_f8(const float* W, int ldn, int K, int k0, int n0, unsigned char* WT, int drow, float qs, LAS float* scr, int lane) {
#pragma unroll 8
    for (int i = 0; i < 32; ++i) { const int kk = 2 * i + (lane >> 5); scr[kk * 33 + (lane & 31)] = W[(size_t)(k0 + kk) * ldn + n0 + (lane & 31)] * qs; }
    LDS_WAIT(); asm volatile("" ::: "memory");
    const int c = lane & 7;
#pragma unroll
    for (int j = 0; j < 4; ++j) { const int n = (lane >> 3) + 8 * j; const LAS float* s_ = scr + (8 * c) * 33 + n;
        u32x2 o; o.x = pk4_fp8(s_[0 * 33], s_[1 * 33], s_[2 * 33], s_[3 * 33]); o.y = pk4_fp8(s_[4 * 33], s_[5 * 33], s_[6 * 33], s_[7 * 33]);
        *(u32x2*)(WT + (size_t)(drow + n) * K + k0 + 8 * c) = o; }
    LDS_WAIT(); asm volatile("" ::: "memory");
}
__device__ __forceinline__ void transpose_item64(const float* W, int ldn, int K, int k0, int n0, bf16_t* WT, int drow, LAS float* scr, int lane, float qs, float qis) {
    f32x4 v[16];
    const float* src = W + (size_t)(k0 + (lane >> 4)) * ldn + n0 + 4 * (lane & 15);
#pragma unroll
    for (int j = 0; j < 16; ++j) v[j] = __builtin_nontemporal_load((const f32x4*)(src + (size_t)(4 * j) * ldn));
    LAS float* sw = scr + (lane >> 4) * 65 + 4 * (lane & 15);
#pragma unroll
    for (int j = 0; j < 16; ++j) { sw[(4 * j) * 65 + 0] = v[j][0]; sw[(4 * j) * 65 + 1] = v[j][1]; sw[(4 * j) * 65 + 2] = v[j][2]; sw[(4 * j) * 65 + 3] = v[j][3]; }
    LDS_WAIT(); asm volatile("" ::: "memory");
    const int c = lane & 7;
#pragma unroll
    for (int jj = 0; jj < 8; ++jj) { const int n = (lane >> 3) + 8 * jj; const LAS float* s = scr + (8 * c) * 65 + n;
        u32x2 o; o.x = pk4_fp8(s[0 * 65] * qs, s[1 * 65] * qs, s[2 * 65] * qs, s[3 * 65] * qs); o.y = pk4_fp8(s[4 * 65] * qs, s[5 * 65] * qs, s[6 * 65] * qs, s[7 * 65] * qs);
        *(u32x2*)((unsigned char*)WT + (size_t)(drow + n) * K + k0 + 8 * c) = o; }
    LDS_WAIT(); asm volatile("" ::: "memory");
}
__device__ __forceinline__ int t5_bucket_dev(int rel) {
    const int n = rel < 0 ? -rel : rel; int v;
    if (n < 8) v = n; else v = n < 15 ? 8 : n < 27 ? 9 : n < 50 ? 10 : n < 91 ? 11 : n < 166 ? 12 : n < 305 ? 13 : n < 559 ? 14 : 15;
    return (rel > 0 ? 16 : 0) + v;
}
__device__ __forceinline__ void p0_prologue(Frame& F) { const KArgs ka = kargs();
    struct { const float *c, *w_ada, *w_in, *w_uq, *q_norm_g, *w_ukv, *kv_norm_g, *w_out, *rel_bias; } a;
    a.c = ka->c; a.w_ada = ka->w_ada; a.w_in = ka->w_in; a.w_uq = ka->w_uq; a.q_norm_g = ka->q_norm_g; a.w_ukv = ka->w_ukv; a.kv_norm_g = ka->kv_norm_g; a.w_out = ka->w_out; a.rel_bias = ka->rel_bias;
    LAS float* scr = (LAS float*)(F.lds + 32768 + F.wave * 8704);
    LAS float* sil = (LAS float*)F.lds;
    for (int i = F.tid; i < BATCH * D_MODEL; i += NTHR) { const float v = a.c[i]; sil[i] = v / (1.f + __expf(-v)); }
    __syncthreads();
    const int gw = F.vcu * NWAVES + F.wave, NGW = F.G * NWAVES, lane = F.lane;
    for (int it = gw; it < 16 * 24; it += NGW) {
        const int kb = it / 24, nb = it % 24, k0 = kb * 64, n0 = nb * 256 + lane * 4;
        f32x4 acc[8];
#pragma unroll
        for (int b = 0; b < 8; ++b) acc[b] = (f32x4){0.f, 0.f, 0.f, 0.f};
#pragma unroll 16
        for (int k = 0; k < 64; ++k) { const f32x4 w = *(const f32x4*)(a.w_ada + (size_t)(k0 + k) * 6144 + n0);
#pragma unroll
            for (int b = 0; b < 8; ++b) acc[b] += w * sil[b * 1024 + k0 + k]; }
        float* mp = WSP(float, WS_MODP) + (size_t)kb * 8 * 6144 + n0;
#pragma unroll
        for (int b = 0; b < 8; ++b) *(f32x4*)(mp + b * 6144) = acc[b];
    }
    {
        bf16_t* WIN = WSP(bf16_t, WS_WIN); bf16_t* WUQ = WSP(bf16_t, WS_WUQ); bf16_t* WK = WSP(bf16_t, WS_WK); bf16_t* WV = WSP(bf16_t, WS_WV); bf16_t* WOUT = WSP(bf16_t, WS_WOUT);
        constexpr int I_IN = 16 * 69, I_UQ = 6 * 24, I_KV = 4 * 32, I_OUT = 16 * 32, NIT = I_IN + I_UQ + I_KV + I_OUT;
        for (int it = NGW - 1 - gw; it < NIT; it += NGW) {
            int r = it;
            if (r < I_IN) { const int kb = r / 69, g = r % 69, n0 = g * 32; transpose_item_f8(a.w_in, IN_W, 1024, kb * 64, n0, (unsigned char*)WIN, n0 + (n0 >= 672 ? 96 : 0), WIN_SCALE, scr, lane); continue; } r -= I_IN;
            if (r < I_UQ) { const int kb = r / 24, g = r % 24; transpose_item(a.w_uq, 768, 384, kb * 64, g * 32, WUQ, g * 32, a.q_norm_g, scr, lane); continue; } r -= I_UQ;
            if (r < I_KV) { const int kb = r / 32, g = r % 32, hh = g >> 2, part = g & 3;
                transpose_item(a.w_ukv, 1024, 256, kb * 64, g * 32, part < 2 ? WK : WV, hh * 64 + (part & 1) * 32, a.kv_norm_g, scr, lane); continue; } r -= I_KV;
            { const int kb = r / 32, g = r % 32; transpose_item_f8(a.w_out, 1024, 1024, kb * 64, g * 32, (unsigned char*)WOUT, g * 32, WOUT_SCALE, scr, lane); }
        }
        for (int i = (F.G - 1 - F.vcu) * NTHR + F.tid; i < 96 * 1024 / 16; i += F.G * NTHR) *(u32x4*)((unsigned char*)WIN + (size_t)672 * 1024 + (size_t)i * 16) = (u32x4){0u, 0u, 0u, 0u};
    }
    for (int i = (F.G - 1 - F.vcu) * NTHR + F.tid; i < SEQ * 16; i += F.G * NTHR) { const int pos = i >> 4, j = i & 15;
        const float ang = (float)pos * (float)exp2(-(double)j * (13.287712379549449 / 16.0)); float* rp = WSP(float, WS_ROPE) + pos * 32;
        float sn, cs; sincosf(ang, &sn, &cs);
        rp[j] = cs; rp[16 + j] = sn; }
    for (int i = (F.G - 1 - F.vcu) * NTHR + F.tid; i < 3 * 8 * 320; i += F.G * NTHR) { const int p = i / 2560, hh = (i / 320) & 7, idx = i % 320, delta = idx - 127, dil = 1 << (2 * p);
        float v = NEG_BIG; if (delta >= -64 && delta <= 64) v = a.rel_bias[t5_bucket_dev(delta * dil) * 8 + hh] * LOG2E;
        WSP(float, WS_TABG)[i] = v; }
}
__device__ __forceinline__ void p1_mod_h1(Frame& F) { const KArgs ka = kargs(); const float* const a_x = ka->x; const float* const a_b_ada = ka->b_ada;
    LAS float* shs = (LAS float*)F.lds;
    const float* modp = WSP(const float, WS_MODP); float* mod = WSP(float, WS_MOD);
    for (int i = F.vcu * NTHR + F.tid; i < 8 * 6144; i += F.G * NTHR) { float s = a_b_ada[i % 6144];
#pragma unroll
        for (int kb = 0; kb < 16; ++kb) s += modp[(size_t)kb * 8 * 6144 + i];
        mod[i] = s; }
    bf16_t* H1 = WSP(bf16_t, WS_H);
    const int rpb = M_TOK / F.G;
    const int row0 = F.vcu * rpb, b = row0 >> 12;
    for (int i = F.tid; i < 2048; i += NTHR) { float sv = a_b_ada[i];
#pragma unroll
        for (int kb = 0; kb < 16; ++kb) sv += modp[(size_t)kb * 8 * 6144 + b * 6144 + i];
        shs[i] = sv; }
    __syncthreads();
    f32x4 sh[4], sc[4];
#pragma unroll
    for (int j = 0; j < 4; ++j) { sh[j] = *(const LAS f32x4*)(shs + 4 * F.lane + 256 * j); sc[j] = *(const LAS f32x4*)(shs + 1024 + 4 * F.lane + 256 * j) + 1.f; }
    for (int rr = 2 * F.wave; rr < rpb; rr += 2 * NWAVES) {
        const int row = row0 + rr;
        const f32x4* xr = (const f32x4*)(a_x + (size_t)row * 1024) + F.lane;
        unsigned* o8 = (unsigned*)((unsigned char*)H1 + (size_t)row * 1024) + F.lane;
        f32x4 v[8];
#pragma unroll
        for (int j = 0; j < 8; ++j) v[j] = __builtin_nontemporal_load(xr + 64 * j);
#pragma unroll
        for (int j = 0; j < 8; ++j) { const f32x4 hv = v[j] * sc[j & 3] + sh[j & 3];
            o8[64 * j] = pk4_fp8(hv[0], hv[1], hv[2], hv[3]); }
    }
}
__device__ __forceinline__ void p6_ln1_router(Frame& F) { const KArgs ka = kargs(); const float* const a_w_router = ka->w_router; const float* const a_ln1_g = ka->ln1_g; const float* const a_ln1_b = ka->ln1_b; const bf16_t* const a_m = WSP(const bf16_t, WS_M); const float* const a_x = ka->x;
    LAS f32x4* wr4 = (LAS f32x4*)F.lds;
    for (int idx = F.tid; idx < 1024 * 4; idx += NTHR) { const int k = idx >> 2, e4 = idx & 3, l = (k & 255) >> 2, i = k & 3, j = k >> 8;
        wr4[((j * 4 + i) * 4 + e4) * 64 + l] = *(const f32x4*)(a_w_router + k * 16 + e4 * 4); }
    __syncthreads();
    const float* mod = WSP(const float, WS_MOD); bf16_t* H2 = WSP(bf16_t, WS_H); float* AFF = WSP(float, WS_AFF); float* STAT = WSP(float, WS_STAT);
    const int gw = F.vcu * NWAVES + F.wave, NGW = F.G * NWAVES, lane = F.lane;
    f32x4 vn[2][4]; u32x2 mn[2][4];
#define P6_LOAD(r0_) do { _Pragma("unroll") for (int q = 0; q < 2; ++q) { const int rq_ = (r0_) + q * NGW < M_TOK ? (r0_) + q * NGW : (r0_); const unsigned ro_ = (unsigned)rq_ * 4096u; \
        _Pragma("unroll") for (int j = 0; j < 4; ++j) { vn[q][j] = *(const f32x4*)((const char*)a_x + (ro_ + (unsigned)(lane * 16 + j * 1024))); mn[q][j] = *(const u32x2*)((const char*)a_m + ((ro_ >> 1) + (unsigned)(lane * 8 + j * 512))); } } } while (0)
    P6_LOAD(gw);
    for (int row0 = gw; row0 < M_TOK; row0 += 2 * NGW) {
        f32x4 v[2][4]; float mean[2], rstd[2];
#pragma unroll
        for (int q = 0; q < 2; ++q) { float sm = 0.f;
#pragma unroll
            for (int j = 0; j < 4; ++j) { v[q][j] = vn[q][j] * ALPHA + (f32x4){bf_lo(mn[q][j].x), bf_hi(mn[q][j].x), bf_lo(mn[q][j].y), bf_hi(mn[q][j].y)}; sm += (v[q][j][0] + v[q][j][1]) + (v[q][j][2] + v[q][j][3]); }
            mean[q] = sm; }
        { const int rn = row0 + 2 * NGW < M_TOK ? row0 + 2 * NGW : row0; P6_LOAD(rn); }
#pragma unroll
        for (int q = 0; q < 2; ++q) { mean[q] = wave_sum(mean[q]) * (1.f / 1024.f); float s2 = 0.f;
#pragma unroll
            for (int j = 0; j < 4; ++j) { v[q][j] = v[q][j] - mean[q]; s2 += (v[q][j][0] * v[q][j][0] + v[q][j][1] * v[q][j][1]) + (v[q][j][2] * v[q][j][2] + v[q][j][3] * v[q][j][3]); }
            rstd[q] = 1.f / sqrtf(wave_sum(s2) * (1.f / 1024.f) + NORM_EPS); }
        const int rowq[2] = {row0, row0 + NGW < M_TOK ? row0 + NGW : row0};
        if (lane == 0) { *(f32x2*)(STAT + (size_t)rowq[0] * 2) = (f32x2){mean[0], rstd[0]}; *(f32x2*)(STAT + (size_t)rowq[1] * 2) = (f32x2){mean[1], rstd[1]}; }
        asm volatile("" ::: "memory");
        f32x2 lg2[2][8];
#pragma unroll
        for (int q = 0; q < 2; ++q)
#pragma unroll
            for (int e = 0; e < 8; ++e) lg2[q][e] = (f32x2){0.f, 0.f};
#pragma unroll
        for (int j = 0; j < 4; ++j) { const int col = 4 * lane + 256 * j;
            const f32x4 g = *(const f32x4*)((const char*)a_ln1_g + (unsigned)(col * 4)), bb = *(const f32x4*)((const char*)a_ln1_b + (unsigned)(col * 4));
#pragma unroll
            for (int q = 0; q < 2; ++q) { const int b = rowq[q] >> 12;
                const f32x4 x1 = v[q][j] * rstd[q] * g + bb;
                const f32x4 sh = *(const f32x4*)((const char*)mod + (unsigned)((b * 6144 + 3072 + col) * 4)), sc = *(const f32x4*)((const char*)mod + (unsigned)((b * 6144 + 4096 + col) * 4));
                const f32x4 hv = x1 * (sc + 1.f) + sh; v[q][j] = hv;
                *(unsigned*)((unsigned char*)H2 + ((unsigned)rowq[q] * 1024u + (unsigned)(lane * 4 + j * 256))) = pk4_fp8(hv[0], hv[1], hv[2], hv[3]); } }
        asm volatile("" ::: "memory");
#pragma unroll
        for (int j = 0; j < 4; ++j) {
#pragma unroll
            for (int i = 0; i < 4; ++i) {
#pragma unroll
                for (int e4 = 0; e4 < 4; ++e4) { const f32x4 w = wr4[((j * 4 + i) * 4 + e4) * 64 + lane]; const f32x2 w01 = (f32x2){w[0], w[1]}, w23 = (f32x2){w[2], w[3]};
#pragma unroll
                    for (int q = 0; q < 2; ++q) { const f32x2 hh = (f32x2){v[q][j][i], v[q][j][i]};
                        lg2[q][e4 * 2 + 0] = __builtin_elementwise_fma(hh, w01, lg2[q][e4 * 2 + 0]); lg2[q][e4 * 2 + 1] = __builtin_elementwise_fma(hh, w23, lg2[q][e4 * 2 + 1]); } }
                asm volatile("" : "+v"(lg2[0][0]), "+v"(lg2[0][1]), "+v"(lg2[0][2]), "+v"(lg2[0][3]), "+v"(lg2[0][4]), "+v"(lg2[0][5]), "+v"(lg2[0][6]), "+v"(lg2[0][7]), "+v"(lg2[1][0]), "+v"(lg2[1][1]), "+v"(lg2[1][2]), "+v"(lg2[1][3]), "+v"(lg2[1][4]), "+v"(lg2[1][5]), "+v"(lg2[1][6]), "+v"(lg2[1][7]) :: "memory"); }
        }
#pragma unroll
        for (int q = 0; q < 2; ++q) {
            float lg[16];
#pragma unroll
            for (int e = 0; e < 8; ++e) { lg[2 * e] = lg2[q][e][0]; lg[2 * e + 1] = lg2[q][e][1]; }
#pragma unroll
            for (int i = 0; i < 8; ++i) { float x = lg[i], y = lg[i + 8];
                asm("s_nop 1\n\tv_permlane32_swap_b32 %0, %1" : "+v"(x), "+v"(y)); lg[i] = x + y; }
#pragma unroll
            for (int i = 0; i < 4; ++i) { const bool up = lane & 8; const float keep = up ? lg[i + 4] : lg[i], send = up ? lg[i] : lg[i + 4]; lg[i] = keep + dpp_f<0x128>(send); }
#pragma unroll
            for (int i = 0; i < 2; ++i) { const bool up = lane & 2; const float keep = up ? lg[i + 2] : lg[i], send = up ? lg[i] : lg[i + 2]; lg[i] = keep + dpp_f<0x4E>(send); }
            { const bool up = lane & 1; const float keep = up ? lg[1] : lg[0], send = up ? lg[0] : lg[1]; lg[0] = keep + dpp_f<0xB1>(send); }
            float logit = lg[0]; logit += dpp_f<0x1B>(dpp_f<0x141>(logit)); logit += __shfl_xor(logit, 16);
            const float mx = wave_max(logit);
            const float ex = expf(logit - mx); const float se = wave_sum(ex) * 0.25f;
            const int e = ((lane >> 5) & 1) * 8 + ((lane >> 3) & 1) * 4 + ((lane >> 1) & 1) * 2 + (lane & 1);
            const int b = rowq[q] >> 12, sq = rowq[q] & (SEQ - 1);
            if ((lane & 0x14) == 0) AFF[((size_t)b * 16 + e) * SEQ + sq] = ex / se;
            asm volatile("" ::: "memory");
        }
    }
#undef P6_LOAD
}
__device__ __forceinline__ unsigned block_excl_scan(unsigned v, LAS unsigned* tmp, int tid, int lane, int wave, unsigned& total) {
    unsigned inc = v;
#pragma unroll
    for (int o = 1; o < 64; o <<= 1) { const unsigned t = __shfl_up(inc, o); if (lane >= o) inc += t; }
    __syncthreads();
    if (lane == 63) tmp[wave] = inc;
    __syncthreads();
    unsigned base = 0, tot = 0;
#pragma unroll
    for (int w = 0; w < NWAVES; ++w) { const unsigned t = tmp[w]; if (w < wave) base += t; tot += t; }
    total = tot;
    return base + inc - v;
}
__device__ __forceinline__ void topk_unit(Frame& F, int b, int e) {
    LAS unsigned* hist = (LAS unsigned*)F.lds; LAS unsigned* sh = hist + 256; LAS unsigned* tmp = hist + 272;
    const int tid = F.tid, lane = F.lane, wave = F.wave;
    const float* aff = WSP(const float, WS_AFF) + ((size_t)b * 16 + e) * SEQ;
    unsigned key[8];
    { const u32x4 k0 = *(const u32x4*)(aff + tid * 8), k1 = *(const u32x4*)(aff + tid * 8 + 4); key[0] = k0.x; key[1] = k0.y; key[2] = k0.z; key[3] = k0.w; key[4] = k1.x; key[5] = k1.y; key[6] = k1.z; key[7] = k1.w; }
    unsigned prefix = 0, need = CAP;
#pragma unroll 1
    for (int pass = 0; pass < 4; ++pass) {
        const int shift = 24 - 8 * pass;
        if (tid < 256) hist[tid] = 0u;
        __syncthreads();
#pragma unroll
        for (int i = 0; i < 8; ++i) { const bool in = (pass == 0) || ((key[i] >> (shift + 8)) == prefix); if (in) (void)__hip_atomic_fetch_add(&hist[(key[i] >> shift) & 255u], 1u, __ATOMIC_RELAXED, __HIP_MEMORY_SCOPE_WORKGROUP); }
        __syncthreads();
        if (wave == 0) {
            const unsigned c0 = hist[4 * lane], c1 = hist[4 * lane + 1], c2 = hist[4 * lane + 2], c3 = hist[4 * lane + 3], s = c0 + c1 + c2 + c3;
            unsigned incl = s;
#pragma unroll
            for (int o = 1; o < 64; o <<= 1) { const unsigned t = __shfl_down(incl, o); if (lane + o < 64) incl += t; }
            const unsigned above = incl - s;
            if (above < need && need <= incl) {
                unsigned aa = above; int d;
                if (aa + c3 >= need) d = 3; else { aa += c3; if (aa + c2 >= need) d = 2; else { aa += c2; if (aa + c1 >= need) d = 1; else { aa += c1; d = 0; } } }
                sh[0] = (prefix << 8) | (unsigned)(4 * lane + d); sh[1] = need - aa;
            }
        }
        __syncthreads();
        prefix = sh[0]; need = sh[1];
    }
    const unsigned T = prefix;
    unsigned cg = 0, ce = 0;
#pragma unroll
    for (int i = 0; i < 8; ++i) { cg += key[i] > T; ce += key[i] == T; }
    unsigned tot;
    const unsigned eq_before = block_excl_scan(ce, tmp, tid, lane, wave, tot);
    unsigned sel_mask = 0, nsel = 0, er = eq_before;
#pragma unroll
    for (int i = 0; i < 8; ++i) { bool s = key[i] > T; if (key[i] == T) { s = er < need; ++er; } if (s) { sel_mask |= 1u << i; ++nsel; } }
    unsigned slot = block_excl_scan(nsel, tmp, tid, lane, wave, tot);
    LAS int* lst = (LAS int*)(hist + 512);
    float* vals = WSP(float, WS_VALS) + (e * 8 + b) * CAP; int* inv = WSP(int, WS_INV);
#pragma unroll
    for (int i = 0; i < 8; ++i) { const int tok = tid * 8 + i; int sl = -1;
        if (sel_mask & (1u << i)) { sl = (int)slot; if (slot < (unsigned)CAP) { lst[slot] = tok; vals[slot] = __builtin_bit_cast(float, key[i]); } ++slot; }
        inv[((size_t)b * SEQ + tok) * 16 + e] = sl; }
    __syncthreads();
    { unsigned* VOFF = WSP(unsigned, WS_VOFF);
#pragma unroll
      for (int hh = 0; hh < 2; ++hh) { u32x4 o;
#pragma unroll
          for (int i = 0; i < 2; ++i) { int R, C; pg8::stage_rc(tid * 16 + i * 8192, R, C);
              o[i] = (unsigned)lst[hh * 256 + R] * 1024u + (unsigned)(C * 2); o[2 + i] = (unsigned)lst[hh * 256 + 128 + R] * 1024u + (unsigned)(C * 2); }
          *(u32x4*)(VOFF + ((size_t)((e * 8 + b) * 2 + hh) * 512 + tid) * 4) = o; } }
    __syncthreads();
}
template <int PART>
__device__ __forceinline__ void p7_expert_weights(Frame& F) { const KArgs ka = kargs(); const float* const a_w_gate = ka->w_gate; const float* const a_w_up = ka->w_up; const float* const a_w_down = ka->w_down;
    LAS float* scr = (LAS float*)(F.lds + 4096 + F.wave * 16640);
    bf16_t* WGU = WSP(bf16_t, WS_WGU); bf16_t* WD = WSP(bf16_t, WS_WD);
    constexpr int I_G = 16 * 16 * 24, I_D = 16 * 24 * 16;
    const int bx = (int)blockIdx.x;
    if (PART == 0) {
        const bool split = (F.G == 256); const bool tk = split && bx < BATCH * N_EXP;
        const int v0 = split ? ((tk ? bx : bx - 128) * NWAVES + F.wave) + (tk ? 7168 : 0) : F.wave * F.G + bx;
        const int vstep = split ? 1024 : F.G * NWAVES, vend = split ? (tk ? 2 * I_G : 7168) : 2 * I_G;
        static_assert(1024 * 12 == 2 * I_G, "P7 item split");
        for (int it = v0; it < vend; it += vstep) {
            int r = it; const int up = r >= I_G; if (up) r -= I_G; const int ex = r / 384, q = r % 384, kb = q / 24, g = q % 24, f = g * 64;
            transpose_item64((up ? a_w_up : a_w_gate) + (size_t)ex * 1024 * 1536, 1536, 1024, kb * 64, f, (bf16_t*)((unsigned char*)WGU + (size_t)ex * 3072 * 1024), (f >> 7) * 256 + up * 128 + (f & 127), scr, F.lane, WGU_SCALE, 0.f); }
    } else {
        for (int r = F.wave * F.G + bx; r < I_D; r += F.G * NWAVES) { const int ex = r / 384, q = r % 384, kb = q / 16, g = q % 16;
            transpose_item64(a_w_down + (size_t)ex * 1536 * 1024, 1024, 1536, kb * 64, g * 64, (bf16_t*)((unsigned char*)WD + (size_t)ex * 1024 * 1536), g * 64, scr, F.lane, WD_SCALE, 0.f); }
    }
}
__device__ __forceinline__ void p10_final(Frame& F, float* dst_override = nullptr) { const KArgs ka = kargs(); const float* const a_ln2_g = ka->ln2_g; const float* const a_ln2_b = ka->ln2_b; float* const a_out = ka->out;
    const float* const a_ln1_g = ka->ln1_g; const float* const a_ln1_b = ka->ln1_b; const float* const a_x = ka->x;
    const float* mod = WSP(const float, WS_MOD); const bf16_t* Y = WSP(const bf16_t, WS_Y); const int* inv = WSP(const int, WS_INV); const float* STAT = WSP(const float, WS_STAT); const bf16_t* const a_m = WSP(const bf16_t, WS_M);
    const int gw = F.vcu * NWAVES + F.wave, NGW = F.G * NWAVES, lane = F.lane;
    int slot_n = inv[(size_t)gw * 16 + (lane & 15)];
    f32x4 xn[4]; u32x2 mn[4]; f32x2 stn = *(const f32x2*)(STAT + (size_t)gw * 2);
    { const f32x4* xr0 = (const f32x4*)(a_x + (size_t)gw * 1024) + lane; const u32x2* mr0 = (const u32x2*)(a_m + (size_t)gw * 1024) + lane;
#pragma unroll
      for (int j = 0; j < 4; ++j) { xn[j] = xr0[64 * j]; mn[j] = mr0[64 * j]; } }
    for (int row = gw; row < M_TOK; row += NGW) {
        const int b = row >> 12;
        f32x4* xr = (f32x4*)(a_out + (size_t)row * 1024) + lane;
        const int myslot = slot_n; f32x4 xc[4]; const float mean1 = stn[0], rstd1 = stn[1];
#pragma unroll
        for (int j = 0; j < 4; ++j) xc[j] = xn[j] * ALPHA + (f32x4){bf_lo(mn[j].x), bf_hi(mn[j].x), bf_lo(mn[j].y), bf_hi(mn[j].y)};
        unsigned long long msk = __ballot(myslot >= 0) & 0xFFFFull;
        f32x4 mo[4];
#pragma unroll
        for (int j = 0; j < 4; ++j) mo[j] = (f32x4){0.f, 0.f, 0.f, 0.f};
        { const int rn = row + NGW < M_TOK ? row + NGW : row;
          slot_n = inv[(size_t)rn * 16 + (lane & 15)]; stn = *(const f32x2*)(STAT + (size_t)rn * 2);
          const f32x4* xrn = (const f32x4*)(a_x + (size_t)rn * 1024) + lane; const u32x2* mrn = (const u32x2*)(a_m + (size_t)rn * 1024) + lane;
#pragma unroll
          for (int j = 0; j < 4; ++j) { xn[j] = xrn[64 * j]; mn[j] = mrn[64 * j]; } }
        while (msk) {
            const int e0 = __builtin_ctzll(msk); msk &= msk - 1;
            const bool two = msk != 0; const int e1 = two ? __builtin_ctzll(msk) : e0; if (two) msk &= msk - 1;
            const int s0 = __shfl(myslot, e0), s1 = __shfl(myslot, e1);
            const unsigned* y0 = (const unsigned*)((const unsigned char*)Y + ((size_t)(e0 * 8 + b) * CAP + s0) * 1024) + lane;
            const unsigned* y1 = (const unsigned*)((const unsigned char*)Y + ((size_t)(e1 * 8 + b) * CAP + s1) * 1024) + lane;
            unsigned w0[4], w1[4];
#pragma unroll
            for (int j = 0; j < 4; ++j) { w0[j] = y0[64 * j]; w1[j] = y1[64 * j]; }
            const float f1 = two ? 1.f : 0.f;
#pragma unroll
            for (int j = 0; j < 4; ++j) { const auto a0 = __builtin_amdgcn_cvt_pk_f32_fp8((int)w0[j], false), a1 = __builtin_amdgcn_cvt_pk_f32_fp8((int)w0[j], true);
                const auto c0 = __builtin_amdgcn_cvt_pk_f32_fp8((int)w1[j], false), c1 = __builtin_amdgcn_cvt_pk_f32_fp8((int)w1[j], true);
                mo[j][0] += a0[0] + f1 * c0[0]; mo[j][1] += a0[1] + f1 * c0[1]; mo[j][2] += a1[0] + f1 * c1[0]; mo[j][3] += a1[1] + f1 * c1[1]; }
        }
        f32x4 v[4]; float sm = 0.f;
#pragma unroll
        for (int j = 0; j < 4; ++j) { const int col = 4 * lane + 256 * j; const f32x4 g2 = *(const f32x4*)(mod + b * 6144 + 5120 + col);
            const f32x4 x1 = (xc[j] - mean1) * rstd1 * *(const f32x4*)(a_ln1_g + col) + *(const f32x4*)(a_ln1_b + col);
            v[j] = x1 * ALPHA + g2 * mo[j] * (DBG_MOE_F / Y_SCALE); sm += (v[j][0] + v[j][1]) + (v[j][2] + v[j][3]); }
        const float mean = wave_sum(sm) * (1.f / 1024.f); float s2 = 0.f;
#pragma unroll
        for (int j = 0; j < 4; ++j) { v[j] = v[j] - mean; s2 += (v[j][0] * v[j][0] + v[j][1] * v[j][1]) + (v[j][2] * v[j][2] + v[j][3] * v[j][3]); }
        const float rstd = 1.f / sqrtf(wave_sum(s2) * (1.f / 1024.f) + NORM_EPS);
#pragma unroll
        for (int j = 0; j < 4; ++j) { const int col = 4 * lane + 256 * j; const f32x4 g = *(const f32x4*)(a_ln2_g + col), bb = *(const f32x4*)(a_ln2_b + col);
            (dst_override ? (f32x4*)(dst_override + (size_t)row * 1024) + lane : xr)[64 * j] = v[j] * rstd * g + bb; }
    }
}
constexpr int N_PHASES = 11;
__global__ void __launch_bounds__(NTHR, 2) fwd_kernel(Args args) {
    extern __shared__ __attribute__((aligned(16))) unsigned char lds_raw[];
    Frame F;
    F.lds = (LAS unsigned char*)lds_raw;
    F.tid = threadIdx.x; F.lane = F.tid & 63; F.wave = __builtin_amdgcn_readfirstlane(F.tid >> 6);
    F.G = gridDim.x; { const int bx = blockIdx.x; F.vcu = (F.G % 8 == 0) ? (bx % 8) * (F.G / 8) + bx / 8 : bx; }
    F.ws = kargs()->ws;
    volatile LAS unsigned* MISC = (volatile LAS unsigned*)(F.lds + MISC_OFF);
    for (int u = F.tid; u < (LDS_BYTES - MISC_OFF) / 4; u += NTHR) MISC[u] = 0u;
    __syncthreads();
    const int lo = kargs()->ph_lo, hi = kargs()->ph_hi;
    unsigned* barw = (unsigned*)(F.ws + WS_CTL) + CW_BAR;
    XcdBarrier bar; bar.bar = barw; bar.x = 0; bar.st = nullptr;
    if (hi - lo > 1) bar = xcd_barrier_post(barw, MISC + 8);
#ifndef PHMASK
#define PHMASK 0x7ff
#endif
#define IN(k) ((((PHMASK) >> (k)) & 1) && lo <= (k) && (k) < hi)
#define SEAM(k) do { if (IN(k) && IN((k) + 1)) xcd_barrier(bar); } while (0)

    if (IN(0)) { p0_prologue(F);
#if DBG_REP_P0 > 1
        __syncthreads(); p0_prologue(F);
#endif
    } SEAM(0);
    if (IN(1)) { _Pragma("unroll 1") for (int rep_ = 0; rep_ < DBG_REP_THIN; ++rep_) p1_mod_h1(F); } SEAM(1);
    if (IN(2)) {
        pg8::Gemm g{WSP(const bf16_t, WS_H), WSP(const bf16_t, WS_WIN), M_TOK, IN_WP, 1024, 1 << 30, nullptr};
        pg8::StaticOrder S; S.init(M_TOK, IN_WP, F.G, (int)blockIdx.x);
        static_assert(WS_DV - WS_DK == WS_DK - WS_DQ, "dq/dk/dv contiguous");
        EpiProj E{WSP(bf16_t, WS_CQ), WSP(bf16_t, WS_CKV), WSP(bf16_t, WS_KN)  , WSP(bf16_t, WS_DQ), WSP(float, WS_SSQ), WSP(const float, WS_ROPE)};
        pg8::gemm_phase<EpiProj, false, true>(F.lds, g, S, E);

    } SEAM(2);
    if (IN(3)) {
#ifdef DBG_DIL_MODE
        __syncthreads();
        for (int u = F.vcu; u < BATCH * DIL_H * 4; u += F.G) dil_unit<DBG_DIL_MODE>(F, u >> 5, (u >> 2) & 7, u & 3);
        __syncthreads();
#endif
#ifndef NO_P3G
#ifndef NO_GQ
        { pg8::Gemm g{WSP(const bf16_t, WS_CQ), WSP(const bf16_t, WS_WUQ), M_TOK, 768, Q_LORA, 1 << 30, nullptr};
          pg8::StaticOrder S; S.init(M_TOK, 768, F.G, (int)blockIdx.x);
          EpiQ E{WSP(bf16_t, WS_Q), WSP(const float, WS_SSQ), WSP(const float, WS_ROPE)};
          pg8::gemm_phase<EpiQ, false>(F.lds, g, S, E);
#if DBG_REP_P3G > 1
          pg8::gemm_phase<EpiQ, false>(F.lds, g, S, E);
#endif
 }
#endif
#ifndef NO_GK
        { pg8::Gemm g{WSP(const bf16_t, WS_CKV), WSP(const bf16_t, WS_WK), M_TOK, 512, KV_LORA, 1 << 30, nullptr};
          pg8::StaticOrder S; S.init(M_TOK, 512, F.G, (int)blockIdx.x);
          EpiKN8 E{WSP(unsigned char, WS_KN), WSP(const float, WS_SSQ)};
          pg8::gemm_phase<EpiKN8, false>(F.lds, g, S, E); }
#endif
        { pg8::Gemm g{WSP(const bf16_t, WS_WV), WSP(const bf16_t, WS_CKV), 512, M_TOK, KV_LORA, 1 << 30, nullptr};
          pg8::StaticOrder S; S.init(512, M_TOK, F.G, (int)blockIdx.x);
          EpiVt8 E{WSP(unsigned char, WS_V), WSP(const float, WS_SSQ)};
          pg8::gemm_phase<EpiVt8, false>(F.lds, g, S, E); }
#endif
    } SEAM(3);
    if (IN(4)) {
        const bool dil_first = (F.vcu & 1) == 0;
#ifndef NO_DIL
        if (dil_first) {
            for (int u = F.vcu; u < BATCH * DIL_H * 4; u += F.G) dil_unit<0>(F, u >> 5, (u >> 2) & 7, u & 3);
            __syncthreads();
        }
#endif
#pragma unroll 1
        for (int rep = 0; rep < DBG_REP_MLA; ++rep)
        for (int u = F.vcu; u < BATCH * MLA_H * 8; u += F.G) mla_unit(F, u >> 6, (u >> 3) & 7, u & 7);
#ifndef NO_DIL
        if (!dil_first) {
            __syncthreads();
            for (int u = F.vcu; u < BATCH * DIL_H * 4; u += F.G) dil_unit<0>(F, u >> 5, (u >> 2) & 7, u & 3);
            __syncthreads();
        }
#endif
    } SEAM(4);
    if (IN(5)) {
        pg8::Gemm g{WSP(const bf16_t, WS_MIX), WSP(const bf16_t, WS_WOUT), M_TOK, 1024, 1024, 1 << 30, nullptr};
        pg8::StaticOrder S; S.init(M_TOK, 1024, F.G, (int)blockIdx.x);
        EpiOut E{WSP(bf16_t, WS_M), WSP(const float, WS_MOD)};
        pg8::gemm_phase<EpiOut, false, true>(F.lds, g, S, E);

    } SEAM(5);
    if (IN(6)) { _Pragma("unroll 1") for (int rep_ = 0; rep_ < DBG_REP_THIN; ++rep_) { p6_ln1_router(F); __syncthreads(); } } SEAM(6);
    if (IN(7)) {
        for (int u = blockIdx.x; u < BATCH * N_EXP; u += F.G) topk_unit(F, u >> 4, u & 15);
        p7_expert_weights<0>(F);
    } SEAM(7);
    if (IN(8)) {
        const bool wd_first = (F.vcu & 1) == 0;
        if (wd_first) { p7_expert_weights<1>(F); __syncthreads(); }
        pg8::Gemm g{WSP(const bf16_t, WS_H), WSP(const bf16_t, WS_WGU), MROWS, 3072, 1024, 16, WSP(const int, WS_VOFF)};
        pg8::StaticOrder S; S.init(MROWS, 3072, F.G, (int)blockIdx.x);
        EpiGU E{WSP(bf16_t, WS_HID)};
        pg8::gemm_phase<EpiGU, true, true>(F.lds, g, S, E);
#if DBG_REP_P8 > 1
          pg8::gemm_phase<EpiGU, false, true>(F.lds, g, S, E);
#endif
        if (!wd_first) { __syncthreads(); p7_expert_weights<1>(F); }
    } SEAM(8);
    if (IN(9)) {
        pg8::Gemm g{WSP(const bf16_t, WS_HID), WSP(const bf16_t, WS_WD), MROWS, 1024, D_FF, 16, nullptr};
        pg8::StaticOrder S; S.init(MROWS, 1024, F.G, (int)blockIdx.x);
        EpiDown E{WSP(bf16_t, WS_Y), WSP(const float, WS_VALS)};
        pg8::gemm_phase<EpiDown, false, true>(F.lds, g, S, E);
#if DBG_REP_P9 > 1
          pg8::gemm_phase<EpiDown, false, true>(F.lds, g, S, E);
#endif

    } SEAM(9);
    if (IN(10)) {
#ifdef DBG_REP_P10
        p10_final(F, WSP(float, WS_Z)); __syncthreads();
#endif
        p10_final(F); }
#undef IN
#undef SEAM
}

extern "C" void kernel_launch(void* const* d_in, const int* in_sizes, int n_in, void* d_out, int out_size, void* d_ws, size_t ws_size, hipStream_t stream) {
    static int grid = 0;
    if (grid == 0) {
        if (n_in != 19 || in_sizes[0] != M_TOK * D_MODEL || out_size != M_TOK * D_MODEL || ws_size < WS_END) {
            fprintf(stderr, "kernel_launch: unexpected shapes (n_in %d, in0 %d, out %d, ws %zu); nothing launched\n", n_in, n_in > 0 ? in_sizes[0] : -1, out_size, ws_size); grid = -1; return; }
        int dev = 0, cus = 0, per_cu = 0;
        if (hipGetDevice(&dev) != hipSuccess || hipDeviceGetAttribute(&cus, hipDeviceAttributeMultiprocessorCount, dev) != hipSuccess) { grid = -1; return; }
        if (hipFuncSetAttribute((const void*)fwd_kernel, hipFuncAttributeMaxDynamicSharedMemorySize, LDS_BYTES) != hipSuccess) { fprintf(stderr, "kernel_launch: hipFuncSetAttribute failed\n"); grid = -1; return; }
        if (hipOccupancyMaxActiveBlocksPerMultiprocessor(&per_cu, (const void*)fwd_kernel, NTHR, LDS_BYTES) != hipSuccess || per_cu < 1)
            fprintf(stderr, "kernel_launch: note: occupancy query reports %d workgroups per CU\n", per_cu);
        (void)hipGetLastError();
        grid = cus < 256 ? cus : 256;
    }
    if (grid < 0) return;
    (void)hipMemsetAsync((char*)d_ws + WS_CTL, 0, CTL_ZERO_BYTES, stream);
    Args a{};
    a.x = (const float*)d_in[0]; a.c = (const float*)d_in[1]; a.w_ada = (const float*)d_in[2]; a.b_ada = (const float*)d_in[3]; a.w_in = (const float*)d_in[4];
    a.q_norm_g = (const float*)d_in[5]; a.w_uq = (const float*)d_in[6]; a.kv_norm_g = (const float*)d_in[7]; a.w_ukv = (const float*)d_in[8]; a.rel_bias = (const float*)d_in[9];
    a.w_out = (const float*)d_in[10]; a.ln1_g = (const float*)d_in[11]; a.ln1_b = (const float*)d_in[12]; a.w_router = (const float*)d_in[13]; a.w_gate = (const float*)d_in[14];
    a.w_up = (const float*)d_in[15]; a.w_down = (const float*)d_in[16]; a.ln2_g = (const float*)d_in[17]; a.ln2_b = (const float*)d_in[18];
    a.out = (float*)d_out; a.ws = (unsigned char*)d_ws;
#if MK_ONE_LAUNCH
    a.ph_lo = 0; a.ph_hi = N_PHASES;
    hipLaunchKernelGGL(fwd_kernel, dim3(grid), dim3(NTHR), LDS_BYTES, stream, a);
#else
    for (int p = 0; p < N_PHASES; ++p) { a.ph_lo = p; a.ph_hi = p + 1; hipLaunchKernelGGL(fwd_kernel, dim3(grid), dim3(NTHR), LDS_BYTES, stream, a); }
#endif
}
```

```cpp
#include <hip/hip_runtime.h>
#include <cstdio>
#include <cstdint>

#ifndef MK_ONE_LAUNCH
#define MK_ONE_LAUNCH 1
#endif

#define LAS __attribute__((address_space(3)))
#define GAS __attribute__((address_space(1)))
typedef unsigned short bf16_t;
typedef short bf16x8 __attribute__((ext_vector_type(8)));
typedef short s16x4 __attribute__((ext_vector_type(4)));
typedef float f32x4 __attribute__((ext_vector_type(4)));
typedef float f32x2 __attribute__((ext_vector_type(2)));
typedef float f32x16 __attribute__((ext_vector_type(16)));
typedef unsigned u32x4 __attribute__((ext_vector_type(4)));
typedef unsigned u32x2 __attribute__((ext_vector_type(2)));
typedef int i32x4 __attribute__((ext_vector_type(4)));
typedef int i32x8 __attribute__((ext_vector_type(8)));

constexpr int D_MODEL = 1024, BATCH = 8, SEQ = 4096, M_TOK = BATCH * SEQ;
constexpr int MLA_H = 8, MLA_NOPE = 64, MLA_ROPE = 32, MLA_V = 64, Q_LORA = 384, KV_LORA = 256, MLA_DQ = 96;
constexpr int DIL_H = 8, DIL_D = 64;
constexpr int N_EXP = 16, CAP = 512, D_FF = 1536;
constexpr int IN_W = 2208, IN_WP = 2304;
constexpr float ALPHA = 1.189207115002721f;
constexpr float NORM_EPS = 1e-6f;
constexpr float LOG2E = 1.4426950408889634f;
constexpr float QS_MLA = 0.10206207261596575f * LOG2E;
constexpr float Q8_SCALE = QS_MLA * 2.f * 8.f, K8_SCALE = 0.5f;
constexpr float QS_DIL = 0.125f * LOG2E;
constexpr float NEG_BIG = -1e30f;
#ifndef DBG_MLA_F
#define DBG_MLA_F 1.f
#endif
#ifndef DBG_DIL_F
#define DBG_DIL_F 1.f
#endif
#ifndef DBG_XEXP
#define DBG_XEXP 0
#endif
#ifndef DBG_REP_P0
#define DBG_REP_P0 1
#endif
#ifndef DBG_REP_P7
#define DBG_REP_P7 1
#endif
#ifndef DBG_REP_MLA
#define DBG_REP_MLA 1
#endif
#ifndef DBG_REP_DIL
#define DBG_REP_DIL 1
#endif
#ifndef DBG_REP_P8
#define DBG_REP_P8 1
#endif
#ifndef DBG_REP_P2
#define DBG_REP_P2 1
#endif
#ifndef DBG_REP_P9
#define DBG_REP_P9 1
#endif
#ifndef DBG_REP_P5
#define DBG_REP_P5 1
#endif
#ifndef DBG_REP_THIN
#define DBG_REP_THIN 1
#endif
#ifndef DBG_REP_P3G
#define DBG_REP_P3G 1
#endif
#ifndef DBG_MIX_F
#define DBG_MIX_F 1.f
#endif
#ifndef DBG_MOE_F
#define DBG_MOE_F 1.f
#endif
constexpr float WGU_SCALE = 32.f, WD_SCALE = 64.f, HID_SCALE = 4.f, WIN_SCALE = 32.f, WOUT_SCALE = 32.f, MIX_SCALE = 16.f, Y_SCALE = 64.f;
constexpr int MROWS = N_EXP * BATCH * CAP;

constexpr size_t MiB = 1u << 20;
constexpr size_t WS_CTL = 0, CTL_ZERO_BYTES = 1 * MiB;
constexpr size_t WS_ROPE = 1 * MiB;
constexpr size_t WS_TABG = 1 * MiB + 512 * 1024;
constexpr size_t WS_MODP = 2 * MiB;
constexpr size_t WS_MOD = 5 * MiB;
constexpr size_t WS_AFF = 6 * MiB;
constexpr size_t WS_STAT = 8 * MiB;
constexpr size_t WS_VALS = 8 * MiB + 256 * 1024;
constexpr size_t WS_INV = 9 * MiB;
constexpr size_t WS_SSQ = 11 * MiB;
constexpr size_t WS_WIN = 16 * MiB;
constexpr size_t WS_WUQ = 21 * MiB;
constexpr size_t WS_WK = 22 * MiB;
constexpr size_t WS_WV = 22 * MiB + 512 * 1024;
constexpr size_t WS_WOUT = 23 * MiB;
constexpr size_t WS_LSE = 26 * MiB;
constexpr size_t WS_H = 32 * MiB;
constexpr size_t WS_O1 = 32 * MiB, WS_O2 = 64 * MiB;
constexpr size_t WS_WGU = 96 * MiB;
constexpr size_t WS_WD = 192 * MiB;
constexpr size_t WS_CQ = 96 * MiB;
constexpr size_t WS_CKV = 120 * MiB;
constexpr size_t WS_KR = 136 * MiB;
constexpr size_t WS_DQ = 138 * MiB, WS_DK = 170 * MiB, WS_DV = 202 * MiB;
constexpr size_t WS_Q = 240 * MiB;
constexpr size_t WS_KN = 288 * MiB;
constexpr size_t WS_V = 320 * MiB;
constexpr size_t WS_Z = 240 * MiB;
constexpr size_t WS_MIX = 368 * MiB;
constexpr size_t WS_HID = 240 * MiB;
constexpr size_t WS_VOFF = 336 * MiB;
constexpr size_t WS_XG = 336 * MiB;
constexpr size_t WS_Y = 32 * MiB;
constexpr size_t WS_M = 432 * MiB;
constexpr size_t WS_END = 496 * MiB;
constexpr int CW_BAR = 4096;
constexpr int CW_QUEUE = 64;

constexpr int RING_BYTES = 147456;
constexpr int MISC_OFF = RING_BYTES;
constexpr int LDS_BYTES = RING_BYTES + 512;
constexpr int NWAVES = 8, NTHR = 512;

__device__ __forceinline__ unsigned f2bf(float f) { unsigned u = __builtin_bit_cast(unsigned, f); return (u + 0x7fffu + ((u >> 16) & 1u)) >> 16; }
__device__ __forceinline__ unsigned pk2(float lo, float hi) { return f2bf(lo) | (f2bf(hi) << 16); }
__device__ __forceinline__ unsigned cvt_pk_bf16(float lo, float hi) { unsigned r; asm volatile("v_cvt_pk_bf16_f32 %0, %1, %2" : "=v"(r) : "v"(lo), "v"(hi)); return r; }
__device__ __forceinline__ float bf_lo(unsigned w) { return __builtin_bit_cast(float, w << 16); }
__device__ __forceinline__ float bf_hi(unsigned w) { return __builtin_bit_cast(float, w & 0xffff0000u); }
template <int CTRL> __device__ __forceinline__ float dpp_f(float v) { return __builtin_bit_cast(float, __builtin_amdgcn_update_dpp(0, __builtin_bit_cast(int, v), CTRL, 0xF, 0xF, true)); }
__device__ __forceinline__ float lane_f(float v, int l) { return __builtin_bit_cast(float, __builtin_amdgcn_readlane(__builtin_bit_cast(int, v), l)); }
__device__ __forceinline__ float wave_sum(float v) {
    v += dpp_f<0xB1>(v); v += dpp_f<0x4E>(v); v += dpp_f<0x141>(v); v += dpp_f<0x140>(v);
    return (lane_f(v, 0) + lane_f(v, 16)) + (lane_f(v, 32) + lane_f(v, 48));
}
__device__ __forceinline__ float wave_max(float v) {
    v = fmaxf(v, dpp_f<0xB1>(v)); v = fmaxf(v, dpp_f<0x4E>(v)); v = fmaxf(v, dpp_f<0x141>(v)); v = fmaxf(v, dpp_f<0x140>(v));
    return fmaxf(fmaxf(lane_f(v, 0), lane_f(v, 16)), fmaxf(lane_f(v, 32), lane_f(v, 48)));
}
#ifndef DBG_FP8_EMU
#define DBG_FP8_EMU 0
#endif
#ifndef DBG_HID_S
#define DBG_HID_S 4.f
#endif
__device__ __forceinline__ unsigned pk4_fp8(float a, float b, float c, float d) {
    a = __builtin_amdgcn_fmed3f(a, -448.f, 448.f); b = __builtin_amdgcn_fmed3f(b, -448.f, 448.f); c = __builtin_amdgcn_fmed3f(c, -448.f, 448.f); d = __builtin_amdgcn_fmed3f(d, -448.f, 448.f);
    int p = __builtin_amdgcn_cvt_pk_fp8_f32(a, b, 0, false); p = __builtin_amdgcn_cvt_pk_fp8_f32(c, d, p, true); return (unsigned)p;
}
__device__ __forceinline__ unsigned pk4_fp8_nc(float a, float b, float c, float d) { int p = __builtin_amdgcn_cvt_pk_fp8_f32(a, b, 0, false); p = __builtin_amdgcn_cvt_pk_fp8_f32(c, d, p, true); return (unsigned)p; }
__device__ __forceinline__ float q8(float x, float sc, float isc) {
#if DBG_FP8_EMU
    const int p = __builtin_amdgcn_cvt_pk_fp8_f32(x * sc, 0.f, 0, false); return __builtin_amdgcn_cvt_f32_fp8(p, 0) * isc;
#else
    return x;
#endif
}
#define LDS_WAIT() asm volatile("s_waitcnt lgkmcnt(0)" ::: "memory")
#define VM_WAIT() asm volatile("s_waitcnt vmcnt(0)" ::: "memory")

namespace pg8 {
constexpr int BM = 256, BK = 64, HALF = 128, HTB = HALF * BK * 2, STAGE_BYTES = 8 * HTB, NXCD = 8, WGM = 8;
__host__ __device__ __forceinline__ int lds_byte(int r, int c) { const int st = (r >> 4) * 2 + (c >> 5), rr = r & 15, cc = c & 31, ob = rr * 64 + cc * 2; return st * 1024 + (ob ^ (((ob >> 9) & 1) << 5)); }
__host__ __device__ __forceinline__ void stage_rc(int b, int& R, int& C) { const int st = b / 1024, sb = b % 1024, swz = sb ^ (((sb >> 9) & 1) << 5); R = (st >> 1) * 16 + swz / 64; C = (st & 1) * 32 + (swz % 64) / 2; }
__host__ __device__ __forceinline__ int perm32(int rho) { const int n = rho >> 4, i = rho & 15; return 8 * (i >> 2) + 4 * n + (i & 3); }

struct Unit { int pm, pn; };
struct Gemm { const bf16_t* A; const bf16_t* Bt; int M, N, K; int grp; const int* rowsrc; };

struct StaticOrder {
    int nM, nN, nwg, G, c;
    __device__ void init(int M, int N, int G_, int c_) { nM = M / BM; nN = N / BM; nwg = nM * nN; G = G_; c = c_; }
    __device__ bool next(int i, Unit& u) const {
        const long L = (long)i * G + c; if (L >= nwg) return false;
        int wgid = (int)L; { const int q = nwg / NXCD, r = nwg % NXCD, xcd = wgid % NXCD, off = wgid / NXCD; wgid = (xcd < r ? xcd * (q + 1) : r * (q + 1) + (xcd - r) * q) + off; }
        const int nig = WGM * nN, gid = wgid / nig, fm = gid * WGM, gsz = (nM - fm) < WGM ? (nM - fm) : WGM;
        u.pm = fm + ((wgid % nig) % gsz); u.pn = (wgid % nig) / gsz; return true;
    }
};

using ::i32x4; using ::i32x8;
template <class Epi, bool GATHER, bool FP8 = false>
__device__ __forceinline__ void gemm_phase(LAS unsigned char* lds, const Gemm g, const StaticOrder& S, const Epi& E) {
    const int tid = threadIdx.x, wid = __builtin_amdgcn_readfirstlane(tid >> 6), lane = tid & 63, wr = wid >> 2, wc = wid & 3, fr = lane & 15, fq = lane >> 4;
    const int K = g.K, KB = FP8 ? g.K : g.K * 2, nt = KB / 128, nN = g.N / BM;
    unsigned voffA[2], voffB[2];
#pragma unroll
    for (int i = 0; i < 2; ++i) { int R, C; stage_rc(tid * 16 + i * 8192, R, C); const int Rb = (R & ~31) + perm32(R & 31);
        voffA[i] = (unsigned)(R * KB + C * 2); voffB[i] = (unsigned)(Rb * KB + C * 2); }
    const size_t kstep = (size_t)(BK * 2);
    const size_t hstep = GATHER ? (size_t)0 : (size_t)HALF * KB;
    const size_t hstepB = (size_t)HALF * KB, tstep = 2 * hstepB;
    const unsigned ldsw = (unsigned)wid * 1024u;
    const int aoff = lds_byte(wr * 64 + fr, fq * 8), boff = lds_byte(wc * 32 + fr, fq * 8);
#define PG8_SA(b, h) (((b) * 2 + (h)) * HTB)
#define PG8_SB(b, h) ((4 + (b) * 2 + (h)) * HTB)
    const unsigned lds_base_u = (unsigned)__builtin_amdgcn_readfirstlane((int)(unsigned)(uintptr_t)lds + (int)ldsw);
#define PG8_STAGE(bufoff, gbase, voff) do { _Pragma("unroll") for (int _i = 0; _i < 2; ++_i) { \
        if constexpr (FP8) { unsigned keep_; asm volatile("s_mov_b32 %0, m0\n\ts_mov_b32 m0, %3\n\ts_nop 0\n\tglobal_load_lds_dwordx4 %1, %2\n\ts_mov_b32 m0, %0" \
              : "=&s"(keep_) : "v"((voff)[_i]), "s"((const char*)(gbase)), "s"(lds_base_u + (unsigned)((bufoff) + _i * 8192)) : "memory"); } \
        else __builtin_amdgcn_global_load_lds((const unsigned*)((const char*)(gbase) + (voff)[_i]), (LAS unsigned*)(lds + (bufoff) + ldsw + _i * 8192), 16, 0, 0); } } while (0)
#define PG8_LDA(dst, b, h) do { _Pragma("unroll") for (int m = 0; m < 4; ++m) _Pragma("unroll") for (int k = 0; k < 2; ++k) dst[m][k] = *(const LAS bf16x8*)(lds + PG8_SA(b, h) + aoff + m * 2048 + k * 1024); } while (0)
#define PG8_LDB(dst, b, h) do { _Pragma("unroll") for (int n = 0; n < 2; ++n) _Pragma("unroll") for (int k = 0; k < 2; ++k) dst[n][k] = *(const LAS bf16x8*)(lds + PG8_SB(b, h) + boff + n * 2048 + k * 1024); } while (0)
#define PG8_MMA(ai, bj, At, Bt) do { __builtin_amdgcn_s_setprio(1); _Pragma("unroll") for (int m = 0; m < 4; ++m) _Pragma("unroll") for (int n = 0; n < 2; ++n) { \
        if constexpr (FP8) { const i32x8 b8_ = __builtin_shufflevector(__builtin_bit_cast(i32x4, Bt[n][0]), __builtin_bit_cast(i32x4, Bt[n][1]), 0, 1, 2, 3, 4, 5, 6, 7); \
            const i32x8 a8_ = __builtin_shufflevector(__builtin_bit_cast(i32x4, At[m][0]), __builtin_bit_cast(i32x4, At[m][1]), 0, 1, 2, 3, 4, 5, 6, 7); \
            asm volatile("v_mfma_f32_16x16x128_f8f6f4 %0, %1, %2, %0" : "+v"(acc[ai][bj][m][n]) : "v"(b8_), "v"(a8_)); } \
        else { _Pragma("unroll") for (int k = 0; k < 2; ++k) acc[ai][bj][m][n] = __builtin_amdgcn_mfma_f32_16x16x32_bf16(Bt[n][k], At[m][k], acc[ai][bj][m][n], 0, 0, 0); } } \
        __builtin_amdgcn_s_setprio(0); } while (0)
#define PG8_WAIT_V(n) asm volatile("s_waitcnt vmcnt(" #n ")" ::: "memory")
#define PG8_WAIT_L(n) asm volatile("s_waitcnt lgkmcnt(" #n ")" ::: "memory")
#define PG8_BAR __builtin_amdgcn_s_barrier()
#define PG8_SCHED __builtin_amdgcn_sched_barrier(0)
#define PG8_ASRC(U) (GATHER ? (const char*)g.A + (size_t)(((U).pm >> 1) & 7) * ((size_t)SEQ * KB) : (const char*)g.A + (size_t)(U).pm * tstep)
#define PG8_GV(U) (*(const u32x4*)((const unsigned*)g.rowsrc + ((size_t)(U).pm * 512 + tid) * 4))
#define PG8_BSRC(U) ((const char*)g.Bt + (size_t)(((U).pm / g.grp) * nN + (U).pn) * tstep)
    Unit cur, nxt; int ui = 0;
    if (!S.next(0, cur)) return;
    u32x4 gvc = (u32x4){0u, 0u, 0u, 0u}, gvn = gvc, gvnn = gvc;
    if constexpr (GATHER) { gvc = PG8_GV(cur); Unit t1; gvn = S.next(1, t1) ? PG8_GV(t1) : gvc; }
#define PG8_STAGE_A(bufoff, base, H, NEXT) do { if constexpr (GATHER) { const bool nx_ = (NEXT); unsigned va_[2] = {nx_ ? gvn[2 * (H)] : gvc[2 * (H)], nx_ ? gvn[2 * (H) + 1] : gvc[2 * (H) + 1]}; PG8_STAGE(bufoff, base, va_); } \
        else PG8_STAGE(bufoff, (base) + (H) * hstep, voffA); } while (0)
    f32x4 acc[2][2][4][2];
#pragma unroll
    for (int a = 0; a < 2; ++a)
#pragma unroll
        for (int b = 0; b < 2; ++b)
#pragma unroll
            for (int m = 0; m < 4; ++m)
#pragma unroll
                for (int n = 0; n < 2; ++n) acc[a][b][m][n] = (f32x4){0.f, 0.f, 0.f, 0.f};
    bf16x8 At[4][2], B0[2][2], B1[2][2];
    const char* cA = PG8_ASRC(cur);
    const char* cB = PG8_BSRC(cur);
    PG8_STAGE(PG8_SB(0, 0), cB, voffB); PG8_STAGE(PG8_SB(0, 1), cB + hstepB, voffB); PG8_STAGE_A(PG8_SA(0, 0), cA, 0, false); PG8_STAGE_A(PG8_SA(0, 1), cA, 1, false);
    if (wr == 1) PG8_BAR;
    PG8_WAIT_V(2); PG8_BAR;
    PG8_STAGE(PG8_SB(1, 0), cB + kstep, voffB); PG8_STAGE_A(PG8_SA(1, 0), cA + kstep, 0, false); PG8_STAGE(PG8_SB(1, 1), cB + hstepB + kstep, voffB);
    PG8_WAIT_V(6); PG8_BAR;
    for (;;) {
        const bool has_next = S.next(ui + 1, nxt);
        const char* nA = cA; const char* nB = cB;
        if (has_next) { nA = PG8_ASRC(nxt); nB = PG8_BSRC(nxt); }
#pragma unroll 1
        for (int t = 0; t < nt; t += 2) {
            const bool last = (t == nt - 2);
            const char* a1 = cA + (size_t)(t + 1) * kstep;
            const char* a2 = last ? nA : cA + (size_t)(t + 2) * kstep; const char* b2 = last ? nB : cB + (size_t)(t + 2) * kstep;
            const char* a3 = a2 + kstep; const char* b3 = b2 + kstep;
            PG8_LDB(B0, 0, 0); PG8_LDB(B1, 0, 1); PG8_SCHED; PG8_LDA(At, 0, 0); PG8_STAGE_A(PG8_SA(1, 1), a1, 1, false);
            PG8_WAIT_V(8); PG8_WAIT_L(0); PG8_BAR; PG8_MMA(0, 0, At, B0); PG8_MMA(0, 1, At, B1); PG8_BAR; PG8_SCHED;
            PG8_LDA(At, 0, 1); PG8_STAGE(PG8_SB(0, 0), b2, voffB); PG8_STAGE(PG8_SB(0, 1), b2 + hstepB, voffB); PG8_STAGE_A(PG8_SA(0, 0), a2, 0, last);
            PG8_WAIT_V(8); PG8_WAIT_L(0); PG8_BAR; PG8_MMA(1, 0, At, B0); PG8_MMA(1, 1, At, B1); PG8_BAR; PG8_SCHED;
            PG8_LDB(B0, 1, 0); PG8_LDB(B1, 1, 1); PG8_SCHED; PG8_LDA(At, 1, 0); PG8_STAGE_A(PG8_SA(0, 1), a2, 1, last);
            PG8_WAIT_V(8); PG8_WAIT_L(0); PG8_BAR; PG8_MMA(0, 0, At, B0); PG8_MMA(0, 1, At, B1); PG8_BAR; PG8_SCHED;
            PG8_LDA(At, 1, 1); PG8_STAGE(PG8_SB(1, 0), b3, voffB); PG8_STAGE(PG8_SB(1, 1), b3 + hstepB, voffB); PG8_STAGE_A(PG8_SA(1, 0), a3, 0, last);
            PG8_WAIT_V(8); PG8_WAIT_L(0); PG8_BAR; PG8_MMA(1, 0, At, B0); PG8_MMA(1, 1, At, B1); PG8_BAR; PG8_SCHED;
        }
        if (wr == 0) PG8_BAR;
        if constexpr (FP8) asm volatile("s_nop 15\n\ts_nop 15\n\ts_nop 15\n\ts_nop 15" ::: "memory");
        if constexpr (GATHER) { Unit t2; gvnn = S.next(ui + 2, t2) ? PG8_GV(t2) : gvn; }
        E(acc, cur, wr, wc, fr, fq);
        if (!has_next) break;
        if constexpr (GATHER) { gvc = gvn; gvn = gvnn; }
#pragma unroll
        for (int a = 0; a < 2; ++a)
#pragma unroll
            for (int b = 0; b < 2; ++b)
#pragma unroll
                for (int m = 0; m < 4; ++m)
#pragma unroll
                    for (int n = 0; n < 2; ++n) acc[a][b][m][n] = (f32x4){0.f, 0.f, 0.f, 0.f};
        cur = nxt; cA = nA; cB = nB; ++ui;
        if (wr == 1) PG8_BAR;
    }
    PG8_WAIT_V(0);
    PG8_BAR;
#undef PG8_STAGE_A
#undef PG8_GV
#undef PG8_SA
#undef PG8_SB
#undef PG8_STAGE
#undef PG8_LDA
#undef PG8_LDB
#undef PG8_MMA
#undef PG8_WAIT_V
#undef PG8_WAIT_L
#undef PG8_BAR
#undef PG8_SCHED
#undef PG8_ASRC
#undef PG8_BSRC
}
}

#define XB_TMO      128
#define XB_XCNT(j)  (256  + 64 * (j))
#define XB_XSUB(j)  (1280 + 64 * (j))
#define XB_XGEN(j)  (2304 + 64 * (j))
#define XB_TOP      3328
#define XB_TOPGEN   3392
#define XCD_BAR_WORDS 3456
#define XB_SPIN_CAP (1u << 18)
__device__ __forceinline__ unsigned xb_ld(unsigned* p)              { return __hip_atomic_load(p, __ATOMIC_RELAXED, __HIP_MEMORY_SCOPE_AGENT); }
__device__ __forceinline__ unsigned xb_add(unsigned* p, unsigned v) { return __hip_atomic_fetch_add(p, v, __ATOMIC_RELAXED, __HIP_MEMORY_SCOPE_AGENT); }
__device__ __forceinline__ unsigned xb_xcc_id() { return (unsigned)__builtin_amdgcn_s_getreg((3 << 11) | 20) & 0xFu; }
#define XB_SPIN(cond, bar) do { unsigned _sp = 0; while (cond) { __builtin_amdgcn_s_sleep(1); \
    if ((++_sp & 255u) == 0u) { if (xb_ld(&(bar)[XB_TMO])) break; if (_sp > XB_SPIN_CAP) { atomicAdd(&(bar)[XB_TMO], 1u); break; } } } } while (0)
struct XcdBarrier { unsigned* bar; unsigned x; volatile LAS unsigned* st; };
__device__ __forceinline__ XcdBarrier xcd_barrier_post(unsigned* bar, volatile LAS unsigned* st) {
    XcdBarrier b; b.bar = bar; b.x = xb_xcc_id(); b.st = st;
    if (threadIdx.x == 0) (void)xb_add(&bar[XB_XCNT(b.x)], 1u);
    return b;
}
__device__ __forceinline__ void xcd_barrier_complete(unsigned* bar, unsigned x, unsigned& nloc, unsigned& nx) {
    const unsigned G = gridDim.x * gridDim.y * gridDim.z;
    unsigned sum, cnt, mine, sp = 0u;
    for (;;) {
        sum = 0u; cnt = 0u; mine = 0u;
#pragma unroll
        for (unsigned j = 0; j < 16; ++j) { const unsigned c = xb_ld(&bar[XB_XCNT(j)]); sum += c; cnt += (c > 0u) ? 1u : 0u; mine = (j == x) ? c : mine; }
        if (sum == G) break;
        __builtin_amdgcn_s_sleep(1);
        if ((++sp & 255u) == 0u) { if (xb_ld(&bar[XB_TMO])) break; if (sp > XB_SPIN_CAP) { atomicAdd(&bar[XB_TMO], 1u); break; } }
    }
    nloc = mine > 0u ? mine : 1u; nx = cnt > 0u ? cnt : 1u;
}
__device__ __forceinline__ void xcd_barrier(const XcdBarrier& b) {
    asm volatile("s_waitcnt vmcnt(0)" ::: "memory");
    __syncthreads();
    if (threadIdx.x == 0) {
        unsigned* bar = b.bar;
        __builtin_amdgcn_s_waitcnt(0);
        unsigned nloc = b.st[0], nx = b.st[1];
        if (nloc == 0u) { xcd_barrier_complete(bar, b.x, nloc, nx); b.st[0] = nloc; b.st[1] = nx; }
        const unsigned old = xb_add(&bar[XB_XSUB(b.x)], 1u);
        const unsigned gen = old / nloc;
        if (old + 1u == (gen + 1u) * nloc) {
            __builtin_amdgcn_fence(__ATOMIC_RELEASE, "agent");
            asm volatile("s_waitcnt vmcnt(0)" ::: "memory");
            const unsigned og = xb_add(&bar[XB_TOP], 1u);
            const unsigned tg = og / nx;
            if (og + 1u == (tg + 1u) * nx) xb_add(&bar[XB_TOPGEN], 1u);
            else XB_SPIN(xb_ld(&bar[XB_TOPGEN]) == tg, bar);
            __builtin_amdgcn_fence(__ATOMIC_ACQUIRE, "agent");
            xb_add(&bar[XB_XGEN(b.x)], 1u);
            asm volatile("s_waitcnt vmcnt(0)" ::: "memory");
        } else {
            XB_SPIN(xb_ld(&bar[XB_XGEN(b.x)]) == gen, bar);
            __builtin_amdgcn_fence(__ATOMIC_ACQUIRE, "agent");
            asm volatile("s_waitcnt vmcnt(0)" ::: "memory");
        }
    }
    __syncthreads();
}

struct Args {
    const float *x, *c, *w_ada, *b_ada, *w_in, *q_norm_g, *w_uq, *kv_norm_g, *w_ukv, *rel_bias, *w_out, *ln1_g, *ln1_b, *w_router, *w_gate, *w_up, *w_down, *ln2_g, *ln2_b;
    float* out; unsigned char* ws; int ph_lo, ph_hi;
};
struct Frame {
    LAS unsigned char* lds;
    int tid, lane, wave, vcu, G;
    unsigned char* ws;
};
#define WSP(T, off) ((T*)(F.ws + (off)))
typedef const __attribute__((address_space(4))) Args* KArgs;
__device__ __forceinline__ KArgs kargs() { KArgs p = (KArgs)__builtin_amdgcn_kernarg_segment_ptr(); asm volatile("" : "+s"(p)); return p; }

using pg8::Unit;
#define DPERM(s_) ((((s_) & 15) << 8) + ((s_) >> 4))
struct EpiProj {
    bf16_t *CQ, *CKV, *KR, *DQ; float* SSQ; const float* rope;
    __device__ __forceinline__ void operator()(const f32x4 (&acc)[2][2][4][2], const Unit& u, int wr, int wc, int fr, int fq) const {
        const int pn = u.pn;
        if (pn >= 3) {
            const int t = pn - 3; bf16_t* base = DQ + (size_t)(t >> 1) * ((WS_DK - WS_DQ) / 2); const float sc = (t < 2 ? QS_DIL : 1.f) * (1.f / WIN_SCALE);
            const int col0 = (t & 1) * 256 + wc * 32 + 8 * fq;
#pragma unroll
            for (int ai = 0; ai < 2; ++ai)
#pragma unroll
                for (int m = 0; m < 4; ++m) { const size_t row = (size_t)u.pm * 256 + ai * 128 + wr * 64 + m * 16 + fr;
#pragma unroll
                    for (int bj = 0; bj < 2; ++bj) { const f32x4 v0 = acc[ai][bj][m][0] * sc, v1 = acc[ai][bj][m][1] * sc;
                        u32x4 w; w.x = cvt_pk_bf16(v0[0], v0[1]); w.y = cvt_pk_bf16(v0[2], v0[3]); w.z = cvt_pk_bf16(v1[0], v1[1]); w.w = cvt_pk_bf16(v1[2], v1[3]);
                        const int col = col0 + bj * 128;
                        *(u32x4*)(base + ((size_t)((int)(row >> 12) * 8 + (col >> 6)) * SEQ + DPERM((int)row & (SEQ - 1))) * 64 + (col & 63)) = w; } }
        } else {
#pragma unroll
            for (int ai = 0; ai < 2; ++ai)
#pragma unroll
                for (int m = 0; m < 4; ++m) { const size_t row = (size_t)u.pm * 256 + ai * 128 + wr * 64 + m * 16 + fr;
#pragma unroll
                    for (int bj = 0; bj < 2; ++bj) { const f32x4 v0 = acc[ai][bj][m][0] * (1.f / WIN_SCALE), v1 = acc[ai][bj][m][1] * (1.f / WIN_SCALE);
                        const int seg = pn * 2 + bj;
                        if (seg < 5) {
                            float s = (v0[0] * v0[0] + v0[1] * v0[1]) + (v0[2] * v0[2] + v0[3] * v0[3]) + (v1[0] * v1[0] + v1[1] * v1[1]) + (v1[2] * v1[2] + v1[3] * v1[3]);
                            s += __shfl_xor(s, 16); s += __shfl_xor(s, 32);
                            if (fq == 0) SSQ[row * 32 + seg * 4 + wc] = s;
                            u32x4 w; w.x = cvt_pk_bf16(v0[0], v0[1]); w.y = cvt_pk_bf16(v0[2], v0[3]); w.z = cvt_pk_bf16(v1[0], v1[1]); w.w = cvt_pk_bf16(v1[2], v1[3]);
                            if (seg < 3) *(u32x4*)(CQ + row * 384 + seg * 128 + wc * 32 + 8 * fq) = w;
                            else *(u32x4*)(CKV + row * 256 + (seg - 3) * 128 + wc * 32 + 8 * fq) = w;
                        } else if (wc == 0) {
                            const int pos = (int)(row & (SEQ - 1)); const float* rp = rope + pos * 32 + 8 * (fq & 1);
                            const f32x4 c0 = *(const f32x4*)(rp), c1 = *(const f32x4*)(rp + 4), s0 = *(const f32x4*)(rp + 16), s1 = *(const f32x4*)(rp + 20);
                            f32x4 o0, o1;
#pragma unroll
                            for (int j = 0; j < 4; ++j) { const float a = v0[j], b = v1[j]; const float pa = __shfl_xor(a, 32), pb = __shfl_xor(b, 32);
                                o0[j] = fq < 2 ? a * c0[j] - pa * s0[j] : pa * s0[j] + a * c0[j];
                                o1[j] = fq < 2 ? b * c1[j] - pb * s1[j] : pb * s1[j] + b * c1[j]; }
                            u32x2 w; w.x = pk4_fp8(o0[0] * K8_SCALE, o0[1] * K8_SCALE, o0[2] * K8_SCALE, o0[3] * K8_SCALE); w.y = pk4_fp8(o1[0] * K8_SCALE, o1[1] * K8_SCALE, o1[2] * K8_SCALE, o1[3] * K8_SCALE);
                            unsigned char* k8 = (unsigned char*)KR + ((size_t)((row >> 12) * 8) * SEQ + (row & (SEQ - 1))) * 128 + 8 * fq;
#pragma unroll
                            for (int hh = 0; hh < 8; ++hh) { *(u32x2*)(k8 + (size_t)hh * SEQ * 128 + 64) = w; *(u32x2*)(k8 + (size_t)hh * SEQ * 128 + 96) = (u32x2){fq == 0 ? 0x00383838u : 0u, 0u}; }
                        } } }
        }
    }
};
struct EpiQ {
    bf16_t* Q; const float* SSQ; const float* rope;
    __device__ __forceinline__ void operator()(const f32x4 (&acc)[2][2][4][2], const Unit& u, int wr, int wc, int fr, int fq) const {
#pragma unroll
        for (int ai = 0; ai < 2; ++ai)
#pragma unroll
            for (int m = 0; m < 4; ++m) { const size_t row = (size_t)u.pm * 256 + ai * 128 + wr * 64 + m * 16 + fr;
                const f32x4 q0 = *(const f32x4*)(SSQ + row * 32), q1 = *(const f32x4*)(SSQ + row * 32 + 4), q2 = *(const f32x4*)(SSQ + row * 32 + 8);
                const float ss = ((q0[0] + q0[1]) + (q0[2] + q0[3])) + ((q1[0] + q1[1]) + (q1[2] + q1[3])) + ((q2[0] + q2[1]) + (q2[2] + q2[3]));
                const float rs = Q8_SCALE / sqrtf(ss * (1.f / Q_LORA) + NORM_EPS);
                const int pos = (int)(row & (SEQ - 1));
#pragma unroll
                for (int bj = 0; bj < 2; ++bj) { f32x4 v0 = acc[ai][bj][m][0] * rs, v1 = acc[ai][bj][m][1] * rs;
                    const int G32 = u.pn * 8 + bj * 4 + wc;
                    if (G32 % 3 == 2) {
                        const float* rp = rope + pos * 32 + 8 * (fq & 1);
                        const f32x4 c0 = *(const f32x4*)(rp), c1 = *(const f32x4*)(rp + 4), s0 = *(const f32x4*)(rp + 16), s1 = *(const f32x4*)(rp + 20);
                        f32x4 o0, o1;
#pragma unroll
                        for (int j = 0; j < 4; ++j) { const float a = v0[j], b = v1[j]; const float pa = __shfl_xor(a, 32), pb = __shfl_xor(b, 32);
                            o0[j] = fq < 2 ? a * c0[j] - pa * s0[j] : pa * s0[j] + a * c0[j];
                            o1[j] = fq < 2 ? b * c1[j] - pb * s1[j] : pb * s1[j] + b * c1[j]; }
                        v0 = o0; v1 = o1;
                    }
                    u32x2 w; w.x = pk4_fp8(v0[0], v0[1], v0[2], v0[3]); w.y = pk4_fp8(v1[0], v1[1], v1[2], v1[3]);
                    unsigned char* q8 = (unsigned char*)Q + ((size_t)((row >> 12) * 8 + G32 / 3) * SEQ + pos) * 128 + (G32 % 3) * 32 + 8 * fq;
                    *(u32x2*)q8 = w; if (G32 % 3 == 2) *(u32x2*)(q8 + 32) = (u32x2){0u, 0u}; }
                asm volatile("" ::: "memory"); }
    }
};
struct EpiKV {
    bf16_t* O; const float* SSQ;
    __device__ __forceinline__ void operator()(const f32x4 (&acc)[2][2][4][2], const Unit& u, int wr, int wc, int fr, int fq) const {
#pragma unroll
        for (int ai = 0; ai < 2; ++ai)
#pragma unroll
            for (int m = 0; m < 4; ++m) { const size_t row = (size_t)u.pm * 256 + ai * 128 + wr * 64 + m * 16 + fr;
                const f32x4 q0 = *(const f32x4*)(SSQ + row * 32 + 12), q1 = *(const f32x4*)(SSQ + row * 32 + 16);
                const float ss = ((q0[0] + q0[1]) + (q0[2] + q0[3])) + ((q1[0] + q1[1]) + (q1[2] + q1[3]));
                const float rs = 1.f / sqrtf(ss * (1.f / KV_LORA) + NORM_EPS);
#pragma unroll
                for (int bj = 0; bj < 2; ++bj) { const f32x4 v0 = acc[ai][bj][m][0] * rs, v1 = acc[ai][bj][m][1] * rs;
                    u32x4 w; w.x = cvt_pk_bf16(v0[0], v0[1]); w.y = cvt_pk_bf16(v0[2], v0[3]); w.z = cvt_pk_bf16(v1[0], v1[1]); w.w = cvt_pk_bf16(v1[2], v1[3]);
                    *(u32x4*)(O + row * 512 + u.pn * 256 + bj * 128 + wc * 32 + 8 * fq) = w; }
                asm volatile("" ::: "memory"); }
    }
};
struct EpiKN8 {
    unsigned char* K8; const float* SSQ;
    __device__ __forceinline__ void operator()(const f32x4 (&acc)[2][2][4][2], const Unit& u, int wr, int wc, int fr, int fq) const {
#pragma unroll
        for (int ai = 0; ai < 2; ++ai)
#pragma unroll
            for (int m = 0; m < 4; ++m) { const size_t row = (size_t)u.pm * 256 + ai * 128 + wr * 64 + m * 16 + fr;
                const f32x4 q0 = *(const f32x4*)(SSQ + row * 32 + 12), q1 = *(const f32x4*)(SSQ + row * 32 + 16);
                const float ss = ((q0[0] + q0[1]) + (q0[2] + q0[3])) + ((q1[0] + q1[1]) + (q1[2] + q1[3]));
                const float rs = K8_SCALE / sqrtf(ss * (1.f / KV_LORA) + NORM_EPS);
#pragma unroll
                for (int bj = 0; bj < 2; ++bj) { const f32x4 v0 = acc[ai][bj][m][0] * rs, v1 = acc[ai][bj][m][1] * rs;
                    const int col = u.pn * 256 + bj * 128 + wc * 32 + 8 * fq;
                    u32x2 w; w.x = pk4_fp8(v0[0], v0[1], v0[2], v0[3]); w.y = pk4_fp8(v1[0], v1[1], v1[2], v1[3]);
                    *(u32x2*)(K8 + ((size_t)((row >> 12) * 8 + (col >> 6)) * SEQ + (row & (SEQ - 1))) * 128 + (col & 63)) = w; }
                asm volatile("" ::: "memory"); }
    }
};
struct EpiVt8 {
    unsigned char* Vt; const float* SSQ;
    __device__ __forceinline__ void operator()(const f32x4 (&acc)[2][2][4][2], const Unit& u, int wr, int wc, int fr, int fq) const {
        float rs[2][8];
#pragma unroll
        for (int bj = 0; bj < 2; ++bj)
#pragma unroll
            for (int j = 0; j < 8; ++j) { const size_t tok = (size_t)u.pn * 256 + bj * 128 + wc * 32 + 8 * fq + j;
                const f32x4 q0 = *(const f32x4*)(SSQ + tok * 32 + 12), q1 = *(const f32x4*)(SSQ + tok * 32 + 16);
                rs[bj][j] = 1.f / sqrtf((((q0[0] + q0[1]) + (q0[2] + q0[3])) + ((q1[0] + q1[1]) + (q1[2] + q1[3]))) * (1.f / KV_LORA) + NORM_EPS); }
#pragma unroll
        for (int ai = 0; ai < 2; ++ai)
#pragma unroll
            for (int m = 0; m < 4; ++m) { const int ch = u.pm * 256 + ai * 128 + wr * 64 + m * 16 + fr;
#pragma unroll
                for (int bj = 0; bj < 2; ++bj) { const f32x4 v0 = acc[ai][bj][m][0], v1 = acc[ai][bj][m][1];
                    const int tok = u.pn * 256 + bj * 128 + wc * 32 + 8 * fq;
                    u32x2 w; w.x = pk4_fp8(v0[0] * rs[bj][0], v0[1] * rs[bj][1], v0[2] * rs[bj][2], v0[3] * rs[bj][3]); w.y = pk4_fp8(v1[0] * rs[bj][4], v1[1] * rs[bj][5], v1[2] * rs[bj][6], v1[3] * rs[bj][7]);
                    *(u32x2*)(Vt + ((size_t)((tok >> 12) * 512 + ch)) * SEQ + (tok & (SEQ - 1))) = w; } }
    }
};
struct EpiOut {
    bf16_t* out; const float* mod;
    __device__ __forceinline__ void operator()(const f32x4 (&acc)[2][2][4][2], const Unit& u, int wr, int wc, int fr, int fq) const {
#pragma unroll
        for (int ai = 0; ai < 2; ++ai)
#pragma unroll
            for (int m = 0; m < 4; ++m) { const size_t row = (size_t)u.pm * 256 + ai * 128 + wr * 64 + m * 16 + fr; const int b = (int)(row >> 12);
#pragma unroll
                for (int bj = 0; bj < 2; ++bj) { const int col = u.pn * 256 + bj * 128 + wc * 32 + 8 * fq;
                    const float* gp = mod + b * 6144 + 2048 + col;
                    const f32x4 g0 = *(const f32x4*)gp, g1 = *(const f32x4*)(gp + 4);
                    const f32x4 m0 = g0 * acc[ai][bj][m][0] * (DBG_MIX_F / (WOUT_SCALE * MIX_SCALE)), m1 = g1 * acc[ai][bj][m][1] * (DBG_MIX_F / (WOUT_SCALE * MIX_SCALE));
                    u32x4 w; w.x = cvt_pk_bf16(m0[0], m0[1]); w.y = cvt_pk_bf16(m0[2], m0[3]); w.z = cvt_pk_bf16(m1[0], m1[1]); w.w = cvt_pk_bf16(m1[2], m1[3]);
                    *(u32x4*)(out + row * 1024 + col) = w; } }
    }
};
struct EpiGU {
    bf16_t* H;
    __device__ __forceinline__ void operator()(const f32x4 (&acc)[2][2][4][2], const Unit& u, int wr, int wc, int fr, int fq) const {
#pragma unroll
        for (int ai = 0; ai < 2; ++ai)
#pragma unroll
            for (int m = 0; m < 4; ++m) { const unsigned row = (unsigned)(u.pm * 256 + ai * 128 + wr * 64 + m * 16 + fr);
                float o[8];
#pragma unroll
                for (int n = 0; n < 2; ++n)
#pragma unroll
                    for (int j = 0; j < 4; ++j) { const float ag = acc[ai][0][m][n][j], au = acc[ai][1][m][n][j];
                        constexpr float kk = WGU_SCALE * WGU_SCALE / HID_SCALE;
                        const float e = __builtin_amdgcn_exp2f(ag * (-LOG2E / WGU_SCALE));
                        o[n * 4 + j] = (ag * au) * __builtin_amdgcn_rcpf(__builtin_fmaf(e, kk, kk)); }
                u32x2 w; w.x = pk4_fp8(o[0], o[1], o[2], o[3]); w.y = pk4_fp8(o[4], o[5], o[6], o[7]);
                *(u32x2*)((unsigned char*)H + (row * 1536u + (unsigned)(u.pn * 128 + wc * 32 + 8 * fq))) = w; }
    }
};
struct EpiDown {
    bf16_t* Y; const float* vals;
    __device__ __forceinline__ void operator()(const f32x4 (&acc)[2][2][4][2], const Unit& u, int wr, int wc, int fr, int fq) const {
#pragma unroll
        for (int ai = 0; ai < 2; ++ai)
#pragma unroll
            for (int m = 0; m < 4; ++m) { const unsigned row = (unsigned)(u.pm * 256 + ai * 128 + wr * 64 + m * 16 + fr); const float vv = vals[row] * (Y_SCALE / (WD_SCALE * HID_SCALE));
#pragma unroll
                for (int bj = 0; bj < 2; ++bj) { const f32x4 v0 = acc[ai][bj][m][0] * vv, v1 = acc[ai][bj][m][1] * vv;
                    u32x2 w; w.x = pk4_fp8(v0[0], v0[1], v0[2], v0[3]); w.y = pk4_fp8(v1[0], v1[1], v1[2], v1[3]);
                    *(u32x2*)((unsigned char*)Y + (row * 1024u + (unsigned)(u.pn * 256 + bj * 128 + wc * 32 + 8 * fq))) = w; } }
    }
};

__device__ __forceinline__ s16x4 vtr(const LAS char* p) { return __builtin_bit_cast(s16x4, __builtin_amdgcn_ds_read_tr16_b64_v4i16((LAS s16x4*)p)); }
template <int ND0, int KPITCH, bool BIAS>
__device__ __forceinline__ void attn_tile(const LAS char* Kt, const LAS char* Vt, const bf16x8 (&qr)[ND0], float& m_run, float& l_run, f32x16& o0, f32x16& o1,
                                          const LAS float* tab, int lane) {
    const int r32 = lane & 31, hi = lane >> 5;
    f32x16 p0, p1;
#pragma unroll
    for (int r = 0; r < 16; ++r) { p0[r] = 0.f; p1[r] = 0.f; }
    const LAS char* kp = Kt + r32 * KPITCH + hi * 16;
    bf16x8 kf[2 * ND0];
#pragma unroll
    for (int d0 = 0; d0 < ND0; ++d0) { kf[2 * d0] = *(const LAS bf16x8*)(kp + d0 * 32); kf[2 * d0 + 1] = *(const LAS bf16x8*)(kp + 32 * KPITCH + d0 * 32); }
#pragma unroll
    for (int d0 = 0; d0 < ND0; ++d0) {
        p0 = __builtin_amdgcn_mfma_f32_32x32x16_bf16(kf[2 * d0], qr[d0], p0, 0, 0, 0);
        p1 = __builtin_amdgcn_mfma_f32_32x32x16_bf16(kf[2 * d0 + 1], qr[d0], p1, 0, 0, 0);
    }
    const LAS char* vp = Vt + (4 * hi + ((lane & 15) >> 2)) * 64 + ((lane >> 4) & 1) * 32 + (lane & 3) * 8;
    bf16x8 vf[8];
#pragma unroll
    for (int ks = 0; ks < 4; ++ks) {
        const s16x4 l0 = vtr(vp + ks * 1024), h0 = vtr(vp + ks * 1024 + 512), l1 = vtr(vp + 4096 + ks * 1024), h1 = vtr(vp + 4096 + ks * 1024 + 512);
        vf[2 * ks] = (bf16x8){l0[0], l0[1], l0[2], l0[3], h0[0], h0[1], h0[2], h0[3]}; vf[2 * ks + 1] = (bf16x8){l1[0], l1[1], l1[2], l1[3], h1[0], h1[1], h1[2], h1[3]};
    }
    __builtin_amdgcn_sched_barrier(0);
    if constexpr (BIAS) {
#pragma unroll
        for (int r = 0; r < 16; ++r) { const int kvl = (r & 3) + 8 * (r >> 2) + 4 * hi; p0[r] += tab[kvl]; p1[r] += tab[kvl + 32]; }
    }
    float mx = fmaxf(p0[0], p1[0]);
#pragma unroll
    for (int r = 1; r < 16; ++r) mx = fmaxf(mx, fmaxf(p0[r], p1[r]));
    mx = fmaxf(mx, __shfl_xor(mx, 32));
    const float m_new = fmaxf(m_run, mx);
    const float alpha = __builtin_amdgcn_exp2f(m_run - m_new);
    m_run = m_new;
    float rs = 0.f;
#pragma unroll
    for (int r = 0; r < 16; ++r) { p0[r] = __builtin_amdgcn_exp2f(p0[r] - m_new); p1[r] = __builtin_amdgcn_exp2f(p1[r] - m_new); rs += p0[r] + p1[r]; }
    l_run = l_run * alpha + rs;
#pragma unroll
    for (int r = 0; r < 16; ++r) { o0[r] *= alpha; o1[r] *= alpha; }
    bf16x8 pf[4];
#pragma unroll
    for (int ks = 0; ks < 4; ++ks) { u32x4 w;
        if (ks < 2) { w.x = cvt_pk_bf16(p0[8 * ks + 0], p0[8 * ks + 1]); w.y = cvt_pk_bf16(p0[8 * ks + 2], p0[8 * ks + 3]); w.z = cvt_pk_bf16(p0[8 * ks + 4], p0[8 * ks + 5]); w.w = cvt_pk_bf16(p0[8 * ks + 6], p0[8 * ks + 7]); }
        else { const int k2 = ks - 2; w.x = cvt_pk_bf16(p1[8 * k2 + 0], p1[8 * k2 + 1]); w.y = cvt_pk_bf16(p1[8 * k2 + 2], p1[8 * k2 + 3]); w.z = cvt_pk_bf16(p1[8 * k2 + 4], p1[8 * k2 + 5]); w.w = cvt_pk_bf16(p1[8 * k2 + 6], p1[8 * k2 + 7]); }
        pf[ks] = __builtin_bit_cast(bf16x8, w); }
#pragma unroll
    for (int ks = 0; ks < 4; ++ks) {
        o0 = __builtin_amdgcn_mfma_f32_32x32x16_bf16(vf[2 * ks], pf[ks], o0, 0, 0, 0);
        o1 = __builtin_amdgcn_mfma_f32_32x32x16_bf16(vf[2 * ks + 1], pf[ks], o1, 0, 0, 0);
    }
}

constexpr int MLA_KP = 144, MLA_KB = 64 * MLA_KP, MLA_VP = 80, MLA_BUF = MLA_KB + 64 * MLA_VP;
constexpr float MLA_POFS = 0.f;
__device__ __forceinline__ float max3f(float a, float b, float c) { float r; asm("v_max3_f32 %0, %1, %2, %3" : "=v"(r) : "v"(a), "v"(b), "v"(c)); return r; }
__device__ __forceinline__ float xhalf_max(float m) { auto rr = __builtin_amdgcn_permlane32_swap(__float_as_uint(m), __float_as_uint(m), false, false); float a = __uint_as_float(rr[0]), b = __uint_as_float(rr[1]); float r; asm("v_max_f32_e32 %0, %1, %2" : "=v"(r) : "v"(a), "v"(b)); return r; }
__device__ __forceinline__ float fmin126(float a) { float r; asm("v_min_f32_e32 %0, 0x42fc0000, %1" : "=v"(r) : "v"(a)); return r; }
__device__ __forceinline__ float xhalf_sum(float m) { auto rr = __builtin_amdgcn_permlane32_swap(__float_as_uint(m), __float_as_uint(m), false, false); return __uint_as_float(rr[0]) + __uint_as_float(rr[1]); }
__device__ __forceinline__ float rowmax32(const f32x16& p0, const f32x16& p1) {
    float a = max3f(p0[0], p0[1], p1[0]), b = max3f(p0[2], p0[3], p1[1]); a = max3f(a, p1[2], p1[3]);
#pragma unroll
    for (int r = 4; r < 16; r += 4) { a = max3f(a, p0[r], p0[r + 1]); b = max3f(b, p0[r + 2], p0[r + 3]); a = max3f(a, p1[r], p1[r + 1]); b = max3f(b, p1[r + 2], p1[r + 3]); }
    float m; asm("v_max_f32_e32 %0, %1, %2" : "=v"(m) : "v"(a), "v"(b));
    return xhalf_max(m);
}
template <int ND0, int KPITCH>
__device__ __forceinline__ void qk_tile(f32x16& p0, f32x16& p1, const LAS char* Kt, const bf16x8 (&qr)[ND0], const f32x16& cinit, int lane) {
    const LAS char* kp = Kt + (lane & 31) * KPITCH + (lane >> 5) * 16;
#pragma unroll
    for (int d0 = 0; d0 < ND0; ++d0) {
        const bf16x8 a0 = *(const LAS bf16x8*)(kp + d0 * 32), a1 = *(const LAS bf16x8*)(kp + 32 * KPITCH + d0 * 32);
        if (d0 == 0) { p0 = __builtin_amdgcn_mfma_f32_32x32x16_bf16(a0, qr[0], cinit, 0, 0, 0); p1 = __builtin_amdgcn_mfma_f32_32x32x16_bf16(a1, qr[0], cinit, 0, 0, 0); }
        else { p0 = __builtin_amdgcn_mfma_f32_32x32x16_bf16(a0, qr[d0], p0, 0, 0, 0); p1 = __builtin_amdgcn_mfma_f32_32x32x16_bf16(a1, qr[d0], p1, 0, 0, 0); }
    }
}
__device__ __forceinline__ void pv_tile(f32x16& o0, f32x16& o1, const f32x16& p0, const f32x16& p1, const LAS char* Vt, int lane) {
    const int hi = lane >> 5;
    bf16x8 pf[4];
#pragma unroll
    for (int ks = 0; ks < 4; ++ks) { u32x4 w;
        if (ks < 2) { w.x = cvt_pk_bf16(p0[8 * ks + 0], p0[8 * ks + 1]); w.y = cvt_pk_bf16(p0[8 * ks + 2], p0[8 * ks + 3]); w.z = cvt_pk_bf16(p0[8 * ks + 4], p0[8 * ks + 5]); w.w = cvt_pk_bf16(p0[8 * ks + 6], p0[8 * ks + 7]); }
        else { const int k2 = ks - 2; w.x = cvt_pk_bf16(p1[8 * k2 + 0], p1[8 * k2 + 1]); w.y = cvt_pk_bf16(p1[8 * k2 + 2], p1[8 * k2 + 3]); w.z = cvt_pk_bf16(p1[8 * k2 + 4], p1[8 * k2 + 5]); w.w = cvt_pk_bf16(p1[8 * k2 + 6], p1[8 * k2 + 7]); }
        pf[ks] = __builtin_bit_cast(bf16x8, w); }
    const LAS char* vp = Vt + (4 * hi + ((lane & 15) >> 2)) * 64 + ((lane >> 4) & 1) * 32 + (lane & 3) * 8;
#pragma unroll
    for (int ks = 0; ks < 4; ++ks) {
        const s16x4 l0 = vtr(vp + ks * 1024), h0 = vtr(vp + ks * 1024 + 512), l1 = vtr(vp + 4096 + ks * 1024), h1 = vtr(vp + 4096 + ks * 1024 + 512);
        const bf16x8 v0 = (bf16x8){l0[0], l0[1], l0[2], l0[3], h0[0], h0[1], h0[2], h0[3]}, v1 = (bf16x8){l1[0], l1[1], l1[2], l1[3], h1[0], h1[1], h1[2], h1[3]};
        o0 = __builtin_amdgcn_mfma_f32_32x32x16_bf16(v0, pf[ks], o0, 0, 0, 0);
        o1 = __builtin_amdgcn_mfma_f32_32x32x16_bf16(v1, pf[ks], o1, 0, 0, 0);
    }
}
#define SGB(mask, n) __builtin_amdgcn_sched_group_barrier(mask, n, 0)
__device__ __forceinline__ unsigned enc3_fp8(float v) {
    const int w1 = __builtin_amdgcn_cvt_pk_fp8_f32(__builtin_amdgcn_fmed3f(v, -448.f, 448.f), 0.f, 0, false); const float r1 = v - __builtin_amdgcn_cvt_f32_fp8(w1, 0);
    const int w2 = __builtin_amdgcn_cvt_pk_fp8_f32(__builtin_amdgcn_fmed3f(r1, -448.f, 448.f), 0.f, 0, false); const float r2 = r1 - __builtin_amdgcn_cvt_f32_fp8(w2, 0);
    const int w3 = __builtin_amdgcn_cvt_pk_fp8_f32(__builtin_amdgcn_fmed3f(r2, -448.f, 448.f), 0.f, 0, false);
    return ((unsigned)w1 & 0xffu) | (((unsigned)w2 & 0xffu) << 8) | (((unsigned)w3 & 0xffu) << 16);
}
__device__ __forceinline__ void mla_unit(Frame& F, int b, int h, int qb) {
    int tid = F.tid; asm volatile("" : "+v"(tid));
    const int lane = tid & 63, wid = F.wave, r32 = lane & 31, hi = lane >> 5;
    const unsigned char* Q8 = WSP(const unsigned char, WS_Q); const unsigned char* K8 = WSP(const unsigned char, WS_KN); const unsigned char* Vt8 = WSP(const unsigned char, WS_V);
    bf16_t* MIX = WSP(bf16_t, WS_MIX);
    const size_t tok0 = (size_t)b * SEQ;
    const int q0 = qb * 512 + wid * 64 + r32;
    i32x8 qA[2], qB[2];
    { const unsigned char* qp = Q8 + ((size_t)(b * 8 + h) * SEQ + q0) * 128 + 32 * hi;
#pragma unroll
      for (int ks = 0; ks < 2; ++ks) { const i32x4 lo = *(const i32x4*)(qp + 64 * ks), hh = *(const i32x4*)(qp + 64 * ks + 16); qA[ks] = __builtin_shufflevector(lo, hh, 0, 1, 2, 3, 4, 5, 6, 7);
          const i32x4 lo2 = *(const i32x4*)(qp + 32 * 128 + 64 * ks), hh2 = *(const i32x4*)(qp + 32 * 128 + 64 * ks + 16); qB[ks] = __builtin_shufflevector(lo2, hh2, 0, 1, 2, 3, 4, 5, 6, 7); } }
    const int kv_s = tid >> 3, c_s = tid & 7;
    const unsigned char* k_base = K8 + (size_t)(b * 8 + h) * SEQ * 128; const unsigned k_off = (unsigned)(kv_s * 128 + c_s * 16);
    const unsigned char* v_base = Vt8 + (size_t)(b * 8 + h) * 64 * SEQ; const unsigned v_off = (unsigned)(((tid >> 2) & 63) * SEQ + (tid & 3) * 16);
    const int k_dst = (((kv_s & 31) << 1) | (kv_s >> 5)) * MLA_KP + c_s * 16, v_dst = MLA_KB + ((tid >> 2) & 63) * MLA_VP + (tid & 3) * 16;
    LAS char* lds = (LAS char*)F.lds;
    f32x16 oA0, oA1, oB0, oB1;
#pragma unroll
    for (int r = 0; r < 16; ++r) { oA0[r] = 0.f; oA1[r] = 0.f; oB0[r] = 0.f; oB1[r] = 0.f; }
    float lA = 0.f, lB = 0.f;
    const f32x16 zero16 = (f32x16){0.f, 0.f, 0.f, 0.f, 0.f, 0.f, 0.f, 0.f, 0.f, 0.f, 0.f, 0.f, 0.f, 0.f, 0.f, 0.f};
    const int selw = ((((lane & 15) >> 2) & 1) == ((lane >> 4) & 1)) ? 0x38383838 : 0;
    const i32x8 sel8 = (i32x8){selw, selw, selw, selw, selw, selw, selw, selw};
    const f32x4 zero4 = (f32x4){0.f, 0.f, 0.f, 0.f};
#define MLA_SUM8(b) __builtin_amdgcn_mfma_scale_f32_16x16x128_f8f6f4(sel8, b, zero4, 0, 0, 0, 0, 0, 0)
    u32x4 rk0, rv0, rk1, rv1;
#define MLA_LOADG(t, rk, rv) do { const unsigned o_ = (unsigned)((t) < 64 ? (t) : 63) * 64u; rk = *(const u32x4*)(k_base + (k_off + o_ * 128u)); rv = *(const u32x4*)(v_base + (v_off + o_)); } while (0)
#define MLA_STORE_OFF(off, rk, rv) do { LAS char* d_ = lds + (off); *(LAS u32x4*)(d_ + k_dst) = rk; *(LAS u32x4*)(d_ + v_dst) = rv; } while (0)
#define MLA_KFRAG(dst, base, a, ks) do { const LAS char* p_ = (base) + (a) * 32 * MLA_KP + (ks) * 64; \
        const i32x4 lo_ = *(const LAS i32x4*)p_, hi_ = *(const LAS i32x4*)(p_ + 16); dst = __builtin_shufflevector(lo_, hi_, 0, 1, 2, 3, 4, 5, 6, 7); } while (0)
#define MLA_MFMA8(a, b, c) __builtin_amdgcn_mfma_scale_f32_32x32x64_f8f6f4(a, b, c, 0, 0, 0, 0, 0, 0)
    static_assert(6 * MLA_BUF <= RING_BYTES, "MLA ring");
    const int sig = 32 * ((r32 >> 2) & 1) + (r32 & 3) + 4 * (r32 >> 3);
    const LAS char* kp0 = lds + (2 * (sig & 31) + (sig >> 5)) * MLA_KP + hi * 32;
    const LAS char* vp0 = lds + MLA_KB + r32 * MLA_VP + 32 * hi;
    MLA_LOADG(0, rk0, rv0); MLA_LOADG(1, rk1, rv1); MLA_STORE_OFF(0, rk0, rv0); MLA_STORE_OFF(MLA_BUF, rk1, rv1);
    MLA_LOADG(2, rk0, rv0); MLA_LOADG(3, rk1, rv1); MLA_STORE_OFF(2 * MLA_BUF, rk0, rv0); MLA_STORE_OFF(3 * MLA_BUF, rk1, rv1);
    __syncthreads();
    MLA_LOADG(4, rk0, rv0); MLA_LOADG(5, rk1, rv1);
    i32x8 kf[4];
#define MLA_KFRAGS(slot) do { const LAS char* kp_ = kp0 + (slot); MLA_KFRAG(kf[0], kp_, 0, 0); MLA_KFRAG(kf[1], kp_, 0, 1); MLA_KFRAG(kf[2], kp_, 1, 0); MLA_KFRAG(kf[3], kp_, 1, 1); } while (0)
#define MLA_VFRAGS(slot) do { const LAS char* vp_ = vp0 + (slot); \
        _Pragma("unroll") for (int dh = 0; dh < 2; ++dh) { const i32x4 lo_ = *(const LAS i32x4*)(vp_ + dh * 32 * MLA_VP), hi_ = *(const LAS i32x4*)(vp_ + dh * 32 * MLA_VP + 16); vf[dh] = __builtin_shufflevector(lo_, hi_, 0, 1, 2, 3, 4, 5, 6, 7); } } while (0)
#define MLA_SCORE(q) do { s0 = MLA_MFMA8(kf[0], q[0], zero16); s1 = MLA_MFMA8(kf[2], q[0], zero16); s0 = MLA_MFMA8(kf[1], q[1], s0); s1 = MLA_MFMA8(kf[3], q[1], s1); } while (0)
    f32x16 s0, s1; i32x8 vf[2];
    MLA_KFRAGS(0);
    { MLA_SCORE(qA); const unsigned ea = enc3_fp8(56.5f + 8.f * MLA_POFS - rowmax32(s0, s1));
      MLA_SCORE(qB); const unsigned eb = enc3_fp8(56.5f + 8.f * MLA_POFS - rowmax32(s0, s1));
      qA[1][0] = hi ? (int)ea : qA[1][0]; qB[1][0] = hi ? (int)eb : qB[1][0]; }
#define MLA_PBYTES(pf_) do { _Pragma("unroll") for (int g_ = 0; g_ < 4; ++g_) { unsigned b0_ = 0u, b1_ = 0u; \
            _Pragma("unroll") for (int j_ = 0; j_ < 4; ++j_) { b0_ = __builtin_amdgcn_cvt_pk_u8_f32(s0[4 * g_ + j_], j_, b0_); b1_ = __builtin_amdgcn_cvt_pk_u8_f32(s1[4 * g_ + j_], j_, b1_); } \
            pf_[g_] = (int)b0_; pf_[4 + g_] = (int)b1_; } } while (0)
#define SB0() __builtin_amdgcn_sched_barrier(0)
#define MLA_TILE(this_slot, next_slot) do { i32x8 pf_; \
        MLA_PBYTES(pf_); SB0(); lB += t_[0]; MLA_VFRAGS(this_slot); SB0(); MLA_SCORE(qB); SB0(); \
        oA0 = MLA_MFMA8(vf[0], pf_, oA0); oA1 = MLA_MFMA8(vf[1], pf_, oA1); t_ = MLA_SUM8(pf_); SB0(); \
        MLA_PBYTES(pf_); SB0(); lA += t_[0]; MLA_KFRAGS(next_slot); SB0(); \
        oB0 = MLA_MFMA8(vf[0], pf_, oB0); oB1 = MLA_MFMA8(vf[1], pf_, oB1); t_ = MLA_SUM8(pf_); SB0(); MLA_SCORE(qA); SB0(); } while (0)
    MLA_SCORE(qA); f32x4 t_ = zero4;
    if (wid < 4) __builtin_amdgcn_s_setprio(3); else __builtin_amdgcn_s_setprio(1);
    int sl = 0;
#pragma unroll 1
    for (int tp = 0; tp < 32; ++tp) {
        const int s_a = sl * MLA_BUF, s_b = s_a + MLA_BUF, sl2 = sl + 2 >= 6 ? sl - 4 : sl + 2, s_c = sl2 * MLA_BUF, sl4 = sl2 + 2 >= 6 ? sl2 - 4 : sl2 + 2, f_a = sl4 * MLA_BUF, f_b = f_a + MLA_BUF;
        MLA_STORE_OFF(f_a, rk0, rv0); MLA_STORE_OFF(f_b, rk1, rv1);
        MLA_LOADG(2 * tp + 6, rk0, rv0); MLA_LOADG(2 * tp + 7, rk1, rv1);
        __builtin_amdgcn_sched_barrier(0);
        MLA_TILE(s_a, s_b);
        MLA_TILE(s_b, s_c);
        asm volatile("s_waitcnt lgkmcnt(0)" ::: "memory"); __builtin_amdgcn_s_barrier(); asm volatile("" ::: "memory");
        sl = sl2;
    }
    lB += t_[0];
    __builtin_amdgcn_s_setprio(0);
#undef MLA_TILE
#undef SB0
#undef MLA_PBYTES
#undef MLA_SCORE
#undef MLA_KFRAGS
#undef MLA_VFRAGS
#undef MLA_KFRAG
#undef MLA_MFMA8
#undef MLA_STORE_OFF
#undef MLA_LOADG
    int tid2 = F.tid; asm volatile("" : "+v"(tid2));
    const int hi2 = (tid2 >> 5) & 1; const size_t orow0 = tok0 + qb * 512 + wid * 64 + (tid2 & 31);
#pragma unroll
    for (int grp = 0; grp < 2; ++grp) {
        const f32x16& o0 = grp ? oB0 : oA0; const f32x16& o1 = grp ? oB1 : oA1;
        const float inv = DBG_MLA_F / (grp ? lB : lA);
        unsigned char* orow = (unsigned char*)MIX + (orow0 + 32 * grp) * 1024 + h * 64 + 8 * hi2;
        const float invs = inv * MIX_SCALE;
#pragma unroll
        for (int hf = 0; hf < 2; ++hf) { const f32x16& oo = hf ? o1 : o0;
#pragma unroll
            for (int gp = 0; gp < 2; ++gp) { const int e0 = 8 * gp;
                const unsigned a4 = pk4_fp8(oo[e0] * invs, oo[e0 + 1] * invs, oo[e0 + 2] * invs, oo[e0 + 3] * invs), b4 = pk4_fp8(oo[e0 + 4] * invs, oo[e0 + 5] * invs, oo[e0 + 6] * invs, oo[e0 + 7] * invs);
                const unsigned rcv = (unsigned)__shfl_xor((int)(hi2 ? a4 : b4), 32);
                *(u32x2*)(orow + hf * 32 + 16 * gp) = hi2 ? (u32x2){rcv, b4} : (u32x2){a4, rcv}; }
        }
    }
}

constexpr int DIL_KP = 144, DIL_KB = 64 * DIL_KP, DIL_BUF = DIL_KB + 8192, DIL_PAIR = 2 * DIL_BUF, DIL_TAB = 4 * DIL_PAIR;
static_assert(DIL_TAB + 3 * 320 * 4 <= RING_BYTES, "dilated LDS");
template <int MODE>
__device__ __forceinline__ void dil_unit(Frame& F, int b, int h, int sb) {
    const int tid = F.tid, lane = F.lane, wid = F.wave, r32 = lane & 31, hi = lane >> 5;
    const bf16_t* DQ = WSP(const bf16_t, WS_DQ); const bf16_t* DK = WSP(const bf16_t, WS_DK); const bf16_t* DV = WSP(const bf16_t, WS_DV);
    bf16_t* O1 = WSP(bf16_t, WS_O1); bf16_t* O2 = WSP(bf16_t, WS_O2); float* LSE = WSP(float, WS_LSE); bf16_t* MIX = WSP(bf16_t, WS_MIX);
    LAS char* lds = (LAS char*)F.lds;
    LAS float* tab = (LAS float*)(lds + DIL_TAB);
    { const float* tg = WSP(const float, WS_TABG); for (int i = tid; i < 960; i += NTHR) tab[i] = tg[((i / 320) * 8 + h) * 320 + (i % 320)]; }
    const int pair = wid >> 1, pt = (wid & 1) * 64 + lane;
    LAS char* pl = lds + pair * DIL_PAIR;
    const size_t tok0 = (size_t)b * SEQ, hrow0 = (size_t)(b * 8 + h) * SEQ;
    const int qi = (wid & 1) * 32 + r32;
#define DIL_BLK(p_, rho_, dsh_, nb_, r_, n_) const int dsh_ = 2 * (p_), nb_ = 64 >> dsh_; const int i__ = 4 * (rho_) + pair, nbsb__ = 16 >> dsh_, r_ = i__ / nbsb__, n_ = ((sb * 1024) >> dsh_) / 64 + i__ % nbsb__
    u32x4 rk[4], rv[4]; bf16x8 qr[4], qn[4];
#define DIL_LOAD(ts_) do { const int p__ = (ts_) / 12, rho__ = ((ts_) % 12) / 3, jt__ = (ts_) % 3; DIL_BLK(p__, rho__, dsh__, nb__, r__, n__); \
        int kb_ = n__ - 1 + jt__; kb_ = kb_ < 0 ? 0 : (kb_ >= nb__ ? nb__ - 1 : kb_); \
        _Pragma("unroll") for (int c_ = 0; c_ < 4; ++c_) { const int ch_ = pt + 128 * c_, kv_ = ch_ >> 3, cc_ = ch_ & 7; \
            const size_t kpos_ = (size_t)((kb_ * 64 + kv_) << dsh__) + r__; \
            const size_t ko_ = (hrow0 + DPERM((int)kpos_)) * 64 + cc_ * 8; rk[c_] = *(const u32x4*)(DK + ko_); rv[c_] = *(const u32x4*)(DV + ko_); } } while (0)
#define DIL_STORE(buf) do { _Pragma("unroll") for (int c_ = 0; c_ < 4; ++c_) { const int ch_ = pt + 128 * c_, kv_ = ch_ >> 3, cc_ = ch_ & 7; \
            *(LAS u32x4*)(pl + (buf) * DIL_BUF + kv_ * DIL_KP + cc_ * 16) = rk[c_]; \
            *(LAS u32x4*)(pl + (buf) * DIL_BUF + DIL_KB + (cc_ >> 2) * 4096 + kv_ * 64 + (cc_ & 3) * 16) = rv[c_]; } } while (0)
#define DIL_QLOAD(dst, blk_) do { const int p__ = (blk_) / 4, rho__ = (blk_) % 4; DIL_BLK(p__, rho__, dsh__, nb__, r__, n__); (void)nb__; \
        const size_t qpos__ = (size_t)((n__ * 64 + qi) << dsh__) + r__; \
        _Pragma("unroll") for (int d0 = 0; d0 < 4; ++d0) dst[d0] = *(const bf16x8*)(DQ + (hrow0 + DPERM((int)qpos__)) * 64 + d0 * 16 + hi * 8); } while (0)
    DIL_LOAD(0); DIL_QLOAD(qr, 0); DIL_STORE(0);
    asm volatile("" :: "v"(qr[0]), "v"(qr[1]), "v"(qr[2]), "v"(qr[3]));
    __syncthreads();
    float m_run = NEG_BIG, l_run = 0.f; f32x16 o0, o1;
#pragma unroll 1
    for (int ts = 0; ts < 36; ++ts) {
        const int p = ts / 12, rho = (ts % 12) / 3, jt = ts % 3;
        DIL_BLK(p, rho, dsh, nb, r, n);
        if (MODE != 2 && ts + 1 < 36) DIL_LOAD(ts + 1);
        if (jt == 1 && ts + 2 < 36) DIL_QLOAD(qn, ts / 3 + 1);
        if (jt == 0) { m_run = NEG_BIG; l_run = 0.f;
#pragma unroll
            for (int rr = 0; rr < 16; ++rr) { o0[rr] = 0.f; o1[rr] = 0.f; } }
        const int kb = n - 1 + jt;
        if (MODE != 1 && kb >= 0 && kb < nb) {
            const LAS float* tq = tab + p * 320 + (64 * (jt - 1) - qi + 127);
            attn_tile<4, DIL_KP, true>(pl + (ts & 1) * DIL_BUF, pl + (ts & 1) * DIL_BUF + DIL_KB, qr, m_run, l_run, o0, o1, tq, lane);
        }
        if (MODE != 2 && ts + 1 < 36) DIL_STORE((ts + 1) & 1);
        if (jt == 2) asm volatile("" :: "v"(qn[0]), "v"(qn[1]), "v"(qn[2]), "v"(qn[3]));
        if (MODE != 0 && jt == 2) { if (m_run == 12345.f) MIX[0] = (bf16_t)(int)(l_run + o0[3] + o1[5]); }
        if (MODE == 0 && jt == 2) {
            const size_t qpos = (size_t)((n * 64 + qi) << dsh) + r;
            const float lt = l_run + __shfl_xor(l_run, 32); const float inv = 1.f / lt;
            const float lse = m_run + __builtin_amdgcn_logf(lt);
            const size_t grow = tok0 + qpos, prow = hrow0 + DPERM((int)qpos);
            if (p < 2) {
                bf16_t* orow = (p == 0 ? O1 : O2) + prow * 64 + 32 * hi;
#pragma unroll
                for (int k = 0; k < 4; ++k) { const f32x16& oo = k < 2 ? o0 : o1; const int e0 = 8 * (k & 1);
                    u32x4 w; w.x = cvt_pk_bf16(oo[e0] * inv, oo[e0 + 1] * inv); w.y = cvt_pk_bf16(oo[e0 + 2] * inv, oo[e0 + 3] * inv); w.z = cvt_pk_bf16(oo[e0 + 4] * inv, oo[e0 + 5] * inv); w.w = cvt_pk_bf16(oo[e0 + 6] * inv, oo[e0 + 7] * inv);
                    *(u32x4*)(orow + 8 * k) = w; }
                if (hi == 0) LSE[(size_t)p * BATCH * DIL_H * SEQ + prow] = lse;
            } else {
                const float l0 = LSE[prow], l1 = LSE[(size_t)BATCH * DIL_H * SEQ + prow];
                const float mm = fmaxf(fmaxf(l0, l1), lse);
                const float e0 = __builtin_amdgcn_exp2f(l0 - mm), e1 = __builtin_amdgcn_exp2f(l1 - mm), e2 = __builtin_amdgcn_exp2f(lse - mm);
                const float isum = DBG_DIL_F / (e0 + e1 + e2); const float w0 = e0 * isum, w1 = e1 * isum, w2 = e2 * isum * inv;
                const bf16_t* a1 = O1 + prow * 64; const bf16_t* a2 = O2 + prow * 64;
                unsigned char* orow = (unsigned char*)MIX + grow * 1024 + 512 + h * 64;
                u32x4 xa[4], xb[4];
#pragma unroll
                for (int k = 0; k < 4; ++k) { xa[k] = *(const u32x4*)(a1 + 32 * hi + 8 * k); xb[k] = *(const u32x4*)(a2 + 32 * hi + 8 * k); }
                unsigned wm[2][4];
#pragma unroll
                for (int g = 0; g < 4; ++g) {
#pragma unroll
                    for (int hf = 0; hf < 2; ++hf) {
                        const u32x4& A1 = xa[hf * 2 + (g >> 1)]; const u32x4& A2 = xb[hf * 2 + (g >> 1)];
                        u32x2 x1, x2; x1.x = (g & 1) ? A1.z : A1.x; x1.y = (g & 1) ? A1.w : A1.y; x2.x = (g & 1) ? A2.z : A2.x; x2.y = (g & 1) ? A2.w : A2.y;
                        const f32x16& oo = hf ? o1 : o0;
                        const float y0 = w0 * bf_lo(x1.x) + w1 * bf_lo(x2.x) + w2 * oo[4 * g], y1 = w0 * bf_hi(x1.x) + w1 * bf_hi(x2.x) + w2 * oo[4 * g + 1];
                        const float y2 = w0 * bf_lo(x1.y) + w1 * bf_lo(x2.y) + w2 * oo[4 * g + 2], y3 = w0 * bf_hi(x1.y) + w1 * bf_hi(x2.y) + w2 * oo[4 * g + 3];
                        wm[hf][g] = pk4_fp8(y0 * MIX_SCALE, y1 * MIX_SCALE, y2 * MIX_SCALE, y3 * MIX_SCALE);
                    }
                }
#pragma unroll
                for (int hf = 0; hf < 2; ++hf)
#pragma unroll
                    for (int gp = 0; gp < 2; ++gp) {
                        const unsigned rcv = (unsigned)__shfl_xor((int)(hi ? wm[hf][2 * gp] : wm[hf][2 * gp + 1]), 32);
                        *(u32x2*)(orow + hf * 32 + 16 * gp + 8 * hi) = hi ? (u32x2){rcv, wm[hf][2 * gp + 1]} : (u32x2){wm[hf][2 * gp], rcv};
                    }
            }
#pragma unroll
            for (int d0 = 0; d0 < 4; ++d0) qr[d0] = qn[d0];
        }
        if (ts == 25) VM_WAIT();
        __syncthreads();
    }
#undef DIL_LOAD
#undef DIL_STORE
#undef DIL_QLOAD
#undef DIL_BLK
}

__device__ __forceinline__ void transpose_item(const float* W, int ldn, int K, int k0, int n0, bf16_t* WT, int drow, const float* kscale, LAS float* scr, int lane) {
#pragma unroll 8
    for (int i = 0; i < 32; ++i) { const int kk = 2 * i + (lane >> 5); float v = W[(size_t)(k0 + kk) * ldn + n0 + (lane & 31)]; if (kscale) v *= kscale[k0 + kk]; scr[kk * 33 + (lane & 31)] = v; }
    LDS_WAIT(); asm volatile("" ::: "memory");
    const int c = lane & 7;
#pragma unroll
    for (int j = 0; j < 4; ++j) { const int n = (lane >> 3) + 8 * j; const LAS float* s = scr + (8 * c) * 33 + n;
        u32x4 o; o.x = pk2(s[0 * 33], s[1 * 33]); o.y = pk2(s[2 * 33], s[3 * 33]); o.z = pk2(s[4 * 33], s[5 * 33]); o.w = pk2(s[6 * 33], s[7 * 33]);
        *(u32x4*)(WT + (size_t)(drow + n) * K + k0 + 8 * c) = o; }
    LDS_WAIT(); asm volatile("" ::: "memory");
}
__device__ __forceinline__ void transpose_item_f8(const float* W, int ldn, int K, int k0, int n0, unsigned char* WT, int drow, float qs, LAS float* scr, int lane) {
#pragma unroll 8
    for (int i = 0; i < 32; ++i) { const int kk = 2 * i + (lane >> 5); scr[kk * 33 + (lane & 31)] = W[(size_t)(k0 + kk) * ldn + n0 + (lane & 31)] * qs; }
    LDS_WAIT(); asm volatile("" ::: "memory");
    const int c = lane & 7;
#pragma unroll
    for (int j = 0; j < 4; ++j) { const int n = (lane >> 3) + 8 * j; const LAS float* s_ = scr + (8 * c) * 33 + n;
        u32x2 o; o.x = pk4_fp8(s_[0 * 33], s_[1 * 33], s_[2 * 33], s_[3 * 33]); o.y = pk4_fp8(s_[4 * 33], s_[5 * 33], s_[6 * 33], s_[7 * 33]);
        *(u32x2*)(WT + (size_t)(drow + n) * K + k0 + 8 * c) = o; }
    LDS_WAIT(); asm volatile("" ::: "memory");
}
__device__ __forceinline__ void transpose_item64(const float* W, int ldn, int K, int k0, int n0, bf16_t* WT, int drow, LAS float* scr, int lane, float qs, float qis) {
    f32x4 v[16];
    const float* src = W + (size_t)(k0 + (lane >> 4)) * ldn + n0 + 4 * (lane & 15);
#pragma unroll
    for (int j = 0; j < 16; ++j) v[j] = __builtin_nontemporal_load((const f32x4*)(src + (size_t)(4 * j) * ldn));
    LAS float* sw = scr + (lane >> 4) * 65 + 4 * (lane & 15);
#pragma unroll
    for (int j = 0; j < 16; ++j) { sw[(4 * j) * 65 + 0] = v[j][0]; sw[(4 * j) * 65 + 1] = v[j][1]; sw[(4 * j) * 65 + 2] = v[j][2]; sw[(4 * j) * 65 + 3] = v[j][3]; }
    LDS_WAIT(); asm volatile("" ::: "memory");
    const int c = lane & 7;
#pragma unroll
    for (int jj = 0; jj < 8; ++jj) { const int n = (lane >> 3) + 8 * jj; const LAS float* s = scr + (8 * c) * 65 + n;
        u32x2 o; o.x = pk4_fp8(s[0 * 65] * qs, s[1 * 65] * qs, s[2 * 65] * qs, s[3 * 65] * qs); o.y = pk4_fp8(s[4 * 65] * qs, s[5 * 65] * qs, s[6 * 65] * qs, s[7 * 65] * qs);
        *(u32x2*)((unsigned char*)WT + (size_t)(drow + n) * K + k0 + 8 * c) = o; }
    LDS_WAIT(); asm volatile("" ::: "memory");
}
__device__ __forceinline__ int t5_bucket_dev(int rel) {
    const int n = rel < 0 ? -rel : rel; int v;
    if (n < 8) v = n; else v = n < 15 ? 8 : n < 27 ? 9 : n < 50 ? 10 : n < 91 ? 11 : n < 166 ? 12 : n < 305 ? 13 : n < 559 ? 14 : 15;
    return (rel > 0 ? 16 : 0) + v;
}
__device__ __forceinline__ void p0_prologue(Frame& F) { const KArgs ka = kargs();
    struct { const float *c, *w_ada, *w_in, *w_uq, *q_norm_g, *w_ukv, *kv_norm_g, *w_out, *rel_bias; } a;
    a.c = ka->c; a.w_ada = ka->w_ada; a.w_in = ka->w_in; a.w_uq = ka->w_uq; a.q_norm_g = ka->q_norm_g; a.w_ukv = ka->w_ukv; a.kv_norm_g = ka->kv_norm_g; a.w_out = ka->w_out; a.rel_bias = ka->rel_bias;
    LAS float* scr = (LAS float*)(F.lds + 32768 + F.wave * 8704);
    LAS float* sil = (LAS float*)F.lds;
    for (int i = F.tid; i < BATCH * D_MODEL; i += NTHR) { const float v = a.c[i]; sil[i] = v / (1.f + __expf(-v)); }
    __syncthreads();
    const int gw = F.vcu * NWAVES + F.wave, NGW = F.G * NWAVES, lane = F.lane;
    for (int it = gw; it < 16 * 24; it += NGW) {
        const int kb = it / 24, nb = it % 24, k0 = kb * 64, n0 = nb * 256 + lane * 4;
        f32x4 acc[8];
#pragma unroll
        for (int b = 0; b < 8; ++b) acc[b] = (f32x4){0.f, 0.f, 0.f, 0.f};
#pragma unroll 16
        for (int k = 0; k < 64; ++k) { const f32x4 w = *(const f32x4*)(a.w_ada + (size_t)(k0 + k) * 6144 + n0);
#pragma unroll
            for (int b = 0; b < 8; ++b) acc[b] += w * sil[b * 1024 + k0 + k]; }
        float* mp = WSP(float, WS_MODP) + (size_t)kb * 8 * 6144 + n0;
#pragma unroll
        for (int b = 0; b < 8; ++b) *(f32x4*)(mp + b * 6144) = acc[b];
    }
    {
        bf16_t* WIN = WSP(bf16_t, WS_WIN); bf16_t* WUQ = WSP(bf16_t, WS_WUQ); bf16_t* WK = WSP(bf16_t, WS_WK); bf16_t* WV = WSP(bf16_t, WS_WV); bf16_t* WOUT = WSP(bf16_t, WS_WOUT);
        constexpr int I_IN = 16 * 69, I_UQ = 6 * 24, I_KV = 4 * 32, I_OUT = 16 * 32, NIT = I_IN + I_UQ + I_KV + I_OUT;
        for (int it = NGW - 1 - gw; it < NIT; it += NGW) {
            int r = it;
            if (r < I_IN) { const int kb = r / 69, g = r % 69, n0 = g * 32; transpose_item_f8(a.w_in, IN_W, 1024, kb * 64, n0, (unsigned char*)WIN, n0 + (n0 >= 672 ? 96 : 0), WIN_SCALE, scr, lane); continue; } r -= I_IN;
            if (r < I_UQ) { const int kb = r / 24, g = r % 24; transpose_item(a.w_uq, 768, 384, kb * 64, g * 32, WUQ, g * 32, a.q_norm_g, scr, lane); continue; } r -= I_UQ;
            if (r < I_KV) { const int kb = r / 32, g = r % 32, hh = g >> 2, part = g & 3;
                transpose_item(a.w_ukv, 1024, 256, kb * 64, g * 32, part < 2 ? WK : WV, hh * 64 + (part & 1) * 32, a.kv_norm_g, scr, lane); continue; } r -= I_KV;
            { const int kb = r / 32, g = r % 32; transpose_item_f8(a.w_out, 1024, 1024, kb * 64, g * 32, (unsigned char*)WOUT, g * 32, WOUT_SCALE, scr, lane); }
        }
        for (int i = (F.G - 1 - F.vcu) * NTHR + F.tid; i < 96 * 1024 / 16; i += F.G * NTHR) *(u32x4*)((unsigned char*)WIN + (size_t)672 * 1024 + (size_t)i * 16) = (u32x4){0u, 0u, 0u, 0u};
    }
    for (int i = (F.G - 1 - F.vcu) * NTHR + F.tid; i < SEQ * 16; i += F.G * NTHR) { const int pos = i >> 4, j = i & 15;
        const float ang = (float)pos * (float)exp2(-(double)j * (13.287712379549449 / 16.0)); float* rp = WSP(float, WS_ROPE) + pos * 32;
        float sn, cs; sincosf(ang, &sn, &cs);
        rp[j] = cs; rp[16 + j] = sn; }
    for (int i = (F.G - 1 - F.vcu) * NTHR + F.tid; i < 3 * 8 * 320; i += F.G * NTHR) { const int p = i / 2560, hh = (i / 320) & 7, idx = i % 320, delta = idx - 127, dil = 1 << (2 * p);
        float v = NEG_BIG; if (delta >= -64 && delta <= 64) v = a.rel_bias[t5_bucket_dev(delta * dil) * 8 + hh] * LOG2E;
        WSP(float, WS_TABG)[i] = v; }
}
__device__ __forceinline__ void p1_mod_h1(Frame& F) { const KArgs ka = kargs(); const float* const a_x = ka->x; const float* const a_b_ada = ka->b_ada;
    LAS float* shs = (LAS float*)F.lds;
    const float* modp = WSP(const float, WS_MODP); float* mod = WSP(float, WS_MOD);
    for (int i = F.vcu * NTHR + F.tid; i < 8 * 6144; i += F.G * NTHR) { float s = a_b_ada[i % 6144];
#pragma unroll
        for (int kb = 0; kb < 16; ++kb) s += modp[(size_t)kb * 8 * 6144 + i];
        mod[i] = s; }
    bf16_t* H1 = WSP(bf16_t, WS_H);
    const int rpb = M_TOK / F.G;
    const int row0 = F.vcu * rpb, b = row0 >> 12;
    for (int i = F.tid; i < 2048; i += NTHR) { float sv = a_b_ada[i];
#pragma unroll
        for (int kb = 0; kb < 16; ++kb) sv += modp[(size_t)kb * 8 * 6144 + b * 6144 + i];
        shs[i] = sv; }
    __syncthreads();
    f32x4 sh[4], sc[4];
#pragma unroll
    for (int j = 0; j < 4; ++j) { sh[j] = *(const LAS f32x4*)(shs + 4 * F.lane + 256 * j); sc[j] = *(const LAS f32x4*)(shs + 1024 + 4 * F.lane + 256 * j) + 1.f; }
    for (int rr = 2 * F.wave; rr < rpb; rr += 2 * NWAVES) {
        const int row = row0 + rr;
        const f32x4* xr = (const f32x4*)(a_x + (size_t)row * 1024) + F.lane;
        unsigned* o8 = (unsigned*)((unsigned char*)H1 + (size_t)row * 1024) + F.lane;
        f32x4 v[8];
#pragma unroll
        for (int j = 0; j < 8; ++j) v[j] = __builtin_nontemporal_load(xr + 64 * j);
#pragma unroll
        for (int j = 0; j < 8; ++j) { const f32x4 hv = v[j] * sc[j & 3] + sh[j & 3];
            o8[64 * j] = pk4_fp8(hv[0], hv[1], hv[2], hv[3]); }
    }
}
__device__ __forceinline__ void p6_ln1_router(Frame& F) { const KArgs ka = kargs(); const float* const a_w_router = ka->w_router; const float* const a_ln1_g = ka->ln1_g; const float* const a_ln1_b = ka->ln1_b; const bf16_t* const a_m = WSP(const bf16_t, WS_M); const float* const a_x = ka->x;
    LAS f32x4* wr4 = (LAS f32x4*)F.lds;
    for (int idx = F.tid; idx < 1024 * 4; idx += NTHR) { const int k = idx >> 2, e4 = idx & 3, l = (k & 255) >> 2, i = k & 3, j = k >> 8;
        wr4[((j * 4 + i) * 4 + e4) * 64 + l] = *(const f32x4*)(a_w_router + k * 16 + e4 * 4); }
    LAS f32x4* gl4 = (LAS f32x4*)(F.lds + 64 * 1024); LAS f32x4* ml4 = gl4 + 512;
    const float* mod = WSP(const float, WS_MOD);
    gl4[F.tid] = F.tid < 256 ? *(const f32x4*)(a_ln1_g + 4 * F.tid) : *(const f32x4*)(a_ln1_b + 4 * (F.tid - 256));
#pragma unroll
    for (int bq = 0; bq < 8; ++bq) { const f32x4 t = *(const f32x4*)(mod + bq * 6144 + 3072 + 4 * F.tid); ml4[bq * 512 + F.tid] = F.tid < 256 ? t : t + 1.f; }
    __syncthreads();
    bf16_t* H2 = WSP(bf16_t, WS_H); float* AFF = WSP(float, WS_AFF); float* STAT = WSP(float, WS_STAT);
    const int gw = F.vcu * NWAVES + F.wave, NGW = F.G * NWAVES, lane = F.lane;
    f32x4 vn[2][4]; u32x2 mn[2][4];
#define P6_LOAD(r0_) do { _Pragma("unroll") for (int q = 0; q < 2; ++q) { const int rq_ = (r0_) + q * NGW < M_TOK ? (r0_) + q * NGW : (r0_); const unsigned ro_ = (unsigned)rq_ * 4096u; \
        _Pragma("unroll") for (int j = 0; j < 4; ++j) { vn[q][j] = *(const f32x4*)((const char*)a_x + (ro_ + (unsigned)(lane * 16 + j * 1024))); mn[q][j] = *(const u32x2*)((const char*)a_m + ((ro_ >> 1) + (unsigned)(lane * 8 + j * 512))); } } } while (0)
    P6_LOAD(gw);
    unsigned sh2[2][4]; f32x2 sst[2]; float saff[2]; int srow[2]; bool have = false;
    const int e_l = ((lane >> 5) & 1) * 8 + ((lane >> 3) & 1) * 4 + ((lane >> 1) & 1) * 2 + (lane & 1);
#define P6_STORES() do { _Pragma("unroll") for (int q = 0; q < 2; ++q) { _Pragma("unroll") for (int j = 0; j < 4; ++j) *(unsigned*)((unsigned char*)H2 + ((unsigned)srow[q] * 1024u + (unsigned)(lane * 4 + j * 256))) = sh2[q][j]; \
            AFF[((size_t)(srow[q] >> 12) * 16 + e_l) * SEQ + (srow[q] & (SEQ - 1))] = saff[q]; } \
        *(f32x2*)(STAT + (size_t)((lane & 1) ? srow[1] : srow[0]) * 2) = (lane & 1) ? sst[1] : sst[0]; } while (0)
    for (int row0 = gw; row0 < M_TOK; row0 += 2 * NGW) {
        f32x4 v[2][4]; float mean[2], rstd[2];
#pragma unroll
        for (int q = 0; q < 2; ++q) { float sm = 0.f;
#pragma unroll
            for (int j = 0; j < 4; ++j) { v[q][j] = vn[q][j] * ALPHA + (f32x4){bf_lo(mn[q][j].x), bf_hi(mn[q][j].x), bf_lo(mn[q][j].y), bf_hi(mn[q][j].y)}; sm += (v[q][j][0] + v[q][j][1]) + (v[q][j][2] + v[q][j][3]); }
            mean[q] = sm; }
        asm volatile("" :: "v"(mean[0]), "v"(mean[1]) : "memory");
        if (have) P6_STORES();
        have = true;
        { const int rn = row0 + 2 * NGW < M_TOK ? row0 + 2 * NGW : row0; P6_LOAD(rn); }
#pragma unroll
        for (int q = 0; q < 2; ++q) { mean[q] = wave_sum(mean[q]) * (1.f / 1024.f); float s2 = 0.f;
#pragma unroll
            for (int j = 0; j < 4; ++j) { v[q][j] = v[q][j] - mean[q]; s2 += (v[q][j][0] * v[q][j][0] + v[q][j][1] * v[q][j][1]) + (v[q][j][2] * v[q][j][2] + v[q][j][3] * v[q][j][3]); }
            rstd[q] = 1.f / sqrtf(wave_sum(s2) * (1.f / 1024.f) + NORM_EPS); }
        const int rowq[2] = {row0, row0 + NGW < M_TOK ? row0 + NGW : row0};
        sst[0] = (f32x2){mean[0], rstd[0]}; sst[1] = (f32x2){mean[1], rstd[1]}; srow[0] = rowq[0]; srow[1] = rowq[1];
        f32x2 lg2[2][8];
#pragma unroll
        for (int q = 0; q < 2; ++q)
#pragma unroll
            for (int e = 0; e < 8; ++e) lg2[q][e] = (f32x2){0.f, 0.f};
#pragma unroll
        for (int j = 0; j < 4; ++j) { const int col = 4 * lane + 256 * j;
            const f32x4 g = gl4[lane + 64 * j], bb = gl4[256 + lane + 64 * j];
#pragma unroll
            for (int q = 0; q < 2; ++q) { const int b = rowq[q] >> 12;
                const f32x4 x1 = v[q][j] * rstd[q] * g + bb;
                const f32x4 sh = ml4[b * 512 + lane + 64 * j], sc = ml4[b * 512 + 256 + lane + 64 * j];
                const f32x4 hv = x1 * sc + sh; v[q][j] = hv;
                sh2[q][j] = pk4_fp8(hv[0], hv[1], hv[2], hv[3]); } }
#pragma unroll
        for (int j = 0; j < 4; ++j) {
#pragma unroll
            for (int i = 0; i < 4; ++i) {
#pragma unroll
                for (int e4 = 0; e4 < 4; ++e4) { const f32x4 w = wr4[((j * 4 + i) * 4 + e4) * 64 + lane]; const f32x2 w01 = (f32x2){w[0], w[1]}, w23 = (f32x2){w[2], w[3]};
#pragma unroll
                    for (int q = 0; q < 2; ++q) { const f32x2 hh = (f32x2){v[q][j][i], v[q][j][i]};
                        lg2[q][e4 * 2 + 0] = __builtin_elementwise_fma(hh, w01, lg2[q][e4 * 2 + 0]); lg2[q][e4 * 2 + 1] = __builtin_elementwise_fma(hh, w23, lg2[q][e4 * 2 + 1]); } }
                asm volatile("" : "+v"(lg2[0][0]), "+v"(lg2[0][1]), "+v"(lg2[0][2]), "+v"(lg2[0][3]), "+v"(lg2[0][4]), "+v"(lg2[0][5]), "+v"(lg2[0][6]), "+v"(lg2[0][7]), "+v"(lg2[1][0]), "+v"(lg2[1][1]), "+v"(lg2[1][2]), "+v"(lg2[1][3]), "+v"(lg2[1][4]), "+v"(lg2[1][5]), "+v"(lg2[1][6]), "+v"(lg2[1][7]) :: "memory"); }
        }
#pragma unroll
        for (int q = 0; q < 2; ++q) {
            float lg[16];
#pragma unroll
            for (int e = 0; e < 8; ++e) { lg[2 * e] = lg2[q][e][0]; lg[2 * e + 1] = lg2[q][e][1]; }
#pragma unroll
            for (int i = 0; i < 8; ++i) { float x = lg[i], y = lg[i + 8];
                asm("s_nop 1\n\tv_permlane32_swap_b32 %0, %1" : "+v"(x), "+v"(y)); lg[i] = x + y; }
#pragma unroll
            for (int i = 0; i < 4; ++i) { const bool up = lane & 8; const float keep = up ? lg[i + 4] : lg[i], send = up ? lg[i] : lg[i + 4]; lg[i] = keep + dpp_f<0x128>(send); }
#pragma unroll
            for (int i = 0; i < 2; ++i) { const bool up = lane & 2; const float keep = up ? lg[i + 2] : lg[i], send = up ? lg[i] : lg[i + 2]; lg[i] = keep + dpp_f<0x4E>(send); }
            { const bool up = lane & 1; const float keep = up ? lg[1] : lg[0], send = up ? lg[0] : lg[1]; lg[0] = keep + dpp_f<0xB1>(send); }
            float logit = lg[0]; logit += dpp_f<0x1B>(dpp_f<0x141>(logit)); logit += __shfl_xor(logit, 16);
            const float mx = wave_max(logit);
            const float ex = expf(logit - mx); const float se = wave_sum(ex) * 0.25f;
            saff[q] = ex / se;
        }
    }
    if (have) P6_STORES();
#undef P6_STORES
#undef P6_LOAD
}
__device__ __forceinline__ unsigned block_excl_scan(unsigned v, LAS unsigned* tmp, int tid, int lane, int wave, unsigned& total) {
    unsigned inc = v;
#pragma unroll
    for (int o = 1; o < 64; o <<= 1) { const unsigned t = __shfl_up(inc, o); if (lane >= o) inc += t; }
    __syncthreads();
    if (lane == 63) tmp[wave] = inc;
    __syncthreads();
    unsigned base = 0, tot = 0;
#pragma unroll
    for (int w = 0; w < NWAVES; ++w) { const unsigned t = tmp[w]; if (w < wave) base += t; tot += t; }
    total = tot;
    return base + inc - v;
}
__device__ __forceinline__ void topk_unit(Frame& F, int b, int e) {
    LAS unsigned* hist = (LAS unsigned*)F.lds; LAS unsigned* sh = hist + 256; LAS unsigned* tmp = hist + 272;
    const int tid = F.tid, lane = F.lane, wave = F.wave;
    const float* aff = WSP(const float, WS_AFF) + ((size_t)b * 16 + e) * SEQ;
    unsigned key[8];
    { const u32x4 k0 = *(const u32x4*)(aff + tid * 8), k1 = *(const u32x4*)(aff + tid * 8 + 4); key[0] = k0.x; key[1] = k0.y; key[2] = k0.z; key[3] = k0.w; key[4] = k1.x; key[5] = k1.y; key[6] = k1.z; key[7] = k1.w; }
    unsigned prefix = 0, need = CAP;
#pragma unroll 1
    for (int pass = 0; pass < 4; ++pass) {
        const int shift = 24 - 8 * pass;
        if (tid < 256) hist[tid] = 0u;
        __syncthreads();
#pragma unroll
        for (int i = 0; i < 8; ++i) { const bool in = (pass == 0) || ((key[i] >> (shift + 8)) == prefix); if (in) (void)__hip_atomic_fetch_add(&hist[(key[i] >> shift) & 255u], 1u, __ATOMIC_RELAXED, __HIP_MEMORY_SCOPE_WORKGROUP); }
        __syncthreads();
        if (wave == 0) {
            const unsigned c0 = hist[4 * lane], c1 = hist[4 * lane + 1], c2 = hist[4 * lane + 2], c3 = hist[4 * lane + 3], s = c0 + c1 + c2 + c3;
            unsigned incl = s;
#pragma unroll
            for (int o = 1; o < 64; o <<= 1) { const unsigned t = __shfl_down(incl, o); if (lane + o < 64) incl += t; }
            const unsigned above = incl - s;
            if (above < need && need <= incl) {
                unsigned aa = above; int d;
                if (aa + c3 >= need) d = 3; else { aa += c3; if (aa + c2 >= need) d = 2; else { aa += c2; if (aa + c1 >= need) d = 1; else { aa += c1; d = 0; } } }
                sh[0] = (prefix << 8) | (unsigned)(4 * lane + d); sh[1] = need - aa;
            }
        }
        __syncthreads();
        prefix = sh[0]; need = sh[1];
    }
    const unsigned T = prefix;
    unsigned cg = 0, ce = 0;
#pragma unroll
    for (int i = 0; i < 8; ++i) { cg += key[i] > T; ce += key[i] == T; }
    unsigned tot;
    const unsigned eq_before = block_excl_scan(ce, tmp, tid, lane, wave, tot);
    unsigned sel_mask = 0, nsel = 0, er = eq_before;
#pragma unroll
    for (int i = 0; i < 8; ++i) { bool s = key[i] > T; if (key[i] == T) { s = er < need; ++er; } if (s) { sel_mask |= 1u << i; ++nsel; } }
    unsigned slot = block_excl_scan(nsel, tmp, tid, lane, wave, tot);
    LAS int* lst = (LAS int*)(hist + 512);
    float* vals = WSP(float, WS_VALS) + (e * 8 + b) * CAP; int* inv = WSP(int, WS_INV);
#pragma unroll
    for (int i = 0; i < 8; ++i) { const int tok = tid * 8 + i; int sl = -1;
        if (sel_mask & (1u << i)) { sl = (int)slot; if (slot < (unsigned)CAP) { lst[slot] = tok; vals[slot] = __builtin_bit_cast(float, key[i]); } ++slot; }
        inv[((size_t)b * SEQ + tok) * 16 + e] = sl; }
    __syncthreads();
    { unsigned* VOFF = WSP(unsigned, WS_VOFF);
#pragma unroll
      for (int hh = 0; hh < 2; ++hh) { u32x4 o;
#pragma unroll
          for (int i = 0; i < 2; ++i) { int R, C; pg8::stage_rc(tid * 16 + i * 8192, R, C);
              o[i] = (unsigned)lst[hh * 256 + R] * 1024u + (unsigned)(C * 2); o[2 + i] = (unsigned)lst[hh * 256 + 128 + R] * 1024u + (unsigned)(C * 2); }
          *(u32x4*)(VOFF + ((size_t)((e * 8 + b) * 2 + hh) * 512 + tid) * 4) = o; } }
    __syncthreads();
}
template <int PART>
__device__ __forceinline__ void p7_expert_weights(Frame& F) { const KArgs ka = kargs(); const float* const a_w_gate = ka->w_gate; const float* const a_w_up = ka->w_up; const float* const a_w_down = ka->w_down;
    LAS float* scr = (LAS float*)(F.lds + 4096 + F.wave * 16640);
    bf16_t* WGU = WSP(bf16_t, WS_WGU); bf16_t* WD = WSP(bf16_t, WS_WD);
    constexpr int I_G = 16 * 16 * 24, I_D = 16 * 24 * 16;
    const int bx = (int)blockIdx.x;
    if (PART == 0) {
        const bool split = (F.G == 256); const bool tk = split && bx < BATCH * N_EXP;
        const int v0 = split ? ((tk ? bx : bx - 128) * NWAVES + F.wave) + (tk ? 7168 : 0) : F.wave * F.G + bx;
        const int vstep = split ? 1024 : F.G * NWAVES, vend = split ? (tk ? 2 * I_G : 7168) : 2 * I_G;
        static_assert(1024 * 12 == 2 * I_G, "P7 item split");
        for (int it = v0; it < vend; it += vstep) {
            int r = it; const int up = r >= I_G; if (up) r -= I_G; const int ex = r / 384, q = r % 384, kb = q / 24, g = q % 24, f = g * 64;
            transpose_item64((up ? a_w_up : a_w_gate) + (size_t)ex * 1024 * 1536, 1536, 1024, kb * 64, f, (bf16_t*)((unsigned char*)WGU + (size_t)ex * 3072 * 1024), (f >> 7) * 256 + up * 128 + (f & 127), scr, F.lane, WGU_SCALE, 0.f); }
    } else {
        for (int r = F.wave * F.G + bx; r < I_D; r += F.G * NWAVES) { const int ex = r / 384, q = r % 384, kb = q / 16, g = q % 16;
            transpose_item64(a_w_down + (size_t)ex * 1536 * 1024, 1024, 1536, kb * 64, g * 64, (bf16_t*)((unsigned char*)WD + (size_t)ex * 1024 * 1536), g * 64, scr, F.lane, WD_SCALE, 0.f); }
    }
}
__device__ __forceinline__ void p10_final(Frame& F, float* dst_override = nullptr) { const KArgs ka = kargs(); const float* const a_ln2_g = ka->ln2_g; const float* const a_ln2_b = ka->ln2_b; float* const a_out = ka->out;
    const float* const a_ln1_g = ka->ln1_g; const float* const a_ln1_b = ka->ln1_b; const float* const a_x = ka->x;
    const float* mod = WSP(const float, WS_MOD); const bf16_t* Y = WSP(const bf16_t, WS_Y); const int* inv = WSP(const int, WS_INV); const float* STAT = WSP(const float, WS_STAT); const bf16_t* const a_m = WSP(const bf16_t, WS_M);
    const int gw = F.vcu * NWAVES + F.wave, NGW = F.G * NWAVES, lane = F.lane;
    int slot_n = inv[(size_t)gw * 16 + (lane & 15)];
    f32x4 xn[4]; u32x2 mn[4]; f32x2 stn = *(const f32x2*)(STAT + (size_t)gw * 2);
    { const f32x4* xr0 = (const f32x4*)(a_x + (size_t)gw * 1024) + lane; const u32x2* mr0 = (const u32x2*)(a_m + (size_t)gw * 1024) + lane;
#pragma unroll
      for (int j = 0; j < 4; ++j) { xn[j] = xr0[64 * j]; mn[j] = mr0[64 * j]; } }
    for (int row = gw; row < M_TOK; row += NGW) {
        const int b = row >> 12;
        f32x4* xr = (f32x4*)(a_out + (size_t)row * 1024) + lane;
        const int myslot = slot_n; f32x4 xc[4]; const float mean1 = stn[0], rstd1 = stn[1];
#pragma unroll
        for (int j = 0; j < 4; ++j) xc[j] = xn[j] * ALPHA + (f32x4){bf_lo(mn[j].x), bf_hi(mn[j].x), bf_lo(mn[j].y), bf_hi(mn[j].y)};
        unsigned long long msk = __ballot(myslot >= 0) & 0xFFFFull;
        f32x4 mo[4];
#pragma unroll
        for (int j = 0; j < 4; ++j) mo[j] = (f32x4){0.f, 0.f, 0.f, 0.f};
        { const int rn = row + NGW < M_TOK ? row + NGW : row;
          slot_n = inv[(size_t)rn * 16 + (lane & 15)]; stn = *(const f32x2*)(STAT + (size_t)rn * 2);
          const f32x4* xrn = (const f32x4*)(a_x + (size_t)rn * 1024) + lane; const u32x2* mrn = (const u32x2*)(a_m + (size_t)rn * 1024) + lane;
#pragma unroll
          for (int j = 0; j < 4; ++j) { xn[j] = xrn[64 * j]; mn[j] = mrn[64 * j]; } }
        while (msk) {
            const int e0 = __builtin_ctzll(msk); msk &= msk - 1;
            const bool two = msk != 0; const int e1 = two ? __builtin_ctzll(msk) : e0; if (two) msk &= msk - 1;
            const int s0 = __shfl(myslot, e0), s1 = __shfl(myslot, e1);
            const unsigned* y0 = (const unsigned*)((const unsigned char*)Y + ((size_t)(e0 * 8 + b) * CAP + s0) * 1024) + lane;
            const unsigned* y1 = (const unsigned*)((const unsigned char*)Y + ((size_t)(e1 * 8 + b) * CAP + s1) * 1024) + lane;
            unsigned w0[4], w1[4];
#pragma unroll
            for (int j = 0; j < 4; ++j) { w0[j] = y0[64 * j]; w1[j] = y1[64 * j]; }
            const float f1 = two ? 1.f : 0.f;
#pragma unroll
            for (int j = 0; j < 4; ++j) { const auto a0 = __builtin_amdgcn_cvt_pk_f32_fp8((int)w0[j], false), a1 = __builtin_amdgcn_cvt_pk_f32_fp8((int)w0[j], true);
                const auto c0 = __builtin_amdgcn_cvt_pk_f32_fp8((int)w1[j], false), c1 = __builtin_amdgcn_cvt_pk_f32_fp8((int)w1[j], true);
                mo[j][0] += a0[0] + f1 * c0[0]; mo[j][1] += a0[1] + f1 * c0[1]; mo[j][2] += a1[0] + f1 * c1[0]; mo[j][3] += a1[1] + f1 * c1[1]; }
        }
        f32x4 v[4]; float sm = 0.f;
#pragma unroll
        for (int j = 0; j < 4; ++j) { const int col = 4 * lane + 256 * j; const f32x4 g2 = *(const f32x4*)(mod + b * 6144 + 5120 + col);
            const f32x4 x1 = (xc[j] - mean1) * rstd1 * *(const f32x4*)(a_ln1_g + col) + *(const f32x4*)(a_ln1_b + col);
            v[j] = x1 * ALPHA + g2 * mo[j] * (DBG_MOE_F / Y_SCALE); sm += (v[j][0] + v[j][1]) + (v[j][2] + v[j][3]); }
        const float mean = wave_sum(sm) * (1.f / 1024.f); float s2 = 0.f;
#pragma unroll
        for (int j = 0; j < 4; ++j) { v[j] = v[j] - mean; s2 += (v[j][0] * v[j][0] + v[j][1] * v[j][1]) + (v[j][2] * v[j][2] + v[j][3] * v[j][3]); }
        const float rstd = 1.f / sqrtf(wave_sum(s2) * (1.f / 1024.f) + NORM_EPS);
#pragma unroll
        for (int j = 0; j < 4; ++j) { const int col = 4 * lane + 256 * j; const f32x4 g = *(const f32x4*)(a_ln2_g + col), bb = *(const f32x4*)(a_ln2_b + col);
            (dst_override ? (f32x4*)(dst_override + (size_t)row * 1024) + lane : xr)[64 * j] = v[j] * rstd * g + bb; }
    }
}
constexpr int N_PHASES = 11;
__global__ void __launch_bounds__(NTHR, 2) fwd_kernel(Args args) {
    extern __shared__ __attribute__((aligned(16))) unsigned char lds_raw[];
    Frame F;
    F.lds = (LAS unsigned char*)lds_raw;
    F.tid = threadIdx.x; F.lane = F.tid & 63; F.wave = __builtin_amdgcn_readfirstlane(F.tid >> 6);
    F.G = gridDim.x; { const int bx = blockIdx.x; F.vcu = (F.G % 8 == 0) ? (bx % 8) * (F.G / 8) + bx / 8 : bx; }
    F.ws = kargs()->ws;
    volatile LAS unsigned* MISC = (volatile LAS unsigned*)(F.lds + MISC_OFF);
    for (int u = F.tid; u < (LDS_BYTES - MISC_OFF) / 4; u += NTHR) MISC[u] = 0u;
    __syncthreads();
    const int lo = kargs()->ph_lo, hi = kargs()->ph_hi;
    unsigned* barw = (unsigned*)(F.ws + WS_CTL) + CW_BAR;
    XcdBarrier bar; bar.bar = barw; bar.x = 0; bar.st = nullptr;
    if (hi - lo > 1) bar = xcd_barrier_post(barw, MISC + 8);
#ifndef PHMASK
#define PHMASK 0x7ff
#endif
#define IN(k) ((((PHMASK) >> (k)) & 1) && lo <= (k) && (k) < hi)
#define SEAM(k) do { if (IN(k) && IN((k) + 1)) xcd_barrier(bar); } while (0)

    if (IN(0)) { p0_prologue(F);
#if DBG_REP_P0 > 1
        __syncthreads(); p0_prologue(F);
#endif
    } SEAM(0);
    if (IN(1)) { _Pragma("unroll 1") for (int rep_ = 0; rep_ < DBG_REP_THIN; ++rep_) p1_mod_h1(F); } SEAM(1);
    if (IN(2)) {
        pg8::Gemm g{WSP(const bf16_t, WS_H), WSP(const bf16_t, WS_WIN), M_TOK, IN_WP, 1024, 1 << 30, nullptr};
        pg8::StaticOrder S; S.init(M_TOK, IN_WP, F.G, (int)blockIdx.x);
        static_assert(WS_DV - WS_DK == WS_DK - WS_DQ, "dq/dk/dv contiguous");
        EpiProj E{WSP(bf16_t, WS_CQ), WSP(bf16_t, WS_CKV), WSP(bf16_t, WS_KN)  , WSP(bf16_t, WS_DQ), WSP(float, WS_SSQ), WSP(const float, WS_ROPE)};
        pg8::gemm_phase<EpiProj, false, true>(F.lds, g, S, E);

    } SEAM(2);
    if (IN(3)) {
#ifdef DBG_DIL_MODE
        __syncthreads();
        for (int u = F.vcu; u < BATCH * DIL_H * 4; u += F.G) dil_unit<DBG_DIL_MODE>(F, u >> 5, (u >> 2) & 7, u & 3);
        __syncthreads();
#endif
#ifndef NO_P3G
#ifndef NO_GQ
        { pg8::Gemm g{WSP(const bf16_t, WS_CQ), WSP(const bf16_t, WS_WUQ), M_TOK, 768, Q_LORA, 1 << 30, nullptr};
          pg8::StaticOrder S; S.init(M_TOK, 768, F.G, (int)blockIdx.x);
          EpiQ E{WSP(bf16_t, WS_Q), WSP(const float, WS_SSQ), WSP(const float, WS_ROPE)};
          pg8::gemm_phase<EpiQ, false>(F.lds, g, S, E);
#if DBG_REP_P3G > 1
          pg8::gemm_phase<EpiQ, false>(F.lds, g, S, E);
#endif
 }
#endif
#ifndef NO_GK
        { pg8::Gemm g{WSP(const bf16_t, WS_CKV), WSP(const bf16_t, WS_WK), M_TOK, 512, KV_LORA, 1 << 30, nullptr};
          pg8::StaticOrder S; S.init(M_TOK, 512, F.G, (int)blockIdx.x);
          EpiKN8 E{WSP(unsigned char, WS_KN), WSP(const float, WS_SSQ)};
          pg8::gemm_phase<EpiKN8, false>(F.lds, g, S, E); }
#endif
        { pg8::Gemm g{WSP(const bf16_t, WS_WV), WSP(const bf16_t, WS_CKV), 512, M_TOK, KV_LORA, 1 << 30, nullptr};
          pg8::StaticOrder S; S.init(512, M_TOK, F.G, (int)blockIdx.x);
          EpiVt8 E{WSP(unsigned char, WS_V), WSP(const float, WS_SSQ)};
          pg8::gemm_phase<EpiVt8, false>(F.lds, g, S, E); }
#endif
    } SEAM(3);
    if (IN(4)) {
        const bool dil_first = (F.vcu & 1) == 0;
#ifndef NO_DIL
        if (dil_first) {
            for (int u = F.vcu; u < BATCH * DIL_H * 4; u += F.G) dil_unit<0>(F, u >> 5, (u >> 2) & 7, u & 3);
            __syncthreads();
        }
#endif
#pragma unroll 1
        for (int rep = 0; rep < DBG_REP_MLA; ++rep)
        for (int u = F.vcu; u < BATCH * MLA_H * 8; u += F.G) mla_unit(F, u >> 6, (u >> 3) & 7, u & 7);
#ifndef NO_DIL
        if (!dil_first) {
            __syncthreads();
            for (int u = F.vcu; u < BATCH * DIL_H * 4; u += F.G) dil_unit<0>(F, u >> 5, (u >> 2) & 7, u & 3);
            __syncthreads();
        }
#endif
    } SEAM(4);
    if (IN(5)) {
        pg8::Gemm g{WSP(const bf16_t, WS_MIX), WSP(const bf16_t, WS_WOUT), M_TOK, 1024, 1024, 1 << 30, nullptr};
        pg8::StaticOrder S; S.init(M_TOK, 1024, F.G, (int)blockIdx.x);
        EpiOut E{WSP(bf16_t, WS_M), WSP(const float, WS_MOD)};
        pg8::gemm_phase<EpiOut, false, true>(F.lds, g, S, E);

    } SEAM(5);
    if (IN(6)) { _Pragma("unroll 1") for (int rep_ = 0; rep_ < DBG_REP_THIN; ++rep_) { p6_ln1_router(F); __syncthreads(); } } SEAM(6);
    if (IN(7)) {
        for (int u = blockIdx.x; u < BATCH * N_EXP; u += F.G) topk_unit(F, u >> 4, u & 15);
        p7_expert_weights<0>(F);
    } SEAM(7);
    if (IN(8)) {
        const bool wd_first = (F.vcu & 1) == 0;
        if (wd_first) { p7_expert_weights<1>(F); __syncthreads(); }
        pg8::Gemm g{WSP(const bf16_t, WS_H), WSP(const bf16_t, WS_WGU), MROWS, 3072, 1024, 16, WSP(const int, WS_VOFF)};
        pg8::StaticOrder S; S.init(MROWS, 3072, F.G, (int)blockIdx.x);
        EpiGU E{WSP(bf16_t, WS_HID)};
        pg8::gemm_phase<EpiGU, true, true>(F.lds, g, S, E);
#if DBG_REP_P8 > 1
          pg8::gemm_phase<EpiGU, false, true>(F.lds, g, S, E);
#endif
        if (!wd_first) { __syncthreads(); p7_expert_weights<1>(F); }
    } SEAM(8);
    if (IN(9)) {
        pg8::Gemm g{WSP(const bf16_t, WS_HID), WSP(const bf16_t, WS_WD), MROWS, 1024, D_FF, 16, nullptr};
        pg8::StaticOrder S; S.init(MROWS, 1024, F.G, (int)blockIdx.x);
        EpiDown E{WSP(bf16_t, WS_Y), WSP(const float, WS_VALS)};
        pg8::gemm_phase<EpiDown, false, true>(F.lds, g, S, E);
#if DBG_REP_P9 > 1
          pg8::gemm_phase<EpiDown, false, true>(F.lds, g, S, E);
#endif

    } SEAM(9);
    if (IN(10)) {
#ifdef DBG_REP_P10
        p10_final(F, WSP(float, WS_Z)); __syncthreads();
#endif
        p10_final(F); }
#undef IN
#undef SEAM
}

extern "C" void kernel_launch(void* const* d_in, const int* in_sizes, int n_in, void* d_out, int out_size, void* d_ws, size_t ws_size, hipStream_t stream) {
    static int grid = 0;
    if (grid == 0) {
        if (n_in != 19 || in_sizes[0] != M_TOK * D_MODEL || out_size != M_TOK * D_MODEL || ws_size < WS_END) {
            fprintf(stderr, "kernel_launch: unexpected shapes (n_in %d, in0 %d, out %d, ws %zu); nothing launched\n", n_in, n_in > 0 ? in_sizes[0] : -1, out_size, ws_size); grid = -1; return; }
        int dev = 0, cus = 0, per_cu = 0;
        if (hipGetDevice(&dev) != hipSuccess || hipDeviceGetAttribute(&cus, hipDeviceAttributeMultiprocessorCount, dev) != hipSuccess) { grid = -1; return; }
        if (hipFuncSetAttribute((const void*)fwd_kernel, hipFuncAttributeMaxDynamicSharedMemorySize, LDS_BYTES) != hipSuccess) { fprintf(stderr, "kernel_launch: hipFuncSetAttribute failed\n"); grid = -1; return; }
        if (hipOccupancyMaxActiveBlocksPerMultiprocessor(&per_cu, (const void*)fwd_kernel, NTHR, LDS_BYTES) != hipSuccess || per_cu < 1)
            fprintf(stderr, "kernel_launch: note: occupancy query reports %d workgroups per CU\n", per_cu);
        (void)hipGetLastError();
        grid = cus < 256 ? cus : 256;
    }
    if (grid < 0) return;
    (void)hipMemsetAsync((char*)d_ws + WS_CTL, 0, CTL_ZERO_BYTES, stream);
    Args a{};
    a.x = (const float*)d_in[0]; a.c = (const float*)d_in[1]; a.w_ada = (const float*)d_in[2]; a.b_ada = (const float*)d_in[3]; a.w_in = (const float*)d_in[4];
    a.q_norm_g = (const float*)d_in[5]; a.w_uq = (const float*)d_in[6]; a.kv_norm_g = (const float*)d_in[7]; a.w_ukv = (const float*)d_in[8]; a.rel_bias = (const float*)d_in[9];
    a.w_out = (const float*)d_in[10]; a.ln1_g = (const float*)d_in[11]; a.ln1_b = (const float*)d_in[12]; a.w_router = (const float*)d_in[13]; a.w_gate = (const float*)d_in[14];
    a.w_up = (const float*)d_in[15]; a.w_down = (const float*)d_in[16]; a.ln2_g = (const float*)d_in[17]; a.ln2_b = (const float*)d_in[18];
    a.out = (float*)d_out; a.ws = (unsigned char*)d_ws;
#if MK_ONE_LAUNCH
    a.ph_lo = 0; a.ph_hi = N_PHASES;
    hipLaunchKernelGGL(fwd_kernel, dim3(grid), dim3(NTHR), LDS_BYTES, stream, a);
#else
    for (int p = 0; p < N_PHASES; ++p) { a.ph_lo = p; a.ph_hi = p + 1; hipLaunchKernelGGL(fwd_kernel, dim3(grid), dim3(NTHR), LDS_BYTES, stream, a); }
#endif
}
```

```cpp
#include <hip/hip_runtime.h>
#include <cstdio>
#include <cstdint>

#ifndef MK_ONE_LAUNCH
#define MK_ONE_LAUNCH 1
#endif

#define LAS __attribute__((address_space(3)))
#define GAS __attribute__((address_space(1)))
typedef unsigned short bf16_t;
typedef short bf16x8 __attribute__((ext_vector_type(8)));
typedef short s16x4 __attribute__((ext_vector_type(4)));
typedef float f32x4 __attribute__((ext_vector_type(4)));
typedef float f32x2 __attribute__((ext_vector_type(2)));
typedef float f32x16 __attribute__((ext_vector_type(16)));
typedef unsigned u32x4 __attribute__((ext_vector_type(4)));
typedef unsigned u32x2 __attribute__((ext_vector_type(2)));
typedef int i32x4 __attribute__((ext_vector_type(4)));
typedef int i32x8 __attribute__((ext_vector_type(8)));

constexpr int D_MODEL = 1024, BATCH = 8, SEQ = 4096, M_TOK = BATCH * SEQ;
constexpr int MLA_H = 8, MLA_NOPE = 64, MLA_ROPE = 32, MLA_V = 64, Q_LORA = 384, KV_LORA = 256, MLA_DQ = 96;
constexpr int DIL_H = 8, DIL_D = 64;
constexpr int N_EXP = 16, CAP = 512, D_FF = 1536;
constexpr int IN_W = 2208, IN_WP = 2304;
constexpr float ALPHA = 1.189207115002721f;
constexpr float NORM_EPS = 1e-6f;
constexpr float LOG2E = 1.4426950408889634f;
constexpr float QS_MLA = 0.10206207261596575f * LOG2E;
constexpr float Q8_SCALE = QS_MLA * 2.f * 8.f, K8_SCALE = 0.5f;
constexpr float QS_DIL = 0.125f * LOG2E;
constexpr float NEG_BIG = -1e30f;
#ifndef DBG_MLA_F
#define DBG_MLA_F 1.f
#endif
#ifndef DBG_DIL_F
#define DBG_DIL_F 1.f
#endif
#ifndef DBG_XEXP
#define DBG_XEXP 0
#endif
#ifndef DBG_REP_P0
#define DBG_REP_P0 1
#endif
#ifndef DBG_REP_P7
#define DBG_REP_P7 1
#endif
#ifndef DBG_REP_MLA
#define DBG_REP_MLA 1
#endif
#ifndef DBG_REP_DIL
#define DBG_REP_DIL 1
#endif
#ifndef DBG_REP_P8
#define DBG_REP_P8 1
#endif
#ifndef DBG_REP_P2
#define DBG_REP_P2 1
#endif
#ifndef DBG_REP_P9
#define DBG_REP_P9 1
#endif
#ifndef DBG_REP_P5
#define DBG_REP_P5 1
#endif
#ifndef DBG_REP_THIN
#define DBG_REP_THIN 1
#endif
#ifndef DBG_REP_P3G
#define DBG_REP_P3G 1
#endif
#ifndef DBG_MIX_F
#define DBG_MIX_F 1.f
#endif
#ifndef DBG_MOE_F
#define DBG_MOE_F 1.f
#endif
constexpr float WGU_SCALE = 32.f, WD_SCALE = 64.f, HID_SCALE = 4.f, WIN_SCALE = 32.f, WOUT_SCALE = 32.f, MIX_SCALE = 16.f, Y_SCALE = 64.f;
constexpr int MROWS = N_EXP * BATCH * CAP;

constexpr size_t MiB = 1u << 20;
constexpr size_t WS_CTL = 0, CTL_ZERO_BYTES = 1 * MiB;
constexpr size_t WS_ROPE = 1 * MiB;
constexpr size_t WS_TABG = 1 * MiB + 512 * 1024;
constexpr size_t WS_MODP = 2 * MiB;
constexpr size_t WS_MOD = 5 * MiB;
constexpr size_t WS_AFF = 6 * MiB;
constexpr size_t WS_STAT = 8 * MiB;
constexpr size_t WS_VALS = 8 * MiB + 256 * 1024;
constexpr size_t WS_INV = 9 * MiB;
constexpr size_t WS_SSQ = 11 * MiB;
constexpr size_t WS_WIN = 16 * MiB;
constexpr size_t WS_WUQ = 21 * MiB;
constexpr size_t WS_WK = 22 * MiB;
constexpr size_t WS_WV = 22 * MiB + 512 * 1024;
constexpr size_t WS_WOUT = 23 * MiB;
constexpr size_t WS_LSE = 26 * MiB;
constexpr size_t WS_H = 32 * MiB;
constexpr size_t WS_O1 = 32 * MiB, WS_O2 = 64 * MiB;
constexpr size_t WS_WGU = 96 * MiB;
constexpr size_t WS_WD = 192 * MiB;
constexpr size_t WS_CQ = 96 * MiB;
constexpr size_t WS_CKV = 120 * MiB;
constexpr size_t WS_KR = 136 * MiB;
constexpr size_t WS_DQ = 138 * MiB, WS_DK = 170 * MiB, WS_DV = 202 * MiB;
constexpr size_t WS_Q = 240 * MiB;
constexpr size_t WS_KN = 288 * MiB;
constexpr size_t WS_V = 320 * MiB;
constexpr size_t WS_Z = 240 * MiB;
constexpr size_t WS_MIX = 368 * MiB;
constexpr size_t WS_HID = 240 * MiB;
constexpr size_t WS_VOFF = 336 * MiB;
constexpr size_t WS_XG = 336 * MiB;
constexpr size_t WS_Y = 32 * MiB;
constexpr size_t WS_M = 432 * MiB;
constexpr size_t WS_END = 496 * MiB;
constexpr int CW_BAR = 4096;
constexpr int CW_QUEUE = 64;

constexpr int RING_BYTES = 147456;
constexpr int MISC_OFF = RING_BYTES;
constexpr int LDS_BYTES = RING_BYTES + 512;
constexpr int NWAVES = 8, NTHR = 512;

__device__ __forceinline__ unsigned f2bf(float f) { unsigned u = __builtin_bit_cast(unsigned, f); return (u + 0x7fffu + ((u >> 16) & 1u)) >> 16; }
__device__ __forceinline__ unsigned pk2(float lo, float hi) { return f2bf(lo) | (f2bf(hi) << 16); }
__device__ __forceinline__ unsigned cvt_pk_bf16(float lo, float hi) { unsigned r; asm volatile("v_cvt_pk_bf16_f32 %0, %1, %2" : "=v"(r) : "v"(lo), "v"(hi)); return r; }
__device__ __forceinline__ float bf_lo(unsigned w) { return __builtin_bit_cast(float, w << 16); }
__device__ __forceinline__ float bf_hi(unsigned w) { return __builtin_bit_cast(float, w & 0xffff0000u); }
template <int CTRL> __device__ __forceinline__ float dpp_f(float v) { return __builtin_bit_cast(float, __builtin_amdgcn_update_dpp(0, __builtin_bit_cast(int, v), CTRL, 0xF, 0xF, true)); }
__device__ __forceinline__ float lane_f(float v, int l) { return __builtin_bit_cast(float, __builtin_amdgcn_readlane(__builtin_bit_cast(int, v), l)); }
__device__ __forceinline__ float wave_sum(float v) {
    v += dpp_f<0xB1>(v); v += dpp_f<0x4E>(v); v += dpp_f<0x141>(v); v += dpp_f<0x140>(v);
    return (lane_f(v, 0) + lane_f(v, 16)) + (lane_f(v, 32) + lane_f(v, 48));
}
__device__ __forceinline__ float wave_max(float v) {
    v = fmaxf(v, dpp_f<0xB1>(v)); v = fmaxf(v, dpp_f<0x4E>(v)); v = fmaxf(v, dpp_f<0x141>(v)); v = fmaxf(v, dpp_f<0x140>(v));
    return fmaxf(fmaxf(lane_f(v, 0), lane_f(v, 16)), fmaxf(lane_f(v, 32), lane_f(v, 48)));
}
#ifndef DBG_FP8_EMU
#define DBG_FP8_EMU 0
#endif
#ifndef DBG_HID_S
#define DBG_HID_S 4.f
#endif
__device__ __forceinline__ unsigned pk4_fp8(float a, float b, float c, float d) {
    a = __builtin_amdgcn_fmed3f(a, -448.f, 448.f); b = __builtin_amdgcn_fmed3f(b, -448.f, 448.f); c = __builtin_amdgcn_fmed3f(c, -448.f, 448.f); d = __builtin_amdgcn_fmed3f(d, -448.f, 448.f);
    int p = __builtin_amdgcn_cvt_pk_fp8_f32(a, b, 0, false); p = __builtin_amdgcn_cvt_pk_fp8_f32(c, d, p, true); return (unsigned)p;
}
__device__ __forceinline__ unsigned pk4_fp8_nc(float a, float b, float c, float d) { int p = __builtin_amdgcn_cvt_pk_fp8_f32(a, b, 0, false); p = __builtin_amdgcn_cvt_pk_fp8_f32(c, d, p, true); return (unsigned)p; }
__device__ __forceinline__ float q8(float x, float sc, float isc) {
#if DBG_FP8_EMU
    const int p = __builtin_amdgcn_cvt_pk_fp8_f32(x * sc, 0.f, 0, false); return __builtin_amdgcn_cvt_f32_fp8(p, 0) * isc;
#else
    return x;
#endif
}
#define LDS_WAIT() asm volatile("s_waitcnt lgkmcnt(0)" ::: "memory")
#define VM_WAIT() asm volatile("s_waitcnt vmcnt(0)" ::: "memory")

namespace pg8 {
constexpr int BM = 256, BK = 64, HALF = 128, HTB = HALF * BK * 2, STAGE_BYTES = 8 * HTB, NXCD = 8, WGM = 8;
__host__ __device__ __forceinline__ int lds_byte(int r, int c) { const int st = (r >> 4) * 2 + (c >> 5), rr = r & 15, cc = c & 31, ob = rr * 64 + cc * 2; return st * 1024 + (ob ^ (((ob >> 9) & 1) << 5)); }
__host__ __device__ __forceinline__ void stage_rc(int b, int& R, int& C) { const int st = b / 1024, sb = b % 1024, swz = sb ^ (((sb >> 9) & 1) << 5); R = (st >> 1) * 16 + swz / 64; C = (st & 1) * 32 + (swz % 64) / 2; }
__host__ __device__ __forceinline__ int perm32(int rho) { const int n = rho >> 4, i = rho & 15; return 8 * (i >> 2) + 4 * n + (i & 3); }

struct Unit { int pm, pn; };
struct Gemm { const bf16_t* A; const bf16_t* Bt; int M, N, K; int grp; const int* rowsrc; };

struct StaticOrder {
    int nM, nN, nwg, G, c;
    __device__ void init(int M, int N, int G_, int c_) { nM = M / BM; nN = N / BM; nwg = nM * nN; G = G_; c = c_; }
    __device__ bool next(int i, Unit& u) const {
        const long L = (long)i * G + c; if (L >= nwg) return false;
        int wgid = (int)L; { const int q = nwg / NXCD, r = nwg % NXCD, xcd = wgid % NXCD, off = wgid / NXCD; wgid = (xcd < r ? xcd * (q + 1) : r * (q + 1) + (xcd - r) * q) + off; }
        const int nig = WGM * nN, gid = wgid / nig, fm = gid * WGM, gsz = (nM - fm) < WGM ? (nM - fm) : WGM;
        u.pm = fm + ((wgid % nig) % gsz); u.pn = (wgid % nig) / gsz; return true;
    }
};

using ::i32x4; using ::i32x8;
template <class Epi, bool GATHER, bool FP8 = false>
__device__ __forceinline__ void gemm_phase(LAS unsigned char* lds, const Gemm g, const StaticOrder& S, const Epi& E) {
    const int tid = threadIdx.x, wid = __builtin_amdgcn_readfirstlane(tid >> 6), lane = tid & 63, wr = wid >> 2, wc = wid & 3, fr = lane & 15, fq = lane >> 4;
    const int K = g.K, KB = FP8 ? g.K : g.K * 2, nt = KB / 128, nN = g.N / BM;
    unsigned voffA[2], voffB[2];
#pragma unroll
    for (int i = 0; i < 2; ++i) { int R, C; stage_rc(tid * 16 + i * 8192, R, C); const int Rb = (R & ~31) + perm32(R & 31);
        voffA[i] = (unsigned)(R * KB + C * 2); voffB[i] = (unsigned)(Rb * KB + C * 2); }
    const size_t kstep = (size_t)(BK * 2);
    const size_t hstep = GATHER ? (size_t)0 : (size_t)HALF * KB;
    const size_t hstepB = (size_t)HALF * KB, tstep = 2 * hstepB;
    const unsigned ldsw = (unsigned)wid * 1024u;
    const int aoff = lds_byte(wr * 64 + fr, fq * 8), boff = lds_byte(wc * 32 + fr, fq * 8);
#define PG8_SA(b, h) (((b) * 2 + (h)) * HTB)
#define PG8_SB(b, h) ((4 + (b) * 2 + (h)) * HTB)
    const unsigned lds_base_u = (unsigned)__builtin_amdgcn_readfirstlane((int)(unsigned)(uintptr_t)lds + (int)ldsw);
#define PG8_STAGE(bufoff, gbase, voff) do { _Pragma("unroll") for (int _i = 0; _i < 2; ++_i) { \
        if constexpr (FP8) { unsigned keep_; asm volatile("s_mov_b32 %0, m0\n\ts_mov_b32 m0, %3\n\ts_nop 0\n\tglobal_load_lds_dwordx4 %1, %2\n\ts_mov_b32 m0, %0" \
              : "=&s"(keep_) : "v"((voff)[_i]), "s"((const char*)(gbase)), "s"(lds_base_u + (unsigned)((bufoff) + _i * 8192)) : "memory"); } \
        else __builtin_amdgcn_global_load_lds((const unsigned*)((const char*)(gbase) + (voff)[_i]), (LAS unsigned*)(lds + (bufoff) + ldsw + _i * 8192), 16, 0, 0); } } while (0)
#define PG8_LDA(dst, b, h) do { _Pragma("unroll") for (int m = 0; m < 4; ++m) _Pragma("unroll") for (int k = 0; k < 2; ++k) dst[m][k] = *(const LAS bf16x8*)(lds + PG8_SA(b, h) + aoff + m * 2048 + k * 1024); } while (0)
#define PG8_LDB(dst, b, h) do { _Pragma("unroll") for (int n = 0; n < 2; ++n) _Pragma("unroll") for (int k = 0; k < 2; ++k) dst[n][k] = *(const LAS bf16x8*)(lds + PG8_SB(b, h) + boff + n * 2048 + k * 1024); } while (0)
#define PG8_MMA(ai, bj, At, Bt) do { __builtin_amdgcn_s_setprio(1); _Pragma("unroll") for (int m = 0; m < 4; ++m) _Pragma("unroll") for (int n = 0; n < 2; ++n) { \
        if constexpr (FP8) { const i32x8 b8_ = __builtin_shufflevector(__builtin_bit_cast(i32x4, Bt[n][0]), __builtin_bit_cast(i32x4, Bt[n][1]), 0, 1, 2, 3, 4, 5, 6, 7); \
            const i32x8 a8_ = __builtin_shufflevector(__builtin_bit_cast(i32x4, At[m][0]), __builtin_bit_cast(i32x4, At[m][1]), 0, 1, 2, 3, 4, 5, 6, 7); \
            asm volatile("v_mfma_f32_16x16x128_f8f6f4 %0, %1, %2, %0" : "+v"(acc[ai][bj][m][n]) : "v"(b8_), "v"(a8_)); } \
        else { _Pragma("unroll") for (int k = 0; k < 2; ++k) acc[ai][bj][m][n] = __builtin_amdgcn_mfma_f32_16x16x32_bf16(Bt[n][k], At[m][k], acc[ai][bj][m][n], 0, 0, 0); } } \
        __builtin_amdgcn_s_setprio(0); } while (0)
#define PG8_WAIT_V(n) asm volatile("s_waitcnt vmcnt(" #n ")" ::: "memory")
#define PG8_WAIT_L(n) asm volatile("s_waitcnt lgkmcnt(" #n ")" ::: "memory")
#define PG8_BAR __builtin_amdgcn_s_barrier()
#define PG8_SCHED __builtin_amdgcn_sched_barrier(0)
#define PG8_ASRC(U) (GATHER ? (const char*)g.A + (size_t)(((U).pm >> 1) & 7) * ((size_t)SEQ * KB) : (const char*)g.A + (size_t)(U).pm * tstep)
#define PG8_GV(U) (*(const u32x4*)((const unsigned*)g.rowsrc + ((size_t)(U).pm * 512 + tid) * 4))
#define PG8_BSRC(U) ((const char*)g.Bt + (size_t)(((U).pm / g.grp) * nN + (U).pn) * tstep)
    Unit cur, nxt; int ui = 0;
    if (!S.next(0, cur)) return;
    u32x4 gvc = (u32x4){0u, 0u, 0u, 0u}, gvn = gvc, gvnn = gvc;
    if constexpr (GATHER) { gvc = PG8_GV(cur); Unit t1; gvn = S.next(1, t1) ? PG8_GV(t1) : gvc; }
#define PG8_STAGE_A(bufoff, base, H, NEXT) do { if constexpr (GATHER) { const bool nx_ = (NEXT); unsigned va_[2] = {nx_ ? gvn[2 * (H)] : gvc[2 * (H)], nx_ ? gvn[2 * (H) + 1] : gvc[2 * (H) + 1]}; PG8_STAGE(bufoff, base, va_); } \
        else PG8_STAGE(bufoff, (base) + (H) * hstep, voffA); } while (0)
    f32x4 acc[2][2][4][2];
#pragma unroll
    for (int a = 0; a < 2; ++a)
#pragma unroll
        for (int b = 0; b < 2; ++b)
#pragma unroll
            for (int m = 0; m < 4; ++m)
#pragma unroll
                for (int n = 0; n < 2; ++n) acc[a][b][m][n] = (f32x4){0.f, 0.f, 0.f, 0.f};
    bf16x8 At[4][2], B0[2][2], B1[2][2];
    const char* cA = PG8_ASRC(cur);
    const char* cB = PG8_BSRC(cur);
    PG8_STAGE(PG8_SB(0, 0), cB, voffB); PG8_STAGE(PG8_SB(0, 1), cB + hstepB, voffB); PG8_STAGE_A(PG8_SA(0, 0), cA, 0, false); PG8_STAGE_A(PG8_SA(0, 1), cA, 1, false);
    if (wr == 1) PG8_BAR;
    PG8_WAIT_V(2); PG8_BAR;
    PG8_STAGE(PG8_SB(1, 0), cB + kstep, voffB); PG8_STAGE_A(PG8_SA(1, 0), cA + kstep, 0, false); PG8_STAGE(PG8_SB(1, 1), cB + hstepB + kstep, voffB);
    PG8_WAIT_V(6); PG8_BAR;
    for (;;) {
        const bool has_next = S.next(ui + 1, nxt);
        const char* nA = cA; const char* nB = cB;
        if (has_next) { nA = PG8_ASRC(nxt); nB = PG8_BSRC(nxt); }
#pragma unroll 1
        for (int t = 0; t < nt; t += 2) {
            const bool last = (t == nt - 2);
            const char* a1 = cA + (size_t)(t + 1) * kstep;
            const char* a2 = last ? nA : cA + (size_t)(t + 2) * kstep; const char* b2 = last ? nB : cB + (size_t)(t + 2) * kstep;
            const char* a3 = a2 + kstep; const char* b3 = b2 + kstep;
            PG8_LDB(B0, 0, 0); PG8_LDB(B1, 0, 1); PG8_SCHED; PG8_LDA(At, 0, 0); PG8_STAGE_A(PG8_SA(1, 1), a1, 1, false);
            PG8_WAIT_V(8); PG8_WAIT_L(0); PG8_BAR; PG8_MMA(0, 0, At, B0); PG8_MMA(0, 1, At, B1); PG8_BAR; PG8_SCHED;
            PG8_LDA(At, 0, 1); PG8_STAGE(PG8_SB(0, 0), b2, voffB); PG8_STAGE(PG8_SB(0, 1), b2 + hstepB, voffB); PG8_STAGE_A(PG8_SA(0, 0), a2, 0, last);
            PG8_WAIT_V(8); PG8_WAIT_L(0); PG8_BAR; PG8_MMA(1, 0, At, B0); PG8_MMA(1, 1, At, B1); PG8_BAR; PG8_SCHED;
            PG8_LDB(B0, 1, 0); PG8_LDB(B1, 1, 1); PG8_SCHED; PG8_LDA(At, 1, 0); PG8_STAGE_A(PG8_SA(0, 1), a2, 1, last);
            PG8_WAIT_V(8); PG8_WAIT_L(0); PG8_BAR; PG8_MMA(0, 0, At, B0); PG8_MMA(0, 1, At, B1); PG8_BAR; PG8_SCHED;
            PG8_LDA(At, 1, 1); PG8_STAGE(PG8_SB(1, 0), b3, voffB); PG8_STAGE(PG8_SB(1, 1), b3 + hstepB, voffB); PG8_STAGE_A(PG8_SA(1, 0), a3, 0, last);
            PG8_WAIT_V(8); PG8_WAIT_L(0); PG8_BAR; PG8_MMA(1, 0, At, B0); PG8_MMA(1, 1, At, B1); PG8_BAR; PG8_SCHED;
        }
        if (wr == 0) PG8_BAR;
        if constexpr (FP8) asm volatile("s_nop 15\n\ts_nop 15\n\ts_nop 15\n\ts_nop 15" ::: "memory");
        if constexpr (GATHER) { Unit t2; gvnn = S.next(ui + 2, t2) ? PG8_GV(t2) : gvn; }
        E(acc, cur, wr, wc, fr, fq);
        if (!has_next) break;
        if constexpr (GATHER) { gvc = gvn; gvn = gvnn; }
#pragma unroll
        for (int a = 0; a < 2; ++a)
#pragma unroll
            for (int b = 0; b < 2; ++b)
#pragma unroll
                for (int m = 0; m < 4; ++m)
#pragma unroll
                    for (int n = 0; n < 2; ++n) acc[a][b][m][n] = (f32x4){0.f, 0.f, 0.f, 0.f};
        cur = nxt; cA = nA; cB = nB; ++ui;
        if (wr == 1) PG8_BAR;
    }
    PG8_WAIT_V(0);
    PG8_BAR;
#undef PG8_STAGE_A
#undef PG8_GV
#undef PG8_SA
#undef PG8_SB
#undef PG8_STAGE
#undef PG8_LDA
#undef PG8_LDB
#undef PG8_MMA
#undef PG8_WAIT_V
#undef PG8_WAIT_L
#undef PG8_BAR
#undef PG8_SCHED
#undef PG8_ASRC
#undef PG8_BSRC
}
}

#define XB_TMO      128
#define XB_XCNT(j)  (256  + 64 * (j))
#define XB_XSUB(j)  (1280 + 64 * (j))
#define XB_XGEN(j)  (2304 + 64 * (j))
#define XB_TOP      3328
#define XB_TOPGEN   3392
#define XCD_BAR_WORDS 3456
#define XB_SPIN_CAP (1u << 18)
__device__ __forceinline__ unsigned xb_ld(unsigned* p)              { return __hip_atomic_load(p, __ATOMIC_RELAXED, __HIP_MEMORY_SCOPE_AGENT); }
__device__ __forceinline__ unsigned xb_add(unsigned* p, unsigned v) { return __hip_atomic_fetch_add(p, v, __ATOMIC_RELAXED, __HIP_MEMORY_SCOPE_AGENT); }
__device__ __forceinline__ unsigned xb_xcc_id() { return (unsigned)__builtin_amdgcn_s_getreg((3 << 11) | 20) & 0xFu; }
#define XB_SPIN(cond, bar) do { unsigned _sp = 0; while (cond) { __builtin_amdgcn_s_sleep(1); \
    if ((++_sp & 255u) == 0u) { if (xb_ld(&(bar)[XB_TMO])) break; if (_sp > XB_SPIN_CAP) { atomicAdd(&(bar)[XB_TMO], 1u); break; } } } } while (0)
struct XcdBarrier { unsigned* bar; unsigned x; volatile LAS unsigned* st; };
__device__ __forceinline__ XcdBarrier xcd_barrier_post(unsigned* bar, volatile LAS unsigned* st) {
    XcdBarrier b; b.bar = bar; b.x = xb_xcc_id(); b.st = st;
    if (threadIdx.x == 0) (void)xb_add(&bar[XB_XCNT(b.x)], 1u);
    return b;
}
__device__ __forceinline__ void xcd_barrier_complete(unsigned* bar, unsigned x, unsigned& nloc, unsigned& nx) {
    const unsigned G = gridDim.x * gridDim.y * gridDim.z;
    unsigned sum, cnt, mine, sp = 0u;
    for (;;) {
        sum = 0u; cnt = 0u; mine = 0u;
#pragma unroll
        for (unsigned j = 0; j < 16; ++j) { const unsigned c = xb_ld(&bar[XB_XCNT(j)]); sum += c; cnt += (c > 0u) ? 1u : 0u; mine = (j == x) ? c : mine; }
        if (sum == G) break;
        __builtin_amdgcn_s_sleep(1);
        if ((++sp & 255u) == 0u) { if (xb_ld(&bar[XB_TMO])) break; if (sp > XB_SPIN_CAP) { atomicAdd(&bar[XB_TMO], 1u); break; } }
    }
    nloc = mine > 0u ? mine : 1u; nx = cnt > 0u ? cnt : 1u;
}
__device__ __forceinline__ void xcd_barrier(const XcdBarrier& b) {
    asm volatile("s_waitcnt vmcnt(0)" ::: "memory");
    __syncthreads();
    if (threadIdx.x == 0) {
        unsigned* bar = b.bar;
        __builtin_amdgcn_s_waitcnt(0);
        unsigned nloc = b.st[0], nx = b.st[1];
        if (nloc == 0u) { xcd_barrier_complete(bar, b.x, nloc, nx); b.st[0] = nloc; b.st[1] = nx; }
        const unsigned old = xb_add(&bar[XB_XSUB(b.x)], 1u);
        const unsigned gen = old / nloc;
        if (old + 1u == (gen + 1u) * nloc) {
            __builtin_amdgcn_fence(__ATOMIC_RELEASE, "agent");
            asm volatile("s_waitcnt vmcnt(0)" ::: "memory");
            const unsigned og = xb_add(&bar[XB_TOP], 1u);
            const unsigned tg = og / nx;
            if (og + 1u == (tg + 1u) * nx) xb_add(&bar[XB_TOPGEN], 1u);
            else XB_SPIN(xb_ld(&bar[XB_TOPGEN]) == tg, bar);
            __builtin_amdgcn_fence(__ATOMIC_ACQUIRE, "agent");
            xb_add(&bar[XB_XGEN(b.x)], 1u);
            asm volatile("s_waitcnt vmcnt(0)" ::: "memory");
        } else {
            XB_SPIN(xb_ld(&bar[XB_XGEN(b.x)]) == gen, bar);
            __builtin_amdgcn_fence(__ATOMIC_ACQUIRE, "agent");
            asm volatile("s_waitcnt vmcnt(0)" ::: "memory");
        }
    }
    __syncthreads();
}

struct Args {
    const float *x, *c, *w_ada, *b_ada, *w_in, *q_norm_g, *w_uq, *kv_norm_g, *w_ukv, *rel_bias, *w_out, *ln1_g, *ln1_b, *w_router, *w_gate, *w_up, *w_down, *ln2_g, *ln2_b;
    float* out; unsigned char* ws; int ph_lo, ph_hi;
};
struct Frame {
    LAS unsigned char* lds;
    int tid, lane, wave, vcu, G;
    unsigned char* ws;
};
#define WSP(T, off) ((T*)(F.ws + (off)))
typedef const __attribute__((address_space(4))) Args* KArgs;
__device__ __forceinline__ KArgs kargs() { KArgs p = (KArgs)__builtin_amdgcn_kernarg_segment_ptr(); asm volatile("" : "+s"(p)); return p; }

using pg8::Unit;
#define DPERM(s_) ((((s_) & 15) << 8) + ((s_) >> 4))
struct EpiProj {
    bf16_t *CQ, *CKV, *KR, *DQ; float* SSQ; const float* rope;
    __device__ __forceinline__ void operator()(const f32x4 (&acc)[2][2][4][2], const Unit& u, int wr, int wc, int fr, int fq) const {
        const int pn = u.pn;
        if (pn >= 3) {
            const int t = pn - 3; bf16_t* base = DQ + (size_t)(t >> 1) * ((WS_DK - WS_DQ) / 2); const float sc = (t < 2 ? QS_DIL : 1.f) * (1.f / WIN_SCALE);
            const int col0 = (t & 1) * 256 + wc * 32 + 8 * fq;
#pragma unroll
            for (int ai = 0; ai < 2; ++ai)
#pragma unroll
                for (int m = 0; m < 4; ++m) { const size_t row = (size_t)u.pm * 256 + ai * 128 + wr * 64 + m * 16 + fr;
#pragma unroll
                    for (int bj = 0; bj < 2; ++bj) { const f32x4 v0 = acc[ai][bj][m][0] * sc, v1 = acc[ai][bj][m][1] * sc;
                        u32x4 w; w.x = cvt_pk_bf16(v0[0], v0[1]); w.y = cvt_pk_bf16(v0[2], v0[3]); w.z = cvt_pk_bf16(v1[0], v1[1]); w.w = cvt_pk_bf16(v1[2], v1[3]);
                        const int col = col0 + bj * 128;
                        *(u32x4*)(base + ((size_t)((int)(row >> 12) * 8 + (col >> 6)) * SEQ + DPERM((int)row & (SEQ - 1))) * 64 + (col & 63)) = w; } }
        } else {
#pragma unroll
            for (int ai = 0; ai < 2; ++ai)
#pragma unroll
                for (int m = 0; m < 4; ++m) { const size_t row = (size_t)u.pm * 256 + ai * 128 + wr * 64 + m * 16 + fr;
#pragma unroll
                    for (int bj = 0; bj < 2; ++bj) { const f32x4 v0 = acc[ai][bj][m][0] * (1.f / WIN_SCALE), v1 = acc[ai][bj][m][1] * (1.f / WIN_SCALE);
                        const int seg = pn * 2 + bj;
                        if (seg < 5) {
                            float s = (v0[0] * v0[0] + v0[1] * v0[1]) + (v0[2] * v0[2] + v0[3] * v0[3]) + (v1[0] * v1[0] + v1[1] * v1[1]) + (v1[2] * v1[2] + v1[3] * v1[3]);
                            s += __shfl_xor(s, 16); s += __shfl_xor(s, 32);
                            if (fq == 0) SSQ[row * 32 + seg * 4 + wc] = s;
                            u32x4 w; w.x = cvt_pk_bf16(v0[0], v0[1]); w.y = cvt_pk_bf16(v0[2], v0[3]); w.z = cvt_pk_bf16(v1[0], v1[1]); w.w = cvt_pk_bf16(v1[2], v1[3]);
                            if (seg < 3) *(u32x4*)(CQ + row * 384 + seg * 128 + wc * 32 + 8 * fq) = w;
                            else *(u32x4*)(CKV + row * 256 + (seg - 3) * 128 + wc * 32 + 8 * fq) = w;
                        } else if (wc == 0) {
                            const int pos = (int)(row & (SEQ - 1)); const float* rp = rope + pos * 32 + 8 * (fq & 1);
                            const f32x4 c0 = *(const f32x4*)(rp), c1 = *(const f32x4*)(rp + 4), s0 = *(const f32x4*)(rp + 16), s1 = *(const f32x4*)(rp + 20);
                            f32x4 o0, o1;
#pragma unroll
                            for (int j = 0; j < 4; ++j) { const float a = v0[j], b = v1[j]; const float pa = __shfl_xor(a, 32), pb = __shfl_xor(b, 32);
                                o0[j] = fq < 2 ? a * c0[j] - pa * s0[j] : pa * s0[j] + a * c0[j];
                                o1[j] = fq < 2 ? b * c1[j] - pb * s1[j] : pb * s1[j] + b * c1[j]; }
                            u32x2 w; w.x = pk4_fp8(o0[0] * K8_SCALE, o0[1] * K8_SCALE, o0[2] * K8_SCALE, o0[3] * K8_SCALE); w.y = pk4_fp8(o1[0] * K8_SCALE, o1[1] * K8_SCALE, o1[2] * K8_SCALE, o1[3] * K8_SCALE);
                            unsigned char* k8 = (unsigned char*)KR + ((size_t)((row >> 12) * 8) * SEQ + (row & (SEQ - 1))) * 128 + 8 * fq;
#pragma unroll
                            for (int hh = 0; hh < 8; ++hh) { *(u32x2*)(k8 + (size_t)hh * SEQ * 128 + 64) = w; *(u32x2*)(k8 + (size_t)hh * SEQ * 128 + 96) = (u32x2){fq == 0 ? 0x00383838u : 0u, 0u}; }
                        } } }
        }
    }
};
struct EpiQ {
    bf16_t* Q; const float* SSQ; const float* rope;
    __device__ __forceinline__ void operator()(const f32x4 (&acc)[2][2][4][2], const Unit& u, int wr, int wc, int fr, int fq) const {
#pragma unroll
        for (int ai = 0; ai < 2; ++ai)
#pragma unroll
            for (int m = 0; m < 4; ++m) { const size_t row = (size_t)u.pm * 256 + ai * 128 + wr * 64 + m * 16 + fr;
                const f32x4 q0 = *(const f32x4*)(SSQ + row * 32), q1 = *(const f32x4*)(SSQ + row * 32 + 4), q2 = *(const f32x4*)(SSQ + row * 32 + 8);
                const float ss = ((q0[0] + q0[1]) + (q0[2] + q0[3])) + ((q1[0] + q1[1]) + (q1[2] + q1[3])) + ((q2[0] + q2[1]) + (q2[2] + q2[3]));
                const float rs = Q8_SCALE / sqrtf(ss * (1.f / Q_LORA) + NORM_EPS);
                const int pos = (int)(row & (SEQ - 1));
#pragma unroll
                for (int bj = 0; bj < 2; ++bj) { f32x4 v0 = acc[ai][bj][m][0] * rs, v1 = acc[ai][bj][m][1] * rs;
                    const int G32 = u.pn * 8 + bj * 4 + wc;
                    if (G32 % 3 == 2) {
                        const float* rp = rope + pos * 32 + 8 * (fq & 1);
                        const f32x4 c0 = *(const f32x4*)(rp), c1 = *(const f32x4*)(rp + 4), s0 = *(const f32x4*)(rp + 16), s1 = *(const f32x4*)(rp + 20);
                        f32x4 o0, o1;
#pragma unroll
                        for (int j = 0; j < 4; ++j) { const float a = v0[j], b = v1[j]; const float pa = __shfl_xor(a, 32), pb = __shfl_xor(b, 32);
                            o0[j] = fq < 2 ? a * c0[j] - pa * s0[j] : pa * s0[j] + a * c0[j];
                            o1[j] = fq < 2 ? b * c1[j] - pb * s1[j] : pb * s1[j] + b * c1[j]; }
                        v0 = o0; v1 = o1;
                    }
                    u32x2 w; w.x = pk4_fp8(v0[0], v0[1], v0[2], v0[3]); w.y = pk4_fp8(v1[0], v1[1], v1[2], v1[3]);
                    unsigned char* q8 = (unsigned char*)Q + ((size_t)((row >> 12) * 8 + G32 / 3) * SEQ + pos) * 128 + (G32 % 3) * 32 + 8 * fq;
                    *(u32x2*)q8 = w; if (G32 % 3 == 2) *(u32x2*)(q8 + 32) = (u32x2){0u, 0u}; }
                asm volatile("" ::: "memory"); }
    }
};
struct EpiKV {
    bf16_t* O; const float* SSQ;
    __device__ __forceinline__ void operator()(const f32x4 (&acc)[2][2][4][2], const Unit& u, int wr, int wc, int fr, int fq) const {
#pragma unroll
        for (int ai = 0; ai < 2; ++ai)
#pragma unroll
            for (int m = 0; m < 4; ++m) { const size_t row = (size_t)u.pm * 256 + ai * 128 + wr * 64 + m * 16 + fr;
                const f32x4 q0 = *(const f32x4*)(SSQ + row * 32 + 12), q1 = *(const f32x4*)(SSQ + row * 32 + 16);
                const float ss = ((q0[0] + q0[1]) + (q0[2] + q0[3])) + ((q1[0] + q1[1]) + (q1[2] + q1[3]));
                const float rs = 1.f / sqrtf(ss * (1.f / KV_LORA) + NORM_EPS);
#pragma unroll
                for (int bj = 0; bj < 2; ++bj) { const f32x4 v0 = acc[ai][bj][m][0] * rs, v1 = acc[ai][bj][m][1] * rs;
                    u32x4 w; w.x = cvt_pk_bf16(v0[0], v0[1]); w.y = cvt_pk_bf16(v0[2], v0[3]); w.z = cvt_pk_bf16(v1[0], v1[1]); w.w = cvt_pk_bf16(v1[2], v1[3]);
                    *(u32x4*)(O + row * 512 + u.pn * 256 + bj * 128 + wc * 32 + 8 * fq) = w; }
                asm volatile("" ::: "memory"); }
    }
};
struct EpiKN8 {
    unsigned char* K8; const float* SSQ;
    __device__ __forceinline__ void operator()(const f32x4 (&acc)[2][2][4][2], const Unit& u, int wr, int wc, int fr, int fq) const {
#pragma unroll
        for (int ai = 0; ai < 2; ++ai)
#pragma unroll
            for (int m = 0; m < 4; ++m) { const size_t row = (size_t)u.pm * 256 + ai * 128 + wr * 64 + m * 16 + fr;
                const f32x4 q0 = *(const f32x4*)(SSQ + row * 32 + 12), q1 = *(const f32x4*)(SSQ + row * 32 + 16);
                const float ss = ((q0[0] + q0[1]) + (q0[2] + q0[3])) + ((q1[0] + q1[1]) + (q1[2] + q1[3]));
                const float rs = K8_SCALE / sqrtf(ss * (1.f / KV_LORA) + NORM_EPS);
#pragma unroll
                for (int bj = 0; bj < 2; ++bj) { const f32x4 v0 = acc[ai][bj][m][0] * rs, v1 = acc[ai][bj][m][1] * rs;
                    const int col = u.pn * 256 + bj * 128 + wc * 32 + 8 * fq;
                    u32x2 w; w.x = pk4_fp8(v0[0], v0[1], v0[2], v0[3]); w.y = pk4_fp8(v1[0], v1[1], v1[2], v1[3]);
                    *(u32x2*)(K8 + ((size_t)((row >> 12) * 8 + (col >> 6)) * SEQ + (row & (SEQ - 1))) * 128 + (col & 63)) = w; }
                asm volatile("" ::: "memory"); }
    }
};
struct EpiVt8 {
    unsigned char* Vt; const float* SSQ;
    __device__ __forceinline__ void operator()(const f32x4 (&acc)[2][2][4][2], const Unit& u, int wr, int wc, int fr, int fq) const {
        float rs[2][8];
#pragma unroll
        for (int bj = 0; bj < 2; ++bj)
#pragma unroll
            for (int j = 0; j < 8; ++j) { const size_t tok = (size_t)u.pn * 256 + bj * 128 + wc * 32 + 8 * fq + j;
                const f32x4 q0 = *(const f32x4*)(SSQ + tok * 32 + 12), q1 = *(const f32x4*)(SSQ + tok * 32 + 16);
                rs[bj][j] = 1.f / sqrtf((((q0[0] + q0[1]) + (q0[2] + q0[3])) + ((q1[0] + q1[1]) + (q1[2] + q1[3]))) * (1.f / KV_LORA) + NORM_EPS); }
#pragma unroll
        for (int ai = 0; ai < 2; ++ai)
#pragma unroll
            for (int m = 0; m < 4; ++m) { const int ch = u.pm * 256 + ai * 128 + wr * 64 + m * 16 + fr;
#pragma unroll
                for (int bj = 0; bj < 2; ++bj) { const f32x4 v0 = acc[ai][bj][m][0], v1 = acc[ai][bj][m][1];
                    const int tok = u.pn * 256 + bj * 128 + wc * 32 + 8 * fq;
                    u32x2 w; w.x = pk4_fp8(v0[0] * rs[bj][0], v0[1] * rs[bj][1], v0[2] * rs[bj][2], v0[3] * rs[bj][3]); w.y = pk4_fp8(v1[0] * rs[bj][4], v1[1] * rs[bj][5], v1[2] * rs[bj][6], v1[3] * rs[bj][7]);
                    *(u32x2*)(Vt + ((size_t)((tok >> 12) * 512 + ch)) * SEQ + (tok & (SEQ - 1))) = w; } }
    }
};
struct EpiOut {
    bf16_t* out; const float* mod;
    __device__ __forceinline__ void operator()(const f32x4 (&acc)[2][2][4][2], const Unit& u, int wr, int wc, int fr, int fq) const {
#pragma unroll
        for (int ai = 0; ai < 2; ++ai)
#pragma unroll
            for (int m = 0; m < 4; ++m) { const size_t row = (size_t)u.pm * 256 + ai * 128 + wr * 64 + m * 16 + fr; const int b = (int)(row >> 12);
#pragma unroll
                for (int bj = 0; bj < 2; ++bj) { const int col = u.pn * 256 + bj * 128 + wc * 32 + 8 * fq;
                    const float* gp = mod + b * 6144 + 2048 + col;
                    const f32x4 g0 = *(const f32x4*)gp, g1 = *(const f32x4*)(gp + 4);
                    const f32x4 m0 = g0 * acc[ai][bj][m][0] * (DBG_MIX_F / (WOUT_SCALE * MIX_SCALE)), m1 = g1 * acc[ai][bj][m][1] * (DBG_MIX_F / (WOUT_SCALE * MIX_SCALE));
                    u32x4 w; w.x = cvt_pk_bf16(m0[0], m0[1]); w.y = cvt_pk_bf16(m0[2], m0[3]); w.z = cvt_pk_bf16(m1[0], m1[1]); w.w = cvt_pk_bf16(m1[2], m1[3]);
                    *(u32x4*)(out + row * 1024 + col) = w; } }
    }
};
struct EpiGU {
    bf16_t* H;
    __device__ __forceinline__ void operator()(const f32x4 (&acc)[2][2][4][2], const Unit& u, int wr, int wc, int fr, int fq) const {
#pragma unroll
        for (int ai = 0; ai < 2; ++ai)
#pragma unroll
            for (int m = 0; m < 4; ++m) { const unsigned row = (unsigned)(u.pm * 256 + ai * 128 + wr * 64 + m * 16 + fr);
                float o[8];
#pragma unroll
                for (int n = 0; n < 2; ++n)
#pragma unroll
                    for (int j = 0; j < 4; ++j) { const float ag = acc[ai][0][m][n][j], au = acc[ai][1][m][n][j];
                        constexpr float kk = WGU_SCALE * WGU_SCALE / HID_SCALE;
                        const float e = __builtin_amdgcn_exp2f(ag * (-LOG2E / WGU_SCALE));
                        o[n * 4 + j] = (ag * au) * __builtin_amdgcn_rcpf(__builtin_fmaf(e, kk, kk)); }
                u32x2 w; w.x = pk4_fp8(o[0], o[1], o[2], o[3]); w.y = pk4_fp8(o[4], o[5], o[6], o[7]);
                *(u32x2*)((unsigned char*)H + (row * 1536u + (unsigned)(u.pn * 128 + wc * 32 + 8 * fq))) = w; }
    }
};
struct EpiDown {
    bf16_t* Y; const float* vals;
    __device__ __forceinline__ void operator()(const f32x4 (&acc)[2][2][4][2], const Unit& u, int wr, int wc, int fr, int fq) const {
#pragma unroll
        for (int ai = 0; ai < 2; ++ai)
#pragma unroll
            for (int m = 0; m < 4; ++m) { const unsigned row = (unsigned)(u.pm * 256 + ai * 128 + wr * 64 + m * 16 + fr); const float vv = vals[row] * (Y_SCALE / (WD_SCALE * HID_SCALE));
#pragma unroll
                for (int bj = 0; bj < 2; ++bj) { const f32x4 v0 = acc[ai][bj][m][0] * vv, v1 = acc[ai][bj][m][1] * vv;
                    u32x2 w; w.x = pk4_fp8(v0[0], v0[1], v0[2], v0[3]); w.y = pk4_fp8(v1[0], v1[1], v1[2], v1[3]);
                    *(u32x2*)((unsigned char*)Y + (row * 1024u + (unsigned)(u.pn * 256 + bj * 128 + wc * 32 + 8 * fq))) = w; } }
    }
};

__device__ __forceinline__ s16x4 vtr(const LAS char* p) { return __builtin_bit_cast(s16x4, __builtin_amdgcn_ds_read_tr16_b64_v4i16((LAS s16x4*)p)); }
template <int ND0, int KPITCH, bool BIAS>
__device__ __forceinline__ void attn_tile(const LAS char* Kt, const LAS char* Vt, const bf16x8 (&qr)[ND0], float& m_run, float& l_run, f32x16& o0, f32x16& o1,
                                          const LAS float* tab, int lane) {
    const int r32 = lane & 31, hi = lane >> 5;
    f32x16 p0, p1;
#pragma unroll
    for (int r = 0; r < 16; ++r) { p0[r] = 0.f; p1[r] = 0.f; }
    const LAS char* kp = Kt + r32 * KPITCH + hi * 16;
    bf16x8 kf[2 * ND0];
#pragma unroll
    for (int d0 = 0; d0 < ND0; ++d0) { kf[2 * d0] = *(const LAS bf16x8*)(kp + d0 * 32); kf[2 * d0 + 1] = *(const LAS bf16x8*)(kp + 32 * KPITCH + d0 * 32); }
#pragma unroll
    for (int d0 = 0; d0 < ND0; ++d0) {
        p0 = __builtin_amdgcn_mfma_f32_32x32x16_bf16(kf[2 * d0], qr[d0], p0, 0, 0, 0);
        p1 = __builtin_amdgcn_mfma_f32_32x32x16_bf16(kf[2 * d0 + 1], qr[d0], p1, 0, 0, 0);
    }
    const LAS char* vp = Vt + (4 * hi + ((lane & 15) >> 2)) * 64 + ((lane >> 4) & 1) * 32 + (lane & 3) * 8;
    bf16x8 vf[8];
#pragma unroll
    for (int ks = 0; ks < 4; ++ks) {
        const s16x4 l0 = vtr(vp + ks * 1024), h0 = vtr(vp + ks * 1024 + 512), l1 = vtr(vp + 4096 + ks * 1024), h1 = vtr(vp + 4096 + ks * 1024 + 512);
        vf[2 * ks] = (bf16x8){l0[0], l0[1], l0[2], l0[3], h0[0], h0[1], h0[2], h0[3]}; vf[2 * ks + 1] = (bf16x8){l1[0], l1[1], l1[2], l1[3], h1[0], h1[1], h1[2], h1[3]};
    }
    __builtin_amdgcn_sched_barrier(0);
    if constexpr (BIAS) {
#pragma unroll
        for (int r = 0; r < 16; ++r) { const int kvl = (r & 3) + 8 * (r >> 2) + 4 * hi; p0[r] += tab[kvl]; p1[r] += tab[kvl + 32]; }
    }
    float mx = fmaxf(p0[0], p1[0]);
#pragma unroll
    for (int r = 1; r < 16; ++r) mx = fmaxf(mx, fmaxf(p0[r], p1[r]));
    mx = fmaxf(mx, __shfl_xor(mx, 32));
    const float m_new = fmaxf(m_run, mx);
    const float alpha = __builtin_amdgcn_exp2f(m_run - m_new);
    m_run = m_new;
    float rs = 0.f;
#pragma unroll
    for (int r = 0; r < 16; ++r) { p0[r] = __builtin_amdgcn_exp2f(p0[r] - m_new); p1[r] = __builtin_amdgcn_exp2f(p1[r] - m_new); rs += p0[r] + p1[r]; }
    l_run = l_run * alpha + rs;
#pragma unroll
    for (int r = 0; r < 16; ++r) { o0[r] *= alpha; o1[r] *= alpha; }
    bf16x8 pf[4];
#pragma unroll
    for (int ks = 0; ks < 4; ++ks) { u32x4 w;
        if (ks < 2) { w.x = cvt_pk_bf16(p0[8 * ks + 0], p0[8 * ks + 1]); w.y = cvt_pk_bf16(p0[8 * ks + 2], p0[8 * ks + 3]); w.z = cvt_pk_bf16(p0[8 * ks + 4], p0[8 * ks + 5]); w.w = cvt_pk_bf16(p0[8 * ks + 6], p0[8 * ks + 7]); }
        else { const int k2 = ks - 2; w.x = cvt_pk_bf16(p1[8 * k2 + 0], p1[8 * k2 + 1]); w.y = cvt_pk_bf16(p1[8 * k2 + 2], p1[8 * k2 + 3]); w.z = cvt_pk_bf16(p1[8 * k2 + 4], p1[8 * k2 + 5]); w.w = cvt_pk_bf16(p1[8 * k2 + 6], p1[8 * k2 + 7]); }
        pf[ks] = __builtin_bit_cast(bf16x8, w); }
#pragma unroll
    for (int ks = 0; ks < 4; ++ks) {
        o0 = __builtin_amdgcn_mfma_f32_32x32x16_bf16(vf[2 * ks], pf[ks], o0, 0, 0, 0);
        o1 = __builtin_amdgcn_mfma_f32_32x32x16_bf16(vf[2 * ks + 1], pf[ks], o1, 0, 0, 0);
    }
}

constexpr int MLA_KP = 144, MLA_KB = 64 * MLA_KP, MLA_VP = 80, MLA_BUF = MLA_KB + 64 * MLA_VP;
constexpr float MLA_POFS = 0.f;
__device__ __forceinline__ float max3f(float a, float b, float c) { float r; asm("v_max3_f32 %0, %1, %2, %3" : "=v"(r) : "v"(a), "v"(b), "v"(c)); return r; }
__device__ __forceinline__ float xhalf_max(float m) { auto rr = __builtin_amdgcn_permlane32_swap(__float_as_uint(m), __float_as_uint(m), false, false); float a = __uint_as_float(rr[0]), b = __uint_as_float(rr[1]); float r; asm("v_max_f32_e32 %0, %1, %2" : "=v"(r) : "v"(a), "v"(b)); return r; }
__device__ __forceinline__ float fmin126(float a) { float r; asm("v_min_f32_e32 %0, 0x42fc0000, %1" : "=v"(r) : "v"(a)); return r; }
__device__ __forceinline__ float xhalf_sum(float m) { auto rr = __builtin_amdgcn_permlane32_swap(__float_as_uint(m), __float_as_uint(m), false, false); return __uint_as_float(rr[0]) + __uint_as_float(rr[1]); }
__device__ __forceinline__ float rowmax32(const f32x16& p0, const f32x16& p1) {
    float a = max3f(p0[0], p0[1], p1[0]), b = max3f(p0[2], p0[3], p1[1]); a = max3f(a, p1[2], p1[3]);
#pragma unroll
    for (int r = 4; r < 16; r += 4) { a = max3f(a, p0[r], p0[r + 1]); b = max3f(b, p0[r + 2], p0[r + 3]); a = max3f(a, p1[r], p1[r + 1]); b = max3f(b, p1[r + 2], p1[r + 3]); }
    float m; asm("v_max_f32_e32 %0, %1, %2" : "=v"(m) : "v"(a), "v"(b));
    return xhalf_max(m);
}
template <int ND0, int KPITCH>
__device__ __forceinline__ void qk_tile(f32x16& p0, f32x16& p1, const LAS char* Kt, const bf16x8 (&qr)[ND0], const f32x16& cinit, int lane) {
    const LAS char* kp = Kt + (lane & 31) * KPITCH + (lane >> 5) * 16;
#pragma unroll
    for (int d0 = 0; d0 < ND0; ++d0) {
        const bf16x8 a0 = *(const LAS bf16x8*)(kp + d0 * 32), a1 = *(const LAS bf16x8*)(kp + 32 * KPITCH + d0 * 32);
        if (d0 == 0) { p0 = __builtin_amdgcn_mfma_f32_32x32x16_bf16(a0, qr[0], cinit, 0, 0, 0); p1 = __builtin_amdgcn_mfma_f32_32x32x16_bf16(a1, qr[0], cinit, 0, 0, 0); }
        else { p0 = __builtin_amdgcn_mfma_f32_32x32x16_bf16(a0, qr[d0], p0, 0, 0, 0); p1 = __builtin_amdgcn_mfma_f32_32x32x16_bf16(a1, qr[d0], p1, 0, 0, 0); }
    }
}
__device__ __forceinline__ void pv_tile(f32x16& o0, f32x16& o1, const f32x16& p0, const f32x16& p1, const LAS char* Vt, int lane) {
    const int hi = lane >> 5;
    bf16x8 pf[4];
#pragma unroll
    for (int ks = 0; ks < 4; ++ks) { u32x4 w;
        if (ks < 2) { w.x = cvt_pk_bf16(p0[8 * ks + 0], p0[8 * ks + 1]); w.y = cvt_pk_bf16(p0[8 * ks + 2], p0[8 * ks + 3]); w.z = cvt_pk_bf16(p0[8 * ks + 4], p0[8 * ks + 5]); w.w = cvt_pk_bf16(p0[8 * ks + 6], p0[8 * ks + 7]); }
        else { const int k2 = ks - 2; w.x = cvt_pk_bf16(p1[8 * k2 + 0], p1[8 * k2 + 1]); w.y = cvt_pk_bf16(p1[8 * k2 + 2], p1[8 * k2 + 3]); w.z = cvt_pk_bf16(p1[8 * k2 + 4], p1[8 * k2 + 5]); w.w = cvt_pk_bf16(p1[8 * k2 + 6], p1[8 * k2 + 7]); }
        pf[ks] = __builtin_bit_cast(bf16x8, w); }
    const LAS char* vp = Vt + (4 * hi + ((lane & 15) >> 2)) * 64 + ((lane >> 4) & 1) * 32 + (lane & 3) * 8;
#pragma unroll
    for (int ks = 0; ks < 4; ++ks) {
        const s16x4 l0 = vtr(vp + ks * 1024), h0 = vtr(vp + ks * 1024 + 512), l1 = vtr(vp + 4096 + ks * 1024), h1 = vtr(vp + 4096 + ks * 1024 + 512);
        const bf16x8 v0 = (bf16x8){l0[0], l0[1], l0[2], l0[3], h0[0], h0[1], h0[2], h0[3]}, v1 = (bf16x8){l1[0], l1[1], l1[2], l1[3], h1[0], h1[1], h1[2], h1[3]};
        o0 = __builtin_amdgcn_mfma_f32_32x32x16_bf16(v0, pf[ks], o0, 0, 0, 0);
        o1 = __builtin_amdgcn_mfma_f32_32x32x16_bf16(v1, pf[ks], o1, 0, 0, 0);
    }
}
#define SGB(mask, n) __builtin_amdgcn_sched_group_barrier(mask, n, 0)
__device__ __forceinline__ unsigned enc3_fp8(float v) {
    const int w1 = __builtin_amdgcn_cvt_pk_fp8_f32(__builtin_amdgcn_fmed3f(v, -448.f, 448.f), 0.f, 0, false); const float r1 = v - __builtin_amdgcn_cvt_f32_fp8(w1, 0);
    const int w2 = __builtin_amdgcn_cvt_pk_fp8_f32(__builtin_amdgcn_fmed3f(r1, -448.f, 448.f), 0.f, 0, false); const float r2 = r1 - __builtin_amdgcn_cvt_f32_fp8(w2, 0);
    const int w3 = __builtin_amdgcn_cvt_pk_fp8_f32(__builtin_amdgcn_fmed3f(r2, -448.f, 448.f), 0.f, 0, false);
    return ((unsigned)w1 & 0xffu) | (((unsigned)w2 & 0xffu) << 8) | (((unsigned)w3 & 0xffu) << 16);
}
__device__ __forceinline__ void mla_unit(Frame& F, int b, int h, int qb) {
    int tid = F.tid; asm volatile("" : "+v"(tid));
    const int lane = tid & 63, wid = F.wave, r32 = lane & 31, hi = lane >> 5;
    const unsigned char* Q8 = WSP(const unsigned char, WS_Q); const unsigned char* K8 = WSP(const unsigned char, WS_KN); const unsigned char* Vt8 = WSP(const unsigned char, WS_V);
    bf16_t* MIX = WSP(bf16_t, WS_MIX);
    const size_t tok0 = (size_t)b * SEQ;
    const int q0 = qb * 512 + wid * 64 + r32;
    i32x8 qA[2], qB[2];
    { const unsigned char* qp = Q8 + ((size_t)(b * 8 + h) * SEQ + q0) * 128 + 32 * hi;
#pragma unroll
      for (int ks = 0; ks < 2; ++ks) { const i32x4 lo = *(const i32x4*)(qp + 64 * ks), hh = *(const i32x4*)(qp + 64 * ks + 16); qA[ks] = __builtin_shufflevector(lo, hh, 0, 1, 2, 3, 4, 5, 6, 7);
          const i32x4 lo2 = *(const i32x4*)(qp + 32 * 128 + 64 * ks), hh2 = *(const i32x4*)(qp + 32 * 128 + 64 * ks + 16); qB[ks] = __builtin_shufflevector(lo2, hh2, 0, 1, 2, 3, 4, 5, 6, 7); } }
    const int kv_s = tid >> 3, c_s = tid & 7;
    const unsigned char* k_base = K8 + (size_t)(b * 8 + h) * SEQ * 128; const unsigned k_off = (unsigned)(kv_s * 128 + c_s * 16);
    const unsigned char* v_base = Vt8 + (size_t)(b * 8 + h) * 64 * SEQ; const unsigned v_off = (unsigned)(((tid >> 2) & 63) * SEQ + (tid & 3) * 16);
    const int k_dst = (((kv_s & 31) << 1) | (kv_s >> 5)) * MLA_KP + c_s * 16, v_dst = MLA_KB + ((tid >> 2) & 63) * MLA_VP + (tid & 3) * 16;
    LAS char* lds = (LAS char*)F.lds;
    f32x16 oA0, oA1, oB0, oB1;
#pragma unroll
    for (int r = 0; r < 16; ++r) { oA0[r] = 0.f; oA1[r] = 0.f; oB0[r] = 0.f; oB1[r] = 0.f; }
    float lA = 0.f, lB = 0.f;
    const f32x16 zero16 = (f32x16){0.f, 0.f, 0.f, 0.f, 0.f, 0.f, 0.f, 0.f, 0.f, 0.f, 0.f, 0.f, 0.f, 0.f, 0.f, 0.f};
    const int selw = ((((lane & 15) >> 2) & 1) == ((lane >> 4) & 1)) ? 0x38383838 : 0;
    const i32x8 sel8 = (i32x8){selw, selw, selw, selw, selw, selw, selw, selw};
    const f32x4 zero4 = (f32x4){0.f, 0.f, 0.f, 0.f};
#define MLA_SUM8(b) __builtin_amdgcn_mfma_scale_f32_16x16x128_f8f6f4(sel8, b, zero4, 0, 0, 0, 0, 0, 0)
    u32x4 rk0, rv0, rk1, rv1;
#define MLA_LOADG(t, rk, rv) do { const unsigned o_ = (unsigned)((t) < 64 ? (t) : 63) * 64u; rk = *(const u32x4*)(k_base + (k_off + o_ * 128u)); rv = *(const u32x4*)(v_base + (v_off + o_)); } while (0)
#define MLA_STORE_OFF(off, rk, rv) do { LAS char* d_ = lds + (off); *(LAS u32x4*)(d_ + k_dst) = rk; *(LAS u32x4*)(d_ + v_dst) = rv; } while (0)
#define MLA_KFRAG(dst, base, a, ks) do { const LAS char* p_ = (base) + (a) * 32 * MLA_KP + (ks) * 64; \
        const i32x4 lo_ = *(const LAS i32x4*)p_, hi_ = *(const LAS i32x4*)(p_ + 16); dst = __builtin_shufflevector(lo_, hi_, 0, 1, 2, 3, 4, 5, 6, 7); } while (0)
#define MLA_MFMA8(a, b, c) __builtin_amdgcn_mfma_scale_f32_32x32x64_f8f6f4(a, b, c, 0, 0, 0, 0, 0, 0)
    static_assert(6 * MLA_BUF <= RING_BYTES, "MLA ring");
    const int sig = 32 * ((r32 >> 2) & 1) + (r32 & 3) + 4 * (r32 >> 3);
    const LAS char* kp0 = lds + (2 * (sig & 31) + (sig >> 5)) * MLA_KP + hi * 32;
    const LAS char* vp0 = lds + MLA_KB + r32 * MLA_VP + 32 * hi;
    MLA_LOADG(0, rk0, rv0); MLA_LOADG(1, rk1, rv1); MLA_STORE_OFF(0, rk0, rv0); MLA_STORE_OFF(MLA_BUF, rk1, rv1);
    MLA_LOADG(2, rk0, rv0); MLA_LOADG(3, rk1, rv1); MLA_STORE_OFF(2 * MLA_BUF, rk0, rv0); MLA_STORE_OFF(3 * MLA_BUF, rk1, rv1);
    __syncthreads();
    MLA_LOADG(4, rk0, rv0); MLA_LOADG(5, rk1, rv1);
    i32x8 kf[4];
#define MLA_KFRAGS(slot) do { const LAS char* kp_ = kp0 + (slot); MLA_KFRAG(kf[0], kp_, 0, 0); MLA_KFRAG(kf[1], kp_, 0, 1); MLA_KFRAG(kf[2], kp_, 1, 0); MLA_KFRAG(kf[3], kp_, 1, 1); } while (0)
#define MLA_VFRAGS(slot) do { const LAS char* vp_ = vp0 + (slot); \
        _Pragma("unroll") for (int dh = 0; dh < 2; ++dh) { const i32x4 lo_ = *(const LAS i32x4*)(vp_ + dh * 32 * MLA_VP), hi_ = *(const LAS i32x4*)(vp_ + dh * 32 * MLA_VP + 16); vf[dh] = __builtin_shufflevector(lo_, hi_, 0, 1, 2, 3, 4, 5, 6, 7); } } while (0)
#define MLA_SCORE(q) do { s0 = MLA_MFMA8(kf[0], q[0], zero16); s1 = MLA_MFMA8(kf[2], q[0], zero16); s0 = MLA_MFMA8(kf[1], q[1], s0); s1 = MLA_MFMA8(kf[3], q[1], s1); } while (0)
    f32x16 s0, s1; i32x8 vf[2];
    MLA_KFRAGS(0);
    { MLA_SCORE(qA); const unsigned ea = enc3_fp8(56.5f + 8.f * MLA_POFS - rowmax32(s0, s1));
      MLA_SCORE(qB); const unsigned eb = enc3_fp8(56.5f + 8.f * MLA_POFS - rowmax32(s0, s1));
      qA[1][0] = hi ? (int)ea : qA[1][0]; qB[1][0] = hi ? (int)eb : qB[1][0]; }
#define MLA_PBYTES(pf_) do { _Pragma("unroll") for (int g_ = 0; g_ < 4; ++g_) { unsigned b0_ = 0u, b1_ = 0u; \
            _Pragma("unroll") for (int j_ = 0; j_ < 4; ++j_) { b0_ = __builtin_amdgcn_cvt_pk_u8_f32(s0[4 * g_ + j_], j_, b0_); b1_ = __builtin_amdgcn_cvt_pk_u8_f32(s1[4 * g_ + j_], j_, b1_); } \
            pf_[g_] = (int)b0_; pf_[4 + g_] = (int)b1_; } } while (0)
#define SB0() __builtin_amdgcn_sched_barrier(0)
#define MLA_TILE(this_slot, next_slot) do { i32x8 pf_; \
        MLA_PBYTES(pf_); SB0(); lB += t_[0]; MLA_VFRAGS(this_slot); SB0(); MLA_SCORE(qB); SB0(); \
        oA0 = MLA_MFMA8(vf[0], pf_, oA0); oA1 = MLA_MFMA8(vf[1], pf_, oA1); t_ = MLA_SUM8(pf_); SB0(); \
        MLA_PBYTES(pf_); SB0(); lA += t_[0]; MLA_KFRAGS(next_slot); SB0(); \
        oB0 = MLA_MFMA8(vf[0], pf_, oB0); oB1 = MLA_MFMA8(vf[1], pf_, oB1); t_ = MLA_SUM8(pf_); SB0(); MLA_SCORE(qA); SB0(); } while (0)
    MLA_SCORE(qA); f32x4 t_ = zero4;
    if (wid < 4) __builtin_amdgcn_s_setprio(3); else __builtin_amdgcn_s_setprio(1);
    int sl = 0;
#pragma unroll 1
    for (int tp = 0; tp < 32; ++tp) {
        const int s_a = sl * MLA_BUF, s_b = s_a + MLA_BUF, sl2 = sl + 2 >= 6 ? sl - 4 : sl + 2, s_c = sl2 * MLA_BUF, sl4 = sl2 + 2 >= 6 ? sl2 - 4 : sl2 + 2, f_a = sl4 * MLA_BUF, f_b = f_a + MLA_BUF;
        MLA_STORE_OFF(f_a, rk0, rv0); MLA_STORE_OFF(f_b, rk1, rv1);
        MLA_LOADG(2 * tp + 6, rk0, rv0); MLA_LOADG(2 * tp + 7, rk1, rv1);
        __builtin_amdgcn_sched_barrier(0);
        MLA_TILE(s_a, s_b);
        MLA_TILE(s_b, s_c);
        asm volatile("s_waitcnt lgkmcnt(0)" ::: "memory"); __builtin_amdgcn_s_barrier(); asm volatile("" ::: "memory");
        sl = sl2;
    }
    lB += t_[0];
    __builtin_amdgcn_s_setprio(0);
#undef MLA_TILE
#undef SB0
#undef MLA_PBYTES
#undef MLA_SCORE
#undef MLA_KFRAGS
#undef MLA_VFRAGS
#undef MLA_KFRAG
#undef MLA_MFMA8
#undef MLA_STORE_OFF
#undef MLA_LOADG
    int tid2 = F.tid; asm volatile("" : "+v"(tid2));
    const int hi2 = (tid2 >> 5) & 1; const size_t orow0 = tok0 + qb * 512 + wid * 64 + (tid2 & 31);
#pragma unroll
    for (int grp = 0; grp < 2; ++grp) {
        const f32x16& o0 = grp ? oB0 : oA0; const f32x16& o1 = grp ? oB1 : oA1;
        const float inv = DBG_MLA_F / (grp ? lB : lA);
        unsigned char* orow = (unsigned char*)MIX + (orow0 + 32 * grp) * 1024 + h * 64 + 8 * hi2;
        const float invs = inv * MIX_SCALE;
#pragma unroll
        for (int hf = 0; hf < 2; ++hf) { const f32x16& oo = hf ? o1 : o0;
#pragma unroll
            for (int gp = 0; gp < 2; ++gp) { const int e0 = 8 * gp;
                const unsigned a4 = pk4_fp8(oo[e0] * invs, oo[e0 + 1] * invs, oo[e0 + 2] * invs, oo[e0 + 3] * invs), b4 = pk4_fp8(oo[e0 + 4] * invs, oo[e0 + 5] * invs, oo[e0 + 6] * invs, oo[e0 + 7] * invs);
                const unsigned rcv = (unsigned)__shfl_xor((int)(hi2 ? a4 : b4), 32);
                *(u32x2*)(orow + hf * 32 + 16 * gp) = hi2 ? (u32x2){rcv, b4} : (u32x2){a4, rcv}; }
        }
    }
}

constexpr int DIL_KP = 144, DIL_KB = 64 * DIL_KP, DIL_BUF = DIL_KB + 8192, DIL_PAIR = 2 * DIL_BUF, DIL_TAB = 4 * DIL_PAIR;
static_assert(DIL_TAB + 3 * 320 * 4 <= RING_BYTES, "dilated LDS");
template <int MODE>
__device__ __forceinline__ void dil_unit(Frame& F, int b, int h, int sb) {
    const int tid = F.tid, lane = F.lane, wid = F.wave, r32 = lane & 31, hi = lane >> 5;
    const bf16_t* DQ = WSP(const bf16_t, WS_DQ); const bf16_t* DK = WSP(const bf16_t, WS_DK); const bf16_t* DV = WSP(const bf16_t, WS_DV);
    bf16_t* O1 = WSP(bf16_t, WS_O1); bf16_t* O2 = WSP(bf16_t, WS_O2); float* LSE = WSP(float, WS_LSE); bf16_t* MIX = WSP(bf16_t, WS_MIX);
    LAS char* lds = (LAS char*)F.lds;
    LAS float* tab = (LAS float*)(lds + DIL_TAB);
    { const float* tg = WSP(const float, WS_TABG); for (int i = tid; i < 960; i += NTHR) tab[i] = tg[((i / 320) * 8 + h) * 320 + (i % 320)]; }
    const int pair = wid >> 1, pt = (wid & 1) * 64 + lane;
    LAS char* pl = lds + pair * DIL_PAIR;
    const size_t tok0 = (size_t)b * SEQ, hrow0 = (size_t)(b * 8 + h) * SEQ;
    const int qi = (wid & 1) * 32 + r32;
#define DIL_BLK(p_, rho_, dsh_, nb_, r_, n_) const int dsh_ = 2 * (p_), nb_ = 64 >> dsh_; const int i__ = 4 * (rho_) + pair, nbsb__ = 16 >> dsh_, r_ = i__ / nbsb__, n_ = ((sb * 1024) >> dsh_) / 64 + i__ % nbsb__
    u32x4 rk[4], rv[4]; bf16x8 qr[4], qn[4];
#define DIL_LOAD(ts_) do { const int p__ = (ts_) / 12, rho__ = ((ts_) % 12) / 3, jt__ = (ts_) % 3; DIL_BLK(p__, rho__, dsh__, nb__, r__, n__); \
        int kb_ = n__ - 1 + jt__; kb_ = kb_ < 0 ? 0 : (kb_ >= nb__ ? nb__ - 1 : kb_); \
        _Pragma("unroll") for (int c_ = 0; c_ < 4; ++c_) { const int ch_ = pt + 128 * c_, kv_ = ch_ >> 3, cc_ = ch_ & 7; \
            const size_t kpos_ = (size_t)((kb_ * 64 + kv_) << dsh__) + r__; \
            const size_t ko_ = (hrow0 + DPERM((int)kpos_)) * 64 + cc_ * 8; rk[c_] = *(const u32x4*)(DK + ko_); rv[c_] = *(const u32x4*)(DV + ko_); } } while (0)
#define DIL_STORE(buf) do { _Pragma("unroll") for (int c_ = 0; c_ < 4; ++c_) { const int ch_ = pt + 128 * c_, kv_ = ch_ >> 3, cc_ = ch_ & 7; \
            *(LAS u32x4*)(pl + (buf) * DIL_BUF + kv_ * DIL_KP + cc_ * 16) = rk[c_]; \
            *(LAS u32x4*)(pl + (buf) * DIL_BUF + DIL_KB + (cc_ >> 2) * 4096 + kv_ * 64 + (cc_ & 3) * 16) = rv[c_]; } } while (0)
#define DIL_QLOAD(dst, blk_) do { const int p__ = (blk_) / 4, rho__ = (blk_) % 4; DIL_BLK(p__, rho__, dsh__, nb__, r__, n__); (void)nb__; \
        const size_t qpos__ = (size_t)((n__ * 64 + qi) << dsh__) + r__; \
        _Pragma("unroll") for (int d0 = 0; d0 < 4; ++d0) dst[d0] = *(const bf16x8*)(DQ + (hrow0 + DPERM((int)qpos__)) * 64 + d0 * 16 + hi * 8); } while (0)
    DIL_LOAD(0); DIL_QLOAD(qr, 0); DIL_STORE(0);
    asm volatile("" :: "v"(qr[0]), "v"(qr[1]), "v"(qr[2]), "v"(qr[3]));
    __syncthreads();
    float m_run = NEG_BIG, l_run = 0.f; f32x16 o0, o1;
#pragma unroll 1
    for (int ts = 0; ts < 36; ++ts) {
        const int p = ts / 12, rho = (ts % 12) / 3, jt = ts % 3;
        DIL_BLK(p, rho, dsh, nb, r, n);
        if (MODE != 2 && ts + 1 < 36) DIL_LOAD(ts + 1);
        if (jt == 1 && ts + 2 < 36) DIL_QLOAD(qn, ts / 3 + 1);
        if (jt == 0) { m_run = NEG_BIG; l_run = 0.f;
#pragma unroll
            for (int rr = 0; rr < 16; ++rr) { o0[rr] = 0.f; o1[rr] = 0.f; } }
        const int kb = n - 1 + jt;
        if (MODE != 1 && kb >= 0 && kb < nb) {
            const LAS float* tq = tab + p * 320 + (64 * (jt - 1) - qi + 127);
            attn_tile<4, DIL_KP, true>(pl + (ts & 1) * DIL_BUF, pl + (ts & 1) * DIL_BUF + DIL_KB, qr, m_run, l_run, o0, o1, tq, lane);
        }
        if (MODE != 2 && ts + 1 < 36) DIL_STORE((ts + 1) & 1);
        if (jt == 2) asm volatile("" :: "v"(qn[0]), "v"(qn[1]), "v"(qn[2]), "v"(qn[3]));
        if (MODE != 0 && jt == 2) { if (m_run == 12345.f) MIX[0] = (bf16_t)(int)(l_run + o0[3] + o1[5]); }
        if (MODE == 0 && jt == 2) {
            const size_t qpos = (size_t)((n * 64 + qi) << dsh) + r;
            const float lt = l_run + __shfl_xor(l_run, 32); const float inv = 1.f / lt;
            const float lse = m_run + __builtin_amdgcn_logf(lt);
            const size_t grow = tok0 + qpos, prow = hrow0 + DPERM((int)qpos);
            if (p < 2) {
                bf16_t* orow = (p == 0 ? O1 : O2) + prow * 64 + 32 * hi;
#pragma unroll
                for (int k = 0; k < 4; ++k) { const f32x16& oo = k < 2 ? o0 : o1; const int e0 = 8 * (k & 1);
                    u32x4 w; w.x = cvt_pk_bf16(oo[e0] * inv, oo[e0 + 1] * inv); w.y = cvt_pk_bf16(oo[e0 + 2] * inv, oo[e0 + 3] * inv); w.z = cvt_pk_bf16(oo[e0 + 4] * inv, oo[e0 + 5] * inv); w.w = cvt_pk_bf16(oo[e0 + 6] * inv, oo[e0 + 7] * inv);
                    *(u32x4*)(orow + 8 * k) = w; }
                if (hi == 0) LSE[(size_t)p * BATCH * DIL_H * SEQ + prow] = lse;
            } else {
                const float l0 = LSE[prow], l1 = LSE[(size_t)BATCH * DIL_H * SEQ + prow];
                const float mm = fmaxf(fmaxf(l0, l1), lse);
                const float e0 = __builtin_amdgcn_exp2f(l0 - mm), e1 = __builtin_amdgcn_exp2f(l1 - mm), e2 = __builtin_amdgcn_exp2f(lse - mm);
                const float isum = DBG_DIL_F / (e0 + e1 + e2); const float w0 = e0 * isum, w1 = e1 * isum, w2 = e2 * isum * inv;
                const bf16_t* a1 = O1 + prow * 64; const bf16_t* a2 = O2 + prow * 64;
                unsigned char* orow = (unsigned char*)MIX + grow * 1024 + 512 + h * 64;
                u32x4 xa[4], xb[4];
#pragma unroll
                for (int k = 0; k < 4; ++k) { xa[k] = *(const u32x4*)(a1 + 32 * hi + 8 * k); xb[k] = *(const u32x4*)(a2 + 32 * hi + 8 * k); }
                unsigned wm[2][4];
#pragma unroll
                for (int g = 0; g < 4; ++g) {
#pragma unroll
                    for (int hf = 0; hf < 2; ++hf) {
                        const u32x4& A1 = xa[hf * 2 + (g >> 1)]; const u32x4& A2 = xb[hf * 2 + (g >> 1)];
                        u32x2 x1, x2; x1.x = (g & 1) ? A1.z : A1.x; x1.y = (g & 1) ? A1.w : A1.y; x2.x = (g & 1) ? A2.z : A2.x; x2.y = (g & 1) ? A2.w : A2.y;
                        const f32x16& oo = hf ? o1 : o0;
                        const float y0 = w0 * bf_lo(x1.x) + w1 * bf_lo(x2.x) + w2 * oo[4 * g], y1 = w0 * bf_hi(x1.x) + w1 * bf_hi(x2.x) + w2 * oo[4 * g + 1];
                        const float y2 = w0 * bf_lo(x1.y) + w1 * bf_lo(x2.y) + w2 * oo[4 * g + 2], y3 = w0 * bf_hi(x1.y) + w1 * bf_hi(x2.y) + w2 * oo[4 * g + 3];
                        wm[hf][g] = pk4_fp8(y0 * MIX_SCALE, y1 * MIX_SCALE, y2 * MIX_SCALE, y3 * MIX_SCALE);
                    }
                }
#pragma unroll
                for (int hf = 0; hf < 2; ++hf)
#pragma unroll
                    for (int gp = 0; gp < 2; ++gp) {
                        const unsigned rcv = (unsigned)__shfl_xor((int)(hi ? wm[hf][2 * gp] : wm[hf][2 * gp + 1]), 32);
                        *(u32x2*)(orow + hf * 32 + 16 * gp + 8 * hi) = hi ? (u32x2){rcv, wm[hf][2 * gp + 1]} : (u32x2){wm[hf][2 * gp], rcv};
                    }
            }
#pragma unroll
            for (int d0 = 0; d0 < 4; ++d0) qr[d0] = qn[d0];
        }
        if (ts == 25) VM_WAIT();
        __syncthreads();
    }
#undef DIL_LOAD
#undef DIL_STORE
#undef DIL_QLOAD
#undef DIL_BLK
}

__device__ __forceinline__ void transpose_item(const float* W, int ldn, int K, int k0, int n0, bf16_t* WT, int drow, const float* kscale, LAS float* scr, int lane) {
#pragma unroll 8
    for (int i = 0; i < 32; ++i) { const int kk = 2 * i + (lane >> 5); float v = W[(size_t)(k0 + kk) * ldn + n0 + (lane & 31)]; if (kscale) v *= kscale[k0 + kk]; scr[kk * 33 + (lane & 31)] = v; }
    LDS_WAIT(); asm volatile("" ::: "memory");
    const int c = lane & 7;
#pragma unroll
    for (int j = 0; j < 4; ++j) { const int n = (lane >> 3) + 8 * j; const LAS float* s = scr + (8 * c) * 33 + n;
        u32x4 o; o.x = pk2(s[0 * 33], s[1 * 33]); o.y = pk2(s[2 * 33], s[3 * 33]); o.z = pk2(s[4 * 33], s[5 * 33]); o.w = pk2(s[6 * 33], s[7 * 33]);
        *(u32x4*)(WT + (size_t)(drow + n) * K + k0 + 8 * c) = o; }
    LDS_WAIT(); asm volatile("" ::: "memory");
}
__device__ __forceinline__ void transpose_item_f8(const float* W, int ldn, int K, int k0, int n0, unsigned char* WT, int drow, float qs, LAS float* scr, int lane) {
#pragma unroll 8
    for (int i = 0; i < 32; ++i) { const int kk = 2 * i + (lane >> 5); scr[kk * 33 + (lane & 31)] = W[(size_t)(k0 + kk) * ldn + n0 + (lane & 31)] * qs; }
    LDS_WAIT(); asm volatile("" ::: "memory");
    const int c = lane & 7;
#pragma unroll
    for (int j = 0; j < 4; ++j) { const int n = (lane >> 3) + 8 * j; const LAS float* s_ = scr + (8 * c) * 33 + n;
        u32x2 o; o.x = pk4_fp8(s_[0 * 33], s_[1 * 33], s_[2 * 33], s_[3 * 33]); o.y = pk4_fp8(s_[4 * 33], s_[5 * 33], s_[6 * 33], s_[7 * 33]);
        *(u32x2*)(WT + (size_t)(drow + n) * K + k0 + 8 * c) = o; }
    LDS_WAIT(); asm volatile("" ::: "memory");
}
__device__ __forceinline__ void transpose_item64(const float* W, int ldn, int K, int k0, int n0, bf16_t* WT, int drow, LAS float* scr, int lane, float qs, float qis) {
    f32x4 v[16];
    const float* src = W + (size_t)(k0 + (lane >> 4)) * ldn + n0 + 4 * (lane & 15);
#pragma unroll
    for (int j = 0; j < 16; ++j) v[j] = __builtin_nontemporal_load((const f32x4*)(src + (size_t)(4 * j) * ldn));
    LAS float* sw = scr + (lane >> 4) * 65 + 4 * (lane & 15);
#pragma unroll
    for (int j = 0; j < 16; ++j) { sw[(4 * j) * 65 + 0] = v[j][0]; sw[(4 * j) * 65 + 1] = v[j][1]; sw[(4 * j) * 65 + 2] = v[j][2]; sw[(4 * j) * 65 + 3] = v[j][3]; }
    LDS_WAIT(); asm volatile("" ::: "memory");
    const int c = lane & 7;
#pragma unroll
    for (int jj = 0; jj < 8; ++jj) { const int n = (lane >> 3) + 8 * jj; const LAS float* s = scr + (8 * c) * 65 + n;
        u32x2 o; o.x = pk4_fp8(s[0 * 65] * qs, s[1 * 65] * qs, s[2 * 65] * qs, s[3 * 65] * qs); o.y = pk4_fp8(s[4 * 65] * qs, s[5 * 65] * qs, s[6 * 65] * qs, s[7 * 65] * qs);
        *(u32x2*)((unsigned char*)WT + (size_t)(drow + n) * K + k0 + 8 * c) = o; }
    LDS_WAIT(); asm volatile("" ::: "memory");
}
__device__ __forceinline__ int t5_bucket_dev(int rel) {
    const int n = rel < 0 ? -rel : rel; int v;
    if (n < 8) v = n; else v = n < 15 ? 8 : n < 27 ? 9 : n < 50 ? 10 : n < 91 ? 11 : n < 166 ? 12 : n < 305 ? 13 : n < 559 ? 14 : 15;
    return (rel > 0 ? 16 : 0) + v;
}
__device__ __forceinline__ void p0_prologue(Frame& F) { const KArgs ka = kargs();
    struct { const float *c, *w_ada, *w_in, *w_uq, *q_norm_g, *w_ukv, *kv_norm_g, *w_out, *rel_bias; } a;
    a.c = ka->c; a.w_ada = ka->w_ada; a.w_in = ka->w_in; a.w_uq = ka->w_uq; a.q_norm_g = ka->q_norm_g; a.w_ukv = ka->w_ukv; a.kv_norm_g = ka->kv_norm_g; a.w_out = ka->w_out; a.rel_bias = ka->rel_bias;
    LAS float* scr = (LAS float*)(F.lds + 32768 + F.wave * 8704);
    LAS float* sil = (LAS float*)F.lds;
    for (int i = F.tid; i < BATCH * D_MODEL; i += NTHR) { const float v = a.c[i]; sil[i] = v / (1.f + __expf(-v)); }
    __syncthreads();
    const int gw = F.vcu * NWAVES + F.wave, NGW = F.G * NWAVES, lane = F.lane;
    for (int it = gw; it < 16 * 24; it += NGW) {
        const int kb = it / 24, nb = it % 24, k0 = kb * 64, n0 = nb * 256 + lane * 4;
        f32x4 acc[8];
#pragma unroll
        for (int b = 0; b < 8; ++b) acc[b] = (f32x4){0.f, 0.f, 0.f, 0.f};
#pragma unroll 16
        for (int k = 0; k < 64; ++k) { const f32x4 w = *(const f32x4*)(a.w_ada + (size_t)(k0 + k) * 6144 + n0);
#pragma unroll
            for (int b = 0; b < 8; ++b) acc[b] += w * sil[b * 1024 + k0 + k]; }
        float* mp = WSP(float, WS_MODP) + (size_t)kb * 8 * 6144 + n0;
#pragma unroll
        for (int b = 0; b < 8; ++b) *(f32x4*)(mp + b * 6144) = acc[b];
    }
    {
        bf16_t* WIN = WSP(bf16_t, WS_WIN); bf16_t* WUQ = WSP(bf16_t, WS_WUQ); bf16_t* WK = WSP(bf16_t, WS_WK); bf16_t* WV = WSP(bf16_t, WS_WV); bf16_t* WOUT = WSP(bf16_t, WS_WOUT);
        constexpr int I_IN = 16 * 69, I_UQ = 6 * 24, I_KV = 4 * 32, I_OUT = 16 * 32, NIT = I_IN + I_UQ + I_KV + I_OUT;
        for (int it = NGW - 1 - gw; it < NIT; it += NGW) {
            int r = it;
            if (r < I_IN) { const int kb = r / 69, g = r % 69, n0 = g * 32; transpose_item_f8(a.w_in, IN_W, 1024, kb * 64, n0, (unsigned char*)WIN, n0 + (n0 >= 672 ? 96 : 0), WIN_SCALE, scr, lane); continue; } r -= I_IN;
            if (r < I_UQ) { const int kb = r / 24, g = r % 24; transpose_item(a.w_uq, 768, 384, kb * 64, g * 32, WUQ, g * 32, a.q_norm_g, scr, lane); continue; } r -= I_UQ;
            if (r < I_KV) { const int kb = r / 32, g = r % 32, hh = g >> 2, part = g & 3;
                transpose_item(a.w_ukv, 1024, 256, kb * 64, g * 32, part < 2 ? WK : WV, hh * 64 + (part & 1) * 32, a.kv_norm_g, scr, lane); continue; } r -= I_KV;
            { const int kb = r / 32, g = r % 32; transpose_item_f8(a.w_out, 1024, 1024, kb * 64, g * 32, (unsigned char*)WOUT, g * 32, WOUT_SCALE, scr, lane); }
        }
        for (int i = (F.G - 1 - F.vcu) * NTHR + F.tid; i < 96 * 1024 / 16; i += F.G * NTHR) *(u32x4*)((unsigned char*)WIN + (size_t)672 * 1024 + (size_t)i * 16) = (u32x4){0u, 0u, 0u, 0u};
    }
    for (int i = (F.G - 1 - F.vcu) * NTHR + F.tid; i < SEQ * 16; i += F.G * NTHR) { const int pos = i >> 4, j = i & 15;
        const float ang = (float)pos * (float)exp2(-(double)j * (13.287712379549449 / 16.0)); float* rp = WSP(float, WS_ROPE) + pos * 32;
        float sn, cs; sincosf(ang, &sn, &cs);
        rp[j] = cs; rp[16 + j] = sn; }
    for (int i = (F.G - 1 - F.vcu) * NTHR + F.tid; i < 3 * 8 * 320; i += F.G * NTHR) { const int p = i / 2560, hh = (i / 320) & 7, idx = i % 320, delta = idx - 127, dil = 1 << (2 * p);
        float v = NEG_BIG; if (delta >= -64 && delta <= 64) v = a.rel_bias[t5_bucket_dev(delta * dil) * 8 + hh] * LOG2E;
        WSP(float, WS_TABG)[i] = v; }
}
__device__ __forceinline__ void p1_mod_h1(Frame& F) { const KArgs ka = kargs(); const float* const a_x = ka->x; const float* const a_b_ada = ka->b_ada;
    LAS float* shs = (LAS float*)F.lds;
    const float* modp = WSP(const float, WS_MODP); float* mod = WSP(float, WS_MOD);
    for (int i = F.vcu * NTHR + F.tid; i < 8 * 6144; i += F.G * NTHR) { float s = a_b_ada[i % 6144];
#pragma unroll
        for (int kb = 0; kb < 16; ++kb) s += modp[(size_t)kb * 8 * 6144 + i];
        mod[i] = s; }
    bf16_t* H1 = WSP(bf16_t, WS_H);
    const int rpb = M_TOK / F.G;
    const int row0 = F.vcu * rpb, b = row0 >> 12;
    for (int i = F.tid; i < 2048; i += NTHR) { float sv = a_b_ada[i];
#pragma unroll
        for (int kb = 0; kb < 16; ++kb) sv += modp[(size_t)kb * 8 * 6144 + b * 6144 + i];
        shs[i] = sv; }
    __syncthreads();
    f32x4 sh[4], sc[4];
#pragma unroll
    for (int j = 0; j < 4; ++j) { sh[j] = *(const LAS f32x4*)(shs + 4 * F.lane + 256 * j); sc[j] = *(const LAS f32x4*)(shs + 1024 + 4 * F.lane + 256 * j) + 1.f; }
    for (int rr = 2 * F.wave; rr < rpb; rr += 2 * NWAVES) {
        const int row = row0 + rr;
        const f32x4* xr = (const f32x4*)(a_x + (size_t)row * 1024) + F.lane;
        unsigned* o8 = (unsigned*)((unsigned char*)H1 + (size_t)row * 1024) + F.lane;
        f32x4 v[8];
#pragma unroll
        for (int j = 0; j < 8; ++j) v[j] = __builtin_nontemporal_load(xr + 64 * j);
#pragma unroll
        for (int j = 0; j < 8; ++j) { const f32x4 hv = v[j] * sc[j & 3] + sh[j & 3];
            o8[64 * j] = pk4_fp8(hv[0], hv[1], hv[2], hv[3]); }
    }
}
__device__ __forceinline__ void p6_ln1_router(Frame& F) { const KArgs ka = kargs(); const float* const a_w_router = ka->w_router; const float* const a_ln1_g = ka->ln1_g; const float* const a_ln1_b = ka->ln1_b; const bf16_t* const a_m = WSP(const bf16_t, WS_M); const float* const a_x = ka->x;
    LAS f32x4* wr4 = (LAS f32x4*)F.lds;
    for (int idx = F.tid; idx < 1024 * 4; idx += NTHR) { const int k = idx >> 2, e4 = idx & 3, l = (k & 255) >> 2, i = k & 3, j = k >> 8;
        wr4[((j * 4 + i) * 4 + e4) * 64 + l] = *(const f32x4*)(a_w_router + k * 16 + e4 * 4); }
    LAS f32x4* gl4 = (LAS f32x4*)(F.lds + 64 * 1024); LAS f32x4* ml4 = gl4 + 512;
    const float* mod = WSP(const float, WS_MOD);
    gl4[F.tid] = F.tid < 256 ? *(const f32x4*)(a_ln1_g + 4 * F.tid) : *(const f32x4*)(a_ln1_b + 4 * (F.tid - 256));
#pragma unroll
    for (int bq = 0; bq < 8; ++bq) { const f32x4 t = *(const f32x4*)(mod + bq * 6144 + 3072 + 4 * F.tid); ml4[bq * 512 + F.tid] = F.tid < 256 ? t : t + 1.f; }
    __syncthreads();
    bf16_t* H2 = WSP(bf16_t, WS_H); float* AFF = WSP(float, WS_AFF); float* STAT = WSP(float, WS_STAT);
    const int gw = F.vcu * NWAVES + F.wave, NGW = F.G * NWAVES, lane = F.lane;
    f32x4 vn[2][4]; u32x2 mn[2][4];
#define P6_LOAD(r0_) do { _Pragma("unroll") for (int q = 0; q < 2; ++q) { const int rq_ = (r0_) + q * NGW < M_TOK ? (r0_) + q * NGW : (r0_); const unsigned ro_ = (unsigned)rq_ * 4096u; \
        _Pragma("unroll") for (int j = 0; j < 4; ++j) { vn[q][j] = *(const f32x4*)((const char*)a_x + (ro_ + (unsigned)(lane * 16 + j * 1024))); mn[q][j] = *(const u32x2*)((const char*)a_m + ((ro_ >> 1) + (unsigned)(lane * 8 + j * 512))); } } } while (0)
    P6_LOAD(gw);
    unsigned sh2[2][4]; f32x2 sst[2]; float saff[2]; int srow[2]; bool have = false;
    const int e_l = ((lane >> 5) & 1) * 8 + ((lane >> 3) & 1) * 4 + ((lane >> 1) & 1) * 2 + (lane & 1);
#define P6_STORES() do { _Pragma("unroll") for (int q = 0; q < 2; ++q) { _Pragma("unroll") for (int j = 0; j < 4; ++j) *(unsigned*)((unsigned char*)H2 + ((unsigned)srow[q] * 1024u + (unsigned)(lane * 4 + j * 256))) = sh2[q][j]; \
            AFF[((size_t)(srow[q] >> 12) * 16 + e_l) * SEQ + (srow[q] & (SEQ - 1))] = saff[q]; } \
        *(f32x2*)(STAT + (size_t)((lane & 1) ? srow[1] : srow[0]) * 2) = (lane & 1) ? sst[1] : sst[0]; } while (0)
    for (int row0 = gw; row0 < M_TOK; row0 += 2 * NGW) {
        f32x4 v[2][4]; float mean[2], rstd[2];
#pragma unroll
        for (int q = 0; q < 2; ++q) { float sm = 0.f;
#pragma unroll
            for (int j = 0; j < 4; ++j) { v[q][j] = vn[q][j] * ALPHA + (f32x4){bf_lo(mn[q][j].x), bf_hi(mn[q][j].x), bf_lo(mn[q][j].y), bf_hi(mn[q][j].y)}; sm += (v[q][j][0] + v[q][j][1]) + (v[q][j][2] + v[q][j][3]); }
            mean[q] = sm; }
        asm volatile("" :: "v"(mean[0]), "v"(mean[1]) : "memory");
        if (have) P6_STORES();
        have = true;
        { const int rn = row0 + 2 * NGW < M_TOK ? row0 + 2 * NGW : row0; P6_LOAD(rn); }
#pragma unroll
        for (int q = 0; q < 2; ++q) { mean[q] = wave_sum(mean[q]) * (1.f / 1024.f); float s2 = 0.f;
#pragma unroll
            for (int j = 0; j < 4; ++j) { v[q][j] = v[q][j] - mean[q]; s2 += (v[q][j][0] * v[q][j][0] + v[q][j][1] * v[q][j][1]) + (v[q][j][2] * v[q][j][2] + v[q][j][3] * v[q][j][3]); }
            rstd[q] = 1.f / sqrtf(wave_sum(s2) * (1.f / 1024.f) + NORM_EPS); }
        const int rowq[2] = {row0, row0 + NGW < M_TOK ? row0 + NGW : row0};
        sst[0] = (f32x2){mean[0], rstd[0]}; sst[1] = (f32x2){mean[1], rstd[1]}; srow[0] = rowq[0]; srow[1] = rowq[1];
        f32x2 lg2[2][8];
#pragma unroll
        for (int q = 0; q < 2; ++q)
#pragma unroll
            for (int e = 0; e < 8; ++e) lg2[q][e] = (f32x2){0.f, 0.f};
#pragma unroll
        for (int j = 0; j < 4; ++j) { const int col = 4 * lane + 256 * j;
            const f32x4 g = gl4[lane + 64 * j], bb = gl4[256 + lane + 64 * j];
#pragma unroll
            for (int q = 0; q < 2; ++q) { const int b = rowq[q] >> 12;
                const f32x4 x1 = v[q][j] * rstd[q] * g + bb;
                const f32x4 sh = ml4[b * 512 + lane + 64 * j], sc = ml4[b * 512 + 256 + lane + 64 * j];
                const f32x4 hv = x1 * sc + sh; v[q][j] = hv;
                sh2[q][j] = pk4_fp8(hv[0], hv[1], hv[2], hv[3]); } }
#pragma unroll
        for (int j = 0; j < 4; ++j) {
#pragma unroll
            for (int i = 0; i < 4; ++i) {
#pragma unroll
                for (int e4 = 0; e4 < 4; ++e4) { const f32x4 w = wr4[((j * 4 + i) * 4 + e4) * 64 + lane]; const f32x2 w01 = (f32x2){w[0], w[1]}, w23 = (f32x2){w[2], w[3]};
#pragma unroll
                    for (int q = 0; q < 2; ++q) { const f32x2 hh = (f32x2){v[q][j][i], v[q][j][i]};
                        lg2[q][e4 * 2 + 0] = __builtin_elementwise_fma(hh, w01, lg2[q][e4 * 2 + 0]); lg2[q][e4 * 2 + 1] = __builtin_elementwise_fma(hh, w23, lg2[q][e4 * 2 + 1]); } }
                asm volatile("" : "+v"(lg2[0][0]), "+v"(lg2[0][1]), "+v"(lg2[0][2]), "+v"(lg2[0][3]), "+v"(lg2[0][4]), "+v"(lg2[0][5]), "+v"(lg2[0][6]), "+v"(lg2[0][7]), "+v"(lg2[1][0]), "+v"(lg2[1][1]), "+v"(lg2[1][2]), "+v"(lg2[1][3]), "+v"(lg2[1][4]), "+v"(lg2[1][5]), "+v"(lg2[1][6]), "+v"(lg2[1][7]) :: "memory"); }
        }
#pragma unroll
        for (int q = 0; q < 2; ++q) {
            float lg[16];
#pragma unroll
            for (int e = 0; e < 8; ++e) { lg[2 * e] = lg2[q][e][0]; lg[2 * e + 1] = lg2[q][e][1]; }
#pragma unroll
            for (int i = 0; i < 8; ++i) { float x = lg[i], y = lg[i + 8];
                asm("s_nop 1\n\tv_permlane32_swap_b32 %0, %1" : "+v"(x), "+v"(y)); lg[i] = x + y; }
#pragma unroll
            for (int i = 0; i < 4; ++i) { const bool up = lane & 8; const float keep = up ? lg[i + 4] : lg[i], send = up ? lg[i] : lg[i + 4]; lg[i] = keep + dpp_f<0x128>(send); }
#pragma unroll
            for (int i = 0; i < 2; ++i) { const bool up = lane & 2; const float keep = up ? lg[i + 2] : lg[i], send = up ? lg[i] : lg[i + 2]; lg[i] = keep + dpp_f<0x4E>(send); }
            { const bool up = lane & 1; const float keep = up ? lg[1] : lg[0], send = up ? lg[0] : lg[1]; lg[0] = keep + dpp_f<0xB1>(send); }
            float logit = lg[0]; logit += dpp_f<0x1B>(dpp_f<0x141>(logit)); logit += __shfl_xor(logit, 16);
            const float mx = wave_max(logit);
            const float ex = expf(logit - mx); const float se = wave_sum(ex) * 0.25f;
            saff[q] = ex / se;
        }
    }
    if (have) P6_STORES();
#undef P6_STORES
#undef P6_LOAD
}
__device__ __forceinline__ unsigned block_excl_scan(unsigned v, LAS unsigned* tmp, int tid, int lane, int wave, unsigned& total) {
    unsigned inc = v;
#pragma unroll
    for (int o = 1; o < 64; o <<= 1) { const unsigned t = __shfl_up(inc, o); if (lane >= o) inc += t; }
    __syncthreads();
    if (lane == 63) tmp[wave] = inc;
    __syncthreads();
    unsigned base = 0, tot = 0;
#pragma unroll
    for (int w = 0; w < NWAVES; ++w) { const unsigned t = tmp[w]; if (w < wave) base += t; tot += t; }
    total = tot;
    return base + inc - v;
}
__device__ __forceinline__ void topk_unit(Frame& F, int b, int e) {
    LAS unsigned* hist = (LAS unsigned*)F.lds; LAS unsigned* sh = hist + 256; LAS unsigned* tmp = hist + 272;
    const int tid = F.tid, lane = F.lane, wave = F.wave;
    const float* aff = WSP(const float, WS_AFF) + ((size_t)b * 16 + e) * SEQ;
    unsigned key[8];
    { const u32x4 k0 = *(const u32x4*)(aff + tid * 8), k1 = *(const u32x4*)(aff + tid * 8 + 4); key[0] = k0.x; key[1] = k0.y; key[2] = k0.z; key[3] = k0.w; key[4] = k1.x; key[5] = k1.y; key[6] = k1.z; key[7] = k1.w; }
    unsigned prefix = 0, need = CAP;
#pragma unroll 1
    for (int pass = 0; pass < 4; ++pass) {
        const int shift = 24 - 8 * pass;
        if (tid < 256) hist[tid] = 0u;
        __syncthreads();
#pragma unroll
        for (int i = 0; i < 8; ++i) { const bool in = (pass == 0) || ((key[i] >> (shift + 8)) == prefix); if (in) (void)__hip_atomic_fetch_add(&hist[(key[i] >> shift) & 255u], 1u, __ATOMIC_RELAXED, __HIP_MEMORY_SCOPE_WORKGROUP); }
        __syncthreads();
        if (wave == 0) {
            const unsigned c0 = hist[4 * lane], c1 = hist[4 * lane + 1], c2 = hist[4 * lane + 2], c3 = hist[4 * lane + 3], s = c0 + c1 + c2 + c3;
            unsigned incl = s;
#pragma unroll
            for (int o = 1; o < 64; o <<= 1) { const unsigned t = __shfl_down(incl, o); if (lane + o < 64) incl += t; }
            const unsigned above = incl - s;
            if (above < need && need <= incl) {
                unsigned aa = above; int d;
                if (aa + c3 >= need) d = 3; else { aa += c3; if (aa + c2 >= need) d = 2; else { aa += c2; if (aa + c1 >= need) d = 1; else { aa += c1; d = 0; } } }
                sh[0] = (prefix << 8) | (unsigned)(4 * lane + d); sh[1] = need - aa;
            }
        }
        __syncthreads();
        prefix = sh[0]; need = sh[1];
    }
    const unsigned T = prefix;
    unsigned cg = 0, ce = 0;
#pragma unroll
    for (int i = 0; i < 8; ++i) { cg += key[i] > T; ce += key[i] == T; }
    unsigned tot;
    const unsigned eq_before = block_excl_scan(ce, tmp, tid, lane, wave, tot);
    unsigned sel_mask = 0, nsel = 0, er = eq_before;
#pragma unroll
    for (int i = 0; i < 8; ++i) { bool s = key[i] > T; if (key[i] == T) { s = er < need; ++er; } if (s) { sel_mask |= 1u << i; ++nsel; } }
    unsigned slot = block_excl_scan(nsel, tmp, tid, lane, wave, tot);
    LAS int* lst = (LAS int*)(hist + 512);
    float* vals = WSP(float, WS_VALS) + (e * 8 + b) * CAP; int* inv = WSP(int, WS_INV);
#pragma unroll
    for (int i = 0; i < 8; ++i) { const int tok = tid * 8 + i; int sl = -1;
        if (sel_mask & (1u << i)) { sl = (int)slot; if (slot < (unsigned)CAP) { lst[slot] = tok; vals[slot] = __builtin_bit_cast(float, key[i]); } ++slot; }
        inv[((size_t)b * SEQ + tok) * 16 + e] = sl; }
    __syncthreads();
    { unsigned* VOFF = WSP(unsigned, WS_VOFF);
#pragma unroll
      for (int hh = 0; hh < 2; ++hh) { u32x4 o;
#pragma unroll
          for (int i = 0; i < 2; ++i) { int R, C; pg8::stage_rc(tid * 16 + i * 8192, R, C);
              o[i] = (unsigned)lst[hh * 256 + R] * 1024u + (unsigned)(C * 2); o[2 + i] = (unsigned)lst[hh * 256 + 128 + R] * 1024u + (unsigned)(C * 2); }
          *(u32x4*)(VOFF + ((size_t)((e * 8 + b) * 2 + hh) * 512 + tid) * 4) = o; } }
    __syncthreads();
}
template <int PART>
__device__ __forceinline__ void p7_expert_weights(Frame& F) { const KArgs ka = kargs(); const float* const a_w_gate = ka->w_gate; const float* const a_w_up = ka->w_up; const float* const a_w_down = ka->w_down;
    LAS float* scr = (LAS float*)(F.lds + 4096 + F.wave * 16640);
    bf16_t* WGU = WSP(bf16_t, WS_WGU); bf16_t* WD = WSP(bf16_t, WS_WD);
    constexpr int I_G = 16 * 16 * 24, I_D = 16 * 24 * 16;
    const int bx = (int)blockIdx.x;
    if (PART == 0) {
        const bool split = (F.G == 256); const bool tk = split && bx < BATCH * N_EXP;
        const int v0 = split ? ((tk ? bx : bx - 128) * NWAVES + F.wave) + (tk ? 7168 : 0) : F.wave * F.G + bx;
        const int vstep = split ? 1024 : F.G * NWAVES, vend = split ? (tk ? 2 * I_G : 7168) : 2 * I_G;
        static_assert(1024 * 12 == 2 * I_G, "P7 item split");
        for (int it = v0; it < vend; it += vstep) {
            int r = it; const int up = r >= I_G; if (up) r -= I_G; const int ex = r / 384, q = r % 384, kb = q / 24, g = q % 24, f = g * 64;
            transpose_item64((up ? a_w_up : a_w_gate) + (size_t)ex * 1024 * 1536, 1536, 1024, kb * 64, f, (bf16_t*)((unsigned char*)WGU + (size_t)ex * 3072 * 1024), (f >> 7) * 256 + up * 128 + (f & 127), scr, F.lane, WGU_SCALE, 0.f); }
    } else {
        for (int r = F.wave * F.G + bx; r < I_D; r += F.G * NWAVES) { const int ex = r / 384, q = r % 384, kb = q / 16, g = q % 16;
            transpose_item64(a_w_down + (size_t)ex * 1536 * 1024, 1024, 1536, kb * 64, g * 64, (bf16_t*)((unsigned char*)WD + (size_t)ex * 1024 * 1536), g * 64, scr, F.lane, WD_SCALE, 0.f); }
    }
}
__device__ __forceinline__ void p10_final(Frame& F, float* dst_override = nullptr) { const KArgs ka = kargs(); const float* const a_ln2_g = ka->ln2_g; const float* const a_ln2_b = ka->ln2_b; float* const a_out = ka->out;
    const float* const a_ln1_g = ka->ln1_g; const float* const a_ln1_b = ka->ln1_b; const float* const a_x = ka->x;
    const float* mod = WSP(const float, WS_MOD); const bf16_t* Y = WSP(const bf16_t, WS_Y); const int* inv = WSP(const int, WS_INV); const float* STAT = WSP(const float, WS_STAT); const bf16_t* const a_m = WSP(const bf16_t, WS_M);
    const int gw = F.vcu * NWAVES + F.wave, NGW = F.G * NWAVES, lane = F.lane;
    LAS f32x4* pl4 = (LAS f32x4*)F.lds;
    for (int i = F.tid; i < 1024; i += NTHR) { const int w = i >> 8, c4 = (i & 255) * 4; pl4[i] = *(const f32x4*)((w == 0 ? a_ln1_g : w == 1 ? a_ln1_b : w == 2 ? a_ln2_g : a_ln2_b) + c4); }
    for (int i = F.tid; i < 2048; i += NTHR) pl4[1024 + i] = *(const f32x4*)(mod + (i >> 8) * 6144 + 5120 + (i & 255) * 4);
    __syncthreads();
    int slot_n = inv[(size_t)gw * 16 + (lane & 15)];
    f32x4 xn[4]; u32x2 mn[4]; f32x2 stn = *(const f32x2*)(STAT + (size_t)gw * 2);
    { const f32x4* xr0 = (const f32x4*)(a_x + (size_t)gw * 1024) + lane; const u32x2* mr0 = (const u32x2*)(a_m + (size_t)gw * 1024) + lane;
#pragma unroll
      for (int j = 0; j < 4; ++j) { xn[j] = xr0[64 * j]; mn[j] = mr0[64 * j]; } }
    for (int row = gw; row < M_TOK; row += NGW) {
        const int b = row >> 12;
        f32x4* xr = (f32x4*)(a_out + (size_t)row * 1024) + lane;
        const int myslot = slot_n; f32x4 xc[4]; const float mean1 = stn[0], rstd1 = stn[1];
#pragma unroll
        for (int j = 0; j < 4; ++j) xc[j] = xn[j] * ALPHA + (f32x4){bf_lo(mn[j].x), bf_hi(mn[j].x), bf_lo(mn[j].y), bf_hi(mn[j].y)};
        unsigned long long msk = __ballot(myslot >= 0) & 0xFFFFull;
        f32x4 mo[4];
#pragma unroll
        for (int j = 0; j < 4; ++j) mo[j] = (f32x4){0.f, 0.f, 0.f, 0.f};
        { const int rn = row + NGW < M_TOK ? row + NGW : row;
          slot_n = inv[(size_t)rn * 16 + (lane & 15)]; stn = *(const f32x2*)(STAT + (size_t)rn * 2);
          const f32x4* xrn = (const f32x4*)(a_x + (size_t)rn * 1024) + lane; const u32x2* mrn = (const u32x2*)(a_m + (size_t)rn * 1024) + lane;
#pragma unroll
          for (int j = 0; j < 4; ++j) { xn[j] = xrn[64 * j]; mn[j] = mrn[64 * j]; } }
        while (msk) {
            const int e0 = __builtin_ctzll(msk); msk &= msk - 1;
            const bool two = msk != 0; const int e1 = two ? __builtin_ctzll(msk) : e0; if (two) msk &= msk - 1;
            const int s0 = __shfl(myslot, e0), s1 = __shfl(myslot, e1);
            const unsigned* y0 = (const unsigned*)((const unsigned char*)Y + ((size_t)(e0 * 8 + b) * CAP + s0) * 1024) + lane;
            const unsigned* y1 = (const unsigned*)((const unsigned char*)Y + ((size_t)(e1 * 8 + b) * CAP + s1) * 1024) + lane;
            unsigned w0[4], w1[4];
#pragma unroll
            for (int j = 0; j < 4; ++j) { w0[j] = y0[64 * j]; w1[j] = y1[64 * j]; }
            const float f1 = two ? 1.f : 0.f;
#pragma unroll
            for (int j = 0; j < 4; ++j) { const auto a0 = __builtin_amdgcn_cvt_pk_f32_fp8((int)w0[j], false), a1 = __builtin_amdgcn_cvt_pk_f32_fp8((int)w0[j], true);
                const auto c0 = __builtin_amdgcn_cvt_pk_f32_fp8((int)w1[j], false), c1 = __builtin_amdgcn_cvt_pk_f32_fp8((int)w1[j], true);
                mo[j][0] += a0[0] + f1 * c0[0]; mo[j][1] += a0[1] + f1 * c0[1]; mo[j][2] += a1[0] + f1 * c1[0]; mo[j][3] += a1[1] + f1 * c1[1]; }
        }
        f32x4 v[4]; float sm = 0.f;
#pragma unroll
        for (int j = 0; j < 4; ++j) { const f32x4 g2 = pl4[1024 + b * 256 + lane + 64 * j];
            const f32x4 x1 = (xc[j] - mean1) * rstd1 * pl4[lane + 64 * j] + pl4[256 + lane + 64 * j];
            v[j] = x1 * ALPHA + g2 * mo[j] * (DBG_MOE_F / Y_SCALE); sm += (v[j][0] + v[j][1]) + (v[j][2] + v[j][3]); }
        const float mean = wave_sum(sm) * (1.f / 1024.f); float s2 = 0.f;
#pragma unroll
        for (int j = 0; j < 4; ++j) { v[j] = v[j] - mean; s2 += (v[j][0] * v[j][0] + v[j][1] * v[j][1]) + (v[j][2] * v[j][2] + v[j][3] * v[j][3]); }
        const float rstd = 1.f / sqrtf(wave_sum(s2) * (1.f / 1024.f) + NORM_EPS);
#pragma unroll
        for (int j = 0; j < 4; ++j) { const f32x4 g = pl4[512 + lane + 64 * j], bb = pl4[768 + lane + 64 * j];
            (dst_override ? (f32x4*)(dst_override + (size_t)row * 1024) + lane : xr)[64 * j] = v[j] * rstd * g + bb; }
    }
}
constexpr int N_PHASES = 11;
__global__ void __launch_bounds__(NTHR, 2) fwd_kernel(Args args) {
    extern __shared__ __attribute__((aligned(16))) unsigned char lds_raw[];
    Frame F;
    F.lds = (LAS unsigned char*)lds_raw;
    F.tid = threadIdx.x; F.lane = F.tid & 63; F.wave = __builtin_amdgcn_readfirstlane(F.tid >> 6);
    F.G = gridDim.x; { const int bx = blockIdx.x; F.vcu = (F.G % 8 == 0) ? (bx % 8) * (F.G / 8) + bx / 8 : bx; }
    F.ws = kargs()->ws;
    volatile LAS unsigned* MISC = (volatile LAS unsigned*)(F.lds + MISC_OFF);
    for (int u = F.tid; u < (LDS_BYTES - MISC_OFF) / 4; u += NTHR) MISC[u] = 0u;
    __syncthreads();
    const int lo = kargs()->ph_lo, hi = kargs()->ph_hi;
    unsigned* barw = (unsigned*)(F.ws + WS_CTL) + CW_BAR;
    XcdBarrier bar; bar.bar = barw; bar.x = 0; bar.st = nullptr;
    if (hi - lo > 1) bar = xcd_barrier_post(barw, MISC + 8);
#ifndef PHMASK
#define PHMASK 0x7ff
#endif
#define IN(k) ((((PHMASK) >> (k)) & 1) && lo <= (k) && (k) < hi)
#define SEAM(k) do { if (IN(k) && IN((k) + 1)) xcd_barrier(bar); } while (0)

    if (IN(0)) { p0_prologue(F);
#if DBG_REP_P0 > 1
        __syncthreads(); p0_prologue(F);
#endif
    } SEAM(0);
    if (IN(1)) { _Pragma("unroll 1") for (int rep_ = 0; rep_ < DBG_REP_THIN; ++rep_) p1_mod_h1(F); } SEAM(1);
    if (IN(2)) {
        pg8::Gemm g{WSP(const bf16_t, WS_H), WSP(const bf16_t, WS_WIN), M_TOK, IN_WP, 1024, 1 << 30, nullptr};
        pg8::StaticOrder S; S.init(M_TOK, IN_WP, F.G, (int)blockIdx.x);
        static_assert(WS_DV - WS_DK == WS_DK - WS_DQ, "dq/dk/dv contiguous");
        EpiProj E{WSP(bf16_t, WS_CQ), WSP(bf16_t, WS_CKV), WSP(bf16_t, WS_KN)  , WSP(bf16_t, WS_DQ), WSP(float, WS_SSQ), WSP(const float, WS_ROPE)};
        pg8::gemm_phase<EpiProj, false, true>(F.lds, g, S, E);

    } SEAM(2);
    if (IN(3)) {
#ifdef DBG_DIL_MODE
        __syncthreads();
        for (int u = F.vcu; u < BATCH * DIL_H * 4; u += F.G) dil_unit<DBG_DIL_MODE>(F, u >> 5, (u >> 2) & 7, u & 3);
        __syncthreads();
#endif
#ifndef NO_P3G
#ifndef NO_GQ
        { pg8::Gemm g{WSP(const bf16_t, WS_CQ), WSP(const bf16_t, WS_WUQ), M_TOK, 768, Q_LORA, 1 << 30, nullptr};
          pg8::StaticOrder S; S.init(M_TOK, 768, F.G, (int)blockIdx.x);
          EpiQ E{WSP(bf16_t, WS_Q), WSP(const float, WS_SSQ), WSP(const float, WS_ROPE)};
          pg8::gemm_phase<EpiQ, false>(F.lds, g, S, E);
#if DBG_REP_P3G > 1
          pg8::gemm_phase<EpiQ, false>(F.lds, g, S, E);
#endif
 }
#endif
#ifndef NO_GK
        { pg8::Gemm g{WSP(const bf16_t, WS_CKV), WSP(const bf16_t, WS_WK), M_TOK, 512, KV_LORA, 1 << 30, nullptr};
          pg8::StaticOrder S; S.init(M_TOK, 512, F.G, (int)blockIdx.x);
          EpiKN8 E{WSP(unsigned char, WS_KN), WSP(const float, WS_SSQ)};
          pg8::gemm_phase<EpiKN8, false>(F.lds, g, S, E); }
#endif
        { pg8::Gemm g{WSP(const bf16_t, WS_WV), WSP(const bf16_t, WS_CKV), 512, M_TOK, KV_LORA, 1 << 30, nullptr};
          pg8::StaticOrder S; S.init(512, M_TOK, F.G, (int)blockIdx.x);
          EpiVt8 E{WSP(unsigned char, WS_V), WSP(const float, WS_SSQ)};
          pg8::gemm_phase<EpiVt8, false>(F.lds, g, S, E); }
#endif
    } SEAM(3);
    if (IN(4)) {
        const bool dil_first = (F.vcu & 1) == 0;
#ifndef NO_DIL
        if (dil_first) {
            for (int u = F.vcu; u < BATCH * DIL_H * 4; u += F.G) dil_unit<0>(F, u >> 5, (u >> 2) & 7, u & 3);
            __syncthreads();
        }
#endif
#pragma unroll 1
        for (int rep = 0; rep < DBG_REP_MLA; ++rep)
        for (int u = F.vcu; u < BATCH * MLA_H * 8; u += F.G) mla_unit(F, u >> 6, (u >> 3) & 7, u & 7);
#ifndef NO_DIL
        if (!dil_first) {
            __syncthreads();
            for (int u = F.vcu; u < BATCH * DIL_H * 4; u += F.G) dil_unit<0>(F, u >> 5, (u >> 2) & 7, u & 3);
            __syncthreads();
        }
#endif
    } SEAM(4);
    if (IN(5)) {
        pg8::Gemm g{WSP(const bf16_t, WS_MIX), WSP(const bf16_t, WS_WOUT), M_TOK, 1024, 1024, 1 << 30, nullptr};
        pg8::StaticOrder S; S.init(M_TOK, 1024, F.G, (int)blockIdx.x);
        EpiOut E{WSP(bf16_t, WS_M), WSP(const float, WS_MOD)};
        pg8::gemm_phase<EpiOut, false, true>(F.lds, g, S, E);

    } SEAM(5);
    if (IN(6)) { _Pragma("unroll 1") for (int rep_ = 0; rep_ < DBG_REP_THIN; ++rep_) { p6_ln1_router(F); __syncthreads(); } } SEAM(6);
    if (IN(7)) {
        for (int u = blockIdx.x; u < BATCH * N_EXP; u += F.G) topk_unit(F, u >> 4, u & 15);
        p7_expert_weights<0>(F);
    } SEAM(7);
    if (IN(8)) {
        const bool wd_first = (F.vcu & 1) == 0;
        if (wd_first) { p7_expert_weights<1>(F); __syncthreads(); }
        pg8::Gemm g{WSP(const bf16_t, WS_H), WSP(const bf16_t, WS_WGU), MROWS, 3072, 1024, 16, WSP(const int, WS_VOFF)};
        pg8::StaticOrder S; S.init(MROWS, 3072, F.G, (int)blockIdx.x);
        EpiGU E{WSP(bf16_t, WS_HID)};
        pg8::gemm_phase<EpiGU, true, true>(F.lds, g, S, E);
#if DBG_REP_P8 > 1
          pg8::gemm_phase<EpiGU, false, true>(F.lds, g, S, E);
#endif
        if (!wd_first) { __syncthreads(); p7_expert_weights<1>(F); }
    } SEAM(8);
    if (IN(9)) {
        pg8::Gemm g{WSP(const bf16_t, WS_HID), WSP(const bf16_t, WS_WD), MROWS, 1024, D_FF, 16, nullptr};
        pg8::StaticOrder S; S.init(MROWS, 1024, F.G, (int)blockIdx.x);
        EpiDown E{WSP(bf16_t, WS_Y), WSP(const float, WS_VALS)};
        pg8::gemm_phase<EpiDown, false, true>(F.lds, g, S, E);
#if DBG_REP_P9 > 1
          pg8::gemm_phase<EpiDown, false, true>(F.lds, g, S, E);
#endif

    } SEAM(9);
    if (IN(10)) {
#ifdef DBG_REP_P10
        p10_final(F, WSP(float, WS_Z)); __syncthreads();
#endif
        p10_final(F); }
#undef IN
#undef SEAM
}

extern "C" void kernel_launch(void* const* d_in, const int* in_sizes, int n_in, void* d_out, int out_size, void* d_ws, size_t ws_size, hipStream_t stream) {
    static int grid = 0;
    if (grid == 0) {
        if (n_in != 19 || in_sizes[0] != M_TOK * D_MODEL || out_size != M_TOK * D_MODEL || ws_size < WS_END) {
            fprintf(stderr, "kernel_launch: unexpected shapes (n_in %d, in0 %d, out %d, ws %zu); nothing launched\n", n_in, n_in > 0 ? in_sizes[0] : -1, out_size, ws_size); grid = -1; return; }
        int dev = 0, cus = 0, per_cu = 0;
        if (hipGetDevice(&dev) != hipSuccess || hipDeviceGetAttribute(&cus, hipDeviceAttributeMultiprocessorCount, dev) != hipSuccess) { grid = -1; return; }
        if (hipFuncSetAttribute((const void*)fwd_kernel, hipFuncAttributeMaxDynamicSharedMemorySize, LDS_BYTES) != hipSuccess) { fprintf(stderr, "kernel_launch: hipFuncSetAttribute failed\n"); grid = -1; return; }
        if (hipOccupancyMaxActiveBlocksPerMultiprocessor(&per_cu, (const void*)fwd_kernel, NTHR, LDS_BYTES) != hipSuccess || per_cu < 1)
            fprintf(stderr, "kernel_launch: note: occupancy query reports %d workgroups per CU\n", per_cu);
        (void)hipGetLastError();
        grid = cus < 256 ? cus : 256;
    }
    if (grid < 0) return;
    (void)hipMemsetAsync((char*)d_ws + WS_CTL, 0, CTL_ZERO_BYTES, stream);
    Args a{};
    a.x = (const float*)d_in[0]; a.c = (const float*)d_in[1]; a.w_ada = (const float*)d_in[2]; a.b_ada = (const float*)d_in[3]; a.w_in = (const float*)d_in[4];
    a.q_norm_g = (const float*)d_in[5]; a.w_uq = (const float*)d_in[6]; a.kv_norm_g = (const float*)d_in[7]; a.w_ukv = (const float*)d_in[8]; a.rel_bias = (const float*)d_in[9];
    a.w_out = (const float*)d_in[10]; a.ln1_g = (const float*)d_in[11]; a.ln1_b = (const float*)d_in[12]; a.w_router = (const float*)d_in[13]; a.w_gate = (const float*)d_in[14];
    a.w_up = (const float*)d_in[15]; a.w_down = (const float*)d_in[16]; a.ln2_g = (const float*)d_in[17]; a.ln2_b = (const float*)d_in[18];
    a.out = (float*)d_out; a.ws = (unsigned char*)d_ws;
#if MK_ONE_LAUNCH
    a.ph_lo = 0; a.ph_hi = N_PHASES;
    hipLaunchKernelGGL(fwd_kernel, dim3(grid), dim3(NTHR), LDS_BYTES, stream, a);
#else
    for (int p = 0; p < N_PHASES; ++p) { a.ph_lo = p; a.ph_hi = p + 1; hipLaunchKernelGGL(fwd_kernel, dim3(grid), dim3(NTHR), LDS_BYTES, stream, a); }
#endif
}
```

```cpp
#include <hip/hip_runtime.h>
#include <cstdio>
#include <cstdint>

#ifndef MK_ONE_LAUNCH
#define MK_ONE_LAUNCH 1
#endif

#define LAS __attribute__((address_space(3)))
#define GAS __attribute__((address_space(1)))
typedef unsigned short bf16_t;
typedef short bf16x8 __attribute__((ext_vector_type(8)));
typedef short s16x4 __attribute__((ext_vector_type(4)));
typedef float f32x4 __attribute__((ext_vector_type(4)));
typedef float f32x2 __attribute__((ext_vector_type(2)));
typedef float f32x16 __attribute__((ext_vector_type(16)));
typedef unsigned u32x4 __attribute__((ext_vector_type(4)));
typedef unsigned u32x2 __attribute__((ext_vector_type(2)));
typedef int i32x4 __attribute__((ext_vector_type(4)));
typedef int i32x8 __attribute__((ext_vector_type(8)));

constexpr int D_MODEL = 1024, BATCH = 8, SEQ = 4096, M_TOK = BATCH * SEQ;
constexpr int MLA_H = 8, MLA_NOPE = 64, MLA_ROPE = 32, MLA_V = 64, Q_LORA = 384, KV_LORA = 256, MLA_DQ = 96;
constexpr int DIL_H = 8, DIL_D = 64;
constexpr int N_EXP = 16, CAP = 512, D_FF = 1536;
constexpr int IN_W = 2208, IN_WP = 2304;
constexpr float ALPHA = 1.189207115002721f;
constexpr float NORM_EPS = 1e-6f;
constexpr float LOG2E = 1.4426950408889634f;
constexpr float QS_MLA = 0.10206207261596575f * LOG2E;
constexpr float Q8_SCALE = QS_MLA * 2.f * 8.f, K8_SCALE = 0.5f;
constexpr float QS_DIL = 0.125f * LOG2E;
constexpr float NEG_BIG = -1e30f;
#ifndef DBG_MLA_F
#define DBG_MLA_F 1.f
#endif
#ifndef DBG_DIL_F
#define DBG_DIL_F 1.f
#endif
#ifndef DBG_XEXP
#define DBG_XEXP 0
#endif
#ifndef DBG_REP_P0
#define DBG_REP_P0 1
#endif
#ifndef DBG_REP_P7
#define DBG_REP_P7 1
#endif
#ifndef DBG_REP_MLA
#define DBG_REP_MLA 1
#endif
#ifndef DBG_REP_DIL
#define DBG_REP_DIL 1
#endif
#ifndef DBG_REP_P8
#define DBG_REP_P8 1
#endif
#ifndef DBG_REP_P2
#define DBG_REP_P2 1
#endif
#ifndef DBG_REP_P9
#define DBG_REP_P9 1
#endif
#ifndef DBG_REP_P5
#define DBG_REP_P5 1
#endif
#ifndef DBG_REP_THIN
#define DBG_REP_THIN 1
#endif
#ifndef DBG_REP_P3G
#define DBG_REP_P3G 1
#endif
#ifndef DBG_MIX_F
#define DBG_MIX_F 1.f
#endif
#ifndef DBG_MOE_F
#define DBG_MOE_F 1.f
#endif
constexpr float WGU_SCALE = 32.f, WD_SCALE = 64.f, HID_SCALE = 4.f, WIN_SCALE = 32.f, WOUT_SCALE = 32.f, MIX_SCALE = 16.f, Y_SCALE = 64.f;
constexpr int MROWS = N_EXP * BATCH * CAP;

constexpr size_t MiB = 1u << 20;
constexpr size_t WS_CTL = 0, CTL_ZERO_BYTES = 1 * MiB;
constexpr size_t WS_ROPE = 1 * MiB;
constexpr size_t WS_TABG = 1 * MiB + 512 * 1024;
constexpr size_t WS_MODP = 2 * MiB;
constexpr size_t WS_MOD = 5 * MiB;
constexpr size_t WS_AFF = 6 * MiB;
constexpr size_t WS_STAT = 8 * MiB;
constexpr size_t WS_VALS = 8 * MiB + 256 * 1024;
constexpr size_t WS_INV = 9 * MiB;
constexpr size_t WS_SSQ = 11 * MiB;
constexpr size_t WS_WIN = 16 * MiB;
constexpr size_t WS_WUQ = 21 * MiB;
constexpr size_t WS_WK = 22 * MiB;
constexpr size_t WS_WV = 22 * MiB + 512 * 1024;
constexpr size_t WS_WOUT = 23 * MiB;
constexpr size_t WS_LSE = 26 * MiB;
constexpr size_t WS_H = 32 * MiB;
constexpr size_t WS_O1 = 32 * MiB, WS_O2 = 64 * MiB;
constexpr size_t WS_WGU = 96 * MiB;
constexpr size_t WS_WD = 192 * MiB;
constexpr size_t WS_CQ = 96 * MiB;
constexpr size_t WS_CKV = 120 * MiB;
constexpr size_t WS_KR = 136 * MiB;
constexpr size_t WS_DQ = 138 * MiB, WS_DK = 170 * MiB, WS_DV = 202 * MiB;
constexpr size_t WS_Q = 240 * MiB;
constexpr size_t WS_KN = 288 * MiB;
constexpr size_t WS_V = 320 * MiB;
constexpr size_t WS_Z = 240 * MiB;
constexpr size_t WS_MIX = 368 * MiB;
constexpr size_t WS_HID = 240 * MiB;
constexpr size_t WS_VOFF = 336 * MiB;
constexpr size_t WS_XG = 336 * MiB;
constexpr size_t WS_Y = 32 * MiB;
constexpr size_t WS_M = 432 * MiB;
constexpr size_t WS_END = 496 * MiB;
constexpr int CW_BAR = 4096;
constexpr int CW_QUEUE = 64;

constexpr int RING_BYTES = 147456;
constexpr int MISC_OFF = RING_BYTES;
constexpr int LDS_BYTES = RING_BYTES + 512;
constexpr int NWAVES = 8, NTHR = 512;

__device__ __forceinline__ unsigned f2bf(float f) { unsigned u = __builtin_bit_cast(unsigned, f); return (u + 0x7fffu + ((u >> 16) & 1u)) >> 16; }
__device__ __forceinline__ unsigned pk2(float lo, float hi) { return f2bf(lo) | (f2bf(hi) << 16); }
__device__ __forceinline__ unsigned cvt_pk_bf16(float lo, float hi) { unsigned r; asm volatile("v_cvt_pk_bf16_f32 %0, %1, %2" : "=v"(r) : "v"(lo), "v"(hi)); return r; }
__device__ __forceinline__ float bf_lo(unsigned w) { return __builtin_bit_cast(float, w << 16); }
__device__ __forceinline__ float bf_hi(unsigned w) { return __builtin_bit_cast(float, w & 0xffff0000u); }
template <int CTRL> __device__ __forceinline__ float dpp_f(float v) { return __builtin_bit_cast(float, __builtin_amdgcn_update_dpp(0, __builtin_bit_cast(int, v), CTRL, 0xF, 0xF, true)); }
__device__ __forceinline__ float lane_f(float v, int l) { return __builtin_bit_cast(float, __builtin_amdgcn_readlane(__builtin_bit_cast(int, v), l)); }
__device__ __forceinline__ float wave_sum(float v) {
    v += dpp_f<0xB1>(v); v += dpp_f<0x4E>(v); v += dpp_f<0x141>(v); v += dpp_f<0x140>(v);
    return (lane_f(v, 0) + lane_f(v, 16)) + (lane_f(v, 32) + lane_f(v, 48));
}
__device__ __forceinline__ float wave_max(float v) {
    v = fmaxf(v, dpp_f<0xB1>(v)); v = fmaxf(v, dpp_f<0x4E>(v)); v = fmaxf(v, dpp_f<0x141>(v)); v = fmaxf(v, dpp_f<0x140>(v));
    return fmaxf(fmaxf(lane_f(v, 0), lane_f(v, 16)), fmaxf(lane_f(v, 32), lane_f(v, 48)));
}
#ifndef DBG_FP8_EMU
#define DBG_FP8_EMU 0
#endif
#ifndef DBG_HID_S
#define DBG_HID_S 4.f
#endif
__device__ __forceinline__ unsigned pk4_fp8(float a, float b, float c, float d) {
    a = __builtin_amdgcn_fmed3f(a, -448.f, 448.f); b = __builtin_amdgcn_fmed3f(b, -448.f, 448.f); c = __builtin_amdgcn_fmed3f(c, -448.f, 448.f); d = __builtin_amdgcn_fmed3f(d, -448.f, 448.f);
    int p = __builtin_amdgcn_cvt_pk_fp8_f32(a, b, 0, false); p = __builtin_amdgcn_cvt_pk_fp8_f32(c, d, p, true); return (unsigned)p;
}
__device__ __forceinline__ unsigned pk4_fp8_nc(float a, float b, float c, float d) { int p = __builtin_amdgcn_cvt_pk_fp8_f32(a, b, 0, false); p = __builtin_amdgcn_cvt_pk_fp8_f32(c, d, p, true); return (unsigned)p; }
__device__ __forceinline__ float q8(float x, float sc, float isc) {
#if DBG_FP8_EMU
    const int p = __builtin_amdgcn_cvt_pk_fp8_f32(x * sc, 0.f, 0, false); return __builtin_amdgcn_cvt_f32_fp8(p, 0) * isc;
#else
    return x;
#endif
}
#define LDS_WAIT() asm volatile("s_waitcnt lgkmcnt(0)" ::: "memory")
#define VM_WAIT() asm volatile("s_waitcnt vmcnt(0)" ::: "memory")

namespace pg8 {
constexpr int BM = 256, BK = 64, HALF = 128, HTB = HALF * BK * 2, STAGE_BYTES = 8 * HTB, NXCD = 8, WGM = 8;
__host__ __device__ __forceinline__ int lds_byte(int r, int c) { const int st = (r >> 4) * 2 + (c >> 5), rr = r & 15, cc = c & 31, ob = rr * 64 + cc * 2; return st * 1024 + (ob ^ (((ob >> 9) & 1) << 5)); }
__host__ __device__ __forceinline__ void stage_rc(int b, int& R, int& C) { const int st = b / 1024, sb = b % 1024, swz = sb ^ (((sb >> 9) & 1) << 5); R = (st >> 1) * 16 + swz / 64; C = (st & 1) * 32 + (swz % 64) / 2; }
__host__ __device__ __forceinline__ int perm32(int rho) { const int n = rho >> 4, i = rho & 15; return 8 * (i >> 2) + 4 * n + (i & 3); }

struct Unit { int pm, pn; };
struct Gemm { const bf16_t* A; const bf16_t* Bt; int M, N, K; int grp; const int* rowsrc; };

struct StaticOrder {
    int nM, nN, nwg, G, c;
    __device__ void init(int M, int N, int G_, int c_) { nM = M / BM; nN = N / BM; nwg = nM * nN; G = G_; c = c_; }
    __device__ bool next(int i, Unit& u) const {
        const long L = (long)i * G + c; if (L >= nwg) return false;
        int wgid = (int)L; { const int q = nwg / NXCD, r = nwg % NXCD, xcd = wgid % NXCD, off = wgid / NXCD; wgid = (xcd < r ? xcd * (q + 1) : r * (q + 1) + (xcd - r) * q) + off; }
        const int nig = WGM * nN, gid = wgid / nig, fm = gid * WGM, gsz = (nM - fm) < WGM ? (nM - fm) : WGM;
        u.pm = fm + ((wgid % nig) % gsz); u.pn = (wgid % nig) / gsz; return true;
    }
};

using ::i32x4; using ::i32x8;
template <class Epi, bool GATHER, bool FP8 = false>
__device__ __forceinline__ void gemm_phase(LAS unsigned char* lds, const Gemm g, const StaticOrder& S, const Epi& E) {
    const int tid = threadIdx.x, wid = __builtin_amdgcn_readfirstlane(tid >> 6), lane = tid & 63, wr = wid >> 2, wc = wid & 3, fr = lane & 15, fq = lane >> 4;
    const int K = g.K, KB = FP8 ? g.K : g.K * 2, nt = KB / 128, nN = g.N / BM;
    unsigned voffA[2], voffB[2];
#pragma unroll
    for (int i = 0; i < 2; ++i) { int R, C; stage_rc(tid * 16 + i * 8192, R, C); const int Rb = (R & ~31) + perm32(R & 31);
        voffA[i] = (unsigned)(R * KB + C * 2); voffB[i] = (unsigned)(Rb * KB + C * 2); }
    const size_t kstep = (size_t)(BK * 2);
    const size_t hstep = GATHER ? (size_t)0 : (size_t)HALF * KB;
    const size_t hstepB = (size_t)HALF * KB, tstep = 2 * hstepB;
    const unsigned ldsw = (unsigned)wid * 1024u;
    const int aoff = lds_byte(wr * 64 + fr, fq * 8), boff = lds_byte(wc * 32 + fr, fq * 8);
#define PG8_SA(b, h) (((b) * 2 + (h)) * HTB)
#define PG8_SB(b, h) ((4 + (b) * 2 + (h)) * HTB)
    const unsigned lds_base_u = (unsigned)__builtin_amdgcn_readfirstlane((int)(unsigned)(uintptr_t)lds + (int)ldsw);
#define PG8_STAGE(bufoff, gbase, voff) do { _Pragma("unroll") for (int _i = 0; _i < 2; ++_i) { \
        if constexpr (FP8) { unsigned keep_; asm volatile("s_mov_b32 %0, m0\n\ts_mov_b32 m0, %3\n\ts_nop 0\n\tglobal_load_lds_dwordx4 %1, %2\n\ts_mov_b32 m0, %0" \
              : "=&s"(keep_) : "v"((voff)[_i]), "s"((const char*)(gbase)), "s"(lds_base_u + (unsigned)((bufoff) + _i * 8192)) : "memory"); } \
        else __builtin_amdgcn_global_load_lds((const unsigned*)((const char*)(gbase) + (voff)[_i]), (LAS unsigned*)(lds + (bufoff) + ldsw + _i * 8192), 16, 0, 0); } } while (0)
#define PG8_LDA(dst, b, h) do { _Pragma("unroll") for (int m = 0; m < 4; ++m) _Pragma("unroll") for (int k = 0; k < 2; ++k) dst[m][k] = *(const LAS bf16x8*)(lds + PG8_SA(b, h) + aoff + m * 2048 + k * 1024); } while (0)
#define PG8_LDB(dst, b, h) do { _Pragma("unroll") for (int n = 0; n < 2; ++n) _Pragma("unroll") for (int k = 0; k < 2; ++k) dst[n][k] = *(const LAS bf16x8*)(lds + PG8_SB(b, h) + boff + n * 2048 + k * 1024); } while (0)
#define PG8_MMA(ai, bj, At, Bt) do { __builtin_amdgcn_s_setprio(1); _Pragma("unroll") for (int m = 0; m < 4; ++m) _Pragma("unroll") for (int n = 0; n < 2; ++n) { \
        if constexpr (FP8) { const i32x8 b8_ = __builtin_shufflevector(__builtin_bit_cast(i32x4, Bt[n][0]), __builtin_bit_cast(i32x4, Bt[n][1]), 0, 1, 2, 3, 4, 5, 6, 7); \
            const i32x8 a8_ = __builtin_shufflevector(__builtin_bit_cast(i32x4, At[m][0]), __builtin_bit_cast(i32x4, At[m][1]), 0, 1, 2, 3, 4, 5, 6, 7); \
            asm volatile("v_mfma_f32_16x16x128_f8f6f4 %0, %1, %2, %0" : "+v"(acc[ai][bj][m][n]) : "v"(b8_), "v"(a8_)); } \
        else { _Pragma("unroll") for (int k = 0; k < 2; ++k) acc[ai][bj][m][n] = __builtin_amdgcn_mfma_f32_16x16x32_bf16(Bt[n][k], At[m][k], acc[ai][bj][m][n], 0, 0, 0); } } \
        __builtin_amdgcn_s_setprio(0); } while (0)
#define PG8_WAIT_V(n) asm volatile("s_waitcnt vmcnt(" #n ")" ::: "memory")
#define PG8_WAIT_L(n) asm volatile("s_waitcnt lgkmcnt(" #n ")" ::: "memory")
#define PG8_BAR __builtin_amdgcn_s_barrier()
#define PG8_SCHED __builtin_amdgcn_sched_barrier(0)
#define PG8_ASRC(U) (GATHER ? (const char*)g.A + (size_t)(((U).pm >> 1) & 7) * ((size_t)SEQ * KB) : (const char*)g.A + (size_t)(U).pm * tstep)
#define PG8_GV(U) (*(const u32x4*)((const unsigned*)g.rowsrc + ((size_t)(U).pm * 512 + tid) * 4))
#define PG8_BSRC(U) ((const char*)g.Bt + (size_t)(((U).pm / g.grp) * nN + (U).pn) * tstep)
    Unit cur, nxt; int ui = 0;
    if (!S.next(0, cur)) return;
    u32x4 gvc = (u32x4){0u, 0u, 0u, 0u}, gvn = gvc, gvnn = gvc;
    if constexpr (GATHER) { gvc = PG8_GV(cur); Unit t1; gvn = S.next(1, t1) ? PG8_GV(t1) : gvc; }
#define PG8_STAGE_A(bufoff, base, H, NEXT) do { if constexpr (GATHER) { const bool nx_ = (NEXT); unsigned va_[2] = {nx_ ? gvn[2 * (H)] : gvc[2 * (H)], nx_ ? gvn[2 * (H) + 1] : gvc[2 * (H) + 1]}; PG8_STAGE(bufoff, base, va_); } \
        else PG8_STAGE(bufoff, (base) + (H) * hstep, voffA); } while (0)
    f32x4 acc[2][2][4][2];
#pragma unroll
    for (int a = 0; a < 2; ++a)
#pragma unroll
        for (int b = 0; b < 2; ++b)
#pragma unroll
            for (int m = 0; m < 4; ++m)
#pragma unroll
                for (int n = 0; n < 2; ++n) acc[a][b][m][n] = (f32x4){0.f, 0.f, 0.f, 0.f};
    bf16x8 At[4][2], B0[2][2], B1[2][2];
    const char* cA = PG8_ASRC(cur);
    const char* cB = PG8_BSRC(cur);
    PG8_STAGE(PG8_SB(0, 0), cB, voffB); PG8_STAGE(PG8_SB(0, 1), cB + hstepB, voffB); PG8_STAGE_A(PG8_SA(0, 0), cA, 0, false); PG8_STAGE_A(PG8_SA(0, 1), cA, 1, false);
    if (wr == 1) PG8_BAR;
    PG8_WAIT_V(2); PG8_BAR;
    PG8_STAGE(PG8_SB(1, 0), cB + kstep, voffB); PG8_STAGE_A(PG8_SA(1, 0), cA + kstep, 0, false); PG8_STAGE(PG8_SB(1, 1), cB + hstepB + kstep, voffB);
    PG8_WAIT_V(6); PG8_BAR;
    for (;;) {
        const bool has_next = S.next(ui + 1, nxt);
        const char* nA = cA; const char* nB = cB;
        if (has_next) { nA = PG8_ASRC(nxt); nB = PG8_BSRC(nxt); }
#pragma unroll 1
        for (int t = 0; t < nt; t += 2) {
            const bool last = (t == nt - 2);
            const char* a1 = cA + (size_t)(t + 1) * kstep;
            const char* a2 = last ? nA : cA + (size_t)(t + 2) * kstep; const char* b2 = last ? nB : cB + (size_t)(t + 2) * kstep;
            const char* a3 = a2 + kstep; const char* b3 = b2 + kstep;
            PG8_LDB(B0, 0, 0); PG8_LDB(B1, 0, 1); PG8_SCHED; PG8_LDA(At, 0, 0); PG8_STAGE_A(PG8_SA(1, 1), a1, 1, false);
            PG8_WAIT_V(8); PG8_WAIT_L(0); PG8_BAR; PG8_MMA(0, 0, At, B0); PG8_MMA(0, 1, At, B1); PG8_BAR; PG8_SCHED;
            PG8_LDA(At, 0, 1); PG8_STAGE(PG8_SB(0, 0), b2, voffB); PG8_STAGE(PG8_SB(0, 1), b2 + hstepB, voffB); PG8_STAGE_A(PG8_SA(0, 0), a2, 0, last);
            PG8_WAIT_V(8); PG8_WAIT_L(0); PG8_BAR; PG8_MMA(1, 0, At, B0); PG8_MMA(1, 1, At, B1); PG8_BAR; PG8_SCHED;
            PG8_LDB(B0, 1, 0); PG8_LDB(B1, 1, 1); PG8_SCHED; PG8_LDA(At, 1, 0); PG8_STAGE_A(PG8_SA(0, 1), a2, 1, last);
            PG8_WAIT_V(8); PG8_WAIT_L(0); PG8_BAR; PG8_MMA(0, 0, At, B0); PG8_MMA(0, 1, At, B1); PG8_BAR; PG8_SCHED;
            PG8_LDA(At, 1, 1); PG8_STAGE(PG8_SB(1, 0), b3, voffB); PG8_STAGE(PG8_SB(1, 1), b3 + hstepB, voffB); PG8_STAGE_A(PG8_SA(1, 0), a3, 0, last);
            PG8_WAIT_V(8); PG8_WAIT_L(0); PG8_BAR; PG8_MMA(1, 0, At, B0); PG8_MMA(1, 1, At, B1); PG8_BAR; PG8_SCHED;
        }
        if (wr == 0) PG8_BAR;
        if constexpr (FP8) asm volatile("s_nop 15\n\ts_nop 15\n\ts_nop 15\n\ts_nop 15" ::: "memory");
        if constexpr (GATHER) { Unit t2; gvnn = S.next(ui + 2, t2) ? PG8_GV(t2) : gvn; }
        E(acc, cur, wr, wc, fr, fq);
        if (!has_next) break;
        if constexpr (GATHER) { gvc = gvn; gvn = gvnn; }
#pragma unroll
        for (int a = 0; a < 2; ++a)
#pragma unroll
            for (int b = 0; b < 2; ++b)
#pragma unroll
                for (int m = 0; m < 4; ++m)
#pragma unroll
                    for (int n = 0; n < 2; ++n) acc[a][b][m][n] = (f32x4){0.f, 0.f, 0.f, 0.f};
        cur = nxt; cA = nA; cB = nB; ++ui;
        if (wr == 1) PG8_BAR;
    }
    PG8_WAIT_V(0);
    PG8_BAR;
#undef PG8_STAGE_A
#undef PG8_GV
#undef PG8_SA
#undef PG8_SB
#undef PG8_STAGE
#undef PG8_LDA
#undef PG8_LDB
#undef PG8_MMA
#undef PG8_WAIT_V
#undef PG8_WAIT_L
#undef PG8_BAR
#undef PG8_SCHED
#undef PG8_ASRC
#undef PG8_BSRC
}
}

#define XB_TMO      128
#define XB_XCNT(j)  (256  + 64 * (j))
#define XB_XSUB(j)  (1280 + 64 * (j))
#define XB_XGEN(j)  (2304 + 64 * (j))
#define XB_TOP      3328
#define XB_TOPGEN   3392
#define XCD_BAR_WORDS 3456
#define XB_SPIN_CAP (1u << 18)
__device__ __forceinline__ unsigned xb_ld(unsigned* p)              { return __hip_atomic_load(p, __ATOMIC_RELAXED, __HIP_MEMORY_SCOPE_AGENT); }
__device__ __forceinline__ unsigned xb_add(unsigned* p, unsigned v) { return __hip_atomic_fetch_add(p, v, __ATOMIC_RELAXED, __HIP_MEMORY_SCOPE_AGENT); }
__device__ __forceinline__ unsigned xb_xcc_id() { return (unsigned)__builtin_amdgcn_s_getreg((3 << 11) | 20) & 0xFu; }
#define XB_SPIN(cond, bar) do { unsigned _sp = 0; while (cond) { __builtin_amdgcn_s_sleep(1); \
    if ((++_sp & 255u) == 0u) { if (xb_ld(&(bar)[XB_TMO])) break; if (_sp > XB_SPIN_CAP) { atomicAdd(&(bar)[XB_TMO], 1u); break; } } } } while (0)
struct XcdBarrier { unsigned* bar; unsigned x; volatile LAS unsigned* st; };
__device__ __forceinline__ XcdBarrier xcd_barrier_post(unsigned* bar, volatile LAS unsigned* st) {
    XcdBarrier b; b.bar = bar; b.x = xb_xcc_id(); b.st = st;
    if (threadIdx.x == 0) (void)xb_add(&bar[XB_XCNT(b.x)], 1u);
    return b;
}
__device__ __forceinline__ void xcd_barrier_complete(unsigned* bar, unsigned x, unsigned& nloc, unsigned& nx) {
    const unsigned G = gridDim.x * gridDim.y * gridDim.z;
    unsigned sum, cnt, mine, sp = 0u;
    for (;;) {
        sum = 0u; cnt = 0u; mine = 0u;
#pragma unroll
        for (unsigned j = 0; j < 16; ++j) { const unsigned c = xb_ld(&bar[XB_XCNT(j)]); sum += c; cnt += (c > 0u) ? 1u : 0u; mine = (j == x) ? c : mine; }
        if (sum == G) break;
        __builtin_amdgcn_s_sleep(1);
        if ((++sp & 255u) == 0u) { if (xb_ld(&bar[XB_TMO])) break; if (sp > XB_SPIN_CAP) { atomicAdd(&bar[XB_TMO], 1u); break; } }
    }
    nloc = mine > 0u ? mine : 1u; nx = cnt > 0u ? cnt : 1u;
}
__device__ __forceinline__ void xcd_barrier(const XcdBarrier& b) {
    asm volatile("s_waitcnt vmcnt(0)" ::: "memory");
    __syncthreads();
    if (threadIdx.x == 0) {
        unsigned* bar = b.bar;
        __builtin_amdgcn_s_waitcnt(0);
        unsigned nloc = b.st[0], nx = b.st[1];
        if (nloc == 0u) { xcd_barrier_complete(bar, b.x, nloc, nx); b.st[0] = nloc; b.st[1] = nx; }
        const unsigned old = xb_add(&bar[XB_XSUB(b.x)], 1u);
        const unsigned gen = old / nloc;
        if (old + 1u == (gen + 1u) * nloc) {
            __builtin_amdgcn_fence(__ATOMIC_RELEASE, "agent");
            asm volatile("s_waitcnt vmcnt(0)" ::: "memory");
            const unsigned og = xb_add(&bar[XB_TOP], 1u);
            const unsigned tg = og / nx;
            if (og + 1u == (tg + 1u) * nx) xb_add(&bar[XB_TOPGEN], 1u);
            else XB_SPIN(xb_ld(&bar[XB_TOPGEN]) == tg, bar);
            __builtin_amdgcn_fence(__ATOMIC_ACQUIRE, "agent");
            xb_add(&bar[XB_XGEN(b.x)], 1u);
            asm volatile("s_waitcnt vmcnt(0)" ::: "memory");
        } else {
            XB_SPIN(xb_ld(&bar[XB_XGEN(b.x)]) == gen, bar);
            __builtin_amdgcn_fence(__ATOMIC_ACQUIRE, "agent");
            asm volatile("s_waitcnt vmcnt(0)" ::: "memory");
        }
    }
    __syncthreads();
}

struct Args {
    const float *x, *c, *w_ada, *b_ada, *w_in, *q_norm_g, *w_uq, *kv_norm_g, *w_ukv, *rel_bias, *w_out, *ln1_g, *ln1_b, *w_router, *w_gate, *w_up, *w_down, *ln2_g, *ln2_b;
    float* out; unsigned char* ws; int ph_lo, ph_hi;
};
struct Frame {
    LAS unsigned char* lds;
    int tid, lane, wave, vcu, G;
    unsigned char* ws;
};
#define WSP(T, off) ((T*)(F.ws + (off)))
typedef const __attribute__((address_space(4))) Args* KArgs;
__device__ __forceinline__ KArgs kargs() { KArgs p = (KArgs)__builtin_amdgcn_kernarg_segment_ptr(); asm volatile("" : "+s"(p)); return p; }

using pg8::Unit;
#define DPERM(s_) ((((s_) & 15) << 8) + ((s_) >> 4))
struct EpiProj {
    bf16_t *CQ, *CKV, *KR, *DQ; float* SSQ; const float* rope;
    __device__ __forceinline__ void operator()(const f32x4 (&acc)[2][2][4][2], const Unit& u, int wr, int wc, int fr, int fq) const {
        const int pn = u.pn;
        if (pn >= 3) {
            const int t = pn - 3; bf16_t* base = DQ + (size_t)(t >> 1) * ((WS_DK - WS_DQ) / 2); const float sc = (t < 2 ? QS_DIL : 1.f) * (1.f / WIN_SCALE);
            const int col0 = (t & 1) * 256 + wc * 32 + 8 * fq;
#pragma unroll
            for (int ai = 0; ai < 2; ++ai)
#pragma unroll
                for (int m = 0; m < 4; ++m) { const size_t row = (size_t)u.pm * 256 + ai * 128 + wr * 64 + m * 16 + fr;
#pragma unroll
                    for (int bj = 0; bj < 2; ++bj) { const f32x4 v0 = acc[ai][bj][m][0] * sc, v1 = acc[ai][bj][m][1] * sc;
                        u32x4 w; w.x = cvt_pk_bf16(v0[0], v0[1]); w.y = cvt_pk_bf16(v0[2], v0[3]); w.z = cvt_pk_bf16(v1[0], v1[1]); w.w = cvt_pk_bf16(v1[2], v1[3]);
                        const int col = col0 + bj * 128;
                        *(u32x4*)(base + ((size_t)((int)(row >> 12) * 8 + (col >> 6)) * SEQ + DPERM((int)row & (SEQ - 1))) * 64 + (col & 63)) = w; } }
        } else {
#pragma unroll
            for (int ai = 0; ai < 2; ++ai)
#pragma unroll
                for (int m = 0; m < 4; ++m) { const size_t row = (size_t)u.pm * 256 + ai * 128 + wr * 64 + m * 16 + fr;
#pragma unroll
                    for (int bj = 0; bj < 2; ++bj) { const f32x4 v0 = acc[ai][bj][m][0] * (1.f / WIN_SCALE), v1 = acc[ai][bj][m][1] * (1.f / WIN_SCALE);
                        const int seg = pn * 2 + bj;
                        if (seg < 5) {
                            float s = (v0[0] * v0[0] + v0[1] * v0[1]) + (v0[2] * v0[2] + v0[3] * v0[3]) + (v1[0] * v1[0] + v1[1] * v1[1]) + (v1[2] * v1[2] + v1[3] * v1[3]);
                            s += __shfl_xor(s, 16); s += __shfl_xor(s, 32);
                            if (fq == 0) SSQ[row * 32 + seg * 4 + wc] = s;
                            u32x4 w; w.x = cvt_pk_bf16(v0[0], v0[1]); w.y = cvt_pk_bf16(v0[2], v0[3]); w.z = cvt_pk_bf16(v1[0], v1[1]); w.w = cvt_pk_bf16(v1[2], v1[3]);
                            if (seg < 3) *(u32x4*)(CQ + row * 384 + seg * 128 + wc * 32 + 8 * fq) = w;
                            else *(u32x4*)(CKV + row * 256 + (seg - 3) * 128 + wc * 32 + 8 * fq) = w;
                        } else if (wc == 0) {
                            const int pos = (int)(row & (SEQ - 1)); const float* rp = rope + pos * 32 + 8 * (fq & 1);
                            const f32x4 c0 = *(const f32x4*)(rp), c1 = *(const f32x4*)(rp + 4), s0 = *(const f32x4*)(rp + 16), s1 = *(const f32x4*)(rp + 20);
                            f32x4 o0, o1;
#pragma unroll
                            for (int j = 0; j < 4; ++j) { const float a = v0[j], b = v1[j]; const float pa = __shfl_xor(a, 32), pb = __shfl_xor(b, 32);
                                o0[j] = fq < 2 ? a * c0[j] - pa * s0[j] : pa * s0[j] + a * c0[j];
                                o1[j] = fq < 2 ? b * c1[j] - pb * s1[j] : pb * s1[j] + b * c1[j]; }
                            u32x2 w; w.x = pk4_fp8(o0[0] * K8_SCALE, o0[1] * K8_SCALE, o0[2] * K8_SCALE, o0[3] * K8_SCALE); w.y = pk4_fp8(o1[0] * K8_SCALE, o1[1] * K8_SCALE, o1[2] * K8_SCALE, o1[3] * K8_SCALE);
                            unsigned char* k8 = (unsigned char*)KR + ((size_t)((row >> 12) * 8) * SEQ + (row & (SEQ - 1))) * 128 + 8 * fq;
#pragma unroll
                            for (int hh = 0; hh < 8; ++hh) { *(u32x2*)(k8 + (size_t)hh * SEQ * 128 + 64) = w; *(u32x2*)(k8 + (size_t)hh * SEQ * 128 + 96) = (u32x2){fq == 0 ? 0x00383838u : 0u, 0u}; }
                        } } }
        }
    }
};
struct EpiQ {
    bf16_t* Q; const float* SSQ; const float* rope;
    __device__ __forceinline__ void operator()(const f32x4 (&acc)[2][2][4][2], const Unit& u, int wr, int wc, int fr, int fq) const {
#pragma unroll
        for (int ai = 0; ai < 2; ++ai)
#pragma unroll
            for (int m = 0; m < 4; ++m) { const size_t row = (size_t)u.pm * 256 + ai * 128 + wr * 64 + m * 16 + fr;
                const f32x4 q0 = *(const f32x4*)(SSQ + row * 32), q1 = *(const f32x4*)(SSQ + row * 32 + 4), q2 = *(const f32x4*)(SSQ + row * 32 + 8);
                const float ss = ((q0[0] + q0[1]) + (q0[2] + q0[3])) + ((q1[0] + q1[1]) + (q1[2] + q1[3])) + ((q2[0] + q2[1]) + (q2[2] + q2[3]));
                const float rs = Q8_SCALE / sqrtf(ss * (1.f / Q_LORA) + NORM_EPS);
                const int pos = (int)(row & (SEQ - 1));
#pragma unroll
                for (int bj = 0; bj < 2; ++bj) { f32x4 v0 = acc[ai][bj][m][0] * rs, v1 = acc[ai][bj][m][1] * rs;
                    const int G32 = u.pn * 8 + bj * 4 + wc;
                    if (G32 % 3 == 2) {
                        const float* rp = rope + pos * 32 + 8 * (fq & 1);
                        const f32x4 c0 = *(const f32x4*)(rp), c1 = *(const f32x4*)(rp + 4), s0 = *(const f32x4*)(rp + 16), s1 = *(const f32x4*)(rp + 20);
                        f32x4 o0, o1;
#pragma unroll
                        for (int j = 0; j < 4; ++j) { const float a = v0[j], b = v1[j]; const float pa = __shfl_xor(a, 32), pb = __shfl_xor(b, 32);
                            o0[j] = fq < 2 ? a * c0[j] - pa * s0[j] : pa * s0[j] + a * c0[j];
                            o1[j] = fq < 2 ? b * c1[j] - pb * s1[j] : pb * s1[j] + b * c1[j]; }
                        v0 = o0; v1 = o1;
                    }
                    u32x2 w; w.x = pk4_fp8(v0[0], v0[1], v0[2], v0[3]); w.y = pk4_fp8(v1[0], v1[1], v1[2], v1[3]);
                    unsigned char* q8 = (unsigned char*)Q + ((size_t)((row >> 12) * 8 + G32 / 3) * SEQ + pos) * 128 + (G32 % 3) * 32 + 8 * fq;
                    *(u32x2*)q8 = w; if (G32 % 3 == 2) *(u32x2*)(q8 + 32) = (u32x2){0u, 0u}; }
                asm volatile("" ::: "memory"); }
    }
};
struct EpiKV {
    bf16_t* O; const float* SSQ;
    __device__ __forceinline__ void operator()(const f32x4 (&acc)[2][2][4][2], const Unit& u, int wr, int wc, int fr, int fq) const {
#pragma unroll
        for (int ai = 0; ai < 2; ++ai)
#pragma unroll
            for (int m = 0; m < 4; ++m) { const size_t row = (size_t)u.pm * 256 + ai * 128 + wr * 64 + m * 16 + fr;
                const f32x4 q0 = *(const f32x4*)(SSQ + row * 32 + 12), q1 = *(const f32x4*)(SSQ + row * 32 + 16);
                const float ss = ((q0[0] + q0[1]) + (q0[2] + q0[3])) + ((q1[0] + q1[1]) + (q1[2] + q1[3]));
                const float rs = 1.f / sqrtf(ss * (1.f / KV_LORA) + NORM_EPS);
#pragma unroll
                for (int bj = 0; bj < 2; ++bj) { const f32x4 v0 = acc[ai][bj][m][0] * rs, v1 = acc[ai][bj][m][1] * rs;
                    u32x4 w; w.x = cvt_pk_bf16(v0[0], v0[1]); w.y = cvt_pk_bf16(v0[2], v0[3]); w.z = cvt_pk_bf16(v1[0], v1[1]); w.w = cvt_pk_bf16(v1[2], v1[3]);
                    *(u32x4*)(O + row * 512 + u.pn * 256 + bj * 128 + wc * 32 + 8 * fq) = w; }
                asm volatile("" ::: "memory"); }
    }
};
struct EpiKN8 {
    unsigned char* K8; const float* SSQ;
    __device__ __forceinline__ void operator()(const f32x4 (&acc)[2][2][4][2], const Unit& u, int wr, int wc, int fr, int fq) const {
#pragma unroll
        for (int ai = 0; ai < 2; ++ai)
#pragma unroll
            for (int m = 0; m < 4; ++m) { const size_t row = (size_t)u.pm * 256 + ai * 128 + wr * 64 + m * 16 + fr;
                const f32x4 q0 = *(const f32x4*)(SSQ + row * 32 + 12), q1 = *(const f32x4*)(SSQ + row * 32 + 16);
                const float ss = ((q0[0] + q0[1]) + (q0[2] + q0[3])) + ((q1[0] + q1[1]) + (q1[2] + q1[3]));
                const float rs = K8_SCALE / sqrtf(ss * (1.f / KV_LORA) + NORM_EPS);
#pragma unroll
                for (int bj = 0; bj < 2; ++bj) { const f32x4 v0 = acc[ai][bj][m][0] * rs, v1 = acc[ai][bj][m][1] * rs;
                    const int col = u.pn * 256 + bj * 128 + wc * 32 + 8 * fq;
                    u32x2 w; w.x = pk4_fp8(v0[0], v0[1], v0[2], v0[3]); w.y = pk4_fp8(v1[0], v1[1], v1[2], v1[3]);
                    *(u32x2*)(K8 + ((size_t)((row >> 12) * 8 + (col >> 6)) * SEQ + (row & (SEQ - 1))) * 128 + (col & 63)) = w; }
                asm volatile("" ::: "memory"); }
    }
};
struct EpiVt8 {
    unsigned char* Vt; const float* SSQ;
    __device__ __forceinline__ void operator()(const f32x4 (&acc)[2][2][4][2], const Unit& u, int wr, int wc, int fr, int fq) const {
        float rs[2][8];
#pragma unroll
        for (int bj = 0; bj < 2; ++bj)
#pragma unroll
            for (int j = 0; j < 8; ++j) { const size_t tok = (size_t)u.pn * 256 + bj * 128 + wc * 32 + 8 * fq + j;
                const f32x4 q0 = *(const f32x4*)(SSQ + tok * 32 + 12), q1 = *(const f32x4*)(SSQ + tok * 32 + 16);
                rs[bj][j] = 1.f / sqrtf((((q0[0] + q0[1]) + (q0[2] + q0[3])) + ((q1[0] + q1[1]) + (q1[2] + q1[3]))) * (1.f / KV_LORA) + NORM_EPS); }
#pragma unroll
        for (int ai = 0; ai < 2; ++ai)
#pragma unroll
            for (int m = 0; m < 4; ++m) { const int ch = u.pm * 256 + ai * 128 + wr * 64 + m * 16 + fr;
#pragma unroll
                for (int bj = 0; bj < 2; ++bj) { const f32x4 v0 = acc[ai][bj][m][0], v1 = acc[ai][bj][m][1];
                    const int tok = u.pn * 256 + bj * 128 + wc * 32 + 8 * fq;
                    u32x2 w; w.x = pk4_fp8(v0[0] * rs[bj][0], v0[1] * rs[bj][1], v0[2] * rs[bj][2], v0[3] * rs[bj][3]); w.y = pk4_fp8(v1[0] * rs[bj][4], v1[1] * rs[bj][5], v1[2] * rs[bj][6], v1[3] * rs[bj][7]);
                    *(u32x2*)(Vt + ((size_t)((tok >> 12) * 512 + ch)) * SEQ + (tok & (SEQ - 1))) = w; } }
    }
};
struct EpiOut {
    bf16_t* out; const float* mod;
    __device__ __forceinline__ void operator()(const f32x4 (&acc)[2][2][4][2], const Unit& u, int wr, int wc, int fr, int fq) const {
#pragma unroll
        for (int ai = 0; ai < 2; ++ai)
#pragma unroll
            for (int m = 0; m < 4; ++m) { const size_t row = (size_t)u.pm * 256 + ai * 128 + wr * 64 + m * 16 + fr; const int b = (int)(row >> 12);
#pragma unroll
                for (int bj = 0; bj < 2; ++bj) { const int col = u.pn * 256 + bj * 128 + wc * 32 + 8 * fq;
                    const float* gp = mod + b * 6144 + 2048 + col;
                    const f32x4 g0 = *(const f32x4*)gp, g1 = *(const f32x4*)(gp + 4);
                    const f32x4 m0 = g0 * acc[ai][bj][m][0] * (DBG_MIX_F / (WOUT_SCALE * MIX_SCALE)), m1 = g1 * acc[ai][bj][m][1] * (DBG_MIX_F / (WOUT_SCALE * MIX_SCALE));
                    u32x4 w; w.x = cvt_pk_bf16(m0[0], m0[1]); w.y = cvt_pk_bf16(m0[2], m0[3]); w.z = cvt_pk_bf16(m1[0], m1[1]); w.w = cvt_pk_bf16(m1[2], m1[3]);
                    *(u32x4*)(out + row * 1024 + col) = w; } }
    }
};
struct EpiGU {
    bf16_t* H;
    __device__ __forceinline__ void operator()(const f32x4 (&acc)[2][2][4][2], const Unit& u, int wr, int wc, int fr, int fq) const {
#pragma unroll
        for (int ai = 0; ai < 2; ++ai)
#pragma unroll
            for (int m = 0; m < 4; ++m) { const unsigned row = (unsigned)(u.pm * 256 + ai * 128 + wr * 64 + m * 16 + fr);
                float o[8];
#pragma unroll
                for (int n = 0; n < 2; ++n)
#pragma unroll
                    for (int j = 0; j < 4; ++j) { const float ag = acc[ai][0][m][n][j], au = acc[ai][1][m][n][j];
                        constexpr float kk = WGU_SCALE * WGU_SCALE / HID_SCALE;
                        const float e = __builtin_amdgcn_exp2f(ag * (-LOG2E / WGU_SCALE));
                        o[n * 4 + j] = (ag * au) * __builtin_amdgcn_rcpf(__builtin_fmaf(e, kk, kk)); }
                u32x2 w; w.x = pk4_fp8(o[0], o[1], o[2], o[3]); w.y = pk4_fp8(o[4], o[5], o[6], o[7]);
                *(u32x2*)((unsigned char*)H + (row * 1536u + (unsigned)(u.pn * 128 + wc * 32 + 8 * fq))) = w; }
    }
};
struct EpiDown {
    bf16_t* Y; const float* vals;
    __device__ __forceinline__ void operator()(const f32x4 (&acc)[2][2][4][2], const Unit& u, int wr, int wc, int fr, int fq) const {
#pragma unroll
        for (int ai = 0; ai < 2; ++ai)
#pragma unroll
            for (int m = 0; m < 4; ++m) { const unsigned row = (unsigned)(u.pm * 256 + ai * 128 + wr * 64 + m * 16 + fr); const float vv = vals[row] * (Y_SCALE / (WD_SCALE * HID_SCALE));
#pragma unroll
                for (int bj = 0; bj < 2; ++bj) { const f32x4 v0 = acc[ai][bj][m][0] * vv, v1 = acc[ai][bj][m][1] * vv;
                    u32x2 w; w.x = pk4_fp8(v0[0], v0[1], v0[2], v0[3]); w.y = pk4_fp8(v1[0], v1[1], v1[2], v1[3]);
                    *(u32x2*)((unsigned char*)Y + (row * 1024u + (unsigned)(u.pn * 256 + bj * 128 + wc * 32 + 8 * fq))) = w; } }
    }
};

__device__ __forceinline__ s16x4 vtr(const LAS char* p) { return __builtin_bit_cast(s16x4, __builtin_amdgcn_ds_read_tr16_b64_v4i16((LAS s16x4*)p)); }
template <int ND0, int KPITCH, bool BIAS>
__device__ __forceinline__ void attn_tile(const LAS char* Kt, const LAS char* Vt, const bf16x8 (&qr)[ND0], float& m_run, float& l_run, f32x16& o0, f32x16& o1,
                                          const LAS float* tab, int lane) {
    const int r32 = lane & 31, hi = lane >> 5;
    f32x16 p0, p1;
#pragma unroll
    for (int r = 0; r < 16; ++r) { p0[r] = 0.f; p1[r] = 0.f; }
    const LAS char* kp = Kt + r32 * KPITCH + hi * 16;
    bf16x8 kf[2 * ND0];
#pragma unroll
    for (int d0 = 0; d0 < ND0; ++d0) { kf[2 * d0] = *(const LAS bf16x8*)(kp + d0 * 32); kf[2 * d0 + 1] = *(const LAS bf16x8*)(kp + 32 * KPITCH + d0 * 32); }
#pragma unroll
    for (int d0 = 0; d0 < ND0; ++d0) {
        p0 = __builtin_amdgcn_mfma_f32_32x32x16_bf16(kf[2 * d0], qr[d0], p0, 0, 0, 0);
        p1 = __builtin_amdgcn_mfma_f32_32x32x16_bf16(kf[2 * d0 + 1], qr[d0], p1, 0, 0, 0);
    }
    const LAS char* vp = Vt + (4 * hi + ((lane & 15) >> 2)) * 64 + ((lane >> 4) & 1) * 32 + (lane & 3) * 8;
    bf16x8 vf[8];
#pragma unroll
    for (int ks = 0; ks < 4; ++ks) {
        const s16x4 l0 = vtr(vp + ks * 1024), h0 = vtr(vp + ks * 1024 + 512), l1 = vtr(vp + 4096 + ks * 1024), h1 = vtr(vp + 4096 + ks * 1024 + 512);
        vf[2 * ks] = (bf16x8){l0[0], l0[1], l0[2], l0[3], h0[0], h0[1], h0[2], h0[3]}; vf[2 * ks + 1] = (bf16x8){l1[0], l1[1], l1[2], l1[3], h1[0], h1[1], h1[2], h1[3]};
    }
    __builtin_amdgcn_sched_barrier(0);
    if constexpr (BIAS) {
#pragma unroll
        for (int r = 0; r < 16; ++r) { const int kvl = (r & 3) + 8 * (r >> 2) + 4 * hi; p0[r] += tab[kvl]; p1[r] += tab[kvl + 32]; }
    }
    float mx = fmaxf(p0[0], p1[0]);
#pragma unroll
    for (int r = 1; r < 16; ++r) mx = fmaxf(mx, fmaxf(p0[r], p1[r]));
    mx = fmaxf(mx, __shfl_xor(mx, 32));
    const float m_new = fmaxf(m_run, mx);
    const float alpha = __builtin_amdgcn_exp2f(m_run - m_new);
    m_run = m_new;
    float rs = 0.f;
#pragma unroll
    for (int r = 0; r < 16; ++r) { p0[r] = __builtin_amdgcn_exp2f(p0[r] - m_new); p1[r] = __builtin_amdgcn_exp2f(p1[r] - m_new); rs += p0[r] + p1[r]; }
    l_run = l_run * alpha + rs;
#pragma unroll
    for (int r = 0; r < 16; ++r) { o0[r] *= alpha; o1[r] *= alpha; }
    bf16x8 pf[4];
#pragma unroll
    for (int ks = 0; ks < 4; ++ks) { u32x4 w;
        if (ks < 2) { w.x = cvt_pk_bf16(p0[8 * ks + 0], p0[8 * ks + 1]); w.y = cvt_pk_bf16(p0[8 * ks + 2], p0[8 * ks + 3]); w.z = cvt_pk_bf16(p0[8 * ks + 4], p0[8 * ks + 5]); w.w = cvt_pk_bf16(p0[8 * ks + 6], p0[8 * ks + 7]); }
        else { const int k2 = ks - 2; w.x = cvt_pk_bf16(p1[8 * k2 + 0], p1[8 * k2 + 1]); w.y = cvt_pk_bf16(p1[8 * k2 + 2], p1[8 * k2 + 3]); w.z = cvt_pk_bf16(p1[8 * k2 + 4], p1[8 * k2 + 5]); w.w = cvt_pk_bf16(p1[8 * k2 + 6], p1[8 * k2 + 7]); }
        pf[ks] = __builtin_bit_cast(bf16x8, w); }
#pragma unroll
    for (int ks = 0; ks < 4; ++ks) {
        o0 = __builtin_amdgcn_mfma_f32_32x32x16_bf16(vf[2 * ks], pf[ks], o0, 0, 0, 0);
        o1 = __builtin_amdgcn_mfma_f32_32x32x16_bf16(vf[2 * ks + 1], pf[ks], o1, 0, 0, 0);
    }
}

constexpr int MLA_KP = 144, MLA_KB = 64 * MLA_KP, MLA_VP = 80, MLA_BUF = MLA_KB + 64 * MLA_VP;
constexpr float MLA_POFS = 0.f;
__device__ __forceinline__ float max3f(float a, float b, float c) { float r; asm("v_max3_f32 %0, %1, %2, %3" : "=v"(r) : "v"(a), "v"(b), "v"(c)); return r; }
__device__ __forceinline__ float xhalf_max(float m) { auto rr = __builtin_amdgcn_permlane32_swap(__float_as_uint(m), __float_as_uint(m), false, false); float a = __uint_as_float(rr[0]), b = __uint_as_float(rr[1]); float r; asm("v_max_f32_e32 %0, %1, %2" : "=v"(r) : "v"(a), "v"(b)); return r; }
__device__ __forceinline__ float fmin126(float a) { float r; asm("v_min_f32_e32 %0, 0x42fc0000, %1" : "=v"(r) : "v"(a)); return r; }
__device__ __forceinline__ float xhalf_sum(float m) { auto rr = __builtin_amdgcn_permlane32_swap(__float_as_uint(m), __float_as_uint(m), false, false); return __uint_as_float(rr[0]) + __uint_as_float(rr[1]); }
__device__ __forceinline__ float rowmax32(const f32x16& p0, const f32x16& p1) {
    float a = max3f(p0[0], p0[1], p1[0]), b = max3f(p0[2], p0[3], p1[1]); a = max3f(a, p1[2], p1[3]);
#pragma unroll
    for (int r = 4; r < 16; r += 4) { a = max3f(a, p0[r], p0[r + 1]); b = max3f(b, p0[r + 2], p0[r + 3]); a = max3f(a, p1[r], p1[r + 1]); b = max3f(b, p1[r + 2], p1[r + 3]); }
    float m; asm("v_max_f32_e32 %0, %1, %2" : "=v"(m) : "v"(a), "v"(b));
    return xhalf_max(m);
}
template <int ND0, int KPITCH>
__device__ __forceinline__ void qk_tile(f32x16& p0, f32x16& p1, const LAS char* Kt, const bf16x8 (&qr)[ND0], const f32x16& cinit, int lane) {
    const LAS char* kp = Kt + (lane & 31) * KPITCH + (lane >> 5) * 16;
#pragma unroll
    for (int d0 = 0; d0 < ND0; ++d0) {
        const bf16x8 a0 = *(const LAS bf16x8*)(kp + d0 * 32), a1 = *(const LAS bf16x8*)(kp + 32 * KPITCH + d0 * 32);
        if (d0 == 0) { p0 = __builtin_amdgcn_mfma_f32_32x32x16_bf16(a0, qr[0], cinit, 0, 0, 0); p1 = __builtin_amdgcn_mfma_f32_32x32x16_bf16(a1, qr[0], cinit, 0, 0, 0); }
        else { p0 = __builtin_amdgcn_mfma_f32_32x32x16_bf16(a0, qr[d0], p0, 0, 0, 0); p1 = __builtin_amdgcn_mfma_f32_32x32x16_bf16(a1, qr[d0], p1, 0, 0, 0); }
    }
}
__device__ __forceinline__ void pv_tile(f32x16& o0, f32x16& o1, const f32x16& p0, const f32x16& p1, const LAS char* Vt, int lane) {
    const int hi = lane >> 5;
    bf16x8 pf[4];
#pragma unroll
    for (int ks = 0; ks < 4; ++ks) { u32x4 w;
        if (ks < 2) { w.x = cvt_pk_bf16(p0[8 * ks + 0], p0[8 * ks + 1]); w.y = cvt_pk_bf16(p0[8 * ks + 2], p0[8 * ks + 3]); w.z = cvt_pk_bf16(p0[8 * ks + 4], p0[8 * ks + 5]); w.w = cvt_pk_bf16(p0[8 * ks + 6], p0[8 * ks + 7]); }
        else { const int k2 = ks - 2; w.x = cvt_pk_bf16(p1[8 * k2 + 0], p1[8 * k2 + 1]); w.y = cvt_pk_bf16(p1[8 * k2 + 2], p1[8 * k2 + 3]); w.z = cvt_pk_bf16(p1[8 * k2 + 4], p1[8 * k2 + 5]); w.w = cvt_pk_bf16(p1[8 * k2 + 6], p1[8 * k2 + 7]); }
        pf[ks] = __builtin_bit_cast(bf16x8, w); }
    const LAS char* vp = Vt + (4 * hi + ((lane & 15) >> 2)) * 64 + ((lane >> 4) & 1) * 32 + (lane & 3) * 8;
#pragma unroll
    for (int ks = 0; ks < 4; ++ks) {
        const s16x4 l0 = vtr(vp + ks * 1024), h0 = vtr(vp + ks * 1024 + 512), l1 = vtr(vp + 4096 + ks * 1024), h1 = vtr(vp + 4096 + ks * 1024 + 512);
        const bf16x8 v0 = (bf16x8){l0[0], l0[1], l0[2], l0[3], h0[0], h0[1], h0[2], h0[3]}, v1 = (bf16x8){l1[0], l1[1], l1[2], l1[3], h1[0], h1[1], h1[2], h1[3]};
        o0 = __builtin_amdgcn_mfma_f32_32x32x16_bf16(v0, pf[ks], o0, 0, 0, 0);
        o1 = __builtin_amdgcn_mfma_f32_32x32x16_bf16(v1, pf[ks], o1, 0, 0, 0);
    }
}
#define SGB(mask, n) __builtin_amdgcn_sched_group_barrier(mask, n, 0)
__device__ __forceinline__ unsigned enc3_fp8(float v) {
    const int w1 = __builtin_amdgcn_cvt_pk_fp8_f32(__builtin_amdgcn_fmed3f(v, -448.f, 448.f), 0.f, 0, false); const float r1 = v - __builtin_amdgcn_cvt_f32_fp8(w1, 0);
    const int w2 = __builtin_amdgcn_cvt_pk_fp8_f32(__builtin_amdgcn_fmed3f(r1, -448.f, 448.f), 0.f, 0, false); const float r2 = r1 - __builtin_amdgcn_cvt_f32_fp8(w2, 0);
    const int w3 = __builtin_amdgcn_cvt_pk_fp8_f32(__builtin_amdgcn_fmed3f(r2, -448.f, 448.f), 0.f, 0, false);
    return ((unsigned)w1 & 0xffu) | (((unsigned)w2 & 0xffu) << 8) | (((unsigned)w3 & 0xffu) << 16);
}
__device__ __forceinline__ void mla_unit(Frame& F, int b, int h, int qb) {
    int tid = F.tid; asm volatile("" : "+v"(tid));
    const int lane = tid & 63, wid = F.wave, r32 = lane & 31, hi = lane >> 5;
    const unsigned char* Q8 = WSP(const unsigned char, WS_Q); const unsigned char* K8 = WSP(const unsigned char, WS_KN); const unsigned char* Vt8 = WSP(const unsigned char, WS_V);
    bf16_t* MIX = WSP(bf16_t, WS_MIX);
    const size_t tok0 = (size_t)b * SEQ;
    const int q0 = qb * 512 + wid * 64 + r32;
    i32x8 qA[2], qB[2];
    { const unsigned char* qp = Q8 + ((size_t)(b * 8 + h) * SEQ + q0) * 128 + 32 * hi;
#pragma unroll
      for (int ks = 0; ks < 2; ++ks) { const i32x4 lo = *(const i32x4*)(qp + 64 * ks), hh = *(const i32x4*)(qp + 64 * ks + 16); qA[ks] = __builtin_shufflevector(lo, hh, 0, 1, 2, 3, 4, 5, 6, 7);
          const i32x4 lo2 = *(const i32x4*)(qp + 32 * 128 + 64 * ks), hh2 = *(const i32x4*)(qp + 32 * 128 + 64 * ks + 16); qB[ks] = __builtin_shufflevector(lo2, hh2, 0, 1, 2, 3, 4, 5, 6, 7); } }
    const int kv_s = tid >> 3, c_s = tid & 7;
    const unsigned char* k_base = K8 + (size_t)(b * 8 + h) * SEQ * 128; const unsigned k_off = (unsigned)(kv_s * 128 + c_s * 16);
    const unsigned char* v_base = Vt8 + (size_t)(b * 8 + h) * 64 * SEQ; const unsigned v_off = (unsigned)(((tid >> 2) & 63) * SEQ + (tid & 3) * 16);
    const int k_dst = (((kv_s & 31) << 1) | (kv_s >> 5)) * MLA_KP + c_s * 16, v_dst = MLA_KB + ((tid >> 2) & 63) * MLA_VP + (tid & 3) * 16;
    LAS char* lds = (LAS char*)F.lds;
    f32x16 oA0, oA1, oB0, oB1;
#pragma unroll
    for (int r = 0; r < 16; ++r) { oA0[r] = 0.f; oA1[r] = 0.f; oB0[r] = 0.f; oB1[r] = 0.f; }
    float lA = 0.f, lB = 0.f;
    const f32x16 zero16 = (f32x16){0.f, 0.f, 0.f, 0.f, 0.f, 0.f, 0.f, 0.f, 0.f, 0.f, 0.f, 0.f, 0.f, 0.f, 0.f, 0.f};
    const int selw = ((((lane & 15) >> 2) & 1) == ((lane >> 4) & 1)) ? 0x38383838 : 0;
    const i32x8 sel8 = (i32x8){selw, selw, selw, selw, selw, selw, selw, selw};
    const f32x4 zero4 = (f32x4){0.f, 0.f, 0.f, 0.f};
#define MLA_SUM8(b) __builtin_amdgcn_mfma_scale_f32_16x16x128_f8f6f4(sel8, b, zero4, 0, 0, 0, 0, 0, 0)
    u32x4 rk0, rv0, rk1, rv1;
#define MLA_LOADG(t, rk, rv) do { const unsigned o_ = (unsigned)((t) < 64 ? (t) : 63) * 64u; rk = *(const u32x4*)(k_base + (k_off + o_ * 128u)); rv = *(const u32x4*)(v_base + (v_off + o_)); } while (0)
#define MLA_STORE_OFF(off, rk, rv) do { LAS char* d_ = lds + (off); *(LAS u32x4*)(d_ + k_dst) = rk; *(LAS u32x4*)(d_ + v_dst) = rv; } while (0)
#define MLA_KFRAG(dst, base, a, ks) do { const LAS char* p_ = (base) + (a) * 32 * MLA_KP + (ks) * 64; \
        const i32x4 lo_ = *(const LAS i32x4*)p_, hi_ = *(const LAS i32x4*)(p_ + 16); dst = __builtin_shufflevector(lo_, hi_, 0, 1, 2, 3, 4, 5, 6, 7); } while (0)
#define MLA_MFMA8(a, b, c) __builtin_amdgcn_mfma_scale_f32_32x32x64_f8f6f4(a, b, c, 0, 0, 0, 0, 0, 0)
    static_assert(6 * MLA_BUF <= RING_BYTES, "MLA ring");
    const int sig = 32 * ((r32 >> 2) & 1) + (r32 & 3) + 4 * (r32 >> 3);
    const LAS char* kp0 = lds + (2 * (sig & 31) + (sig >> 5)) * MLA_KP + hi * 32;
    const LAS char* vp0 = lds + MLA_KB + r32 * MLA_VP + 32 * hi;
    MLA_LOADG(0, rk0, rv0); MLA_LOADG(1, rk1, rv1); MLA_STORE_OFF(0, rk0, rv0); MLA_STORE_OFF(MLA_BUF, rk1, rv1);
    MLA_LOADG(2, rk0, rv0); MLA_LOADG(3, rk1, rv1); MLA_STORE_OFF(2 * MLA_BUF, rk0, rv0); MLA_STORE_OFF(3 * MLA_BUF, rk1, rv1);
    __syncthreads();
    MLA_LOADG(4, rk0, rv0); MLA_LOADG(5, rk1, rv1);
    i32x8 kf[4];
#define MLA_KFRAGS(slot) do { const LAS char* kp_ = kp0 + (slot); MLA_KFRAG(kf[0], kp_, 0, 0); MLA_KFRAG(kf[1], kp_, 0, 1); MLA_KFRAG(kf[2], kp_, 1, 0); MLA_KFRAG(kf[3], kp_, 1, 1); } while (0)
#define MLA_VFRAGS(slot) do { const LAS char* vp_ = vp0 + (slot); \
        _Pragma("unroll") for (int dh = 0; dh < 2; ++dh) { const i32x4 lo_ = *(const LAS i32x4*)(vp_ + dh * 32 * MLA_VP), hi_ = *(const LAS i32x4*)(vp_ + dh * 32 * MLA_VP + 16); vf[dh] = __builtin_shufflevector(lo_, hi_, 0, 1, 2, 3, 4, 5, 6, 7); } } while (0)
#define MLA_SCORE(q) do { s0 = MLA_MFMA8(kf[0], q[0], zero16); s1 = MLA_MFMA8(kf[2], q[0], zero16); s0 = MLA_MFMA8(kf[1], q[1], s0); s1 = MLA_MFMA8(kf[3], q[1], s1); } while (0)
    f32x16 s0, s1; i32x8 vf[2];
    MLA_KFRAGS(0);
    { MLA_SCORE(qA); const unsigned ea = enc3_fp8(56.5f + 8.f * MLA_POFS - rowmax32(s0, s1));
      MLA_SCORE(qB); const unsigned eb = enc3_fp8(56.5f + 8.f * MLA_POFS - rowmax32(s0, s1));
      qA[1][0] = hi ? (int)ea : qA[1][0]; qB[1][0] = hi ? (int)eb : qB[1][0]; }
#define MLA_PBYTES(pf_) do { _Pragma("unroll") for (int g_ = 0; g_ < 4; ++g_) { unsigned b0_ = 0u, b1_ = 0u; \
            _Pragma("unroll") for (int j_ = 0; j_ < 4; ++j_) { b0_ = __builtin_amdgcn_cvt_pk_u8_f32(s0[4 * g_ + j_], j_, b0_); b1_ = __builtin_amdgcn_cvt_pk_u8_f32(s1[4 * g_ + j_], j_, b1_); } \
            pf_[g_] = (int)b0_; pf_[4 + g_] = (int)b1_; } } while (0)
#define SB0() __builtin_amdgcn_sched_barrier(0)
#define MLA_TILE(this_slot, next_slot) do { i32x8 pf_; \
        MLA_PBYTES(pf_); SB0(); lB += t_[0]; MLA_VFRAGS(this_slot); SB0(); MLA_SCORE(qB); SB0(); \
        oA0 = MLA_MFMA8(vf[0], pf_, oA0); oA1 = MLA_MFMA8(vf[1], pf_, oA1); t_ = MLA_SUM8(pf_); SB0(); \
        MLA_PBYTES(pf_); SB0(); lA += t_[0]; MLA_KFRAGS(next_slot); SB0(); \
        oB0 = MLA_MFMA8(vf[0], pf_, oB0); oB1 = MLA_MFMA8(vf[1], pf_, oB1); t_ = MLA_SUM8(pf_); SB0(); MLA_SCORE(qA); SB0(); } while (0)
    MLA_SCORE(qA); f32x4 t_ = zero4;
    if (wid < 4) __builtin_amdgcn_s_setprio(3); else __builtin_amdgcn_s_setprio(1);
    int sl = 0;
#pragma unroll 1
    for (int tp = 0; tp < 32; ++tp) {
        const int s_a = sl * MLA_BUF, s_b = s_a + MLA_BUF, sl2 = sl + 2 >= 6 ? sl - 4 : sl + 2, s_c = sl2 * MLA_BUF, sl4 = sl2 + 2 >= 6 ? sl2 - 4 : sl2 + 2, f_a = sl4 * MLA_BUF, f_b = f_a + MLA_BUF;
        MLA_STORE_OFF(f_a, rk0, rv0); MLA_STORE_OFF(f_b, rk1, rv1);
        MLA_LOADG(2 * tp + 6, rk0, rv0); MLA_LOADG(2 * tp + 7, rk1, rv1);
        __builtin_amdgcn_sched_barrier(0);
        MLA_TILE(s_a, s_b);
        MLA_TILE(s_b, s_c);
        asm volatile("s_waitcnt lgkmcnt(0)" ::: "memory"); __builtin_amdgcn_s_barrier(); asm volatile("" ::: "memory");
        sl = sl2;
    }
    lB += t_[0];
    __builtin_amdgcn_s_setprio(0);
#undef MLA_TILE
#undef SB0
#undef MLA_PBYTES
#undef MLA_SCORE
#undef MLA_KFRAGS
#undef MLA_VFRAGS
#undef MLA_KFRAG
#undef MLA_MFMA8
#undef MLA_STORE_OFF
#undef MLA_LOADG
    int tid2 = F.tid; asm volatile("" : "+v"(tid2));
    const int hi2 = (tid2 >> 5) & 1; const size_t orow0 = tok0 + qb * 512 + wid * 64 + (tid2 & 31);
#pragma unroll
    for (int grp = 0; grp < 2; ++grp) {
        const f32x16& o0 = grp ? oB0 : oA0; const f32x16& o1 = grp ? oB1 : oA1;
        const float inv = DBG_MLA_F / (grp ? lB : lA);
        unsigned char* orow = (unsigned char*)MIX + (orow0 + 32 * grp) * 1024 + h * 64 + 8 * hi2;
        const float invs = inv * MIX_SCALE;
#pragma unroll
        for (int hf = 0; hf < 2; ++hf) { const f32x16& oo = hf ? o1 : o0;
#pragma unroll
            for (int gp = 0; gp < 2; ++gp) { const int e0 = 8 * gp;
                const unsigned a4 = pk4_fp8(oo[e0] * invs, oo[e0 + 1] * invs, oo[e0 + 2] * invs, oo[e0 + 3] * invs), b4 = pk4_fp8(oo[e0 + 4] * invs, oo[e0 + 5] * invs, oo[e0 + 6] * invs, oo[e0 + 7] * invs);
                const unsigned rcv = (unsigned)__shfl_xor((int)(hi2 ? a4 : b4), 32);
                *(u32x2*)(orow + hf * 32 + 16 * gp) = hi2 ? (u32x2){rcv, b4} : (u32x2){a4, rcv}; }
        }
    }
}

constexpr int DIL_KP = 144, DIL_KB = 64 * DIL_KP, DIL_BUF = DIL_KB + 8192, DIL_PAIR = 2 * DIL_BUF, DIL_TAB = 4 * DIL_PAIR;
static_assert(DIL_TAB + 3 * 320 * 4 <= RING_BYTES, "dilated LDS");
template <int MODE>
__device__ __forceinline__ void dil_unit(Frame& F, int b, int h, int sb) {
    const int tid = F.tid, lane = F.lane, wid = F.wave, r32 = lane & 31, hi = lane >> 5;
    const bf16_t* DQ = WSP(const bf16_t, WS_DQ); const bf16_t* DK = WSP(const bf16_t, WS_DK); const bf16_t* DV = WSP(const bf16_t, WS_DV);
    bf16_t* O1 = WSP(bf16_t, WS_O1); bf16_t* O2 = WSP(bf16_t, WS_O2); float* LSE = WSP(float, WS_LSE); bf16_t* MIX = WSP(bf16_t, WS_MIX);
    LAS char* lds = (LAS char*)F.lds;
    LAS float* tab = (LAS float*)(lds + DIL_TAB);
    { const float* tg = WSP(const float, WS_TABG); for (int i = tid; i < 960; i += NTHR) tab[i] = tg[((i / 320) * 8 + h) * 320 + (i % 320)]; }
    const int pair = wid >> 1, pt = (wid & 1) * 64 + lane;
    LAS char* pl = lds + pair * DIL_PAIR;
    const size_t tok0 = (size_t)b * SEQ, hrow0 = (size_t)(b * 8 + h) * SEQ;
    const int qi = (wid & 1) * 32 + r32;
#define DIL_BLK(p_, rho_, dsh_, nb_, r_, n_) const int dsh_ = 2 * (p_), nb_ = 64 >> dsh_; const int i__ = 4 * (rho_) + pair, nbsb__ = 16 >> dsh_, r_ = i__ / nbsb__, n_ = ((sb * 1024) >> dsh_) / 64 + i__ % nbsb__
    u32x4 rk[4], rv[4]; bf16x8 qr[4], qn[4];
#define DIL_LOAD(ts_) do { const int p__ = (ts_) / 12, rho__ = ((ts_) % 12) / 3, jt__ = (ts_) % 3; DIL_BLK(p__, rho__, dsh__, nb__, r__, n__); \
        int kb_ = n__ - 1 + jt__; kb_ = kb_ < 0 ? 0 : (kb_ >= nb__ ? nb__ - 1 : kb_); \
        _Pragma("unroll") for (int c_ = 0; c_ < 4; ++c_) { const int ch_ = pt + 128 * c_, kv_ = ch_ >> 3, cc_ = ch_ & 7; \
            const size_t kpos_ = (size_t)((kb_ * 64 + kv_) << dsh__) + r__; \
            const size_t ko_ = (hrow0 + DPERM((int)kpos_)) * 64 + cc_ * 8; rk[c_] = *(const u32x4*)(DK + ko_); rv[c_] = *(const u32x4*)(DV + ko_); } } while (0)
#define DIL_STORE(buf) do { _Pragma("unroll") for (int c_ = 0; c_ < 4; ++c_) { const int ch_ = pt + 128 * c_, kv_ = ch_ >> 3, cc_ = ch_ & 7; \
            *(LAS u32x4*)(pl + (buf) * DIL_BUF + kv_ * DIL_KP + cc_ * 16) = rk[c_]; \
            *(LAS u32x4*)(pl + (buf) * DIL_BUF + DIL_KB + (cc_ >> 2) * 4096 + kv_ * 64 + (cc_ & 3) * 16) = rv[c_]; } } while (0)
#define DIL_QLOAD(dst, blk_) do { const int p__ = (blk_) / 4, rho__ = (blk_) % 4; DIL_BLK(p__, rho__, dsh__, nb__, r__, n__); (void)nb__; \
        const size_t qpos__ = (size_t)((n__ * 64 + qi) << dsh__) + r__; \
        _Pragma("unroll") for (int d0 = 0; d0 < 4; ++d0) dst[d0] = *(const bf16x8*)(DQ + (hrow0 + DPERM((int)qpos__)) * 64 + d0 * 16 + hi * 8); } while (0)
    DIL_LOAD(0); DIL_QLOAD(qr, 0); DIL_STORE(0);
    asm volatile("" :: "v"(qr[0]), "v"(qr[1]), "v"(qr[2]), "v"(qr[3]));
    __syncthreads();
    float m_run = NEG_BIG, l_run = 0.f; f32x16 o0, o1;
#pragma unroll 1
    for (int ts = 0; ts < 36; ++ts) {
        const int p = ts / 12, rho = (ts % 12) / 3, jt = ts % 3;
        DIL_BLK(p, rho, dsh, nb, r, n);
        if (MODE != 2 && ts + 1 < 36) DIL_LOAD(ts + 1);
        if (jt == 1 && ts + 2 < 36) DIL_QLOAD(qn, ts / 3 + 1);
        if (jt == 0) { m_run = NEG_BIG; l_run = 0.f;
#pragma unroll
            for (int rr = 0; rr < 16; ++rr) { o0[rr] = 0.f; o1[rr] = 0.f; } }
        const int kb = n - 1 + jt;
        if (MODE != 1 && kb >= 0 && kb < nb) {
            const LAS float* tq = tab + p * 320 + (64 * (jt - 1) - qi + 127);
            attn_tile<4, DIL_KP, true>(pl + (ts & 1) * DIL_BUF, pl + (ts & 1) * DIL_BUF + DIL_KB, qr, m_run, l_run, o0, o1, tq, lane);
        }
        if (MODE != 2 && ts + 1 < 36) DIL_STORE((ts + 1) & 1);
        if (jt == 2) asm volatile("" :: "v"(qn[0]), "v"(qn[1]), "v"(qn[2]), "v"(qn[3]));
        if (MODE != 0 && jt == 2) { if (m_run == 12345.f) MIX[0] = (bf16_t)(int)(l_run + o0[3] + o1[5]); }
        if (MODE == 0 && jt == 2) {
            const size_t qpos = (size_t)((n * 64 + qi) << dsh) + r;
            const float lt = l_run + __shfl_xor(l_run, 32); const float inv = 1.f / lt;
            const float lse = m_run + __builtin_amdgcn_logf(lt);
            const size_t grow = tok0 + qpos, prow = hrow0 + DPERM((int)qpos);
            if (p < 2) {
                bf16_t* orow = (p == 0 ? O1 : O2) + prow * 64 + 32 * hi;
#pragma unroll
                for (int k = 0; k < 4; ++k) { const f32x16& oo = k < 2 ? o0 : o1; const int e0 = 8 * (k & 1);
                    u32x4 w; w.x = cvt_pk_bf16(oo[e0] * inv, oo[e0 + 1] * inv); w.y = cvt_pk_bf16(oo[e0 + 2] * inv, oo[e0 + 3] * inv); w.z = cvt_pk_bf16(oo[e0 + 4] * inv, oo[e0 + 5] * inv); w.w = cvt_pk_bf16(oo[e0 + 6] * inv, oo[e0 + 7] * inv);
                    *(u32x4*)(orow + 8 * k) = w; }
                if (hi == 0) LSE[(size_t)p * BATCH * DIL_H * SEQ + prow] = lse;
            } else {
                const float l0 = LSE[prow], l1 = LSE[(size_t)BATCH * DIL_H * SEQ + prow];
                const float mm = fmaxf(fmaxf(l0, l1), lse);
                const float e0 = __builtin_amdgcn_exp2f(l0 - mm), e1 = __builtin_amdgcn_exp2f(l1 - mm), e2 = __builtin_amdgcn_exp2f(lse - mm);
                const float isum = DBG_DIL_F / (e0 + e1 + e2); const float w0 = e0 * isum, w1 = e1 * isum, w2 = e2 * isum * inv;
                const bf16_t* a1 = O1 + prow * 64; const bf16_t* a2 = O2 + prow * 64;
                unsigned char* orow = (unsigned char*)MIX + grow * 1024 + 512 + h * 64;
                u32x4 xa[4], xb[4];
#pragma unroll
                for (int k = 0; k < 4; ++k) { xa[k] = *(const u32x4*)(a1 + 32 * hi + 8 * k); xb[k] = *(const u32x4*)(a2 + 32 * hi + 8 * k); }
                unsigned wm[2][4];
#pragma unroll
                for (int g = 0; g < 4; ++g) {
#pragma unroll
                    for (int hf = 0; hf < 2; ++hf) {
                        const u32x4& A1 = xa[hf * 2 + (g >> 1)]; const u32x4& A2 = xb[hf * 2 + (g >> 1)];
                        u32x2 x1, x2; x1.x = (g & 1) ? A1.z : A1.x; x1.y = (g & 1) ? A1.w : A1.y; x2.x = (g & 1) ? A2.z : A2.x; x2.y = (g & 1) ? A2.w : A2.y;
                        const f32x16& oo = hf ? o1 : o0;
                        const float y0 = w0 * bf_lo(x1.x) + w1 * bf_lo(x2.x) + w2 * oo[4 * g], y1 = w0 * bf_hi(x1.x) + w1 * bf_hi(x2.x) + w2 * oo[4 * g + 1];
                        const float y2 = w0 * bf_lo(x1.y) + w1 * bf_lo(x2.y) + w2 * oo[4 * g + 2], y3 = w0 * bf_hi(x1.y) + w1 * bf_hi(x2.y) + w2 * oo[4 * g + 3];
                        wm[hf][g] = pk4_fp8(y0 * MIX_SCALE, y1 * MIX_SCALE, y2 * MIX_SCALE, y3 * MIX_SCALE);
                    }
                }
#pragma unroll
                for (int hf = 0; hf < 2; ++hf)
#pragma unroll
                    for (int gp = 0; gp < 2; ++gp) {
                        const unsigned rcv = (unsigned)__shfl_xor((int)(hi ? wm[hf][2 * gp] : wm[hf][2 * gp + 1]), 32);
                        *(u32x2*)(orow + hf * 32 + 16 * gp + 8 * hi) = hi ? (u32x2){rcv, wm[hf][2 * gp + 1]} : (u32x2){wm[hf][2 * gp], rcv};
                    }
            }
#pragma unroll
            for (int d0 = 0; d0 < 4; ++d0) qr[d0] = qn[d0];
        }
        if (ts == 25) VM_WAIT();
        __syncthreads();
    }
#undef DIL_LOAD
#undef DIL_STORE
#undef DIL_QLOAD
#undef DIL_BLK
}

__device__ __forceinline__ void transpose_item(const float* W, int ldn, int K, int k0, int n0, bf16_t* WT, int drow, const float* kscale, LAS float* scr, int lane) {
#pragma unroll 8
    for (int i = 0; i < 32; ++i) { const int kk = 2 * i + (lane >> 5); float v = W[(size_t)(k0 + kk) * ldn + n0 + (lane & 31)]; if (kscale) v *= kscale[k0 + kk]; scr[kk * 33 + (lane & 31)] = v; }
    LDS_WAIT(); asm volatile("" ::: "memory");
    const int c = lane & 7;
#pragma unroll
    for (int j = 0; j < 4; ++j) { const int n = (lane >> 3) + 8 * j; const LAS float* s = scr + (8 * c) * 33 + n;
        u32x4 o; o.x = pk2(s[0 * 33], s[1 * 33]); o.y = pk2(s[2 * 33], s[3 * 33]); o.z = pk2(s[4 * 33], s[5 * 33]); o.w = pk2(s[6 * 33], s[7 * 33]);
        *(u32x4*)(WT + (size_t)(drow + n) * K + k0 + 8 * c) = o; }
    LDS_WAIT(); asm volatile("" ::: "memory");
}
__device__ __forceinline__ void transpose_item_f8(const float* W, int ldn, int K, int k0, int n0, unsigned char* WT, int drow, float qs, LAS float* scr, int lane) {
#pragma unroll 8
    for (int i = 0; i < 32; ++i) { const int kk = 2 * i + (lane >> 5); scr[kk * 33 + (lane & 31)] = W[(size_t)(k0 + kk) * ldn + n0 + (lane & 31)] * qs; }
    LDS_WAIT(); asm volatile("" ::: "memory");
    const int c = lane & 7;
#pragma unroll
    for (int j = 0; j < 4; ++j) { const int n = (lane >> 3) + 8 * j; const LAS float* s_ = scr + (8 * c) * 33 + n;
        u32x2 o; o.x = pk4_fp8(s_[0 * 33], s_[1 * 33], s_[2 * 33], s_[3 * 33]); o.y = pk4_fp8(s_[4 * 33], s_[5 * 33], s_[6 * 33], s_[7 * 33]);
        *(u32x2*)(WT + (size_t)(drow + n) * K + k0 + 8 * c) = o; }
    LDS_WAIT(); asm volatile("" ::: "memory");
}
__device__ __forceinline__ void transpose_item64(const float* W, int ldn, int K, int k0, int n0, bf16_t* WT, int drow, LAS float* scr, int lane, float qs, float qis) {
    f32x4 v[16];
    const float* src = W + (size_t)(k0 + (lane >> 4)) * ldn + n0 + 4 * (lane & 15);
#pragma unroll
    for (int j = 0; j < 16; ++j) v[j] = __builtin_nontemporal_load((const f32x4*)(src + (size_t)(4 * j) * ldn));
    LAS float* sw = scr + (lane >> 4) * 65 + 4 * (lane & 15);
#pragma unroll
    for (int j = 0; j < 16; ++j) { sw[(4 * j) * 65 + 0] = v[j][0]; sw[(4 * j) * 65 + 1] = v[j][1]; sw[(4 * j) * 65 + 2] = v[j][2]; sw[(4 * j) * 65 + 3] = v[j][3]; }
    LDS_WAIT(); asm volatile("" ::: "memory");
    const int c = lane & 7;
#pragma unroll
    for (int jj = 0; jj < 8; ++jj) { const int n = (lane >> 3) + 8 * jj; const LAS float* s = scr + (8 * c) * 65 + n;
        u32x2 o; o.x = pk4_fp8(s[0 * 65] * qs, s[1 * 65] * qs, s[2 * 65] * qs, s[3 * 65] * qs); o.y = pk4_fp8(s[4 * 65] * qs, s[5 * 65] * qs, s[6 * 65] * qs, s[7 * 65] * qs);
        *(u32x2*)((unsigned char*)WT + (size_t)(drow + n) * K + k0 + 8 * c) = o; }
    LDS_WAIT(); asm volatile("" ::: "memory");
}
__device__ __forceinline__ int t5_bucket_dev(int rel) {
    const int n = rel < 0 ? -rel : rel; int v;
    if (n < 8) v = n; else v = n < 15 ? 8 : n < 27 ? 9 : n < 50 ? 10 : n < 91 ? 11 : n < 166 ? 12 : n < 305 ? 13 : n < 559 ? 14 : 15;
    return (rel > 0 ? 16 : 0) + v;
}
__device__ __forceinline__ void p0_prologue(Frame& F) { const KArgs ka = kargs();
    struct { const float *c, *w_ada, *w_in, *w_uq, *q_norm_g, *w_ukv, *kv_norm_g, *w_out, *rel_bias; } a;
    a.c = ka->c; a.w_ada = ka->w_ada; a.w_in = ka->w_in; a.w_uq = ka->w_uq; a.q_norm_g = ka->q_norm_g; a.w_ukv = ka->w_ukv; a.kv_norm_g = ka->kv_norm_g; a.w_out = ka->w_out; a.rel_bias = ka->rel_bias;
    LAS float* scr = (LAS float*)(F.lds + 32768 + F.wave * 8704);
    LAS float* sil = (LAS float*)F.lds;
    for (int i = F.tid; i < BATCH * D_MODEL; i += NTHR) { const float v = a.c[i]; sil[i] = v / (1.f + __expf(-v)); }
    __syncthreads();
    const int gw = F.vcu * NWAVES + F.wave, NGW = F.G * NWAVES, lane = F.lane;
    for (int it = gw; it < 16 * 24; it += NGW) {
        const int kb = it / 24, nb = it % 24, k0 = kb * 64, n0 = nb * 256 + lane * 4;
        f32x4 acc[8];
#pragma unroll
        for (int b = 0; b < 8; ++b) acc[b] = (f32x4){0.f, 0.f, 0.f, 0.f};
#pragma unroll 16
        for (int k = 0; k < 64; ++k) { const f32x4 w = *(const f32x4*)(a.w_ada + (size_t)(k0 + k) * 6144 + n0);
#pragma unroll
            for (int b = 0; b < 8; ++b) acc[b] += w * sil[b * 1024 + k0 + k]; }
        float* mp = WSP(float, WS_MODP) + (size_t)kb * 8 * 6144 + n0;
#pragma unroll
        for (int b = 0; b < 8; ++b) *(f32x4*)(mp + b * 6144) = acc[b];
    }
    {
        bf16_t* WIN = WSP(bf16_t, WS_WIN); bf16_t* WUQ = WSP(bf16_t, WS_WUQ); bf16_t* WK = WSP(bf16_t, WS_WK); bf16_t* WV = WSP(bf16_t, WS_WV); bf16_t* WOUT = WSP(bf16_t, WS_WOUT);
        constexpr int I_IN = 16 * 69, I_UQ = 6 * 24, I_KV = 4 * 32, I_OUT = 16 * 32, NIT = I_IN + I_UQ + I_KV + I_OUT;
        for (int it = NGW - 1 - gw; it < NIT; it += NGW) {
            int r = it;
            if (r < I_IN) { const int kb = r / 69, g = r % 69, n0 = g * 32; transpose_item_f8(a.w_in, IN_W, 1024, kb * 64, n0, (unsigned char*)WIN, n0 + (n0 >= 672 ? 96 : 0), WIN_SCALE, scr, lane); continue; } r -= I_IN;
            if (r < I_UQ) { const int kb = r / 24, g = r % 24; transpose_item(a.w_uq, 768, 384, kb * 64, g * 32, WUQ, g * 32, a.q_norm_g, scr, lane); continue; } r -= I_UQ;
            if (r < I_KV) { const int kb = r / 32, g = r % 32, hh = g >> 2, part = g & 3;
                transpose_item(a.w_ukv, 1024, 256, kb * 64, g * 32, part < 2 ? WK : WV, hh * 64 + (part & 1) * 32, a.kv_norm_g, scr, lane); continue; } r -= I_KV;
            { const int kb = r / 32, g = r % 32; transpose_item_f8(a.w_out, 1024, 1024, kb * 64, g * 32, (unsigned char*)WOUT, g * 32, WOUT_SCALE, scr, lane); }
        }
        for (int i = (F.G - 1 - F.vcu) * NTHR + F.tid; i < 96 * 1024 / 16; i += F.G * NTHR) *(u32x4*)((unsigned char*)WIN + (size_t)672 * 1024 + (size_t)i * 16) = (u32x4){0u, 0u, 0u, 0u};
    }
    for (int i = (F.G - 1 - F.vcu) * NTHR + F.tid; i < SEQ * 16; i += F.G * NTHR) { const int pos = i >> 4, j = i & 15;
        const float ang = (float)pos * (float)exp2(-(double)j * (13.287712379549449 / 16.0)); float* rp = WSP(float, WS_ROPE) + pos * 32;
        float sn, cs; sincosf(ang, &sn, &cs);
        rp[j] = cs; rp[16 + j] = sn; }
    for (int i = (F.G - 1 - F.vcu) * NTHR + F.tid; i < 3 * 8 * 320; i += F.G * NTHR) { const int p = i / 2560, hh = (i / 320) & 7, idx = i % 320, delta = idx - 127, dil = 1 << (2 * p);
        float v = NEG_BIG; if (delta >= -64 && delta <= 64) v = a.rel_bias[t5_bucket_dev(delta * dil) * 8 + hh] * LOG2E;
        WSP(float, WS_TABG)[i] = v; }
}
__device__ __forceinline__ void p1_mod_h1(Frame& F) { const KArgs ka = kargs(); const float* const a_x = ka->x; const float* const a_b_ada = ka->b_ada;
    LAS float* shs = (LAS float*)F.lds;
    const float* modp = WSP(const float, WS_MODP); float* mod = WSP(float, WS_MOD);
    for (int i = F.vcu * NTHR + F.tid; i < 8 * 6144; i += F.G * NTHR) { float s = a_b_ada[i % 6144];
#pragma unroll
        for (int kb = 0; kb < 16; ++kb) s += modp[(size_t)kb * 8 * 6144 + i];
        mod[i] = s; }
    bf16_t* H1 = WSP(bf16_t, WS_H);
    const int rpb = M_TOK / F.G;
    const int row0 = F.vcu * rpb, b = row0 >> 12;
    for (int i = F.tid; i < 2048; i += NTHR) { float sv = a_b_ada[i];
#pragma unroll
        for (int kb = 0; kb < 16; ++kb) sv += modp[(size_t)kb * 8 * 6144 + b * 6144 + i];
        shs[i] = sv; }
    __syncthreads();
    f32x4 sh[4], sc[4];
#pragma unroll
    for (int j = 0; j < 4; ++j) { sh[j] = *(const LAS f32x4*)(shs + 4 * F.lane + 256 * j); sc[j] = *(const LAS f32x4*)(shs + 1024 + 4 * F.lane + 256 * j) + 1.f; }
    for (int rr = 2 * F.wave; rr < rpb; rr += 2 * NWAVES) {
        const int row = row0 + rr;
        const f32x4* xr = (const f32x4*)(a_x + (size_t)row * 1024) + F.lane;
        unsigned* o8 = (unsigned*)((unsigned char*)H1 + (size_t)row * 1024) + F.lane;
        f32x4 v[8];
#pragma unroll
        for (int j = 0; j < 8; ++j) v[j] = __builtin_nontemporal_load(xr + 64 * j);
#pragma unroll
        for (int j = 0; j < 8; ++j) { const f32x4 hv = v[j] * sc[j & 3] + sh[j & 3];
            o8[64 * j] = pk4_fp8(hv[0], hv[1], hv[2], hv[3]); }
    }
}
__device__ __forceinline__ void p6_ln1_router(Frame& F) { const KArgs ka = kargs(); const float* const a_w_router = ka->w_router; const float* const a_ln1_g = ka->ln1_g; const float* const a_ln1_b = ka->ln1_b; const bf16_t* const a_m = WSP(const bf16_t, WS_M); const float* const a_x = ka->x;
    LAS f32x4* wr4 = (LAS f32x4*)F.lds;
    for (int idx = F.tid; idx < 1024 * 4; idx += NTHR) { const int k = idx >> 2, e4 = idx & 3, l = (k & 255) >> 2, i = k & 3, j = k >> 8;
        wr4[((j * 4 + i) * 4 + e4) * 64 + l] = *(const f32x4*)(a_w_router + k * 16 + e4 * 4); }
    LAS f32x4* gl4 = (LAS f32x4*)(F.lds + 64 * 1024); LAS f32x4* ml4 = gl4 + 512;
    const float* mod = WSP(const float, WS_MOD);
    gl4[F.tid] = F.tid < 256 ? *(const f32x4*)(a_ln1_g + 4 * F.tid) : *(const f32x4*)(a_ln1_b + 4 * (F.tid - 256));
#pragma unroll
    for (int bq = 0; bq < 8; ++bq) { const f32x4 t = *(const f32x4*)(mod + bq * 6144 + 3072 + 4 * F.tid); ml4[bq * 512 + F.tid] = F.tid < 256 ? t : t + 1.f; }
    __syncthreads();
    bf16_t* H2 = WSP(bf16_t, WS_H); float* AFF = WSP(float, WS_AFF); float* STAT = WSP(float, WS_STAT);
    const int gw = F.vcu * NWAVES + F.wave, NGW = F.G * NWAVES, lane = F.lane;
    f32x4 vn[2][4]; u32x2 mn[2][4];
#define P6_LOAD(r0_) do { _Pragma("unroll") for (int q = 0; q < 2; ++q) { const int rq_ = (r0_) + q * NGW < M_TOK ? (r0_) + q * NGW : (r0_); const unsigned ro_ = (unsigned)rq_ * 4096u; \
        _Pragma("unroll") for (int j = 0; j < 4; ++j) { vn[q][j] = *(const f32x4*)((const char*)a_x + (ro_ + (unsigned)(lane * 16 + j * 1024))); mn[q][j] = *(const u32x2*)((const char*)a_m + ((ro_ >> 1) + (unsigned)(lane * 8 + j * 512))); } } } while (0)
    P6_LOAD(gw);
    unsigned sh2[2][4]; f32x2 sst[2]; float saff[2]; int srow[2]; bool have = false;
    const int e_l = ((lane >> 5) & 1) * 8 + ((lane >> 3) & 1) * 4 + ((lane >> 1) & 1) * 2 + (lane & 1);
#define P6_STORES() do { _Pragma("unroll") for (int q = 0; q < 2; ++q) { _Pragma("unroll") for (int j = 0; j < 4; ++j) *(unsigned*)((unsigned char*)H2 + ((unsigned)srow[q] * 1024u + (unsigned)(lane * 4 + j * 256))) = sh2[q][j]; \
            AFF[((size_t)(srow[q] >> 12) * 16 + e_l) * SEQ + (srow[q] & (SEQ - 1))] = saff[q]; } \
        *(f32x2*)(STAT + (size_t)((lane & 1) ? srow[1] : srow[0]) * 2) = (lane & 1) ? sst[1] : sst[0]; } while (0)
    for (int row0 = gw; row0 < M_TOK; row0 += 2 * NGW) {
        f32x4 v[2][4]; float mean[2], rstd[2];
#pragma unroll
        for (int q = 0; q < 2; ++q) { float sm = 0.f;
#pragma unroll
            for (int j = 0; j < 4; ++j) { v[q][j] = vn[q][j] * ALPHA + (f32x4){bf_lo(mn[q][j].x), bf_hi(mn[q][j].x), bf_lo(mn[q][j].y), bf_hi(mn[q][j].y)}; sm += (v[q][j][0] + v[q][j][1]) + (v[q][j][2] + v[q][j][3]); }
            mean[q] = sm; }
        asm volatile("" :: "v"(mean[0]), "v"(mean[1]) : "memory");
        if (have) P6_STORES();
        have = true;
        { const int rn = row0 + 2 * NGW < M_TOK ? row0 + 2 * NGW : row0; P6_LOAD(rn); }
#pragma unroll
        for (int q = 0; q < 2; ++q) { mean[q] = wave_sum(mean[q]) * (1.f / 1024.f); float s2 = 0.f;
#pragma unroll
            for (int j = 0; j < 4; ++j) { v[q][j] = v[q][j] - mean[q]; s2 += (v[q][j][0] * v[q][j][0] + v[q][j][1] * v[q][j][1]) + (v[q][j][2] * v[q][j][2] + v[q][j][3] * v[q][j][3]); }
            rstd[q] = 1.f / sqrtf(wave_sum(s2) * (1.f / 1024.f) + NORM_EPS); }
        const int rowq[2] = {row0, row0 + NGW < M_TOK ? row0 + NGW : row0};
        sst[0] = (f32x2){mean[0], rstd[0]}; sst[1] = (f32x2){mean[1], rstd[1]}; srow[0] = rowq[0]; srow[1] = rowq[1];
        f32x2 lg2[2][8];
#pragma unroll
        for (int q = 0; q < 2; ++q)
#pragma unroll
            for (int e = 0; e < 8; ++e) lg2[q][e] = (f32x2){0.f, 0.f};
#pragma unroll
        for (int j = 0; j < 4; ++j) { const int col = 4 * lane + 256 * j;
            const f32x4 g = gl4[lane + 64 * j], bb = gl4[256 + lane + 64 * j];
#pragma unroll
            for (int q = 0; q < 2; ++q) { const int b = rowq[q] >> 12;
                const f32x4 x1 = v[q][j] * rstd[q] * g + bb;
                const f32x4 sh = ml4[b * 512 + lane + 64 * j], sc = ml4[b * 512 + 256 + lane + 64 * j];
                const f32x4 hv = x1 * sc + sh; v[q][j] = hv;
                sh2[q][j] = pk4_fp8(hv[0], hv[1], hv[2], hv[3]); } }
#pragma unroll
        for (int j = 0; j < 4; ++j) {
#pragma unroll
            for (int i = 0; i < 4; ++i) {
#pragma unroll
                for (int e4 = 0; e4 < 4; ++e4) { const f32x4 w = wr4[((j * 4 + i) * 4 + e4) * 64 + lane]; const f32x2 w01 = (f32x2){w[0], w[1]}, w23 = (f32x2){w[2], w[3]};
#pragma unroll
                    for (int q = 0; q < 2; ++q) { const f32x2 hh = (f32x2){v[q][j][i], v[q][j][i]};
                        lg2[q][e4 * 2 + 0] = __builtin_elementwise_fma(hh, w01, lg2[q][e4 * 2 + 0]); lg2[q][e4 * 2 + 1] = __builtin_elementwise_fma(hh, w23, lg2[q][e4 * 2 + 1]); } }
                asm volatile("" : "+v"(lg2[0][0]), "+v"(lg2[0][1]), "+v"(lg2[0][2]), "+v"(lg2[0][3]), "+v"(lg2[0][4]), "+v"(lg2[0][5]), "+v"(lg2[0][6]), "+v"(lg2[0][7]), "+v"(lg2[1][0]), "+v"(lg2[1][1]), "+v"(lg2[1][2]), "+v"(lg2[1][3]), "+v"(lg2[1][4]), "+v"(lg2[1][5]), "+v"(lg2[1][6]), "+v"(lg2[1][7]) :: "memory"); }
        }
#pragma unroll
        for (int q = 0; q < 2; ++q) {
            float lg[16];
#pragma unroll
            for (int e = 0; e < 8; ++e) { lg[2 * e] = lg2[q][e][0]; lg[2 * e + 1] = lg2[q][e][1]; }
#pragma unroll
            for (int i = 0; i < 8; ++i) { float x = lg[i], y = lg[i + 8];
                asm("s_nop 1\n\tv_permlane32_swap_b32 %0, %1" : "+v"(x), "+v"(y)); lg[i] = x + y; }
#pragma unroll
            for (int i = 0; i < 4; ++i) { const bool up = lane & 8; const float keep = up ? lg[i + 4] : lg[i], send = up ? lg[i] : lg[i + 4]; lg[i] = keep + dpp_f<0x128>(send); }
#pragma unroll
            for (int i = 0; i < 2; ++i) { const bool up = lane & 2; const float keep = up ? lg[i + 2] : lg[i], send = up ? lg[i] : lg[i + 2]; lg[i] = keep + dpp_f<0x4E>(send); }
            { const bool up = lane & 1; const float keep = up ? lg[1] : lg[0], send = up ? lg[0] : lg[1]; lg[0] = keep + dpp_f<0xB1>(send); }
            float logit = lg[0]; logit += dpp_f<0x1B>(dpp_f<0x141>(logit)); logit += __shfl_xor(logit, 16);
            const float mx = wave_max(logit);
            const float ex = expf(logit - mx); const float se = wave_sum(ex) * 0.25f;
            saff[q] = ex / se;
        }
    }
    if (have) P6_STORES();
#undef P6_STORES
#undef P6_LOAD
}
__device__ __forceinline__ unsigned block_excl_scan(unsigned v, LAS unsigned* tmp, int tid, int lane, int wave, unsigned& total) {
    unsigned inc = v;
#pragma unroll
    for (int o = 1; o < 64; o <<= 1) { const unsigned t = __shfl_up(inc, o); if (lane >= o) inc += t; }
    __syncthreads();
    if (lane == 63) tmp[wave] = inc;
    __syncthreads();
    unsigned base = 0, tot = 0;
#pragma unroll
    for (int w = 0; w < NWAVES; ++w) { const unsigned t = tmp[w]; if (w < wave) base += t; tot += t; }
    total = tot;
    return base + inc - v;
}
__device__ __forceinline__ void topk_unit(Frame& F, int b, int e) {
    LAS unsigned* hist = (LAS unsigned*)F.lds; LAS unsigned* sh = hist + 256; LAS unsigned* tmp = hist + 272;
    const int tid = F.tid, lane = F.lane, wave = F.wave;
    const float* aff = WSP(const float, WS_AFF) + ((size_t)b * 16 + e) * SEQ;
    unsigned key[8];
    { const u32x4 k0 = *(const u32x4*)(aff + tid * 8), k1 = *(const u32x4*)(aff + tid * 8 + 4); key[0] = k0.x; key[1] = k0.y; key[2] = k0.z; key[3] = k0.w; key[4] = k1.x; key[5] = k1.y; key[6] = k1.z; key[7] = k1.w; }
    unsigned prefix = 0, need = CAP;
#pragma unroll 1
    for (int pass = 0; pass < 4; ++pass) {
        const int shift = 24 - 8 * pass;
        if (tid < 256) hist[tid] = 0u;
        __syncthreads();
#pragma unroll
        for (int i = 0; i < 8; ++i) { const bool in = (pass == 0) || ((key[i] >> (shift + 8)) == prefix); if (in) (void)__hip_atomic_fetch_add(&hist[(key[i] >> shift) & 255u], 1u, __ATOMIC_RELAXED, __HIP_MEMORY_SCOPE_WORKGROUP); }
        __syncthreads();
        if (wave == 0) {
            const unsigned c0 = hist[4 * lane], c1 = hist[4 * lane + 1], c2 = hist[4 * lane + 2], c3 = hist[4 * lane + 3], s = c0 + c1 + c2 + c3;
            unsigned incl = s;
#pragma unroll
            for (int o = 1; o < 64; o <<= 1) { const unsigned t = __shfl_down(incl, o); if (lane + o < 64) incl += t; }
            const unsigned above = incl - s;
            if (above < need && need <= incl) {
                unsigned aa = above; int d;
                if (aa + c3 >= need) d = 3; else { aa += c3; if (aa + c2 >= need) d = 2; else { aa += c2; if (aa + c1 >= need) d = 1; else { aa += c1; d = 0; } } }
                sh[0] = (prefix << 8) | (unsigned)(4 * lane + d); sh[1] = need - aa;
            }
        }
        __syncthreads();
        prefix = sh[0]; need = sh[1];
    }
    const unsigned T = prefix;
    unsigned cg = 0, ce = 0;
#pragma unroll
    for (int i = 0; i < 8; ++i) { cg += key[i] > T; ce += key[i] == T; }
    unsigned tot;
    const unsigned eq_before = block_excl_scan(ce, tmp, tid, lane, wave, tot);
    unsigned sel_mask = 0, nsel = 0, er = eq_before;
#pragma unroll
    for (int i = 0; i < 8; ++i) { bool s = key[i] > T; if (key[i] == T) { s = er < need; ++er; } if (s) { sel_mask |= 1u << i; ++nsel; } }
    unsigned slot = block_excl_scan(nsel, tmp, tid, lane, wave, tot);
    LAS int* lst = (LAS int*)(hist + 512);
    float* vals = WSP(float, WS_VALS) + (e * 8 + b) * CAP; int* inv = WSP(int, WS_INV);
#pragma unroll
    for (int i = 0; i < 8; ++i) { const int tok = tid * 8 + i; int sl = -1;
        if (sel_mask & (1u << i)) { sl = (int)slot; if (slot < (unsigned)CAP) { lst[slot] = tok; vals[slot] = __builtin_bit_cast(float, key[i]); } ++slot; }
        inv[((size_t)b * SEQ + tok) * 16 + e] = sl; }
    __syncthreads();
    { unsigned* VOFF = WSP(unsigned, WS_VOFF);
#pragma unroll
      for (int hh = 0; hh < 2; ++hh) { u32x4 o;
#pragma unroll
          for (int i = 0; i < 2; ++i) { int R, C; pg8::stage_rc(tid * 16 + i * 8192, R, C);
              o[i] = (unsigned)lst[hh * 256 + R] * 1024u + (unsigned)(C * 2); o[2 + i] = (unsigned)lst[hh * 256 + 128 + R] * 1024u + (unsigned)(C * 2); }
          *(u32x4*)(VOFF + ((size_t)((e * 8 + b) * 2 + hh) * 512 + tid) * 4) = o; } }
    __syncthreads();
}
template <int PART>
__device__ __forceinline__ void p7_expert_weights(Frame& F) { const KArgs ka = kargs(); const float* const a_w_gate = ka->w_gate; const float* const a_w_up = ka->w_up; const float* const a_w_down = ka->w_down;
    LAS float* scr = (LAS float*)(F.lds + 4096 + F.wave * 16640);
    bf16_t* WGU = WSP(bf16_t, WS_WGU); bf16_t* WD = WSP(bf16_t, WS_WD);
    constexpr int I_G = 16 * 16 * 24, I_D = 16 * 24 * 16;
    const int bx = (int)blockIdx.x;
    if (PART == 0) {
        const bool split = (F.G == 256); const bool tk = split && bx < BATCH * N_EXP;
        const int v0 = split ? ((tk ? bx : bx - 128) * NWAVES + F.wave) + (tk ? 7168 : 0) : F.wave * F.G + bx;
        const int vstep = split ? 1024 : F.G * NWAVES, vend = split ? (tk ? 2 * I_G : 7168) : 2 * I_G;
        static_assert(1024 * 12 == 2 * I_G, "P7 item split");
        for (int it = v0; it < vend; it += vstep) {
            int r = it; const int up = r >= I_G; if (up) r -= I_G; const int ex = r / 384, q = r % 384, kb = q / 24, g = q % 24, f = g * 64;
            transpose_item64((up ? a_w_up : a_w_gate) + (size_t)ex * 1024 * 1536, 1536, 1024, kb * 64, f, (bf16_t*)((unsigned char*)WGU + (size_t)ex * 3072 * 1024), (f >> 7) * 256 + up * 128 + (f & 127), scr, F.lane, WGU_SCALE, 0.f); }
    } else {
        for (int r = F.wave * F.G + bx; r < I_D; r += F.G * NWAVES) { const int ex = r / 384, q = r % 384, kb = q / 16, g = q % 16;
            transpose_item64(a_w_down + (size_t)ex * 1536 * 1024, 1024, 1536, kb * 64, g * 64, (bf16_t*)((unsigned char*)WD + (size_t)ex * 1024 * 1536), g * 64, scr, F.lane, WD_SCALE, 0.f); }
    }
}
__device__ __forceinline__ void p10_final(Frame& F, float* dst_override = nullptr) { const KArgs ka = kargs(); const float* const a_ln2_g = ka->ln2_g; const float* const a_ln2_b = ka->ln2_b; float* const a_out = ka->out;
    const float* const a_ln1_g = ka->ln1_g; const float* const a_ln1_b = ka->ln1_b; const float* const a_x = ka->x;
    const float* mod = WSP(const float, WS_MOD); const bf16_t* Y = WSP(const bf16_t, WS_Y); const int* inv = WSP(const int, WS_INV); const float* STAT = WSP(const float, WS_STAT); const bf16_t* const a_m = WSP(const bf16_t, WS_M);
    const int gw = F.vcu * NWAVES + F.wave, NGW = F.G * NWAVES, lane = F.lane;
    LAS f32x4* pl4 = (LAS f32x4*)F.lds;
    for (int i = F.tid; i < 1024; i += NTHR) { const int w = i >> 8, c4 = (i & 255) * 4; pl4[i] = *(const f32x4*)((w == 0 ? a_ln1_g : w == 1 ? a_ln1_b : w == 2 ? a_ln2_g : a_ln2_b) + c4); }
    for (int i = F.tid; i < 2048; i += NTHR) pl4[1024 + i] = *(const f32x4*)(mod + (i >> 8) * 6144 + 5120 + (i & 255) * 4);
    __syncthreads();
    const int l15 = lane & 15;
    int slot_c = inv[(size_t)gw * 16 + l15];
    int slot_n = inv[(size_t)(gw + NGW < M_TOK ? gw + NGW : gw) * 16 + l15];
    f32x4 xn[4]; u32x2 mn[4]; f32x2 stn; unsigned w0n[4], w1n[4]; unsigned long long msk_c; float f0c, f1c;
#define P10_PREF(rw_, slots_) do { stn = *(const f32x2*)(STAT + (size_t)(rw_) * 2); \
        const f32x4* xr_ = (const f32x4*)(a_x + (size_t)(rw_) * 1024) + lane; const u32x2* mr_ = (const u32x2*)(a_m + (size_t)(rw_) * 1024) + lane; \
        _Pragma("unroll") for (int j = 0; j < 4; ++j) { xn[j] = xr_[64 * j]; mn[j] = mr_[64 * j]; } \
        unsigned long long mk_ = __ballot((slots_) >= 0) & 0xFFFFull; const int bb_ = (rw_) >> 12; \
        const bool one_ = mk_ != 0; const int e0_ = one_ ? __builtin_ctzll(mk_) : 0; mk_ &= mk_ - 1; \
        const bool two_ = mk_ != 0; const int e1_ = two_ ? __builtin_ctzll(mk_) : e0_; mk_ &= mk_ - 1; \
        int s0_ = __shfl((slots_), e0_), s1_ = __shfl((slots_), e1_); s0_ = s0_ < 0 ? 0 : s0_; s1_ = s1_ < 0 ? 0 : s1_; \
        const unsigned* y0_ = (const unsigned*)((const unsigned char*)Y + ((size_t)(e0_ * 8 + bb_) * CAP + s0_) * 1024) + lane; \
        const unsigned* y1_ = (const unsigned*)((const unsigned char*)Y + ((size_t)(e1_ * 8 + bb_) * CAP + s1_) * 1024) + lane; \
        _Pragma("unroll") for (int j = 0; j < 4; ++j) { w0n[j] = y0_[64 * j]; w1n[j] = y1_[64 * j]; } \
        msk_c = mk_; f0c = one_ ? 1.f : 0.f; f1c = two_ ? 1.f : 0.f; } while (0)
    P10_PREF(gw, slot_c);
    f32x4 so[4]; int srow = gw; bool have = false;
#define P10_STORES() do { f32x4* xr_ = (dst_override ? (f32x4*)(dst_override + (size_t)srow * 1024) : (f32x4*)(a_out + (size_t)srow * 1024)) + lane; \
        _Pragma("unroll") for (int j = 0; j < 4; ++j) xr_[64 * j] = so[j]; } while (0)
    for (int row = gw; row < M_TOK; row += NGW) {
        const int b = row >> 12;
        const int myslot = slot_c; f32x4 xc[4]; const float mean1 = stn[0], rstd1 = stn[1];
        unsigned long long msk = msk_c;
        f32x4 mo[4];
#pragma unroll
        for (int j = 0; j < 4; ++j) { xc[j] = xn[j] * ALPHA + (f32x4){bf_lo(mn[j].x), bf_hi(mn[j].x), bf_lo(mn[j].y), bf_hi(mn[j].y)};
            const auto a0 = __builtin_amdgcn_cvt_pk_f32_fp8((int)w0n[j], false), a1 = __builtin_amdgcn_cvt_pk_f32_fp8((int)w0n[j], true);
            const auto c0 = __builtin_amdgcn_cvt_pk_f32_fp8((int)w1n[j], false), c1 = __builtin_amdgcn_cvt_pk_f32_fp8((int)w1n[j], true);
            mo[j] = (f32x4){f0c * a0[0] + f1c * c0[0], f0c * a0[1] + f1c * c0[1], f0c * a1[0] + f1c * c1[0], f0c * a1[1] + f1c * c1[1]}; }
        asm volatile("" :: "v"(xc[0][0]), "v"(xc[1][0]), "v"(xc[2][0]), "v"(xc[3][0]), "v"(mo[0][0]), "v"(mo[1][0]), "v"(mo[2][0]), "v"(mo[3][0]), "v"(mean1) : "memory");
        if (have) P10_STORES();
        have = true;
        { const int rn = row + NGW < M_TOK ? row + NGW : row, rnn = rn + NGW < M_TOK ? rn + NGW : rn;
          slot_c = slot_n; slot_n = inv[(size_t)rnn * 16 + l15];
          P10_PREF(rn, slot_c); }
        while (msk) {
            const int e0 = __builtin_ctzll(msk); msk &= msk - 1;
            const bool two = msk != 0; const int e1 = two ? __builtin_ctzll(msk) : e0; if (two) msk &= msk - 1;
            const int s0 = __shfl(myslot, e0), s1 = __shfl(myslot, e1);
            const unsigned* y0 = (const unsigned*)((const unsigned char*)Y + ((size_t)(e0 * 8 + b) * CAP + s0) * 1024) + lane;
            const unsigned* y1 = (const unsigned*)((const unsigned char*)Y + ((size_t)(e1 * 8 + b) * CAP + s1) * 1024) + lane;
            unsigned w0[4], w1[4];
#pragma unroll
            for (int j = 0; j < 4; ++j) { w0[j] = y0[64 * j]; w1[j] = y1[64 * j]; }
            const float f1 = two ? 1.f : 0.f;
#pragma unroll
            for (int j = 0; j < 4; ++j) { const auto a0 = __builtin_amdgcn_cvt_pk_f32_fp8((int)w0[j], false), a1 = __builtin_amdgcn_cvt_pk_f32_fp8((int)w0[j], true);
                const auto c0 = __builtin_amdgcn_cvt_pk_f32_fp8((int)w1[j], false), c1 = __builtin_amdgcn_cvt_pk_f32_fp8((int)w1[j], true);
                mo[j][0] += a0[0] + f1 * c0[0]; mo[j][1] += a0[1] + f1 * c0[1]; mo[j][2] += a1[0] + f1 * c1[0]; mo[j][3] += a1[1] + f1 * c1[1]; }
        }
        f32x4 v[4]; float sm = 0.f;
#pragma unroll
        for (int j = 0; j < 4; ++j) { const f32x4 g2 = pl4[1024 + b * 256 + lane + 64 * j];
            const f32x4 x1 = (xc[j] - mean1) * rstd1 * pl4[lane + 64 * j] + pl4[256 + lane + 64 * j];
            v[j] = x1 * ALPHA + g2 * mo[j] * (DBG_MOE_F / Y_SCALE); sm += (v[j][0] + v[j][1]) + (v[j][2] + v[j][3]); }
        const float mean = wave_sum(sm) * (1.f / 1024.f); float s2 = 0.f;
#pragma unroll
        for (int j = 0; j < 4; ++j) { v[j] = v[j] - mean; s2 += (v[j][0] * v[j][0] + v[j][1] * v[j][1]) + (v[j][2] * v[j][2] + v[j][3] * v[j][3]); }
        const float rstd = 1.f / sqrtf(wave_sum(s2) * (1.f / 1024.f) + NORM_EPS);
#pragma unroll
        for (int j = 0; j < 4; ++j) { const f32x4 g = pl4[512 + lane + 64 * j], bb = pl4[768 + lane + 64 * j];
            so[j] = v[j] * rstd * g + bb; }
        srow = row;
    }
    if (have) P10_STORES();
#undef P10_STORES
#undef P10_PREF
}
constexpr int N_PHASES = 11;
__global__ void __launch_bounds__(NTHR, 2) fwd_kernel(Args args) {
    extern __shared__ __attribute__((aligned(16))) unsigned char lds_raw[];
    Frame F;
    F.lds = (LAS unsigned char*)lds_raw;
    F.tid = threadIdx.x; F.lane = F.tid & 63; F.wave = __builtin_amdgcn_readfirstlane(F.tid >> 6);
    F.G = gridDim.x; { const int bx = blockIdx.x; F.vcu = (F.G % 8 == 0) ? (bx % 8) * (F.G / 8) + bx / 8 : bx; }
    F.ws = kargs()->ws;
    volatile LAS unsigned* MISC = (volatile LAS unsigned*)(F.lds + MISC_OFF);
    for (int u = F.tid; u < (LDS_BYTES - MISC_OFF) / 4; u += NTHR) MISC[u] = 0u;
    __syncthreads();
    const int lo = kargs()->ph_lo, hi = kargs()->ph_hi;
    unsigned* barw = (unsigned*)(F.ws + WS_CTL) + CW_BAR;
    XcdBarrier bar; bar.bar = barw; bar.x = 0; bar.st = nullptr;
    if (hi - lo > 1) bar = xcd_barrier_post(barw, MISC + 8);
#ifndef PHMASK
#define PHMASK 0x7ff
#endif
#define IN(k) ((((PHMASK) >> (k)) & 1) && lo <= (k) && (k) < hi)
#define SEAM(k) do { if (IN(k) && IN((k) + 1)) xcd_barrier(bar); } while (0)

    if (IN(0)) { p0_prologue(F);
#if DBG_REP_P0 > 1
        __syncthreads(); p0_prologue(F);
#endif
    } SEAM(0);
    if (IN(1)) { _Pragma("unroll 1") for (int rep_ = 0; rep_ < DBG_REP_THIN; ++rep_) p1_mod_h1(F); } SEAM(1);
    if (IN(2)) {
        pg8::Gemm g{WSP(const bf16_t, WS_H), WSP(const bf16_t, WS_WIN), M_TOK, IN_WP, 1024, 1 << 30, nullptr};
        pg8::StaticOrder S; S.init(M_TOK, IN_WP, F.G, (int)blockIdx.x);
        static_assert(WS_DV - WS_DK == WS_DK - WS_DQ, "dq/dk/dv contiguous");
        EpiProj E{WSP(bf16_t, WS_CQ), WSP(bf16_t, WS_CKV), WSP(bf16_t, WS_KN)  , WSP(bf16_t, WS_DQ), WSP(float, WS_SSQ), WSP(const float, WS_ROPE)};
        pg8::gemm_phase<EpiProj, false, true>(F.lds, g, S, E);

    } SEAM(2);
    if (IN(3)) {
#ifdef DBG_DIL_MODE
        __syncthreads();
        for (int u = F.vcu; u < BATCH * DIL_H * 4; u += F.G) dil_unit<DBG_DIL_MODE>(F, u >> 5, (u >> 2) & 7, u & 3);
        __syncthreads();
#endif
#ifndef NO_P3G
#ifndef NO_GQ
        { pg8::Gemm g{WSP(const bf16_t, WS_CQ), WSP(const bf16_t, WS_WUQ), M_TOK, 768, Q_LORA, 1 << 30, nullptr};
          pg8::StaticOrder S; S.init(M_TOK, 768, F.G, (int)blockIdx.x);
          EpiQ E{WSP(bf16_t, WS_Q), WSP(const float, WS_SSQ), WSP(const float, WS_ROPE)};
          pg8::gemm_phase<EpiQ, false>(F.lds, g, S, E);
#if DBG_REP_P3G > 1
          pg8::gemm_phase<EpiQ, false>(F.lds, g, S, E);
#endif
 }
#endif
#ifndef NO_GK
        { pg8::Gemm g{WSP(const bf16_t, WS_CKV), WSP(const bf16_t, WS_WK), M_TOK, 512, KV_LORA, 1 << 30, nullptr};
          pg8::StaticOrder S; S.init(M_TOK, 512, F.G, (int)blockIdx.x);
          EpiKN8 E{WSP(unsigned char, WS_KN), WSP(const float, WS_SSQ)};
          pg8::gemm_phase<EpiKN8, false>(F.lds, g, S, E); }
#endif
        { pg8::Gemm g{WSP(const bf16_t, WS_WV), WSP(const bf16_t, WS_CKV), 512, M_TOK, KV_LORA, 1 << 30, nullptr};
          pg8::StaticOrder S; S.init(512, M_TOK, F.G, (int)blockIdx.x);
          EpiVt8 E{WSP(unsigned char, WS_V), WSP(const float, WS_SSQ)};
          pg8::gemm_phase<EpiVt8, false>(F.lds, g, S, E); }
#endif
    } SEAM(3);
    if (IN(4)) {
        const bool dil_first = (F.vcu & 1) == 0;
#ifndef NO_DIL
        if (dil_first) {
            for (int u = F.vcu; u < BATCH * DIL_H * 4; u += F.G) dil_unit<0>(F, u >> 5, (u >> 2) & 7, u & 3);
            __syncthreads();
        }
#endif
#pragma unroll 1
        for (int rep = 0; rep < DBG_REP_MLA; ++rep)
        for (int u = F.vcu; u < BATCH * MLA_H * 8; u += F.G) mla_unit(F, u >> 6, (u >> 3) & 7, u & 7);
#ifndef NO_DIL
        if (!dil_first) {
            __syncthreads();
            for (int u = F.vcu; u < BATCH * DIL_H * 4; u += F.G) dil_unit<0>(F, u >> 5, (u >> 2) & 7, u & 3);
            __syncthreads();
        }
#endif
    } SEAM(4);
    if (IN(5)) {
        pg8::Gemm g{WSP(const bf16_t, WS_MIX), WSP(const bf16_t, WS_WOUT), M_TOK, 1024, 1024, 1 << 30, nullptr};
        pg8::StaticOrder S; S.init(M_TOK, 1024, F.G, (int)blockIdx.x);
        EpiOut E{WSP(bf16_t, WS_M), WSP(const float, WS_MOD)};
        pg8::gemm_phase<EpiOut, false, true>(F.lds, g, S, E);

    } SEAM(5);
    if (IN(6)) { _Pragma("unroll 1") for (int rep_ = 0; rep_ < DBG_REP_THIN; ++rep_) { p6_ln1_router(F); __syncthreads(); } } SEAM(6);
    if (IN(7)) {
        for (int u = blockIdx.x; u < BATCH * N_EXP; u += F.G) topk_unit(F, u >> 4, u & 15);
        p7_expert_weights<0>(F);
    } SEAM(7);
    if (IN(8)) {
        const bool wd_first = (F.vcu & 1) == 0;
        if (wd_first) { p7_expert_weights<1>(F); __syncthreads(); }
        pg8::Gemm g{WSP(const bf16_t, WS_H), WSP(const bf16_t, WS_WGU), MROWS, 3072, 1024, 16, WSP(const int, WS_VOFF)};
        pg8::StaticOrder S; S.init(MROWS, 3072, F.G, (int)blockIdx.x);
        EpiGU E{WSP(bf16_t, WS_HID)};
        pg8::gemm_phase<EpiGU, true, true>(F.lds, g, S, E);
#if DBG_REP_P8 > 1
          pg8::gemm_phase<EpiGU, false, true>(F.lds, g, S, E);
#endif
        if (!wd_first) { __syncthreads(); p7_expert_weights<1>(F); }
    } SEAM(8);
    if (IN(9)) {
        pg8::Gemm g{WSP(const bf16_t, WS_HID), WSP(const bf16_t, WS_WD), MROWS, 1024, D_FF, 16, nullptr};
        pg8::StaticOrder S; S.init(MROWS, 1024, F.G, (int)blockIdx.x);
        EpiDown E{WSP(bf16_t, WS_Y), WSP(const float, WS_VALS)};
        pg8::gemm_phase<EpiDown, false, true>(F.lds, g, S, E);
#if DBG_REP_P9 > 1
          pg8::gemm_phase<EpiDown, false, true>(F.lds, g, S, E);
#endif

    } SEAM(9);
    if (IN(10)) {
#ifdef DBG_REP_P10
        p10_final(F, WSP(float, WS_Z)); __syncthreads();
#endif
        p10_final(F); }
#undef IN
#undef SEAM
}

extern "C" void kernel_launch(void* const* d_in, const int* in_sizes, int n_in, void* d_out, int out_size, void* d_ws, size_t ws_size, hipStream_t stream) {
    static int grid = 0;
    if (grid == 0) {
        if (n_in != 19 || in_sizes[0] != M_TOK * D_MODEL || out_size != M_TOK * D_MODEL || ws_size < WS_END) {
            fprintf(stderr, "kernel_launch: unexpected shapes (n_in %d, in0 %d, out %d, ws %zu); nothing launched\n", n_in, n_in > 0 ? in_sizes[0] : -1, out_size, ws_size); grid = -1; return; }
        int dev = 0, cus = 0, per_cu = 0;
        if (hipGetDevice(&dev) != hipSuccess || hipDeviceGetAttribute(&cus, hipDeviceAttributeMultiprocessorCount, dev) != hipSuccess) { grid = -1; return; }
        if (hipFuncSetAttribute((const void*)fwd_kernel, hipFuncAttributeMaxDynamicSharedMemorySize, LDS_BYTES) != hipSuccess) { fprintf(stderr, "kernel_launch: hipFuncSetAttribute failed\n"); grid = -1; return; }
        if (hipOccupancyMaxActiveBlocksPerMultiprocessor(&per_cu, (const void*)fwd_kernel, NTHR, LDS_BYTES) != hipSuccess || per_cu < 1)
            fprintf(stderr, "kernel_launch: note: occupancy query reports %d workgroups per CU\n", per_cu);
        (void)hipGetLastError();
        grid = cus < 256 ? cus : 256;
    }
    if (grid < 0) return;
    (void)hipMemsetAsync((char*)d_ws + WS_CTL, 0, CTL_ZERO_BYTES, stream);
    Args a{};
    a.x = (const float*)d_in[0]; a.c = (const float*)d_in[1]; a.w_ada = (const float*)d_in[2]; a.b_ada = (const float*)d_in[3]; a.w_in = (const float*)d_in[4];
    a.q_norm_g = (const float*)d_in[5]; a.w_uq = (const float*)d_in[6]; a.kv_norm_g = (const float*)d_in[7]; a.w_ukv = (const float*)d_in[8]; a.rel_bias = (const float*)d_in[9];
    a.w_out = (const float*)d_in[10]; a.ln1_g = (const float*)d_in[11]; a.ln1_b = (const float*)d_in[12]; a.w_router = (const float*)d_in[13]; a.w_gate = (const float*)d_in[14];
    a.w_up = (const float*)d_in[15]; a.w_down = (const float*)d_in[16]; a.ln2_g = (const float*)d_in[17]; a.ln2_b = (const float*)d_in[18];
    a.out = (float*)d_out; a.ws = (unsigned char*)d_ws;
#if MK_ONE_LAUNCH
    a.ph_lo = 0; a.ph_hi = N_PHASES;
    hipLaunchKernelGGL(fwd_kernel, dim3(grid), dim3(NTHR), LDS_BYTES, stream, a);
#else
    for (int p = 0; p < N_PHASES; ++p) { a.ph_lo = p; a.ph_hi = p + 1; hipLaunchKernelGGL(fwd_kernel, dim3(grid), dim3(NTHR), LDS_BYTES, stream, a); }
#endif
}
```

```cpp
#include <hip/hip_runtime.h>
#include <cstdio>
#include <cstdint>

#ifndef MK_ONE_LAUNCH
#define MK_ONE_LAUNCH 1
#endif

#define LAS __attribute__((address_space(3)))
#define GAS __attribute__((address_space(1)))
typedef unsigned short bf16_t;
typedef short bf16x8 __attribute__((ext_vector_type(8)));
typedef short s16x4 __attribute__((ext_vector_type(4)));
typedef float f32x4 __attribute__((ext_vector_type(4)));
typedef float f32x2 __attribute__((ext_vector_type(2)));
typedef float f32x16 __attribute__((ext_vector_type(16)));
typedef unsigned u32x4 __attribute__((ext_vector_type(4)));
typedef unsigned u32x2 __attribute__((ext_vector_type(2)));
typedef _Float16 h16x4 __attribute__((ext_vector_type(4)));
typedef int i32x4 __attribute__((ext_vector_type(4)));
typedef int i32x8 __attribute__((ext_vector_type(8)));

constexpr int D_MODEL = 1024, BATCH = 8, SEQ = 4096, M_TOK = BATCH * SEQ;
constexpr int MLA_H = 8, MLA_NOPE = 64, MLA_ROPE = 32, MLA_V = 64, Q_LORA = 384, KV_LORA = 256, MLA_DQ = 96;
constexpr int DIL_H = 8, DIL_D = 64;
constexpr int N_EXP = 16, CAP = 512, D_FF = 1536;
constexpr int IN_W = 2208, IN_WP = 2304;
constexpr float ALPHA = 1.189207115002721f;
constexpr float NORM_EPS = 1e-6f;
constexpr float LOG2E = 1.4426950408889634f;
constexpr float QS_MLA = 0.10206207261596575f * LOG2E;
constexpr float Q8_SCALE = QS_MLA * 2.f * 8.f, K8_SCALE = 0.5f;
constexpr float QS_DIL = 0.125f * LOG2E;
constexpr float NEG_BIG = -1e30f;
#ifndef DBG_MLA_F
#define DBG_MLA_F 1.f
#endif
#ifndef DBG_DIL_F
#define DBG_DIL_F 1.f
#endif
#ifndef DBG_XEXP
#define DBG_XEXP 0
#endif
#ifndef DBG_REP_P0
#define DBG_REP_P0 1
#endif
#ifndef DBG_REP_P7
#define DBG_REP_P7 1
#endif
#ifndef DBG_REP_MLA
#define DBG_REP_MLA 1
#endif
#ifndef DBG_REP_DIL
#define DBG_REP_DIL 1
#endif
#ifndef DBG_REP_P8
#define DBG_REP_P8 1
#endif
#ifndef DBG_REP_P2
#define DBG_REP_P2 1
#endif
#ifndef DBG_REP_P9
#define DBG_REP_P9 1
#endif
#ifndef DBG_REP_P5
#define DBG_REP_P5 1
#endif
#ifndef DBG_REP_THIN
#define DBG_REP_THIN 1
#endif
#ifndef DBG_REP_P3G
#define DBG_REP_P3G 1
#endif
#ifndef DBG_MIX_F
#define DBG_MIX_F 1.f
#endif
#ifndef DBG_MOE_F
#define DBG_MOE_F 1.f
#endif
constexpr float WGU_SCALE = 32.f, WD_SCALE = 64.f, HID_SCALE = 4.f, WIN_SCALE = 32.f, WOUT_SCALE = 32.f, MIX_SCALE = 16.f, Y_SCALE = 64.f;
constexpr int MROWS = N_EXP * BATCH * CAP;

constexpr size_t MiB = 1u << 20;
constexpr size_t WS_CTL = 0, CTL_ZERO_BYTES = 1 * MiB;
constexpr size_t WS_ROPE = 1 * MiB;
constexpr size_t WS_TABG = 1 * MiB + 512 * 1024;
constexpr size_t WS_MODP = 2 * MiB;
constexpr size_t WS_MOD = 5 * MiB;
constexpr size_t WS_AFF = 6 * MiB;
constexpr size_t WS_STAT = 8 * MiB;
constexpr size_t WS_VALS = 8 * MiB + 256 * 1024;
constexpr size_t WS_INV = 9 * MiB;
constexpr size_t WS_SSQ = 11 * MiB;
constexpr size_t WS_WIN = 16 * MiB;
constexpr size_t WS_WUQ = 21 * MiB;
constexpr size_t WS_WK = 22 * MiB;
constexpr size_t WS_WV = 22 * MiB + 512 * 1024;
constexpr size_t WS_WOUT = 23 * MiB;
constexpr size_t WS_LSE = 26 * MiB;
constexpr size_t WS_H = 32 * MiB;
constexpr size_t WS_O1 = 32 * MiB, WS_O2 = 64 * MiB;
constexpr size_t WS_WGU = 96 * MiB;
constexpr size_t WS_WD = 192 * MiB;
constexpr size_t WS_CQ = 96 * MiB;
constexpr size_t WS_CKV = 120 * MiB;
constexpr size_t WS_KR = 136 * MiB;
constexpr size_t WS_DQ = 138 * MiB, WS_DK = 170 * MiB, WS_DV = 202 * MiB;
constexpr size_t WS_Q = 240 * MiB;
constexpr size_t WS_KN = 288 * MiB;
constexpr size_t WS_V = 320 * MiB;
constexpr size_t WS_Z = 240 * MiB;
constexpr size_t WS_MIX = 368 * MiB;
constexpr size_t WS_HID = 240 * MiB;
constexpr size_t WS_VOFF = 336 * MiB;
constexpr size_t WS_XG = 336 * MiB;
constexpr size_t WS_Y = 32 * MiB;
constexpr size_t WS_M = 432 * MiB;
constexpr size_t WS_END = 496 * MiB;
constexpr int CW_BAR = 4096;
constexpr int CW_QUEUE = 64;

constexpr int RING_BYTES = 147456;
constexpr int MISC_OFF = RING_BYTES;
constexpr int LDS_BYTES = RING_BYTES + 512;
constexpr int NWAVES = 8, NTHR = 512;

__device__ __forceinline__ unsigned f2bf(float f) { unsigned u = __builtin_bit_cast(unsigned, f); return (u + 0x7fffu + ((u >> 16) & 1u)) >> 16; }
__device__ __forceinline__ unsigned pk2(float lo, float hi) { return f2bf(lo) | (f2bf(hi) << 16); }
__device__ __forceinline__ unsigned cvt_pk_bf16(float lo, float hi) { unsigned r; asm volatile("v_cvt_pk_bf16_f32 %0, %1, %2" : "=v"(r) : "v"(lo), "v"(hi)); return r; }
__device__ __forceinline__ float bf_lo(unsigned w) { return __builtin_bit_cast(float, w << 16); }
__device__ __forceinline__ float bf_hi(unsigned w) { return __builtin_bit_cast(float, w & 0xffff0000u); }
template <int CTRL> __device__ __forceinline__ float dpp_f(float v) { return __builtin_bit_cast(float, __builtin_amdgcn_update_dpp(0, __builtin_bit_cast(int, v), CTRL, 0xF, 0xF, true)); }
__device__ __forceinline__ float lane_f(float v, int l) { return __builtin_bit_cast(float, __builtin_amdgcn_readlane(__builtin_bit_cast(int, v), l)); }
__device__ __forceinline__ float wave_sum(float v) {
    v += dpp_f<0xB1>(v); v += dpp_f<0x4E>(v); v += dpp_f<0x141>(v); v += dpp_f<0x140>(v);
    return (lane_f(v, 0) + lane_f(v, 16)) + (lane_f(v, 32) + lane_f(v, 48));
}
__device__ __forceinline__ void swap32(unsigned& a, unsigned& b) { asm("s_nop 1\n\tv_permlane32_swap_b32 %0, %1" : "+v"(a), "+v"(b)); }
__device__ __forceinline__ unsigned xhalf_get(unsigned v, int hi) { unsigned a = v, b = v; swap32(a, b); return hi ? a : b; }
__device__ __forceinline__ float xhalf_add(float v) { unsigned a = __float_as_uint(v), b = a; swap32(a, b); return __uint_as_float(a) + __uint_as_float(b); }
__device__ __forceinline__ float xhalf_fmax(float v) { unsigned a = __float_as_uint(v), b = a; swap32(a, b); return fmaxf(__uint_as_float(a), __uint_as_float(b)); }
__device__ __forceinline__ float wave_max(float v) {
    v = fmaxf(v, dpp_f<0xB1>(v)); v = fmaxf(v, dpp_f<0x4E>(v)); v = fmaxf(v, dpp_f<0x141>(v)); v = fmaxf(v, dpp_f<0x140>(v));
    return fmaxf(fmaxf(lane_f(v, 0), lane_f(v, 16)), fmaxf(lane_f(v, 32), lane_f(v, 48)));
}
#ifndef DBG_FP8_EMU
#define DBG_FP8_EMU 0
#endif
#ifndef DBG_HID_S
#define DBG_HID_S 4.f
#endif
__device__ __forceinline__ unsigned pk4_fp8(float a, float b, float c, float d) {
    a = __builtin_amdgcn_fmed3f(a, -448.f, 448.f); b = __builtin_amdgcn_fmed3f(b, -448.f, 448.f); c = __builtin_amdgcn_fmed3f(c, -448.f, 448.f); d = __builtin_amdgcn_fmed3f(d, -448.f, 448.f);
    int p = __builtin_amdgcn_cvt_pk_fp8_f32(a, b, 0, false); p = __builtin_amdgcn_cvt_pk_fp8_f32(c, d, p, true); return (unsigned)p;
}
__device__ __forceinline__ unsigned pk4_fp8_nc(float a, float b, float c, float d) { int p = __builtin_amdgcn_cvt_pk_fp8_f32(a, b, 0, false); p = __builtin_amdgcn_cvt_pk_fp8_f32(c, d, p, true); return (unsigned)p; }
__device__ __forceinline__ float q8(float x, float sc, float isc) {
#if DBG_FP8_EMU
    const int p = __builtin_amdgcn_cvt_pk_fp8_f32(x * sc, 0.f, 0, false); return __builtin_amdgcn_cvt_f32_fp8(p, 0) * isc;
#else
    return x;
#endif
}
#define LDS_WAIT() asm volatile("s_waitcnt lgkmcnt(0)" ::: "memory")
#define VM_WAIT() asm volatile("s_waitcnt vmcnt(0)" ::: "memory")

namespace pg8 {
constexpr int BM = 256, BK = 64, HALF = 128, HTB = HALF * BK * 2, STAGE_BYTES = 8 * HTB, NXCD = 8, WGM = 8;
__host__ __device__ __forceinline__ int lds_byte(int r, int c) { const int st = (r >> 4) * 2 + (c >> 5), rr = r & 15, cc = c & 31, ob = rr * 64 + cc * 2; return st * 1024 + (ob ^ (((ob >> 9) & 1) << 5)); }
__host__ __device__ __forceinline__ void stage_rc(int b, int& R, int& C) { const int st = b / 1024, sb = b % 1024, swz = sb ^ (((sb >> 9) & 1) << 5); R = (st >> 1) * 16 + swz / 64; C = (st & 1) * 32 + (swz % 64) / 2; }
__host__ __device__ __forceinline__ int perm32(int rho) { const int n = rho >> 4, i = rho & 15; return 8 * (i >> 2) + 4 * n + (i & 3); }

struct Unit { int pm, pn; };
struct Gemm { const bf16_t* A; const bf16_t* Bt; int M, N, K; int grp; const int* rowsrc; };

struct StaticOrder {
    int nM, nN, nwg, G, c;
    __device__ void init(int M, int N, int G_, int c_) { nM = M / BM; nN = N / BM; nwg = nM * nN; G = G_; c = c_; }
    __device__ bool next(int i, Unit& u) const {
        const long L = (long)i * G + c; if (L >= nwg) return false;
        int wgid = (int)L; { const int q = nwg / NXCD, r = nwg % NXCD, xcd = wgid % NXCD, off = wgid / NXCD; wgid = (xcd < r ? xcd * (q + 1) : r * (q + 1) + (xcd - r) * q) + off; }
        const int nig = WGM * nN, gid = wgid / nig, fm = gid * WGM, gsz = (nM - fm) < WGM ? (nM - fm) : WGM;
        u.pm = fm + ((wgid % nig) % gsz); u.pn = (wgid % nig) / gsz; return true;
    }
};

using ::i32x4; using ::i32x8;
template <class Epi, bool GATHER, bool FP8 = false>
__device__ __forceinline__ void gemm_phase(LAS unsigned char* lds, const Gemm g, const StaticOrder& S, const Epi& E) {
    const int tid = threadIdx.x, wid = __builtin_amdgcn_readfirstlane(tid >> 6), lane = tid & 63, wr = wid >> 2, wc = wid & 3, fr = lane & 15, fq = lane >> 4;
    const int K = g.K, KB = FP8 ? g.K : g.K * 2, nt = KB / 128, nN = g.N / BM;
    unsigned voffA[2], voffB[2];
#pragma unroll
    for (int i = 0; i < 2; ++i) { int R, C; stage_rc(tid * 16 + i * 8192, R, C); const int Rb = (R & ~31) + perm32(R & 31);
        voffA[i] = (unsigned)(R * KB + C * 2); voffB[i] = (unsigned)(Rb * KB + C * 2); }
    const size_t kstep = (size_t)(BK * 2);
    const size_t hstep = GATHER ? (size_t)0 : (size_t)HALF * KB;
    const size_t hstepB = (size_t)HALF * KB, tstep = 2 * hstepB;
    const unsigned ldsw = (unsigned)wid * 1024u;
    const int aoff = lds_byte(wr * 64 + fr, fq * 8), boff = lds_byte(wc * 32 + fr, fq * 8);
#define PG8_SA(b, h) (((b) * 2 + (h)) * HTB)
#define PG8_SB(b, h) ((4 + (b) * 2 + (h)) * HTB)
    const unsigned lds_base_u = (unsigned)__builtin_amdgcn_readfirstlane((int)(unsigned)(uintptr_t)lds + (int)ldsw);
#define PG8_STAGE(bufoff, gbase, voff) do { _Pragma("unroll") for (int _i = 0; _i < 2; ++_i) { \
        if constexpr (FP8) { unsigned keep_; asm volatile("s_mov_b32 %0, m0\n\ts_mov_b32 m0, %3\n\ts_nop 0\n\tglobal_load_lds_dwordx4 %1, %2\n\ts_mov_b32 m0, %0" \
              : "=&s"(keep_) : "v"((voff)[_i]), "s"((const char*)(gbase)), "s"(lds_base_u + (unsigned)((bufoff) + _i * 8192)) : "memory"); } \
        else __builtin_amdgcn_global_load_lds((const unsigned*)((const char*)(gbase) + (voff)[_i]), (LAS unsigned*)(lds + (bufoff) + ldsw + _i * 8192), 16, 0, 0); } } while (0)
#define PG8_LDA(dst, b, h) do { _Pragma("unroll") for (int m = 0; m < 4; ++m) _Pragma("unroll") for (int k = 0; k < 2; ++k) dst[m][k] = *(const LAS bf16x8*)(lds + PG8_SA(b, h) + aoff + m * 2048 + k * 1024); } while (0)
#define PG8_LDB(dst, b, h) do { _Pragma("unroll") for (int n = 0; n < 2; ++n) _Pragma("unroll") for (int k = 0; k < 2; ++k) dst[n][k] = *(const LAS bf16x8*)(lds + PG8_SB(b, h) + boff + n * 2048 + k * 1024); } while (0)
#define PG8_MMA(ai, bj, At, Bt) do { __builtin_amdgcn_s_setprio(1); _Pragma("unroll") for (int m = 0; m < 4; ++m) _Pragma("unroll") for (int n = 0; n < 2; ++n) { \
        if constexpr (FP8) { const i32x8 b8_ = __builtin_shufflevector(__builtin_bit_cast(i32x4, Bt[n][0]), __builtin_bit_cast(i32x4, Bt[n][1]), 0, 1, 2, 3, 4, 5, 6, 7); \
            const i32x8 a8_ = __builtin_shufflevector(__builtin_bit_cast(i32x4, At[m][0]), __builtin_bit_cast(i32x4, At[m][1]), 0, 1, 2, 3, 4, 5, 6, 7); \
            asm volatile("v_mfma_f32_16x16x128_f8f6f4 %0, %1, %2, %0" : "+v"(acc[ai][bj][m][n]) : "v"(b8_), "v"(a8_)); } \
        else { _Pragma("unroll") for (int k = 0; k < 2; ++k) acc[ai][bj][m][n] = __builtin_amdgcn_mfma_f32_16x16x32_bf16(Bt[n][k], At[m][k], acc[ai][bj][m][n], 0, 0, 0); } } \
        __builtin_amdgcn_s_setprio(0); } while (0)
#define PG8_WAIT_V(n) asm volatile("s_waitcnt vmcnt(" #n ")" ::: "memory")
#define PG8_WAIT_L(n) asm volatile("s_waitcnt lgkmcnt(" #n ")" ::: "memory")
#define PG8_BAR __builtin_amdgcn_s_barrier()
#define PG8_SCHED __builtin_amdgcn_sched_barrier(0)
#define PG8_ASRC(U) (GATHER ? (const char*)g.A + (size_t)(((U).pm >> 1) & 7) * ((size_t)SEQ * KB) : (const char*)g.A + (size_t)(U).pm * tstep)
#define PG8_GV(U) (*(const u32x4*)((const unsigned*)g.rowsrc + ((size_t)(U).pm * 512 + tid) * 4))
#define PG8_BSRC(U) ((const char*)g.Bt + (size_t)(((U).pm / g.grp) * nN + (U).pn) * tstep)
    Unit cur, nxt; int ui = 0;
    if (!S.next(0, cur)) return;
    u32x4 gvc = (u32x4){0u, 0u, 0u, 0u}, gvn = gvc, gvnn = gvc;
    if constexpr (GATHER) { gvc = PG8_GV(cur); Unit t1; gvn = S.next(1, t1) ? PG8_GV(t1) : gvc; }
#define PG8_STAGE_A(bufoff, base, H, NEXT) do { if constexpr (GATHER) { const bool nx_ = (NEXT); unsigned va_[2] = {nx_ ? gvn[2 * (H)] : gvc[2 * (H)], nx_ ? gvn[2 * (H) + 1] : gvc[2 * (H) + 1]}; PG8_STAGE(bufoff, base, va_); } \
        else PG8_STAGE(bufoff, (base) + (H) * hstep, voffA); } while (0)
    f32x4 acc[2][2][4][2];
#pragma unroll
    for (int a = 0; a < 2; ++a)
#pragma unroll
        for (int b = 0; b < 2; ++b)
#pragma unroll
            for (int m = 0; m < 4; ++m)
#pragma unroll
                for (int n = 0; n < 2; ++n) acc[a][b][m][n] = (f32x4){0.f, 0.f, 0.f, 0.f};
    bf16x8 At[4][2], B0[2][2], B1[2][2];
    const char* cA = PG8_ASRC(cur);
    const char* cB = PG8_BSRC(cur);
    PG8_STAGE(PG8_SB(0, 0), cB, voffB); PG8_STAGE(PG8_SB(0, 1), cB + hstepB, voffB); PG8_STAGE_A(PG8_SA(0, 0), cA, 0, false); PG8_STAGE_A(PG8_SA(0, 1), cA, 1, false);
    if (wr == 1) PG8_BAR;
    PG8_WAIT_V(2); PG8_BAR;
    PG8_STAGE(PG8_SB(1, 0), cB + kstep, voffB); PG8_STAGE_A(PG8_SA(1, 0), cA + kstep, 0, false); PG8_STAGE(PG8_SB(1, 1), cB + hstepB + kstep, voffB);
    PG8_WAIT_V(6); PG8_BAR;
    for (;;) {
        const bool has_next = S.next(ui + 1, nxt);
        const char* nA = cA; const char* nB = cB;
        if (has_next) { nA = PG8_ASRC(nxt); nB = PG8_BSRC(nxt); }
#pragma unroll 1
        for (int t = 0; t < nt; t += 2) {
            const bool last = (t == nt - 2);
            const char* a1 = cA + (size_t)(t + 1) * kstep;
            const char* a2 = last ? nA : cA + (size_t)(t + 2) * kstep; const char* b2 = last ? nB : cB + (size_t)(t + 2) * kstep;
            const char* a3 = a2 + kstep; const char* b3 = b2 + kstep;
            PG8_LDB(B0, 0, 0); PG8_LDB(B1, 0, 1); PG8_SCHED; PG8_LDA(At, 0, 0); PG8_STAGE_A(PG8_SA(1, 1), a1, 1, false);
            PG8_WAIT_V(8); PG8_WAIT_L(0); PG8_BAR; PG8_MMA(0, 0, At, B0); PG8_MMA(0, 1, At, B1); PG8_BAR; PG8_SCHED;
            PG8_LDA(At, 0, 1); PG8_STAGE(PG8_SB(0, 0), b2, voffB); PG8_STAGE(PG8_SB(0, 1), b2 + hstepB, voffB); PG8_STAGE_A(PG8_SA(0, 0), a2, 0, last);
            PG8_WAIT_V(8); PG8_WAIT_L(0); PG8_BAR; PG8_MMA(1, 0, At, B0); PG8_MMA(1, 1, At, B1); PG8_BAR; PG8_SCHED;
            PG8_LDB(B0, 1, 0); PG8_LDB(B1, 1, 1); PG8_SCHED; PG8_LDA(At, 1, 0); PG8_STAGE_A(PG8_SA(0, 1), a2, 1, last);
            PG8_WAIT_V(8); PG8_WAIT_L(0); PG8_BAR; PG8_MMA(0, 0, At, B0); PG8_MMA(0, 1, At, B1); PG8_BAR; PG8_SCHED;
            PG8_LDA(At, 1, 1); PG8_STAGE(PG8_SB(1, 0), b3, voffB); PG8_STAGE(PG8_SB(1, 1), b3 + hstepB, voffB); PG8_STAGE_A(PG8_SA(1, 0), a3, 0, last);
            PG8_WAIT_V(8); PG8_WAIT_L(0); PG8_BAR; PG8_MMA(1, 0, At, B0); PG8_MMA(1, 1, At, B1); PG8_BAR; PG8_SCHED;
        }
        if (wr == 0) PG8_BAR;
        if constexpr (FP8) asm volatile("s_nop 15\n\ts_nop 15\n\ts_nop 15\n\ts_nop 15" ::: "memory");
        if constexpr (GATHER) { Unit t2; gvnn = S.next(ui + 2, t2) ? PG8_GV(t2) : gvn; }
        E(acc, cur, wr, wc, fr, fq);
        if (!has_next) break;
        if constexpr (GATHER) { gvc = gvn; gvn = gvnn; }
#pragma unroll
        for (int a = 0; a < 2; ++a)
#pragma unroll
            for (int b = 0; b < 2; ++b)
#pragma unroll
                for (int m = 0; m < 4; ++m)
#pragma unroll
                    for (int n = 0; n < 2; ++n) acc[a][b][m][n] = (f32x4){0.f, 0.f, 0.f, 0.f};
        cur = nxt; cA = nA; cB = nB; ++ui;
        if (wr == 1) PG8_BAR;
    }
    PG8_WAIT_V(0);
    PG8_BAR;
#undef PG8_STAGE_A
#undef PG8_GV
#undef PG8_SA
#undef PG8_SB
#undef PG8_STAGE
#undef PG8_LDA
#undef PG8_LDB
#undef PG8_MMA
#undef PG8_WAIT_V
#undef PG8_WAIT_L
#undef PG8_BAR
#undef PG8_SCHED
#undef PG8_ASRC
#undef PG8_BSRC
}
}

#define XB_TMO      128
#define XB_XCNT(j)  (256  + 64 * (j))
#define XB_XSUB(j)  (1280 + 64 * (j))
#define XB_XGEN(j)  (2304 + 64 * (j))
#define XB_TOP      3328
#define XB_TOPGEN   3392
#define XCD_BAR_WORDS 3456
#define XB_SPIN_CAP (1u << 18)
__device__ __forceinline__ unsigned xb_ld(unsigned* p)              { return __hip_atomic_load(p, __ATOMIC_RELAXED, __HIP_MEMORY_SCOPE_AGENT); }
__device__ __forceinline__ unsigned xb_add(unsigned* p, unsigned v) { return __hip_atomic_fetch_add(p, v, __ATOMIC_RELAXED, __HIP_MEMORY_SCOPE_AGENT); }
__device__ __forceinline__ unsigned xb_xcc_id() { return (unsigned)__builtin_amdgcn_s_getreg((3 << 11) | 20) & 0xFu; }
#define XB_SPIN(cond, bar) do { unsigned _sp = 0; while (cond) { __builtin_amdgcn_s_sleep(1); \
    if ((++_sp & 255u) == 0u) { if (xb_ld(&(bar)[XB_TMO])) break; if (_sp > XB_SPIN_CAP) { atomicAdd(&(bar)[XB_TMO], 1u); break; } } } } while (0)
struct XcdBarrier { unsigned* bar; unsigned x; volatile LAS unsigned* st; };
__device__ __forceinline__ XcdBarrier xcd_barrier_post(unsigned* bar, volatile LAS unsigned* st) {
    XcdBarrier b; b.bar = bar; b.x = xb_xcc_id(); b.st = st;
    if (threadIdx.x == 0) (void)xb_add(&bar[XB_XCNT(b.x)], 1u);
    return b;
}
__device__ __forceinline__ void xcd_barrier_complete(unsigned* bar, unsigned x, unsigned& nloc, unsigned& nx) {
    const unsigned G = gridDim.x * gridDim.y * gridDim.z;
    unsigned sum, cnt, mine, sp = 0u;
    for (;;) {
        sum = 0u; cnt = 0u; mine = 0u;
#pragma unroll
        for (unsigned j = 0; j < 16; ++j) { const unsigned c = xb_ld(&bar[XB_XCNT(j)]); sum += c; cnt += (c > 0u) ? 1u : 0u; mine = (j == x) ? c : mine; }
        if (sum == G) break;
        __builtin_amdgcn_s_sleep(1);
        if ((++sp & 255u) == 0u) { if (xb_ld(&bar[XB_TMO])) break; if (sp > XB_SPIN_CAP) { atomicAdd(&bar[XB_TMO], 1u); break; } }
    }
    nloc = mine > 0u ? mine : 1u; nx = cnt > 0u ? cnt : 1u;
}
__device__ __forceinline__ void xcd_barrier(const XcdBarrier& b) {
    asm volatile("s_waitcnt vmcnt(0)" ::: "memory");
    __syncthreads();
    if (threadIdx.x == 0) {
        unsigned* bar = b.bar;
        __builtin_amdgcn_s_waitcnt(0);
        unsigned nloc = b.st[0], nx = b.st[1];
        if (nloc == 0u) { xcd_barrier_complete(bar, b.x, nloc, nx); b.st[0] = nloc; b.st[1] = nx; }
        const unsigned old = xb_add(&bar[XB_XSUB(b.x)], 1u);
        const unsigned gen = old / nloc;
        if (old + 1u == (gen + 1u) * nloc) {
            __builtin_amdgcn_fence(__ATOMIC_RELEASE, "agent");
            asm volatile("s_waitcnt vmcnt(0)" ::: "memory");
            const unsigned og = xb_add(&bar[XB_TOP], 1u);
            const unsigned tg = og / nx;
            if (og + 1u == (tg + 1u) * nx) xb_add(&bar[XB_TOPGEN], 1u);
            else XB_SPIN(xb_ld(&bar[XB_TOPGEN]) == tg, bar);
            __builtin_amdgcn_fence(__ATOMIC_ACQUIRE, "agent");
            xb_add(&bar[XB_XGEN(b.x)], 1u);
            asm volatile("s_waitcnt vmcnt(0)" ::: "memory");
        } else {
            XB_SPIN(xb_ld(&bar[XB_XGEN(b.x)]) == gen, bar);
            __builtin_amdgcn_fence(__ATOMIC_ACQUIRE, "agent");
            asm volatile("s_waitcnt vmcnt(0)" ::: "memory");
        }
    }
    __syncthreads();
}

struct Args {
    const float *x, *c, *w_ada, *b_ada, *w_in, *q_norm_g, *w_uq, *kv_norm_g, *w_ukv, *rel_bias, *w_out, *ln1_g, *ln1_b, *w_router, *w_gate, *w_up, *w_down, *ln2_g, *ln2_b;
    float* out; unsigned char* ws; int ph_lo, ph_hi;
};
struct Frame {
    LAS unsigned char* lds;
    int tid, lane, wave, vcu, G;
    unsigned char* ws;
};
#define WSP(T, off) ((T*)(F.ws + (off)))
typedef const __attribute__((address_space(4))) Args* KArgs;
__device__ __forceinline__ KArgs kargs() { KArgs p = (KArgs)__builtin_amdgcn_kernarg_segment_ptr(); asm volatile("" : "+s"(p)); return p; }

using pg8::Unit;
#define DPERM(s_) ((((s_) & 15) << 8) + ((s_) >> 4))
struct EpiProj {
    bf16_t *CQ, *CKV, *KR, *DQ; float* SSQ; const float* rope;
    __device__ __forceinline__ void operator()(const f32x4 (&acc)[2][2][4][2], const Unit& u, int wr, int wc, int fr, int fq) const {
        const int pn = u.pn;
        if (pn >= 3) {
            const int t = pn - 3; bf16_t* base = DQ + (size_t)(t >> 1) * ((WS_DK - WS_DQ) / 2); const float sc = (t < 2 ? QS_DIL : 1.f) * (1.f / WIN_SCALE);
            const int col0 = (t & 1) * 256 + wc * 32 + 8 * fq;
#pragma unroll
            for (int ai = 0; ai < 2; ++ai)
#pragma unroll
                for (int m = 0; m < 4; ++m) { const size_t row = (size_t)u.pm * 256 + ai * 128 + wr * 64 + m * 16 + fr;
#pragma unroll
                    for (int bj = 0; bj < 2; ++bj) { const f32x4 v0 = acc[ai][bj][m][0] * sc, v1 = acc[ai][bj][m][1] * sc;
                        u32x4 w; w.x = cvt_pk_bf16(v0[0], v0[1]); w.y = cvt_pk_bf16(v0[2], v0[3]); w.z = cvt_pk_bf16(v1[0], v1[1]); w.w = cvt_pk_bf16(v1[2], v1[3]);
                        const int col = col0 + bj * 128;
                        *(u32x4*)(base + ((size_t)((int)(row >> 12) * 8 + (col >> 6)) * SEQ + DPERM((int)row & (SEQ - 1))) * 64 + (col & 63)) = w; } }
        } else {
#pragma unroll
            for (int ai = 0; ai < 2; ++ai)
#pragma unroll
                for (int m = 0; m < 4; ++m) { const size_t row = (size_t)u.pm * 256 + ai * 128 + wr * 64 + m * 16 + fr;
#pragma unroll
                    for (int bj = 0; bj < 2; ++bj) { const f32x4 v0 = acc[ai][bj][m][0] * (1.f / WIN_SCALE), v1 = acc[ai][bj][m][1] * (1.f / WIN_SCALE);
                        const int seg = pn * 2 + bj;
                        if (seg < 5) {
                            float s = (v0[0] * v0[0] + v0[1] * v0[1]) + (v0[2] * v0[2] + v0[3] * v0[3]) + (v1[0] * v1[0] + v1[1] * v1[1]) + (v1[2] * v1[2] + v1[3] * v1[3]);
                            s += __shfl_xor(s, 16); s += __shfl_xor(s, 32);
                            if (fq == 0) SSQ[row * 32 + seg * 4 + wc] = s;
                            u32x4 w; w.x = cvt_pk_bf16(v0[0], v0[1]); w.y = cvt_pk_bf16(v0[2], v0[3]); w.z = cvt_pk_bf16(v1[0], v1[1]); w.w = cvt_pk_bf16(v1[2], v1[3]);
                            if (seg < 3) *(u32x4*)(CQ + row * 384 + seg * 128 + wc * 32 + 8 * fq) = w;
                            else *(u32x4*)(CKV + row * 256 + (seg - 3) * 128 + wc * 32 + 8 * fq) = w;
                        } else if (wc == 0) {
                            const int pos = (int)(row & (SEQ - 1)); const float* rp = rope + pos * 32 + 8 * (fq & 1);
                            const f32x4 c0 = *(const f32x4*)(rp), c1 = *(const f32x4*)(rp + 4), s0 = *(const f32x4*)(rp + 16), s1 = *(const f32x4*)(rp + 20);
                            f32x4 o0, o1;
#pragma unroll
                            for (int j = 0; j < 4; ++j) { const float a = v0[j], b = v1[j]; const float pa = __shfl_xor(a, 32), pb = __shfl_xor(b, 32);
                                o0[j] = fq < 2 ? a * c0[j] - pa * s0[j] : pa * s0[j] + a * c0[j];
                                o1[j] = fq < 2 ? b * c1[j] - pb * s1[j] : pb * s1[j] + b * c1[j]; }
                            u32x2 w; w.x = pk4_fp8(o0[0] * K8_SCALE, o0[1] * K8_SCALE, o0[2] * K8_SCALE, o0[3] * K8_SCALE); w.y = pk4_fp8(o1[0] * K8_SCALE, o1[1] * K8_SCALE, o1[2] * K8_SCALE, o1[3] * K8_SCALE);
                            unsigned char* k8 = (unsigned char*)KR + ((size_t)((row >> 12) * 8) * SEQ + (row & (SEQ - 1))) * 128 + 8 * fq;
#pragma unroll
                            for (int hh = 0; hh < 8; ++hh) { *(u32x2*)(k8 + (size_t)hh * SEQ * 128 + 64) = w; *(u32x2*)(k8 + (size_t)hh * SEQ * 128 + 96) = (u32x2){fq == 0 ? 0x00383838u : 0u, 0u}; }
                        } } }
        }
    }
};
struct EpiQ {
    bf16_t* Q; const float* SSQ; const float* rope;
    __device__ __forceinline__ void operator()(const f32x4 (&acc)[2][2][4][2], const Unit& u, int wr, int wc, int fr, int fq) const {
#pragma unroll
        for (int ai = 0; ai < 2; ++ai)
#pragma unroll
            for (int m = 0; m < 4; ++m) { const size_t row = (size_t)u.pm * 256 + ai * 128 + wr * 64 + m * 16 + fr;
                const f32x4 q0 = *(const f32x4*)(SSQ + row * 32), q1 = *(const f32x4*)(SSQ + row * 32 + 4), q2 = *(const f32x4*)(SSQ + row * 32 + 8);
                const float ss = ((q0[0] + q0[1]) + (q0[2] + q0[3])) + ((q1[0] + q1[1]) + (q1[2] + q1[3])) + ((q2[0] + q2[1]) + (q2[2] + q2[3]));
                const float rs = Q8_SCALE / sqrtf(ss * (1.f / Q_LORA) + NORM_EPS);
                const int pos = (int)(row & (SEQ - 1));
#pragma unroll
                for (int bj = 0; bj < 2; ++bj) { f32x4 v0 = acc[ai][bj][m][0] * rs, v1 = acc[ai][bj][m][1] * rs;
                    const int G32 = u.pn * 8 + bj * 4 + wc;
                    if (G32 % 3 == 2) {
                        const float* rp = rope + pos * 32 + 8 * (fq & 1);
                        const f32x4 c0 = *(const f32x4*)(rp), c1 = *(const f32x4*)(rp + 4), s0 = *(const f32x4*)(rp + 16), s1 = *(const f32x4*)(rp + 20);
                        f32x4 o0, o1;
#pragma unroll
                        for (int j = 0; j < 4; ++j) { const float a = v0[j], b = v1[j]; const float pa = __shfl_xor(a, 32), pb = __shfl_xor(b, 32);
                            o0[j] = fq < 2 ? a * c0[j] - pa * s0[j] : pa * s0[j] + a * c0[j];
                            o1[j] = fq < 2 ? b * c1[j] - pb * s1[j] : pb * s1[j] + b * c1[j]; }
                        v0 = o0; v1 = o1;
                    }
                    u32x2 w; w.x = pk4_fp8(v0[0], v0[1], v0[2], v0[3]); w.y = pk4_fp8(v1[0], v1[1], v1[2], v1[3]);
                    unsigned char* q8 = (unsigned char*)Q + ((size_t)((row >> 12) * 8 + G32 / 3) * SEQ + pos) * 128 + (G32 % 3) * 32 + 8 * fq;
                    *(u32x2*)q8 = w; if (G32 % 3 == 2) *(u32x2*)(q8 + 32) = (u32x2){0u, 0u}; }
                asm volatile("" ::: "memory"); }
    }
};
struct EpiKV {
    bf16_t* O; const float* SSQ;
    __device__ __forceinline__ void operator()(const f32x4 (&acc)[2][2][4][2], const Unit& u, int wr, int wc, int fr, int fq) const {
#pragma unroll
        for (int ai = 0; ai < 2; ++ai)
#pragma unroll
            for (int m = 0; m < 4; ++m) { const size_t row = (size_t)u.pm * 256 + ai * 128 + wr * 64 + m * 16 + fr;
                const f32x4 q0 = *(const f32x4*)(SSQ + row * 32 + 12), q1 = *(const f32x4*)(SSQ + row * 32 + 16);
                const float ss = ((q0[0] + q0[1]) + (q0[2] + q0[3])) + ((q1[0] + q1[1]) + (q1[2] + q1[3]));
                const float rs = 1.f / sqrtf(ss * (1.f / KV_LORA) + NORM_EPS);
#pragma unroll
                for (int bj = 0; bj < 2; ++bj) { const f32x4 v0 = acc[ai][bj][m][0] * rs, v1 = acc[ai][bj][m][1] * rs;
                    u32x4 w; w.x = cvt_pk_bf16(v0[0], v0[1]); w.y = cvt_pk_bf16(v0[2], v0[3]); w.z = cvt_pk_bf16(v1[0], v1[1]); w.w = cvt_pk_bf16(v1[2], v1[3]);
                    *(u32x4*)(O + row * 512 + u.pn * 256 + bj * 128 + wc * 32 + 8 * fq) = w; }
                asm volatile("" ::: "memory"); }
    }
};
struct EpiKN8 {
    unsigned char* K8; const float* SSQ;
    __device__ __forceinline__ void operator()(const f32x4 (&acc)[2][2][4][2], const Unit& u, int wr, int wc, int fr, int fq) const {
#pragma unroll
        for (int ai = 0; ai < 2; ++ai)
#pragma unroll
            for (int m = 0; m < 4; ++m) { const size_t row = (size_t)u.pm * 256 + ai * 128 + wr * 64 + m * 16 + fr;
                const f32x4 q0 = *(const f32x4*)(SSQ + row * 32 + 12), q1 = *(const f32x4*)(SSQ + row * 32 + 16);
                const float ss = ((q0[0] + q0[1]) + (q0[2] + q0[3])) + ((q1[0] + q1[1]) + (q1[2] + q1[3]));
                const float rs = K8_SCALE / sqrtf(ss * (1.f / KV_LORA) + NORM_EPS);
#pragma unroll
                for (int bj = 0; bj < 2; ++bj) { const f32x4 v0 = acc[ai][bj][m][0] * rs, v1 = acc[ai][bj][m][1] * rs;
                    const int col = u.pn * 256 + bj * 128 + wc * 32 + 8 * fq;
                    u32x2 w; w.x = pk4_fp8(v0[0], v0[1], v0[2], v0[3]); w.y = pk4_fp8(v1[0], v1[1], v1[2], v1[3]);
                    *(u32x2*)(K8 + ((size_t)((row >> 12) * 8 + (col >> 6)) * SEQ + (row & (SEQ - 1))) * 128 + (col & 63)) = w; }
                asm volatile("" ::: "memory"); }
    }
};
struct EpiVt8 {
    unsigned char* Vt; const float* SSQ;
    __device__ __forceinline__ void operator()(const f32x4 (&acc)[2][2][4][2], const Unit& u, int wr, int wc, int fr, int fq) const {
        float rs[2][8];
#pragma unroll
        for (int bj = 0; bj < 2; ++bj)
#pragma unroll
            for (int j = 0; j < 8; ++j) { const size_t tok = (size_t)u.pn * 256 + bj * 128 + wc * 32 + 8 * fq + j;
                const f32x4 q0 = *(const f32x4*)(SSQ + tok * 32 + 12), q1 = *(const f32x4*)(SSQ + tok * 32 + 16);
                rs[bj][j] = 1.f / sqrtf((((q0[0] + q0[1]) + (q0[2] + q0[3])) + ((q1[0] + q1[1]) + (q1[2] + q1[3]))) * (1.f / KV_LORA) + NORM_EPS); }
#pragma unroll
        for (int ai = 0; ai < 2; ++ai)
#pragma unroll
            for (int m = 0; m < 4; ++m) { const int ch = u.pm * 256 + ai * 128 + wr * 64 + m * 16 + fr;
#pragma unroll
                for (int bj = 0; bj < 2; ++bj) { const f32x4 v0 = acc[ai][bj][m][0], v1 = acc[ai][bj][m][1];
                    const int tok = u.pn * 256 + bj * 128 + wc * 32 + 8 * fq;
                    u32x2 w; w.x = pk4_fp8(v0[0] * rs[bj][0], v0[1] * rs[bj][1], v0[2] * rs[bj][2], v0[3] * rs[bj][3]); w.y = pk4_fp8(v1[0] * rs[bj][4], v1[1] * rs[bj][5], v1[2] * rs[bj][6], v1[3] * rs[bj][7]);
                    *(u32x2*)(Vt + ((size_t)((tok >> 12) * 512 + ch)) * SEQ + (tok & (SEQ - 1))) = w; } }
    }
};
struct EpiOut {
    bf16_t* out; const float* mod;
    __device__ __forceinline__ void operator()(const f32x4 (&acc)[2][2][4][2], const Unit& u, int wr, int wc, int fr, int fq) const {
#pragma unroll
        for (int ai = 0; ai < 2; ++ai)
#pragma unroll
            for (int m = 0; m < 4; ++m) { const size_t row = (size_t)u.pm * 256 + ai * 128 + wr * 64 + m * 16 + fr; const int b = (int)(row >> 12);
#pragma unroll
                for (int bj = 0; bj < 2; ++bj) { const int col = u.pn * 256 + bj * 128 + wc * 32 + 8 * fq;
                    const float* gp = mod + b * 6144 + 2048 + col;
                    const f32x4 g0 = *(const f32x4*)gp, g1 = *(const f32x4*)(gp + 4);
                    const f32x4 m0 = g0 * acc[ai][bj][m][0] * (DBG_MIX_F / (WOUT_SCALE * MIX_SCALE)), m1 = g1 * acc[ai][bj][m][1] * (DBG_MIX_F / (WOUT_SCALE * MIX_SCALE));
                    u32x4 w; w.x = cvt_pk_bf16(m0[0], m0[1]); w.y = cvt_pk_bf16(m0[2], m0[3]); w.z = cvt_pk_bf16(m1[0], m1[1]); w.w = cvt_pk_bf16(m1[2], m1[3]);
                    *(u32x4*)(out + row * 1024 + col) = w; } }
    }
};
struct EpiGU {
    bf16_t* H;
    __device__ __forceinline__ void operator()(const f32x4 (&acc)[2][2][4][2], const Unit& u, int wr, int wc, int fr, int fq) const {
#pragma unroll
        for (int ai = 0; ai < 2; ++ai)
#pragma unroll
            for (int m = 0; m < 4; ++m) { const unsigned row = (unsigned)(u.pm * 256 + ai * 128 + wr * 64 + m * 16 + fr);
                float o[8];
#pragma unroll
                for (int n = 0; n < 2; ++n)
#pragma unroll
                    for (int j = 0; j < 4; ++j) { const float ag = acc[ai][0][m][n][j], au = acc[ai][1][m][n][j];
                        constexpr float kk = WGU_SCALE * WGU_SCALE / HID_SCALE;
                        const float e = __builtin_amdgcn_exp2f(ag * (-LOG2E / WGU_SCALE));
                        o[n * 4 + j] = (ag * au) * __builtin_amdgcn_rcpf(__builtin_fmaf(e, kk, kk)); }
                u32x2 w; w.x = pk4_fp8(o[0], o[1], o[2], o[3]); w.y = pk4_fp8(o[4], o[5], o[6], o[7]);
                *(u32x2*)((unsigned char*)H + (row * 1536u + (unsigned)(u.pn * 128 + wc * 32 + 8 * fq))) = w; }
    }
};
struct EpiDown {
    bf16_t* Y; const float* vals;
    __device__ __forceinline__ void operator()(const f32x4 (&acc)[2][2][4][2], const Unit& u, int wr, int wc, int fr, int fq) const {
#pragma unroll
        for (int ai = 0; ai < 2; ++ai)
#pragma unroll
            for (int m = 0; m < 4; ++m) { const unsigned row = (unsigned)(u.pm * 256 + ai * 128 + wr * 64 + m * 16 + fr); const float vv = vals[row] * (Y_SCALE / (WD_SCALE * HID_SCALE));
#pragma unroll
                for (int bj = 0; bj < 2; ++bj) { const f32x4 v0 = acc[ai][bj][m][0] * vv, v1 = acc[ai][bj][m][1] * vv;
                    u32x2 w; w.x = pk4_fp8(v0[0], v0[1], v0[2], v0[3]); w.y = pk4_fp8(v1[0], v1[1], v1[2], v1[3]);
                    *(u32x2*)((unsigned char*)Y + (row * 1024u + (unsigned)(u.pn * 256 + bj * 128 + wc * 32 + 8 * fq))) = w; } }
    }
};

__device__ __forceinline__ s16x4 vtr(const LAS char* p) { return __builtin_bit_cast(s16x4, __builtin_amdgcn_ds_read_tr16_b64_v4i16((LAS s16x4*)p)); }
template <int ND0, int KPITCH, bool BIAS>
__device__ __forceinline__ void attn_tile(const LAS char* Kt, const LAS char* Vt, const bf16x8 (&qr)[ND0], float& m_run, float& l_run, f32x16& o0, f32x16& o1,
                                          const LAS float* tab, int lane) {
    const int r32 = lane & 31, hi = lane >> 5;
    f32x16 p0, p1;
#pragma unroll
    for (int r = 0; r < 16; ++r) { p0[r] = 0.f; p1[r] = 0.f; }
    const LAS char* kp = Kt + r32 * KPITCH + hi * 16;
    bf16x8 kf[2 * ND0];
#pragma unroll
    for (int d0 = 0; d0 < ND0; ++d0) { kf[2 * d0] = *(const LAS bf16x8*)(kp + d0 * 32); kf[2 * d0 + 1] = *(const LAS bf16x8*)(kp + 32 * KPITCH + d0 * 32); }
#pragma unroll
    for (int d0 = 0; d0 < ND0; ++d0) {
        p0 = __builtin_amdgcn_mfma_f32_32x32x16_bf16(kf[2 * d0], qr[d0], p0, 0, 0, 0);
        p1 = __builtin_amdgcn_mfma_f32_32x32x16_bf16(kf[2 * d0 + 1], qr[d0], p1, 0, 0, 0);
    }
    const LAS char* vp = Vt + (4 * hi + ((lane & 15) >> 2)) * 64 + ((lane >> 4) & 1) * 32 + (lane & 3) * 8;
    bf16x8 vf[8];
#pragma unroll
    for (int ks = 0; ks < 4; ++ks) {
        const s16x4 l0 = vtr(vp + ks * 1024), h0 = vtr(vp + ks * 1024 + 512), l1 = vtr(vp + 4096 + ks * 1024), h1 = vtr(vp + 4096 + ks * 1024 + 512);
        vf[2 * ks] = (bf16x8){l0[0], l0[1], l0[2], l0[3], h0[0], h0[1], h0[2], h0[3]}; vf[2 * ks + 1] = (bf16x8){l1[0], l1[1], l1[2], l1[3], h1[0], h1[1], h1[2], h1[3]};
    }
    __builtin_amdgcn_sched_barrier(0);
    if constexpr (BIAS) {
#pragma unroll
        for (int r = 0; r < 16; ++r) { const int kvl = (r & 3) + 8 * (r >> 2) + 4 * hi; p0[r] += tab[kvl]; p1[r] += tab[kvl + 32]; }
    }
    float mx = fmaxf(p0[0], p1[0]);
#pragma unroll
    for (int r = 1; r < 16; ++r) mx = fmaxf(mx, fmaxf(p0[r], p1[r]));
    mx = xhalf_fmax(mx);
    const float m_new = fmaxf(m_run, mx);
    const float alpha = __builtin_amdgcn_exp2f(m_run - m_new);
    m_run = m_new;
    float rs = 0.f;
#pragma unroll
    for (int r = 0; r < 16; ++r) { p0[r] = __builtin_amdgcn_exp2f(p0[r] - m_new); p1[r] = __builtin_amdgcn_exp2f(p1[r] - m_new); rs += p0[r] + p1[r]; }
    l_run = l_run * alpha + rs;
#pragma unroll
    for (int r = 0; r < 16; ++r) { o0[r] *= alpha; o1[r] *= alpha; }
    bf16x8 pf[4];
#pragma unroll
    for (int ks = 0; ks < 4; ++ks) { u32x4 w;
        if (ks < 2) { w.x = cvt_pk_bf16(p0[8 * ks + 0], p0[8 * ks + 1]); w.y = cvt_pk_bf16(p0[8 * ks + 2], p0[8 * ks + 3]); w.z = cvt_pk_bf16(p0[8 * ks + 4], p0[8 * ks + 5]); w.w = cvt_pk_bf16(p0[8 * ks + 6], p0[8 * ks + 7]); }
        else { const int k2 = ks - 2; w.x = cvt_pk_bf16(p1[8 * k2 + 0], p1[8 * k2 + 1]); w.y = cvt_pk_bf16(p1[8 * k2 + 2], p1[8 * k2 + 3]); w.z = cvt_pk_bf16(p1[8 * k2 + 4], p1[8 * k2 + 5]); w.w = cvt_pk_bf16(p1[8 * k2 + 6], p1[8 * k2 + 7]); }
        pf[ks] = __builtin_bit_cast(bf16x8, w); }
#pragma unroll
    for (int ks = 0; ks < 4; ++ks) {
        o0 = __builtin_amdgcn_mfma_f32_32x32x16_bf16(vf[2 * ks], pf[ks], o0, 0, 0, 0);
        o1 = __builtin_amdgcn_mfma_f32_32x32x16_bf16(vf[2 * ks + 1], pf[ks], o1, 0, 0, 0);
    }
}

constexpr int MLA_KP = 144, MLA_KB = 64 * MLA_KP, MLA_VP = 80, MLA_BUF = MLA_KB + 64 * MLA_VP;
constexpr float MLA_POFS = 0.f;
__device__ __forceinline__ float max3f(float a, float b, float c) { float r; asm("v_max3_f32 %0, %1, %2, %3" : "=v"(r) : "v"(a), "v"(b), "v"(c)); return r; }
__device__ __forceinline__ float xhalf_max(float m) { auto rr = __builtin_amdgcn_permlane32_swap(__float_as_uint(m), __float_as_uint(m), false, false); float a = __uint_as_float(rr[0]), b = __uint_as_float(rr[1]); float r; asm("v_max_f32_e32 %0, %1, %2" : "=v"(r) : "v"(a), "v"(b)); return r; }
__device__ __forceinline__ float fmin126(float a) { float r; asm("v_min_f32_e32 %0, 0x42fc0000, %1" : "=v"(r) : "v"(a)); return r; }
__device__ __forceinline__ float xhalf_sum(float m) { return xhalf_add(m); }
__device__ __forceinline__ float rowmax32(const f32x16& p0, const f32x16& p1) {
    float a = max3f(p0[0], p0[1], p1[0]), b = max3f(p0[2], p0[3], p1[1]); a = max3f(a, p1[2], p1[3]);
#pragma unroll
    for (int r = 4; r < 16; r += 4) { a = max3f(a, p0[r], p0[r + 1]); b = max3f(b, p0[r + 2], p0[r + 3]); a = max3f(a, p1[r], p1[r + 1]); b = max3f(b, p1[r + 2], p1[r + 3]); }
    float m; asm("v_max_f32_e32 %0, %1, %2" : "=v"(m) : "v"(a), "v"(b));
    return xhalf_max(m);
}
template <int ND0, int KPITCH>
__device__ __forceinline__ void qk_tile(f32x16& p0, f32x16& p1, const LAS char* Kt, const bf16x8 (&qr)[ND0], const f32x16& cinit, int lane) {
    const LAS char* kp = Kt + (lane & 31) * KPITCH + (lane >> 5) * 16;
#pragma unroll
    for (int d0 = 0; d0 < ND0; ++d0) {
        const bf16x8 a0 = *(const LAS bf16x8*)(kp + d0 * 32), a1 = *(const LAS bf16x8*)(kp + 32 * KPITCH + d0 * 32);
        if (d0 == 0) { p0 = __builtin_amdgcn_mfma_f32_32x32x16_bf16(a0, qr[0], cinit, 0, 0, 0); p1 = __builtin_amdgcn_mfma_f32_32x32x16_bf16(a1, qr[0], cinit, 0, 0, 0); }
        else { p0 = __builtin_amdgcn_mfma_f32_32x32x16_bf16(a0, qr[d0], p0, 0, 0, 0); p1 = __builtin_amdgcn_mfma_f32_32x32x16_bf16(a1, qr[d0], p1, 0, 0, 0); }
    }
}
__device__ __forceinline__ void pv_tile(f32x16& o0, f32x16& o1, const f32x16& p0, const f32x16& p1, const LAS char* Vt, int lane) {
    const int hi = lane >> 5;
    bf16x8 pf[4];
#pragma unroll
    for (int ks = 0; ks < 4; ++ks) { u32x4 w;
        if (ks < 2) { w.x = cvt_pk_bf16(p0[8 * ks + 0], p0[8 * ks + 1]); w.y = cvt_pk_bf16(p0[8 * ks + 2], p0[8 * ks + 3]); w.z = cvt_pk_bf16(p0[8 * ks + 4], p0[8 * ks + 5]); w.w = cvt_pk_bf16(p0[8 * ks + 6], p0[8 * ks + 7]); }
        else { const int k2 = ks - 2; w.x = cvt_pk_bf16(p1[8 * k2 + 0], p1[8 * k2 + 1]); w.y = cvt_pk_bf16(p1[8 * k2 + 2], p1[8 * k2 + 3]); w.z = cvt_pk_bf16(p1[8 * k2 + 4], p1[8 * k2 + 5]); w.w = cvt_pk_bf16(p1[8 * k2 + 6], p1[8 * k2 + 7]); }
        pf[ks] = __builtin_bit_cast(bf16x8, w); }
    const LAS char* vp = Vt + (4 * hi + ((lane & 15) >> 2)) * 64 + ((lane >> 4) & 1) * 32 + (lane & 3) * 8;
#pragma unroll
    for (int ks = 0; ks < 4; ++ks) {
        const s16x4 l0 = vtr(vp + ks * 1024), h0 = vtr(vp + ks * 1024 + 512), l1 = vtr(vp + 4096 + ks * 1024), h1 = vtr(vp + 4096 + ks * 1024 + 512);
        const bf16x8 v0 = (bf16x8){l0[0], l0[1], l0[2], l0[3], h0[0], h0[1], h0[2], h0[3]}, v1 = (bf16x8){l1[0], l1[1], l1[2], l1[3], h1[0], h1[1], h1[2], h1[3]};
        o0 = __builtin_amdgcn_mfma_f32_32x32x16_bf16(v0, pf[ks], o0, 0, 0, 0);
        o1 = __builtin_amdgcn_mfma_f32_32x32x16_bf16(v1, pf[ks], o1, 0, 0, 0);
    }
}
#define SGB(mask, n) __builtin_amdgcn_sched_group_barrier(mask, n, 0)
__device__ __forceinline__ unsigned enc3_fp8(float v) {
    const int w1 = __builtin_amdgcn_cvt_pk_fp8_f32(__builtin_amdgcn_fmed3f(v, -448.f, 448.f), 0.f, 0, false); const float r1 = v - __builtin_amdgcn_cvt_f32_fp8(w1, 0);
    const int w2 = __builtin_amdgcn_cvt_pk_fp8_f32(__builtin_amdgcn_fmed3f(r1, -448.f, 448.f), 0.f, 0, false); const float r2 = r1 - __builtin_amdgcn_cvt_f32_fp8(w2, 0);
    const int w3 = __builtin_amdgcn_cvt_pk_fp8_f32(__builtin_amdgcn_fmed3f(r2, -448.f, 448.f), 0.f, 0, false);
    return ((unsigned)w1 & 0xffu) | (((unsigned)w2 & 0xffu) << 8) | (((unsigned)w3 & 0xffu) << 16);
}
__device__ __forceinline__ void mla_unit(Frame& F, int b, int h, int qb) {
    int tid = F.tid; asm volatile("" : "+v"(tid));
    const int lane = tid & 63, wid = F.wave, r32 = lane & 31, hi = lane >> 5;
    const unsigned char* Q8 = WSP(const unsigned char, WS_Q); const unsigned char* K8 = WSP(const unsigned char, WS_KN); const unsigned char* Vt8 = WSP(const unsigned char, WS_V);
    bf16_t* MIX = WSP(bf16_t, WS_MIX);
    const size_t tok0 = (size_t)b * SEQ;
    const int q0 = qb * 512 + wid * 64 + r32;
    i32x8 qA[2], qB[2];
    { const unsigned char* qp = Q8 + ((size_t)(b * 8 + h) * SEQ + q0) * 128 + 32 * hi;
#pragma unroll
      for (int ks = 0; ks < 2; ++ks) { const i32x4 lo = *(const i32x4*)(qp + 64 * ks), hh = *(const i32x4*)(qp + 64 * ks + 16); qA[ks] = __builtin_shufflevector(lo, hh, 0, 1, 2, 3, 4, 5, 6, 7);
          const i32x4 lo2 = *(const i32x4*)(qp + 32 * 128 + 64 * ks), hh2 = *(const i32x4*)(qp + 32 * 128 + 64 * ks + 16); qB[ks] = __builtin_shufflevector(lo2, hh2, 0, 1, 2, 3, 4, 5, 6, 7); } }
    const int kv_s = tid >> 3, c_s = tid & 7;
    const unsigned char* k_base = K8 + (size_t)(b * 8 + h) * SEQ * 128; const unsigned k_off = (unsigned)(kv_s * 128 + c_s * 16);
    const unsigned char* v_base = Vt8 + (size_t)(b * 8 + h) * 64 * SEQ; const unsigned v_off = (unsigned)(((tid >> 2) & 63) * SEQ + (tid & 3) * 16);
    const int k_dst = (((kv_s & 31) << 1) | (kv_s >> 5)) * MLA_KP + c_s * 16, v_dst = MLA_KB + ((tid >> 2) & 63) * MLA_VP + (tid & 3) * 16;
    LAS char* lds = (LAS char*)F.lds;
    f32x16 oA0, oA1, oB0, oB1;
#pragma unroll
    for (int r = 0; r < 16; ++r) { oA0[r] = 0.f; oA1[r] = 0.f; oB0[r] = 0.f; oB1[r] = 0.f; }
    float lA = 0.f, lB = 0.f;
    const f32x16 zero16 = (f32x16){0.f, 0.f, 0.f, 0.f, 0.f, 0.f, 0.f, 0.f, 0.f, 0.f, 0.f, 0.f, 0.f, 0.f, 0.f, 0.f};
    const int selw = ((((lane & 15) >> 2) & 1) == ((lane >> 4) & 1)) ? 0x38383838 : 0;
    const i32x8 sel8 = (i32x8){selw, selw, selw, selw, selw, selw, selw, selw};
    const f32x4 zero4 = (f32x4){0.f, 0.f, 0.f, 0.f};
#define MLA_SUM8(b) __builtin_amdgcn_mfma_scale_f32_16x16x128_f8f6f4(sel8, b, zero4, 0, 0, 0, 0, 0, 0)
    u32x4 rk0, rv0, rk1, rv1;
#define MLA_LOADG(t, rk, rv) do { const unsigned o_ = (unsigned)((t) < 64 ? (t) : 63) * 64u; rk = *(const u32x4*)(k_base + (k_off + o_ * 128u)); rv = *(const u32x4*)(v_base + (v_off + o_)); } while (0)
#define MLA_STORE_OFF(off, rk, rv) do { LAS char* d_ = lds + (off); *(LAS u32x4*)(d_ + k_dst) = rk; *(LAS u32x4*)(d_ + v_dst) = rv; } while (0)
#define MLA_KFRAG(dst, base, a, ks) do { const LAS char* p_ = (base) + (a) * 32 * MLA_KP + (ks) * 64; \
        const i32x4 lo_ = *(const LAS i32x4*)p_, hi_ = *(const LAS i32x4*)(p_ + 16); dst = __builtin_shufflevector(lo_, hi_, 0, 1, 2, 3, 4, 5, 6, 7); } while (0)
#define MLA_MFMA8(a, b, c) __builtin_amdgcn_mfma_scale_f32_32x32x64_f8f6f4(a, b, c, 0, 0, 0, 0, 0, 0)
    static_assert(6 * MLA_BUF <= RING_BYTES, "MLA ring");
    const int sig = 32 * ((r32 >> 2) & 1) + (r32 & 3) + 4 * (r32 >> 3);
    const LAS char* kp0 = lds + (2 * (sig & 31) + (sig >> 5)) * MLA_KP + hi * 32;
    const LAS char* vp0 = lds + MLA_KB + r32 * MLA_VP + 32 * hi;
    MLA_LOADG(0, rk0, rv0); MLA_LOADG(1, rk1, rv1); MLA_STORE_OFF(0, rk0, rv0); MLA_STORE_OFF(MLA_BUF, rk1, rv1);
    MLA_LOADG(2, rk0, rv0); MLA_LOADG(3, rk1, rv1); MLA_STORE_OFF(2 * MLA_BUF, rk0, rv0); MLA_STORE_OFF(3 * MLA_BUF, rk1, rv1);
    __syncthreads();
    MLA_LOADG(4, rk0, rv0); MLA_LOADG(5, rk1, rv1);
    i32x8 kf[4];
#define MLA_KFRAGS(slot) do { const LAS char* kp_ = kp0 + (slot); MLA_KFRAG(kf[0], kp_, 0, 0); MLA_KFRAG(kf[1], kp_, 0, 1); MLA_KFRAG(kf[2], kp_, 1, 0); MLA_KFRAG(kf[3], kp_, 1, 1); } while (0)
#define MLA_VFRAGS(slot) do { const LAS char* vp_ = vp0 + (slot); \
        _Pragma("unroll") for (int dh = 0; dh < 2; ++dh) { const i32x4 lo_ = *(const LAS i32x4*)(vp_ + dh * 32 * MLA_VP), hi_ = *(const LAS i32x4*)(vp_ + dh * 32 * MLA_VP + 16); vf[dh] = __builtin_shufflevector(lo_, hi_, 0, 1, 2, 3, 4, 5, 6, 7); } } while (0)
#define MLA_SCORE(q) do { s0 = MLA_MFMA8(kf[0], q[0], zero16); s1 = MLA_MFMA8(kf[2], q[0], zero16); s0 = MLA_MFMA8(kf[1], q[1], s0); s1 = MLA_MFMA8(kf[3], q[1], s1); } while (0)
    f32x16 s0, s1; i32x8 vf[2];
    MLA_KFRAGS(0);
    { MLA_SCORE(qA); const unsigned ea = enc3_fp8(56.5f + 8.f * MLA_POFS - rowmax32(s0, s1));
      MLA_SCORE(qB); const unsigned eb = enc3_fp8(56.5f + 8.f * MLA_POFS - rowmax32(s0, s1));
      qA[1][0] = hi ? (int)ea : qA[1][0]; qB[1][0] = hi ? (int)eb : qB[1][0]; }
#define MLA_PBYTES(pf_) do { _Pragma("unroll") for (int g_ = 0; g_ < 4; ++g_) { unsigned b0_ = 0u, b1_ = 0u; \
            _Pragma("unroll") for (int j_ = 0; j_ < 4; ++j_) { b0_ = __builtin_amdgcn_cvt_pk_u8_f32(s0[4 * g_ + j_], j_, b0_); b1_ = __builtin_amdgcn_cvt_pk_u8_f32(s1[4 * g_ + j_], j_, b1_); } \
            pf_[g_] = (int)b0_; pf_[4 + g_] = (int)b1_; } } while (0)
#define SB0() __builtin_amdgcn_sched_barrier(0)
#define MLA_TILE(this_slot, next_slot) do { i32x8 pf_; \
        MLA_PBYTES(pf_); SB0(); lB += t_[0]; MLA_VFRAGS(this_slot); SB0(); MLA_SCORE(qB); SB0(); \
        oA0 = MLA_MFMA8(vf[0], pf_, oA0); oA1 = MLA_MFMA8(vf[1], pf_, oA1); t_ = MLA_SUM8(pf_); SB0(); \
        MLA_PBYTES(pf_); SB0(); lA += t_[0]; MLA_KFRAGS(next_slot); SB0(); \
        oB0 = MLA_MFMA8(vf[0], pf_, oB0); oB1 = MLA_MFMA8(vf[1], pf_, oB1); t_ = MLA_SUM8(pf_); SB0(); MLA_SCORE(qA); SB0(); } while (0)
    MLA_SCORE(qA); f32x4 t_ = zero4;
    if (wid < 4) __builtin_amdgcn_s_setprio(3); else __builtin_amdgcn_s_setprio(1);
    int sl = 0;
#pragma unroll 1
    for (int tp = 0; tp < 32; ++tp) {
        const int s_a = sl * MLA_BUF, s_b = s_a + MLA_BUF, sl2 = sl + 2 >= 6 ? sl - 4 : sl + 2, s_c = sl2 * MLA_BUF, sl4 = sl2 + 2 >= 6 ? sl2 - 4 : sl2 + 2, f_a = sl4 * MLA_BUF, f_b = f_a + MLA_BUF;
        MLA_STORE_OFF(f_a, rk0, rv0); MLA_STORE_OFF(f_b, rk1, rv1);
        MLA_LOADG(2 * tp + 6, rk0, rv0); MLA_LOADG(2 * tp + 7, rk1, rv1);
        __builtin_amdgcn_sched_barrier(0);
        MLA_TILE(s_a, s_b);
        MLA_TILE(s_b, s_c);
        asm volatile("s_waitcnt lgkmcnt(0)" ::: "memory"); __builtin_amdgcn_s_barrier(); asm volatile("" ::: "memory");
        sl = sl2;
    }
    lB += t_[0];
    __builtin_amdgcn_s_setprio(0);
#undef MLA_TILE
#undef SB0
#undef MLA_PBYTES
#undef MLA_SCORE
#undef MLA_KFRAGS
#undef MLA_VFRAGS
#undef MLA_KFRAG
#undef MLA_MFMA8
#undef MLA_STORE_OFF
#undef MLA_LOADG
    int tid2 = F.tid; asm volatile("" : "+v"(tid2));
    const int hi2 = (tid2 >> 5) & 1; const size_t orow0 = tok0 + qb * 512 + wid * 64 + (tid2 & 31);
#pragma unroll
    for (int grp = 0; grp < 2; ++grp) {
        const f32x16& o0 = grp ? oB0 : oA0; const f32x16& o1 = grp ? oB1 : oA1;
        const float inv = DBG_MLA_F / (grp ? lB : lA);
        unsigned char* orow = (unsigned char*)MIX + (orow0 + 32 * grp) * 1024 + h * 64 + 8 * hi2;
        const float invs = inv * MIX_SCALE;
#pragma unroll
        for (int hf = 0; hf < 2; ++hf) { const f32x16& oo = hf ? o1 : o0;
#pragma unroll
            for (int gp = 0; gp < 2; ++gp) { const int e0 = 8 * gp;
                const unsigned a4 = pk4_fp8(oo[e0] * invs, oo[e0 + 1] * invs, oo[e0 + 2] * invs, oo[e0 + 3] * invs), b4 = pk4_fp8(oo[e0 + 4] * invs, oo[e0 + 5] * invs, oo[e0 + 6] * invs, oo[e0 + 7] * invs);
                const unsigned rcv = xhalf_get(hi2 ? a4 : b4, hi2);
                *(u32x2*)(orow + hf * 32 + 16 * gp) = hi2 ? (u32x2){rcv, b4} : (u32x2){a4, rcv}; }
        }
    }
}

constexpr int DIL_KP = 144, DIL_KB = 64 * DIL_KP, DIL_BUF = DIL_KB + 8192, DIL_PAIR = 2 * DIL_BUF, DIL_TAB = 4 * DIL_PAIR;
static_assert(DIL_TAB + 3 * 320 * 4 <= RING_BYTES, "dilated LDS");
template <int MODE>
__device__ __forceinline__ void dil_unit(Frame& F, int b, int h, int sb) {
    const int tid = F.tid, lane = F.lane, wid = F.wave, r32 = lane & 31, hi = lane >> 5;
    const bf16_t* DQ = WSP(const bf16_t, WS_DQ); const bf16_t* DK = WSP(const bf16_t, WS_DK); const bf16_t* DV = WSP(const bf16_t, WS_DV);
    bf16_t* O1 = WSP(bf16_t, WS_O1); bf16_t* O2 = WSP(bf16_t, WS_O2); float* LSE = WSP(float, WS_LSE); bf16_t* MIX = WSP(bf16_t, WS_MIX);
    LAS char* lds = (LAS char*)F.lds;
    LAS float* tab = (LAS float*)(lds + DIL_TAB);
    { const float* tg = WSP(const float, WS_TABG); for (int i = tid; i < 960; i += NTHR) tab[i] = tg[((i / 320) * 8 + h) * 320 + (i % 320)]; }
    const int pair = wid >> 1, pt = (wid & 1) * 64 + lane;
    LAS char* pl = lds + pair * DIL_PAIR;
    const size_t tok0 = (size_t)b * SEQ, hrow0 = (size_t)(b * 8 + h) * SEQ;
    const int qi = (wid & 1) * 32 + r32;
#define DIL_BLK(p_, rho_, dsh_, nb_, r_, n_) const int dsh_ = 2 * (p_), nb_ = 64 >> dsh_; const int i__ = 4 * (rho_) + pair, nbsb__ = 16 >> dsh_, r_ = i__ / nbsb__, n_ = ((sb * 1024) >> dsh_) / 64 + i__ % nbsb__
    u32x4 rkA[4], rvA[4], rkB[4], rvB[4]; bf16x8 qr[4], qn[4];
#define DIL_LOAD(ts_, rk, rv) do { const int p__ = (ts_) / 12, rho__ = ((ts_) % 12) / 3, jt__ = (ts_) % 3; DIL_BLK(p__, rho__, dsh__, nb__, r__, n__); \
        int kb_ = n__ - 1 + jt__; kb_ = kb_ < 0 ? 0 : (kb_ >= nb__ ? nb__ - 1 : kb_); \
        _Pragma("unroll") for (int c_ = 0; c_ < 4; ++c_) { const int ch_ = pt + 128 * c_, kv_ = ch_ >> 3, cc_ = ch_ & 7; \
            const size_t kpos_ = (size_t)((kb_ * 64 + kv_) << dsh__) + r__; \
            const size_t ko_ = (hrow0 + DPERM((int)kpos_)) * 64 + cc_ * 8; rk[c_] = *(const u32x4*)(DK + ko_); rv[c_] = *(const u32x4*)(DV + ko_); } } while (0)
#define DIL_STORE(buf, rk, rv) do { _Pragma("unroll") for (int c_ = 0; c_ < 4; ++c_) { const int ch_ = pt + 128 * c_, kv_ = ch_ >> 3, cc_ = ch_ & 7; \
            *(LAS u32x4*)(pl + (buf) * DIL_BUF + kv_ * DIL_KP + cc_ * 16) = rk[c_]; \
            *(LAS u32x4*)(pl + (buf) * DIL_BUF + DIL_KB + (cc_ >> 2) * 4096 + kv_ * 64 + (cc_ & 3) * 16) = rv[c_]; } } while (0)
#define DIL_QLOAD(dst, blk_) do { const int p__ = (blk_) / 4, rho__ = (blk_) % 4; DIL_BLK(p__, rho__, dsh__, nb__, r__, n__); (void)nb__; \
        const size_t qpos__ = (size_t)((n__ * 64 + qi) << dsh__) + r__; \
        _Pragma("unroll") for (int d0 = 0; d0 < 4; ++d0) dst[d0] = *(const bf16x8*)(DQ + (hrow0 + DPERM((int)qpos__)) * 64 + d0 * 16 + hi * 8); } while (0)
    DIL_LOAD(0, rkA, rvA); DIL_QLOAD(qr, 0); DIL_STORE(0, rkA, rvA);
    asm volatile("" :: "v"(qr[0]), "v"(qr[1]), "v"(qr[2]), "v"(qr[3]));
    if (MODE != 2) DIL_LOAD(1, rkA, rvA);
    __syncthreads();
    float m_run = NEG_BIG, l_run = 0.f; f32x16 o0, o1;
    auto dil_epilogue = [&](const int p, const int dsh, const int r, const int n) __attribute__((always_inline)) {
            const size_t qpos = (size_t)((n * 64 + qi) << dsh) + r;
            const float lt = xhalf_add(l_run); const float inv = 1.f / lt;
            const float lse = m_run + __builtin_amdgcn_logf(lt);
            const size_t grow = tok0 + qpos, prow = hrow0 + DPERM((int)qpos);
            if (p < 2) {
                bf16_t* orow = (p == 0 ? O1 : O2) + prow * 64 + 32 * hi;
#pragma unroll
                for (int k = 0; k < 4; ++k) { const f32x16& oo = k < 2 ? o0 : o1; const int e0 = 8 * (k & 1);
                    u32x4 w; w.x = cvt_pk_bf16(oo[e0] * inv, oo[e0 + 1] * inv); w.y = cvt_pk_bf16(oo[e0 + 2] * inv, oo[e0 + 3] * inv); w.z = cvt_pk_bf16(oo[e0 + 4] * inv, oo[e0 + 5] * inv); w.w = cvt_pk_bf16(oo[e0 + 6] * inv, oo[e0 + 7] * inv);
                    *(u32x4*)(orow + 8 * k) = w; }
                if (hi == 0) LSE[(size_t)p * BATCH * DIL_H * SEQ + prow] = lse;
            } else {
                const float l0 = LSE[prow], l1 = LSE[(size_t)BATCH * DIL_H * SEQ + prow];
                const float mm = fmaxf(fmaxf(l0, l1), lse);
                const float e0 = __builtin_amdgcn_exp2f(l0 - mm), e1 = __builtin_amdgcn_exp2f(l1 - mm), e2 = __builtin_amdgcn_exp2f(lse - mm);
                const float isum = DBG_DIL_F / (e0 + e1 + e2); const float w0 = e0 * isum, w1 = e1 * isum, w2 = e2 * isum * inv;
                const bf16_t* a1 = O1 + prow * 64; const bf16_t* a2 = O2 + prow * 64;
                unsigned char* orow = (unsigned char*)MIX + grow * 1024 + 512 + h * 64;
                u32x4 xa[4], xb[4];
#pragma unroll
                for (int k = 0; k < 4; ++k) { xa[k] = *(const u32x4*)(a1 + 32 * hi + 8 * k); xb[k] = *(const u32x4*)(a2 + 32 * hi + 8 * k); }
                unsigned wm[2][4];
#pragma unroll
                for (int g = 0; g < 4; ++g) {
#pragma unroll
                    for (int hf = 0; hf < 2; ++hf) {
                        const u32x4& A1 = xa[hf * 2 + (g >> 1)]; const u32x4& A2 = xb[hf * 2 + (g >> 1)];
                        u32x2 x1, x2; x1.x = (g & 1) ? A1.z : A1.x; x1.y = (g & 1) ? A1.w : A1.y; x2.x = (g & 1) ? A2.z : A2.x; x2.y = (g & 1) ? A2.w : A2.y;
                        const f32x16& oo = hf ? o1 : o0;
                        const float y0 = w0 * bf_lo(x1.x) + w1 * bf_lo(x2.x) + w2 * oo[4 * g], y1 = w0 * bf_hi(x1.x) + w1 * bf_hi(x2.x) + w2 * oo[4 * g + 1];
                        const float y2 = w0 * bf_lo(x1.y) + w1 * bf_lo(x2.y) + w2 * oo[4 * g + 2], y3 = w0 * bf_hi(x1.y) + w1 * bf_hi(x2.y) + w2 * oo[4 * g + 3];
                        wm[hf][g] = pk4_fp8(y0 * MIX_SCALE, y1 * MIX_SCALE, y2 * MIX_SCALE, y3 * MIX_SCALE);
                    }
                }
#pragma unroll
                for (int hf = 0; hf < 2; ++hf)
#pragma unroll
                    for (int gp = 0; gp < 2; ++gp) {
                        const unsigned rcv = xhalf_get(hi ? wm[hf][2 * gp] : wm[hf][2 * gp + 1], hi);
                        *(u32x2*)(orow + hf * 32 + 16 * gp + 8 * hi) = hi ? (u32x2){rcv, wm[hf][2 * gp + 1]} : (u32x2){wm[hf][2 * gp], rcv};
                    }
            }
#pragma unroll
            for (int d0 = 0; d0 < 4; ++d0) qr[d0] = qn[d0];
            };
#define DIL_STEP(ts, rkC, rvC, rkN, rvN) do { \
        const int p = (ts) / 12, rho = ((ts) % 12) / 3, jt = (ts) % 3; \
        DIL_BLK(p, rho, dsh, nb, r, n); \
        if (MODE != 2) DIL_LOAD(((ts) + 2 < 36 ? (ts) + 2 : 35), rkN, rvN);     \
        if (jt == 0) { m_run = NEG_BIG; l_run = 0.f; \
            _Pragma("unroll") for (int rr = 0; rr < 16; ++rr) { o0[rr] = 0.f; o1[rr] = 0.f; } } \
        const int kb = n - 1 + jt; \
        if (MODE != 1 && kb >= 0 && kb < nb) { \
            const LAS float* tq = tab + p * 320 + (64 * (jt - 1) - qi + 127); \
            attn_tile<4, DIL_KP, true>(pl + ((ts) & 1) * DIL_BUF, pl + ((ts) & 1) * DIL_BUF + DIL_KB, qr, m_run, l_run, o0, o1, tq, lane); \
        } \
        if (MODE != 2 && (ts) + 1 < 36) DIL_STORE(((ts) + 1) & 1, rkC, rvC); \
        if (jt == 1 && (ts) + 2 < 36) DIL_QLOAD(qn, (ts) / 3 + 1); \
        if (jt == 2) asm volatile("" :: "v"(qn[0]), "v"(qn[1]), "v"(qn[2]), "v"(qn[3])); \
        if (MODE != 0 && jt == 2) { if (m_run == 12345.f) MIX[0] = (bf16_t)(int)(l_run + o0[3] + o1[5]); } \
        if (MODE == 0 && jt == 2) dil_epilogue(p, dsh, r, n); \
        if ((ts) == 25) VM_WAIT(); \
        __syncthreads(); } while (0)
#pragma unroll 1
    for (int ts2 = 0; ts2 < 36; ts2 += 2) { DIL_STEP(ts2, rkA, rvA, rkB, rvB); DIL_STEP(ts2 + 1, rkB, rvB, rkA, rvA); }
#undef DIL_STEP
#undef DIL_LOAD
#undef DIL_STORE
#undef DIL_QLOAD
#undef DIL_BLK
}

__device__ __forceinline__ void transpose_item(const float* W, int ldn, int K, int k0, int n0, bf16_t* WT, int drow, const float* kscale, LAS float* scr, int lane) {
#pragma unroll 8
    for (int i = 0; i < 32; ++i) { const int kk = 2 * i + (lane >> 5); float v = W[(size_t)(k0 + kk) * ldn + n0 + (lane & 31)]; if (kscale) v *= kscale[k0 + kk]; scr[kk * 33 + (lane & 31)] = v; }
    LDS_WAIT(); asm volatile("" ::: "memory");
    const int c = lane & 7;
#pragma unroll
    for (int j = 0; j < 4; ++j) { const int n = (lane >> 3) + 8 * j; const LAS float* s = scr + (8 * c) * 33 + n;
        u32x4 o; o.x = pk2(s[0 * 33], s[1 * 33]); o.y = pk2(s[2 * 33], s[3 * 33]); o.z = pk2(s[4 * 33], s[5 * 33]); o.w = pk2(s[6 * 33], s[7 * 33]);
        *(u32x4*)(WT + (size_t)(drow + n) * K + k0 + 8 * c) = o; }
    LDS_WAIT(); asm volatile("" ::: "memory");
}
__device__ __forceinline__ void transpose_item_f8(const float* W, int ldn, int K, int k0, int n0, unsigned char* WT, int drow, float qs, LAS float* scr, int lane) {
#pragma unroll 8
    for (int i = 0; i < 32; ++i) { const int kk = 2 * i + (lane >> 5); scr[kk * 33 + (lane & 31)] = W[(size_t)(k0 + kk) * ldn + n0 + (lane & 31)] * qs; }
    LDS_WAIT(); asm volatile("" ::: "memory");
    const int c = lane & 7;
#pragma unroll
    for (int j = 0; j < 4; ++j) { const int n = (lane >> 3) + 8 * j; const LAS float* s_ = scr + (8 * c) * 33 + n;
        u32x2 o; o.x = pk4_fp8(s_[0 * 33], s_[1 * 33], s_[2 * 33], s_[3 * 33]); o.y = pk4_fp8(s_[4 * 33], s_[5 * 33], s_[6 * 33], s_[7 * 33]);
        *(u32x2*)(WT + (size_t)(drow + n) * K + k0 + 8 * c) = o; }
    LDS_WAIT(); asm volatile("" ::: "memory");
}
__device__ __forceinline__ void transpose_item64(const float* W, int ldn, int K, int k0, int n0, bf16_t* WT, int drow, LAS float* scr, int lane, float qs, float qis) {
    f32x4 v[16];
    const float* src = W + (size_t)(k0 + (lane >> 4)) * ldn + n0 + 4 * (lane & 15);
#pragma unroll
    for (int j = 0; j < 16; ++j) v[j] = __builtin_nontemporal_load((const f32x4*)(src + (size_t)(4 * j) * ldn));
    LAS float* sw = scr + (lane >> 4) * 65 + 4 * (lane & 15);
#pragma unroll
    for (int j = 0; j < 16; ++j) { sw[(4 * j) * 65 + 0] = v[j][0]; sw[(4 * j) * 65 + 1] = v[j][1]; sw[(4 * j) * 65 + 2] = v[j][2]; sw[(4 * j) * 65 + 3] = v[j][3]; }
    LDS_WAIT(); asm volatile("" ::: "memory");
    const int c = lane & 7;
#pragma unroll
    for (int jj = 0; jj < 8; ++jj) { const int n = (lane >> 3) + 8 * jj; const LAS float* s = scr + (8 * c) * 65 + n;
        u32x2 o; o.x = pk4_fp8(s[0 * 65] * qs, s[1 * 65] * qs, s[2 * 65] * qs, s[3 * 65] * qs); o.y = pk4_fp8(s[4 * 65] * qs, s[5 * 65] * qs, s[6 * 65] * qs, s[7 * 65] * qs);
        *(u32x2*)((unsigned char*)WT + (size_t)(drow + n) * K + k0 + 8 * c) = o; }
    LDS_WAIT(); asm volatile("" ::: "memory");
}
__device__ __forceinline__ int t5_bucket_dev(int rel) {
    const int n = rel < 0 ? -rel : rel; int v;
    if (n < 8) v = n; else v = n < 15 ? 8 : n < 27 ? 9 : n < 50 ? 10 : n < 91 ? 11 : n < 166 ? 12 : n < 305 ? 13 : n < 559 ? 14 : 15;
    return (rel > 0 ? 16 : 0) + v;
}
__device__ __forceinline__ void p0_prologue(Frame& F) { const KArgs ka = kargs();
    struct { const float *c, *w_ada, *w_in, *w_uq, *q_norm_g, *w_ukv, *kv_norm_g, *w_out, *rel_bias; } a;
    a.c = ka->c; a.w_ada = ka->w_ada; a.w_in = ka->w_in; a.w_uq = ka->w_uq; a.q_norm_g = ka->q_norm_g; a.w_ukv = ka->w_ukv; a.kv_norm_g = ka->kv_norm_g; a.w_out = ka->w_out; a.rel_bias = ka->rel_bias;
    LAS float* scr = (LAS float*)(F.lds + 32768 + F.wave * 8704);
    LAS float* sil = (LAS float*)F.lds;
    for (int i = F.tid; i < BATCH * D_MODEL; i += NTHR) { const float v = a.c[i]; sil[i] = v / (1.f + __expf(-v)); }
    __syncthreads();
    int tid_o = F.tid; asm volatile("" : "+v"(tid_o)); const int lane = tid_o & 63;
    const int gw = F.vcu * NWAVES + F.wave, NGW = F.G * NWAVES;
    for (int it = gw; it < 16 * 24; it += NGW) {
        const int kb = it / 24, nb = it % 24, k0 = kb * 64, n0 = nb * 256 + lane * 4;
        f32x4 acc[8];
#pragma unroll
        for (int b = 0; b < 8; ++b) acc[b] = (f32x4){0.f, 0.f, 0.f, 0.f};
#pragma unroll 16
        for (int k = 0; k < 64; ++k) { const f32x4 w = *(const f32x4*)(a.w_ada + (size_t)(k0 + k) * 6144 + n0);
#pragma unroll
            for (int b = 0; b < 8; ++b) acc[b] += w * sil[b * 1024 + k0 + k]; }
        float* mp = WSP(float, WS_MODP) + (size_t)kb * 8 * 6144 + n0;
#pragma unroll
        for (int b = 0; b < 8; ++b) *(f32x4*)(mp + b * 6144) = acc[b];
    }
    {
        bf16_t* WIN = WSP(bf16_t, WS_WIN); bf16_t* WUQ = WSP(bf16_t, WS_WUQ); bf16_t* WK = WSP(bf16_t, WS_WK); bf16_t* WV = WSP(bf16_t, WS_WV); bf16_t* WOUT = WSP(bf16_t, WS_WOUT);
        constexpr int I_IN = 16 * 69, I_UQ = 6 * 24, I_KV = 4 * 32, I_OUT = 16 * 32, NIT = I_IN + I_UQ + I_KV + I_OUT;
        for (int it = NGW - 1 - gw; it < NIT; it += NGW) {
            int r = it;
            if (r < I_IN) { const int kb = r / 69, g = r % 69, n0 = g * 32; transpose_item_f8(a.w_in, IN_W, 1024, kb * 64, n0, (unsigned char*)WIN, n0 + (n0 >= 672 ? 96 : 0), WIN_SCALE, scr, lane); continue; } r -= I_IN;
            if (r < I_UQ) { const int kb = r / 24, g = r % 24; transpose_item(a.w_uq, 768, 384, kb * 64, g * 32, WUQ, g * 32, a.q_norm_g, scr, lane); continue; } r -= I_UQ;
            if (r < I_KV) { const int kb = r / 32, g = r % 32, hh = g >> 2, part = g & 3;
                transpose_item(a.w_ukv, 1024, 256, kb * 64, g * 32, part < 2 ? WK : WV, hh * 64 + (part & 1) * 32, a.kv_norm_g, scr, lane); continue; } r -= I_KV;
            { const int kb = r / 32, g = r % 32; transpose_item_f8(a.w_out, 1024, 1024, kb * 64, g * 32, (unsigned char*)WOUT, g * 32, WOUT_SCALE, scr, lane); }
        }
        for (int i = (F.G - 1 - F.vcu) * NTHR + F.tid; i < 96 * 1024 / 16; i += F.G * NTHR) *(u32x4*)((unsigned char*)WIN + (size_t)672 * 1024 + (size_t)i * 16) = (u32x4){0u, 0u, 0u, 0u};
    }
    for (int i = (F.G - 1 - F.vcu) * NTHR + F.tid; i < SEQ * 16; i += F.G * NTHR) { const int pos = i >> 4, j = i & 15;
        const float ang = (float)pos * (float)exp2(-(double)j * (13.287712379549449 / 16.0)); float* rp = WSP(float, WS_ROPE) + pos * 32;
        float sn, cs; sincosf(ang, &sn, &cs);
        rp[j] = cs; rp[16 + j] = sn; }
    for (int i = (F.G - 1 - F.vcu) * NTHR + F.tid; i < 3 * 8 * 320; i += F.G * NTHR) { const int p = i / 2560, hh = (i / 320) & 7, idx = i % 320, delta = idx - 127, dil = 1 << (2 * p);
        float v = NEG_BIG; if (delta >= -64 && delta <= 64) v = a.rel_bias[t5_bucket_dev(delta * dil) * 8 + hh] * LOG2E;
        WSP(float, WS_TABG)[i] = v; }
}
__device__ __forceinline__ void p1_mod_h1(Frame& F) { const KArgs ka = kargs(); const float* const a_x = ka->x; const float* const a_b_ada = ka->b_ada;
    LAS float* shs = (LAS float*)F.lds;
    const float* modp = WSP(const float, WS_MODP); float* mod = WSP(float, WS_MOD);
    for (int i = F.vcu * NTHR + F.tid; i < 8 * 6144; i += F.G * NTHR) { float s = a_b_ada[i % 6144];
#pragma unroll
        for (int kb = 0; kb < 16; ++kb) s += modp[(size_t)kb * 8 * 6144 + i];
        mod[i] = s; }
    bf16_t* H1 = WSP(bf16_t, WS_H);
    const int rpb = M_TOK / F.G;
    const int row0 = F.vcu * rpb, b = row0 >> 12;
    for (int i = F.tid; i < 2048; i += NTHR) { float sv = a_b_ada[i];
#pragma unroll
        for (int kb = 0; kb < 16; ++kb) sv += modp[(size_t)kb * 8 * 6144 + b * 6144 + i];
        shs[i] = sv; }
    __syncthreads();
    f32x4 sh[4], sc[4];
#pragma unroll
    for (int j = 0; j < 4; ++j) { sh[j] = *(const LAS f32x4*)(shs + 4 * F.lane + 256 * j); sc[j] = *(const LAS f32x4*)(shs + 1024 + 4 * F.lane + 256 * j) + 1.f; }
    for (int rr = 4 * F.wave; rr < rpb; rr += 4 * NWAVES) {
        const int row = row0 + rr;
        const f32x4* xr = (const f32x4*)(a_x + (size_t)row * 1024) + F.lane;
        unsigned* o8 = (unsigned*)((unsigned char*)H1 + (size_t)row * 1024) + F.lane;
        f32x4 v[16];
#pragma unroll
        for (int j = 0; j < 16; ++j) v[j] = __builtin_nontemporal_load(xr + 64 * j);
#pragma unroll
        for (int j = 0; j < 16; ++j) { const f32x4 hv = v[j] * sc[j & 3] + sh[j & 3];
            o8[64 * j] = pk4_fp8(hv[0], hv[1], hv[2], hv[3]); }
    }
}
__device__ __forceinline__ void p6_ln1_router(Frame& F) { const KArgs ka = kargs(); const float* const a_w_router = ka->w_router; const float* const a_ln1_g = ka->ln1_g; const float* const a_ln1_b = ka->ln1_b; const bf16_t* const a_m = WSP(const bf16_t, WS_M); const float* const a_x = ka->x;
    LAS f32x4* wr4 = (LAS f32x4*)F.lds;
    f32x4 st_w[8], st_m[8], st_g;
#pragma unroll
    for (int t = 0; t < 8; ++t) { const int idx = F.tid + NTHR * t, k = idx >> 2, e4 = idx & 3; st_w[t] = *(const f32x4*)(a_w_router + k * 16 + e4 * 4); }
    LAS f32x4* gl4 = (LAS f32x4*)(F.lds + 64 * 1024); LAS f32x4* ml4 = gl4 + 512;
    const float* mod = WSP(const float, WS_MOD);
    st_g = F.tid < 256 ? *(const f32x4*)(a_ln1_g + 4 * F.tid) : *(const f32x4*)(a_ln1_b + 4 * (F.tid - 256));
#pragma unroll
    for (int bq = 0; bq < 8; ++bq) st_m[bq] = *(const f32x4*)(mod + bq * 6144 + 3072 + 4 * F.tid);
    asm volatile("" ::: "memory");
    bf16_t* H2 = WSP(bf16_t, WS_H); float* AFF = WSP(float, WS_AFF);
    _Float16* X1 = WSP(_Float16, WS_M);
    int tid_o = F.tid; asm volatile("" : "+v"(tid_o)); const int lane = tid_o & 63;
    const int gw = F.vcu * NWAVES + F.wave, NGW = F.G * NWAVES;
    f32x4 vn[2][4]; u32x2 mn[2][4];
#define P6_LOAD(r0_) do { _Pragma("unroll") for (int q = 0; q < 2; ++q) { const int rq_ = (r0_) + q * NGW < M_TOK ? (r0_) + q * NGW : (r0_); const unsigned ro_ = (unsigned)rq_ * 4096u; \
        _Pragma("unroll") for (int j = 0; j < 4; ++j) { vn[q][j] = *(const f32x4*)((const char*)a_x + (ro_ + (unsigned)(lane * 16 + j * 1024))); mn[q][j] = *(const u32x2*)((const char*)a_m + ((ro_ >> 1) + (unsigned)(lane * 8 + j * 512))); } } } while (0)
    P6_LOAD(gw);
    asm volatile("" ::: "memory");
#pragma unroll
    for (int t = 0; t < 8; ++t) { const int idx = F.tid + NTHR * t, k = idx >> 2, e4 = idx & 3, l = (k & 255) >> 2, i = k & 3, j = k >> 8; wr4[((j * 4 + i) * 4 + e4) * 64 + l] = st_w[t]; }
    gl4[F.tid] = st_g;
#pragma unroll
    for (int bq = 0; bq < 8; ++bq) ml4[bq * 512 + F.tid] = F.tid < 256 ? st_m[bq] : st_m[bq] + 1.f;
    __syncthreads();
    unsigned sh2[2][4]; u32x2 sx1[2][4]; float saff[2]; int srow[2]; bool have = false;
    const int e_l = ((lane >> 5) & 1) * 8 + ((lane >> 3) & 1) * 4 + ((lane >> 1) & 1) * 2 + (lane & 1);
#define P6_STORES() do { _Pragma("unroll") for (int q = 0; q < 2; ++q) { _Pragma("unroll") for (int j = 0; j < 4; ++j) { *(unsigned*)((unsigned char*)H2 + ((unsigned)srow[q] * 1024u + (unsigned)(lane * 4 + j * 256))) = sh2[q][j]; \
                *(u32x2*)((char*)X1 + ((unsigned)srow[q] * 2048u + (unsigned)(lane * 8 + j * 512))) = sx1[q][j]; } \
            AFF[((size_t)(srow[q] >> 12) * 16 + e_l) * SEQ + (srow[q] & (SEQ - 1))] = saff[q]; } } while (0)
    for (int row0 = gw; row0 < M_TOK; row0 += 2 * NGW) {
        f32x4 v[2][4]; float mean[2], rstd[2];
#pragma unroll
        for (int q = 0; q < 2; ++q) { float sm = 0.f;
#pragma unroll
            for (int j = 0; j < 4; ++j) { v[q][j] = vn[q][j] * ALPHA + (f32x4){bf_lo(mn[q][j].x), bf_hi(mn[q][j].x), bf_lo(mn[q][j].y), bf_hi(mn[q][j].y)}; sm += (v[q][j][0] + v[q][j][1]) + (v[q][j][2] + v[q][j][3]); }
            mean[q] = sm; }
        asm volatile("" :: "v"(mean[0]), "v"(mean[1]) : "memory");
        if (have) P6_STORES();
        have = true;
        { const int rn = row0 + 2 * NGW < M_TOK ? row0 + 2 * NGW : row0; P6_LOAD(rn); }
#pragma unroll
        for (int q = 0; q < 2; ++q) { mean[q] = wave_sum(mean[q]) * (1.f / 1024.f); float s2 = 0.f;
#pragma unroll
            for (int j = 0; j < 4; ++j) { v[q][j] = v[q][j] - mean[q]; s2 += (v[q][j][0] * v[q][j][0] + v[q][j][1] * v[q][j][1]) + (v[q][j][2] * v[q][j][2] + v[q][j][3] * v[q][j][3]); }
            rstd[q] = 1.f / sqrtf(wave_sum(s2) * (1.f / 1024.f) + NORM_EPS); }
        const int rowq[2] = {row0, row0 + NGW < M_TOK ? row0 + NGW : row0};
        srow[0] = rowq[0]; srow[1] = rowq[1];
        f32x2 lg2[2][8];
#pragma unroll
        for (int q = 0; q < 2; ++q)
#pragma unroll
            for (int e = 0; e < 8; ++e) lg2[q][e] = (f32x2){0.f, 0.f};
#pragma unroll
        for (int j = 0; j < 4; ++j) { const int col = 4 * lane + 256 * j;
            const f32x4 g = gl4[lane + 64 * j], bb = gl4[256 + lane + 64 * j];
#pragma unroll
            for (int q = 0; q < 2; ++q) { const int b = rowq[q] >> 12;
                const f32x4 x1 = v[q][j] * rstd[q] * g + bb; sx1[q][j] = __builtin_bit_cast(u32x2, __builtin_convertvector(x1, h16x4));
                const f32x4 sh = ml4[b * 512 + lane + 64 * j], sc = ml4[b * 512 + 256 + lane + 64 * j];
                const f32x4 hv = x1 * sc + sh; v[q][j] = hv;
                sh2[q][j] = pk4_fp8(hv[0], hv[1], hv[2], hv[3]); } }
#pragma unroll
        for (int j = 0; j < 4; ++j) {
#pragma unroll
            for (int i = 0; i < 4; ++i) {
#pragma unroll
                for (int e4 = 0; e4 < 4; ++e4) { const f32x4 w = wr4[((j * 4 + i) * 4 + e4) * 64 + lane]; const f32x2 w01 = (f32x2){w[0], w[1]}, w23 = (f32x2){w[2], w[3]};
#pragma unroll
                    for (int q = 0; q < 2; ++q) { const f32x2 hh = (f32x2){v[q][j][i], v[q][j][i]};
                        lg2[q][e4 * 2 + 0] = __builtin_elementwise_fma(hh, w01, lg2[q][e4 * 2 + 0]); lg2[q][e4 * 2 + 1] = __builtin_elementwise_fma(hh, w23, lg2[q][e4 * 2 + 1]); } }
                asm volatile("" : "+v"(lg2[0][0]), "+v"(lg2[0][1]), "+v"(lg2[0][2]), "+v"(lg2[0][3]), "+v"(lg2[0][4]), "+v"(lg2[0][5]), "+v"(lg2[0][6]), "+v"(lg2[0][7]), "+v"(lg2[1][0]), "+v"(lg2[1][1]), "+v"(lg2[1][2]), "+v"(lg2[1][3]), "+v"(lg2[1][4]), "+v"(lg2[1][5]), "+v"(lg2[1][6]), "+v"(lg2[1][7]) :: "memory"); }
        }
#pragma unroll
        for (int q = 0; q < 2; ++q) {
            float lg[16];
#pragma unroll
            for (int e = 0; e < 8; ++e) { lg[2 * e] = lg2[q][e][0]; lg[2 * e + 1] = lg2[q][e][1]; }
#pragma unroll
            for (int i = 0; i < 8; ++i) { float x = lg[i], y = lg[i + 8];
                asm("s_nop 1\n\tv_permlane32_swap_b32 %0, %1" : "+v"(x), "+v"(y)); lg[i] = x + y; }
#pragma unroll
            for (int i = 0; i < 4; ++i) { const bool up = lane & 8; const float keep = up ? lg[i + 4] : lg[i], send = up ? lg[i] : lg[i + 4]; lg[i] = keep + dpp_f<0x128>(send); }
#pragma unroll
            for (int i = 0; i < 2; ++i) { const bool up = lane & 2; const float keep = up ? lg[i + 2] : lg[i], send = up ? lg[i] : lg[i + 2]; lg[i] = keep + dpp_f<0x4E>(send); }
            { const bool up = lane & 1; const float keep = up ? lg[1] : lg[0], send = up ? lg[0] : lg[1]; lg[0] = keep + dpp_f<0xB1>(send); }
            float logit = lg[0]; logit += dpp_f<0x1B>(dpp_f<0x141>(logit)); logit += __shfl_xor(logit, 16);
            const float mx = wave_max(logit);
            const float ex = expf(logit - mx); const float se = wave_sum(ex) * 0.25f;
            saff[q] = ex / se;
        }
    }
    if (have) P6_STORES();
#undef P6_STORES
#undef P6_LOAD
}
__device__ __forceinline__ unsigned block_excl_scan(unsigned v, LAS unsigned* tmp, int tid, int lane, int wave, unsigned& total) {
    unsigned inc = v;
#pragma unroll
    for (int o = 1; o < 64; o <<= 1) { const unsigned t = __shfl_up(inc, o); if (lane >= o) inc += t; }
    __syncthreads();
    if (lane == 63) tmp[wave] = inc;
    __syncthreads();
    unsigned base = 0, tot = 0;
#pragma unroll
    for (int w = 0; w < NWAVES; ++w) { const unsigned t = tmp[w]; if (w < wave) base += t; tot += t; }
    total = tot;
    return base + inc - v;
}
__device__ __forceinline__ void topk_unit(Frame& F, int b, int e) {
    LAS unsigned* hist = (LAS unsigned*)F.lds; LAS unsigned* sh = hist + 256; LAS unsigned* tmp = hist + 272;
    const int tid = F.tid, lane = F.lane, wave = F.wave;
    const float* aff = WSP(const float, WS_AFF) + ((size_t)b * 16 + e) * SEQ;
    unsigned key[8];
    { const u32x4 k0 = *(const u32x4*)(aff + tid * 8), k1 = *(const u32x4*)(aff + tid * 8 + 4); key[0] = k0.x; key[1] = k0.y; key[2] = k0.z; key[3] = k0.w; key[4] = k1.x; key[5] = k1.y; key[6] = k1.z; key[7] = k1.w; }
    unsigned prefix = 0, need = CAP;
#pragma unroll 1
    for (int pass = 0; pass < 4; ++pass) {
        const int shift = 24 - 8 * pass;
        if (tid < 256) hist[tid] = 0u;
        __syncthreads();
#pragma unroll
        for (int i = 0; i < 8; ++i) { const bool in = (pass == 0) || ((key[i] >> (shift + 8)) == prefix); if (in) (void)__hip_atomic_fetch_add(&hist[(key[i] >> shift) & 255u], 1u, __ATOMIC_RELAXED, __HIP_MEMORY_SCOPE_WORKGROUP); }
        __syncthreads();
        if (wave == 0) {
            const unsigned c0 = hist[4 * lane], c1 = hist[4 * lane + 1], c2 = hist[4 * lane + 2], c3 = hist[4 * lane + 3], s = c0 + c1 + c2 + c3;
            unsigned incl = s;
#pragma unroll
            for (int o = 1; o < 64; o <<= 1) { const unsigned t = __shfl_down(incl, o); if (lane + o < 64) incl += t; }
            const unsigned above = incl - s;
            if (above < need && need <= incl) {
                unsigned aa = above; int d;
                if (aa + c3 >= need) d = 3; else { aa += c3; if (aa + c2 >= need) d = 2; else { aa += c2; if (aa + c1 >= need) d = 1; else { aa += c1; d = 0; } } }
                sh[0] = (prefix << 8) | (unsigned)(4 * lane + d); sh[1] = need - aa;
            }
        }
        __syncthreads();
        prefix = sh[0]; need = sh[1];
    }
    const unsigned T = prefix;
    unsigned cg = 0, ce = 0;
#pragma unroll
    for (int i = 0; i < 8; ++i) { cg += key[i] > T; ce += key[i] == T; }
    unsigned tot;
    const unsigned eq_before = block_excl_scan(ce, tmp, tid, lane, wave, tot);
    unsigned sel_mask = 0, nsel = 0, er = eq_before;
#pragma unroll
    for (int i = 0; i < 8; ++i) { bool s = key[i] > T; if (key[i] == T) { s = er < need; ++er; } if (s) { sel_mask |= 1u << i; ++nsel; } }
    unsigned slot = block_excl_scan(nsel, tmp, tid, lane, wave, tot);
    LAS int* lst = (LAS int*)(hist + 512);
    float* vals = WSP(float, WS_VALS) + (e * 8 + b) * CAP; int* inv = WSP(int, WS_INV);
#pragma unroll
    for (int i = 0; i < 8; ++i) { const int tok = tid * 8 + i; int sl = -1;
        if (sel_mask & (1u << i)) { sl = (int)slot; if (slot < (unsigned)CAP) { lst[slot] = tok; vals[slot] = __builtin_bit_cast(float, key[i]); } ++slot; }
        inv[((size_t)b * SEQ + tok) * 16 + e] = sl; }
    __syncthreads();
    { unsigned* VOFF = WSP(unsigned, WS_VOFF);
#pragma unroll
      for (int hh = 0; hh < 2; ++hh) { u32x4 o;
#pragma unroll
          for (int i = 0; i < 2; ++i) { int R, C; pg8::stage_rc(tid * 16 + i * 8192, R, C);
              o[i] = (unsigned)lst[hh * 256 + R] * 1024u + (unsigned)(C * 2); o[2 + i] = (unsigned)lst[hh * 256 + 128 + R] * 1024u + (unsigned)(C * 2); }
          *(u32x4*)(VOFF + ((size_t)((e * 8 + b) * 2 + hh) * 512 + tid) * 4) = o; } }
    __syncthreads();
}
struct CvItem { const float* src; unsigned char* dst; };
template <class Dec>
__device__ __forceinline__ void conv_stream(int it, const int step, const int end, const int ldn, const int K, const float qs, LAS float* scr, const int lane, const Dec& dec) {
    if (it >= end) return;
    const int lr = lane >> 4, lc = 4 * (lane & 15), c = lane & 7;
    f32x4 v[16];
    CvItem cur = dec(it);
    { const float* src = cur.src + (size_t)lr * ldn + lc;
#pragma unroll
      for (int j = 0; j < 16; ++j) v[j] = __builtin_nontemporal_load((const f32x4*)(src + (size_t)(4 * j) * ldn)); }
    for (;;) {
        LAS float* sw = scr + lr * 65 + lc;
#pragma unroll
        for (int j = 0; j < 16; ++j) { sw[(4 * j) * 65 + 0] = v[j][0]; sw[(4 * j) * 65 + 1] = v[j][1]; sw[(4 * j) * 65 + 2] = v[j][2]; sw[(4 * j) * 65 + 3] = v[j][3]; }
        LDS_WAIT(); asm volatile("" ::: "memory");
        const int nx = it + step; const bool hn = nx < end; CvItem nxt = cur;
        if (hn) { nxt = dec(nx); const float* src = nxt.src + (size_t)lr * ldn + lc;
#pragma unroll
            for (int j = 0; j < 16; ++j) v[j] = __builtin_nontemporal_load((const f32x4*)(src + (size_t)(4 * j) * ldn)); }
#pragma unroll
        for (int jj = 0; jj < 8; ++jj) { const int n = (lane >> 3) + 8 * jj; const LAS float* s_ = scr + (8 * c) * 65 + n;
            u32x2 o; o.x = pk4_fp8(s_[0 * 65] * qs, s_[1 * 65] * qs, s_[2 * 65] * qs, s_[3 * 65] * qs); o.y = pk4_fp8(s_[4 * 65] * qs, s_[5 * 65] * qs, s_[6 * 65] * qs, s_[7 * 65] * qs);
            *(u32x2*)(cur.dst + (size_t)n * K + 8 * c) = o; }
        LDS_WAIT(); asm volatile("" ::: "memory");
        if (!hn) break;
        it = nx; cur = nxt;
    }
}
template <int PART>
__device__ __forceinline__ void p7_expert_weights(Frame& F) { const KArgs ka = kargs(); const float* const a_w_gate = ka->w_gate; const float* const a_w_up = ka->w_up; const float* const a_w_down = ka->w_down;
    LAS float* scr = (LAS float*)(F.lds + 4096 + F.wave * 16640);
    bf16_t* WGU = WSP(bf16_t, WS_WGU); bf16_t* WD = WSP(bf16_t, WS_WD);
    constexpr int I_G = 16 * 16 * 24, I_D = 16 * 24 * 16;
    const int bx = (int)blockIdx.x;
    if (PART == 0) {
        const bool split = (F.G == 256); const bool tk = split && bx < BATCH * N_EXP;
        const int v0 = split ? ((tk ? bx : bx - 128) * NWAVES + F.wave) + (tk ? 7168 : 0) : F.wave * F.G + bx;
        const int vstep = split ? 1024 : F.G * NWAVES, vend = split ? (tk ? 2 * I_G : 7168) : 2 * I_G;
        static_assert(1024 * 12 == 2 * I_G, "P7 item split");
        for (int it = v0; it < vend; it += vstep) {
            int r = it; const int up = r >= I_G; if (up) r -= I_G; const int ex = r / 384, q = r % 384, kb = q / 24, g = q % 24, f = g * 64;
            transpose_item64((up ? a_w_up : a_w_gate) + (size_t)ex * 1024 * 1536, 1536, 1024, kb * 64, f, (bf16_t*)((unsigned char*)WGU + (size_t)ex * 3072 * 1024), (f >> 7) * 256 + up * 128 + (f & 127), scr, F.lane, WGU_SCALE, 0.f); }
    } else {
        auto dec = [&](int r) { const int ex = r / 384, q = r % 384, kb = q / 16, g = q % 16;
            CvItem c_; c_.src = a_w_down + (size_t)ex * 1536 * 1024 + (size_t)(kb * 64) * 1024 + g * 64;
            c_.dst = (unsigned char*)WD + (size_t)ex * 1024 * 1536 + (size_t)(g * 64) * 1536 + kb * 64; return c_; };
        conv_stream(F.wave * F.G + bx, F.G * NWAVES, I_D, 1024, 1536, WD_SCALE, scr, F.lane, dec);
    }
}
__device__ __forceinline__ void p10_final(Frame& F, float* dst_override = nullptr) { const KArgs ka = kargs(); const float* const a_ln2_g = ka->ln2_g; const float* const a_ln2_b = ka->ln2_b; float* const a_out = ka->out;
    const float* const a_ln1_g = ka->ln1_g; const float* const a_ln1_b = ka->ln1_b; const float* const a_x = ka->x;
    const float* mod = WSP(const float, WS_MOD); const bf16_t* Y = WSP(const bf16_t, WS_Y); const int* inv = WSP(const int, WS_INV); const _Float16* const X1 = WSP(const _Float16, WS_M);
    int tid_o = F.tid; asm volatile("" : "+v"(tid_o)); const int lane = tid_o & 63;
    const int gw = F.vcu * NWAVES + F.wave, NGW = F.G * NWAVES;
    const int l15 = lane & 15;
    int slot_c = inv[(size_t)gw * 16 + l15];
    int slot_n = inv[(size_t)(gw + NGW < M_TOK ? gw + NGW : gw) * 16 + l15];
    LAS f32x4* pl4 = (LAS f32x4*)F.lds;
    for (int i = F.tid; i < 1024; i += NTHR) { const int w = i >> 8, c4 = (i & 255) * 4; pl4[i] = *(const f32x4*)((w == 0 ? a_ln1_g : w == 1 ? a_ln1_b : w == 2 ? a_ln2_g : a_ln2_b) + c4); }
    for (int i = F.tid; i < 2048; i += NTHR) pl4[1024 + i] = *(const f32x4*)(mod + (i >> 8) * 6144 + 5120 + (i & 255) * 4);
    __syncthreads();
    u32x2 xn[4]; unsigned w0n[4], w1n[4]; unsigned long long msk_c; float f0c, f1c;
#define P10_PREF(rw_, slots_) do { const u32x2* xr_ = (const u32x2*)(X1 + (size_t)(rw_) * 1024) + lane; \
        _Pragma("unroll") for (int j = 0; j < 4; ++j) xn[j] = xr_[64 * j]; \
        unsigned long long mk_ = __ballot((slots_) >= 0) & 0xFFFFull; const int bb_ = (rw_) >> 12; \
        const bool one_ = mk_ != 0; const int e0_ = one_ ? __builtin_ctzll(mk_) : 0; mk_ &= mk_ - 1; \
        const bool two_ = mk_ != 0; const int e1_ = two_ ? __builtin_ctzll(mk_) : e0_; mk_ &= mk_ - 1; \
        int s0_ = __shfl((slots_), e0_), s1_ = __shfl((slots_), e1_); s0_ = s0_ < 0 ? 0 : s0_; s1_ = s1_ < 0 ? 0 : s1_; \
        const unsigned* y0_ = (const unsigned*)((const unsigned char*)Y + ((size_t)(e0_ * 8 + bb_) * CAP + s0_) * 1024) + lane; \
        const unsigned* y1_ = (const unsigned*)((const unsigned char*)Y + ((size_t)(e1_ * 8 + bb_) * CAP + s1_) * 1024) + lane; \
        _Pragma("unroll") for (int j = 0; j < 4; ++j) { w0n[j] = y0_[64 * j]; w1n[j] = y1_[64 * j]; } \
        msk_c = mk_; f0c = one_ ? 1.f : 0.f; f1c = two_ ? 1.f : 0.f; } while (0)
    P10_PREF(gw, slot_c);
    f32x4 so[4]; int srow = gw; bool have = false;
#define P10_STORES() do { f32x4* xr_ = (dst_override ? (f32x4*)(dst_override + (size_t)srow * 1024) : (f32x4*)(a_out + (size_t)srow * 1024)) + lane; \
        _Pragma("unroll") for (int j = 0; j < 4; ++j) xr_[64 * j] = so[j]; } while (0)
    for (int row = gw; row < M_TOK; row += NGW) {
        const int b = row >> 12;
        const int myslot = slot_c; f32x4 xc[4];
        unsigned long long msk = msk_c;
        f32x4 mo[4];
#pragma unroll
        for (int j = 0; j < 4; ++j) { xc[j] = __builtin_convertvector(__builtin_bit_cast(h16x4, xn[j]), f32x4);
            const auto a0 = __builtin_amdgcn_cvt_pk_f32_fp8((int)w0n[j], false), a1 = __builtin_amdgcn_cvt_pk_f32_fp8((int)w0n[j], true);
            const auto c0 = __builtin_amdgcn_cvt_pk_f32_fp8((int)w1n[j], false), c1 = __builtin_amdgcn_cvt_pk_f32_fp8((int)w1n[j], true);
            mo[j] = (f32x4){f0c * a0[0] + f1c * c0[0], f0c * a0[1] + f1c * c0[1], f0c * a1[0] + f1c * c1[0], f0c * a1[1] + f1c * c1[1]}; }
        asm volatile("" :: "v"(xc[0][0]), "v"(xc[1][0]), "v"(xc[2][0]), "v"(xc[3][0]), "v"(mo[0][0]), "v"(mo[1][0]), "v"(mo[2][0]), "v"(mo[3][0]) : "memory");
        if (have) P10_STORES();
        have = true;
        { const int rn = row + NGW < M_TOK ? row + NGW : row, rnn = rn + NGW < M_TOK ? rn + NGW : rn;
          slot_c = slot_n; slot_n = inv[(size_t)rnn * 16 + l15];
          P10_PREF(rn, slot_c); }
        while (msk) {
            const int e0 = __builtin_ctzll(msk); msk &= msk - 1;
            const bool two = msk != 0; const int e1 = two ? __builtin_ctzll(msk) : e0; if (two) msk &= msk - 1;
            const int s0 = __shfl(myslot, e0), s1 = __shfl(myslot, e1);
            const unsigned* y0 = (const unsigned*)((const unsigned char*)Y + ((size_t)(e0 * 8 + b) * CAP + s0) * 1024) + lane;
            const unsigned* y1 = (const unsigned*)((const unsigned char*)Y + ((size_t)(e1 * 8 + b) * CAP + s1) * 1024) + lane;
            unsigned w0[4], w1[4];
#pragma unroll
            for (int j = 0; j < 4; ++j) { w0[j] = y0[64 * j]; w1[j] = y1[64 * j]; }
            const float f1 = two ? 1.f : 0.f;
#pragma unroll
            for (int j = 0; j < 4; ++j) { const auto a0 = __builtin_amdgcn_cvt_pk_f32_fp8((int)w0[j], false), a1 = __builtin_amdgcn_cvt_pk_f32_fp8((int)w0[j], true);
                const auto c0 = __builtin_amdgcn_cvt_pk_f32_fp8((int)w1[j], false), c1 = __builtin_amdgcn_cvt_pk_f32_fp8((int)w1[j], true);
                mo[j][0] += a0[0] + f1 * c0[0]; mo[j][1] += a0[1] + f1 * c0[1]; mo[j][2] += a1[0] + f1 * c1[0]; mo[j][3] += a1[1] + f1 * c1[1]; }
        }
        f32x4 v[4]; float sm = 0.f;
#pragma unroll
        for (int j = 0; j < 4; ++j) { const f32x4 g2 = pl4[1024 + b * 256 + lane + 64 * j];
            v[j] = xc[j] * ALPHA + g2 * mo[j] * (DBG_MOE_F / Y_SCALE); sm += (v[j][0] + v[j][1]) + (v[j][2] + v[j][3]); }
        const float mean = wave_sum(sm) * (1.f / 1024.f); float s2 = 0.f;
#pragma unroll
        for (int j = 0; j < 4; ++j) { v[j] = v[j] - mean; s2 += (v[j][0] * v[j][0] + v[j][1] * v[j][1]) + (v[j][2] * v[j][2] + v[j][3] * v[j][3]); }
        const float rstd = 1.f / sqrtf(wave_sum(s2) * (1.f / 1024.f) + NORM_EPS);
#pragma unroll
        for (int j = 0; j < 4; ++j) { const f32x4 g = pl4[512 + lane + 64 * j], bb = pl4[768 + lane + 64 * j];
            so[j] = v[j] * rstd * g + bb; }
        srow = row;
    }
    if (have) P10_STORES();
#undef P10_STORES
#undef P10_PREF
}
constexpr int N_PHASES = 11;
__global__ void __launch_bounds__(NTHR, 2) fwd_kernel(Args args) {
    extern __shared__ __attribute__((aligned(16))) unsigned char lds_raw[];
    Frame F;
    F.lds = (LAS unsigned char*)lds_raw;
    F.tid = threadIdx.x; F.lane = F.tid & 63; F.wave = __builtin_amdgcn_readfirstlane(F.tid >> 6);
    F.G = gridDim.x; { const int bx = blockIdx.x; F.vcu = (F.G % 8 == 0) ? (bx % 8) * (F.G / 8) + bx / 8 : bx; }
    F.ws = kargs()->ws;
    volatile LAS unsigned* MISC = (volatile LAS unsigned*)(F.lds + MISC_OFF);
    for (int u = F.tid; u < (LDS_BYTES - MISC_OFF) / 4; u += NTHR) MISC[u] = 0u;
    __syncthreads();
    const int lo = kargs()->ph_lo, hi = kargs()->ph_hi;
    unsigned* barw = (unsigned*)(F.ws + WS_CTL) + CW_BAR;
    XcdBarrier bar; bar.bar = barw; bar.x = 0; bar.st = nullptr;
    if (hi - lo > 1) bar = xcd_barrier_post(barw, MISC + 8);
#ifndef PHMASK
#define PHMASK 0x7ff
#endif
#define IN(k) ((((PHMASK) >> (k)) & 1) && lo <= (k) && (k) < hi)
#define SEAM(k) do { if (IN(k) && IN((k) + 1)) xcd_barrier(bar); } while (0)

    if (IN(0)) { p0_prologue(F);
#if DBG_REP_P0 > 1
        __syncthreads(); p0_prologue(F);
#endif
    } SEAM(0);
    if (IN(1)) { _Pragma("unroll 1") for (int rep_ = 0; rep_ < DBG_REP_THIN; ++rep_) p1_mod_h1(F); } SEAM(1);
    if (IN(2)) {
        pg8::Gemm g{WSP(const bf16_t, WS_H), WSP(const bf16_t, WS_WIN), M_TOK, IN_WP, 1024, 1 << 30, nullptr};
        pg8::StaticOrder S; S.init(M_TOK, IN_WP, F.G, (int)blockIdx.x);
        static_assert(WS_DV - WS_DK == WS_DK - WS_DQ, "dq/dk/dv contiguous");
        EpiProj E{WSP(bf16_t, WS_CQ), WSP(bf16_t, WS_CKV), WSP(bf16_t, WS_KN)  , WSP(bf16_t, WS_DQ), WSP(float, WS_SSQ), WSP(const float, WS_ROPE)};
        pg8::gemm_phase<EpiProj, false, true>(F.lds, g, S, E);

    } SEAM(2);
    if (IN(3)) {
#ifdef DBG_DIL_MODE
        __syncthreads();
        for (int u = F.vcu; u < BATCH * DIL_H * 4; u += F.G) dil_unit<DBG_DIL_MODE>(F, u >> 5, (u >> 2) & 7, u & 3);
        __syncthreads();
#endif
#ifndef NO_P3G
#ifndef NO_GQ
        { pg8::Gemm g{WSP(const bf16_t, WS_CQ), WSP(const bf16_t, WS_WUQ), M_TOK, 768, Q_LORA, 1 << 30, nullptr};
          pg8::StaticOrder S; S.init(M_TOK, 768, F.G, (int)blockIdx.x);
          EpiQ E{WSP(bf16_t, WS_Q), WSP(const float, WS_SSQ), WSP(const float, WS_ROPE)};
          pg8::gemm_phase<EpiQ, false>(F.lds, g, S, E);
#if DBG_REP_P3G > 1
          pg8::gemm_phase<EpiQ, false>(F.lds, g, S, E);
#endif
 }
#endif
#ifndef NO_GK
        { pg8::Gemm g{WSP(const bf16_t, WS_CKV), WSP(const bf16_t, WS_WK), M_TOK, 512, KV_LORA, 1 << 30, nullptr};
          pg8::StaticOrder S; S.init(M_TOK, 512, F.G, (int)blockIdx.x);
          EpiKN8 E{WSP(unsigned char, WS_KN), WSP(const float, WS_SSQ)};
          pg8::gemm_phase<EpiKN8, false>(F.lds, g, S, E); }
#endif
        { pg8::Gemm g{WSP(const bf16_t, WS_WV), WSP(const bf16_t, WS_CKV), 512, M_TOK, KV_LORA, 1 << 30, nullptr};
          pg8::StaticOrder S; S.init(512, M_TOK, F.G, (int)blockIdx.x);
          EpiVt8 E{WSP(unsigned char, WS_V), WSP(const float, WS_SSQ)};
          pg8::gemm_phase<EpiVt8, false>(F.lds, g, S, E); }
#endif
    } SEAM(3);
    if (IN(4)) {
        const bool dil_first = (F.vcu & 1) == 0;
#ifndef NO_DIL
        if (dil_first) {
            for (int u = F.vcu; u < BATCH * DIL_H * 4; u += F.G) dil_unit<0>(F, u >> 5, (u >> 2) & 7, u & 3);
            __syncthreads();
        }
#endif
#pragma unroll 1
        for (int rep = 0; rep < DBG_REP_MLA; ++rep)
        for (int u = F.vcu; u < BATCH * MLA_H * 8; u += F.G) mla_unit(F, u >> 6, (u >> 3) & 7, u & 7);
#ifndef NO_DIL
        if (!dil_first) {
            __syncthreads();
            for (int u = F.vcu; u < BATCH * DIL_H * 4; u += F.G) dil_unit<0>(F, u >> 5, (u >> 2) & 7, u & 3);
            __syncthreads();
        }
#endif
    } SEAM(4);
    if (IN(5)) {
        pg8::Gemm g{WSP(const bf16_t, WS_MIX), WSP(const bf16_t, WS_WOUT), M_TOK, 1024, 1024, 1 << 30, nullptr};
        pg8::StaticOrder S; S.init(M_TOK, 1024, F.G, (int)blockIdx.x);
        EpiOut E{WSP(bf16_t, WS_M), WSP(const float, WS_MOD)};
        pg8::gemm_phase<EpiOut, false, true>(F.lds, g, S, E);

    } SEAM(5);
    if (IN(6)) { _Pragma("unroll 1") for (int rep_ = 0; rep_ < DBG_REP_THIN; ++rep_) { p6_ln1_router(F); __syncthreads(); } } SEAM(6);
    if (IN(7)) {
        for (int u = blockIdx.x; u < BATCH * N_EXP; u += F.G) topk_unit(F, u >> 4, u & 15);
        p7_expert_weights<0>(F);
    } SEAM(7);
    if (IN(8)) {
        const bool wd_first = (F.vcu & 1) == 0;
        if (wd_first) { p7_expert_weights<1>(F); __syncthreads(); }
        pg8::Gemm g{WSP(const bf16_t, WS_H), WSP(const bf16_t, WS_WGU), MROWS, 3072, 1024, 16, WSP(const int, WS_VOFF)};
        pg8::StaticOrder S; S.init(MROWS, 3072, F.G, (int)blockIdx.x);
        EpiGU E{WSP(bf16_t, WS_HID)};
        pg8::gemm_phase<EpiGU, true, true>(F.lds, g, S, E);
#if DBG_REP_P8 > 1
          pg8::gemm_phase<EpiGU, false, true>(F.lds, g, S, E);
#endif
        if (!wd_first) { __syncthreads(); p7_expert_weights<1>(F); }
    } SEAM(8);
    if (IN(9)) {
        pg8::Gemm g{WSP(const bf16_t, WS_HID), WSP(const bf16_t, WS_WD), MROWS, 1024, D_FF, 16, nullptr};
        pg8::StaticOrder S; S.init(MROWS, 1024, F.G, (int)blockIdx.x);
        EpiDown E{WSP(bf16_t, WS_Y), WSP(const float, WS_VALS)};
        pg8::gemm_phase<EpiDown, false, true>(F.lds, g, S, E);
#if DBG_REP_P9 > 1
          pg8::gemm_phase<EpiDown, false, true>(F.lds, g, S, E);
#endif

    } SEAM(9);
    if (IN(10)) {
#ifdef DBG_REP_P10
        p10_final(F, WSP(float, WS_Z)); __syncthreads();
#endif
        p10_final(F); }
#undef IN
#undef SEAM
}

extern "C" void kernel_launch(void* const* d_in, const int* in_sizes, int n_in, void* d_out, int out_size, void* d_ws, size_t ws_size, hipStream_t stream) {
    static int grid = 0;
    if (grid == 0) {
        if (n_in != 19 || in_sizes[0] != M_TOK * D_MODEL || out_size != M_TOK * D_MODEL || ws_size < WS_END) {
            fprintf(stderr, "kernel_launch: unexpected shapes (n_in %d, in0 %d, out %d, ws %zu); nothing launched\n", n_in, n_in > 0 ? in_sizes[0] : -1, out_size, ws_size); grid = -1; return; }
        int dev = 0, cus = 0, per_cu = 0;
        if (hipGetDevice(&dev) != hipSuccess || hipDeviceGetAttribute(&cus, hipDeviceAttributeMultiprocessorCount, dev) != hipSuccess) { grid = -1; return; }
        if (hipFuncSetAttribute((const void*)fwd_kernel, hipFuncAttributeMaxDynamicSharedMemorySize, LDS_BYTES) != hipSuccess) { fprintf(stderr, "kernel_launch: hipFuncSetAttribute failed\n"); grid = -1; return; }
        if (hipOccupancyMaxActiveBlocksPerMultiprocessor(&per_cu, (const void*)fwd_kernel, NTHR, LDS_BYTES) != hipSuccess || per_cu < 1)
            fprintf(stderr, "kernel_launch: note: occupancy query reports %d workgroups per CU\n", per_cu);
        (void)hipGetLastError();
        grid = cus < 256 ? cus : 256;
    }
    if (grid < 0) return;
    (void)hipMemsetAsync((char*)d_ws + WS_CTL, 0, CTL_ZERO_BYTES, stream);
    Args a{};
    a.x = (const float*)d_in[0]; a.c = (const float*)d_in[1]; a.w_ada = (const float*)d_in[2]; a.b_ada = (const float*)d_in[3]; a.w_in = (const float*)d_in[4];
    a.q_norm_g = (const float*)d_in[5]; a.w_uq = (const float*)d_in[6]; a.kv_norm_g = (const float*)d_in[7]; a.w_ukv = (const float*)d_in[8]; a.rel_bias = (const float*)d_in[9];
    a.w_out = (const float*)d_in[10]; a.ln1_g = (const float*)d_in[11]; a.ln1_b = (const float*)d_in[12]; a.w_router = (const float*)d_in[13]; a.w_gate = (const float*)d_in[14];
    a.w_up = (const float*)d_in[15]; a.w_down = (const float*)d_in[16]; a.ln2_g = (const float*)d_in[17]; a.ln2_b = (const float*)d_in[18];
    a.out = (float*)d_out; a.ws = (unsigned char*)d_ws;
#if MK_ONE_LAUNCH
    a.ph_lo = 0; a.ph_hi = N_PHASES;
    hipLaunchKernelGGL(fwd_kernel, dim3(grid), dim3(NTHR), LDS_BYTES, stream, a);
#else
    for (int p = 0; p < N_PHASES; ++p) { a.ph_lo = p; a.ph_hi = p + 1; hipLaunchKernelGGL(fwd_kernel, dim3(grid), dim3(NTHR), LDS_BYTES, stream, a); }
#endif
}
```
